# Optimizing an MI355X kernel written in HIP

```python
import math
import jax, jax.numpy as jnp
from jax import lax
import numpy as np

D_MODEL = 1024
BATCH = 8
SEQ = 8192
DEPTH = 1

EPS = 1e-6
NEG_INF = -1e30

POOL_WINDOWS = (2, 4, 8, 16)
POOL_GROUPS = len(POOL_WINDOWS)
POOL_IN = 128
POOL_WIDTH = POOL_GROUPS * POOL_IN
POOL_OUT = D_MODEL // POOL_GROUPS

ATT_HEADS = 16
HEAD_DIM = D_MODEL // ATT_HEADS
DILATED_PATTERNS = ((128, 1), (512, 4), (2048, 16))
N_PATTERNS = len(DILATED_PATTERNS)
Q_WIDTH = N_PATTERNS * ATT_HEADS * HEAD_DIM
KV_WIDTH = ATT_HEADS * HEAD_DIM

N_BRANCHES = 2
GATE_WIDTH = N_BRANCHES * D_MODEL
IN_WIDTH = POOL_WIDTH + Q_WIDTH + 2 * KV_WIDTH + GATE_WIDTH

PEER_HEADS = 8
PEER_NKEYS = 128
PEER_N = PEER_NKEYS * PEER_NKEYS
PEER_QDIM = 256
PEER_HALF = PEER_QDIM // 2
PEER_TOPK = 16
PEER_CHUNK = 128

kernel_name = "hybrid_pool_dilattn_peer_block"


def rms_norm(x, g):
    xf = x.astype(jnp.float32)
    y = xf * lax.rsqrt(jnp.mean(xf * xf, axis=-1, keepdims=True) + EPS)
    return (y * g.astype(jnp.float32)).astype(x.dtype)


def alibi_slopes(n):
    def geometric(k):
        start = 2.0 ** (-8.0 / k)
        return [start ** (i + 1) for i in range(k)]
    p = 2 ** int(math.floor(math.log2(n)))
    s = geometric(p) + geometric(2 * p)[0::2][: n - p]
    return np.sort(np.array(s, dtype=np.float32))[::-1].copy()


def pool_mixer(a, w_pool, pool_scale):
    B, S = a.shape[0], a.shape[1]
    af = a.astype(jnp.float32)
    cs = jnp.pad(jnp.cumsum(af, axis=1), ((0, 0), (1, 0), (0, 0), (0, 0)))
    t = jnp.arange(S)[:, None]
    win = jnp.array(POOL_WINDOWS, dtype=jnp.int32)[None, :]
    lo = jnp.maximum(t + 1 - win, 0)
    grp = jnp.arange(POOL_GROUPS)[None, :]
    window_sum = cs[:, 1:] - cs[:, lo, grp, :]
    count = jnp.minimum(t + 1, win).astype(jnp.float32)[None, :, :, None]
    d = (window_sum / count - af).astype(a.dtype)
    y = jnp.einsum('bsgc,gco->bsgo', d, w_pool)
    return y.reshape(B, S, D_MODEL) * pool_scale


def dilated_group(q, k, v, window, dilation, slopes):
    B, S, H, Dh = q.shape
    band = window // dilation
    n = -(-S // (dilation * band)) * band
    L = n * dilation
    nb = n // band

    def blocks(x):
        x = jnp.pad(x, ((0, 0), (0, L - S), (0, 0), (0, 0)))
        return x.reshape(B, nb, band, dilation, H, Dh)

    def with_prev(xb):
        prev = jnp.pad(xb, ((0, 0), (1, 0), (0, 0), (0, 0), (0, 0), (0, 0)))[:, :nb]
        return jnp.concatenate([prev, xb], axis=2)

    qb = blocks(q)
    kb = with_prev(blocks(k))
    vb = with_prev(blocks(v))
    s = jnp.einsum('bnqrhe,bnkrhe->bnrhqk', qb, kb).astype(jnp.float32)
    qi = jnp.arange(band)[:, None]
    ki = jnp.arange(2 * band)[None, :]
    step = qi + band - ki
    key_idx = jnp.arange(nb)[:, None, None] * band + ki[None] - band
    valid = (step >= 0)[None] & (step <= band)[None] & (key_idx >= 0)
    alibi = -slopes[:, None, None] * (step * dilation).astype(jnp.float32)[None]
    s = jnp.where(valid[None, :, None, None], s + alibi[None, None, None], NEG_INF)
    m = jnp.max(s, axis=-1, keepdims=True)
    p = jnp.exp(s - m)
    den = jnp.sum(p, axis=-1)
    o = jnp.einsum('bnrhqk,bnkrhe->bnrhqe', p, vb.astype(jnp.float32)) / den[..., None]
    o = o.transpose(0, 1, 4, 2, 3, 5).reshape(B, L, H, Dh)[:, :S]
    m = m[..., 0].transpose(0, 1, 4, 2, 3).reshape(B, L, H)[:, :S]
    den = den.transpose(0, 1, 4, 2, 3).reshape(B, L, H)[:, :S]
    return o, m, den


def dilated_attention(q, k, v, slopes):
    outs, maxs, dens = [], [], []
    for g, (window, dilation) in enumerate(DILATED_PATTERNS):
        o, m, den = dilated_group(q[:, :, g], k, v, window, dilation, slopes[g])
        outs.append(o)
        maxs.append(m)
        dens.append(den)
    o = jnp.stack(outs)
    m = jnp.stack(maxs)
    den = jnp.stack(dens)
    w = den * jnp.exp(m - jnp.max(m, axis=0, keepdims=True))
    w = w / jnp.sum(w, axis=0, keepdims=True)
    return jnp.sum(w[..., None] * o, axis=0)


def peer(hn, w_query, sub_keys, expert_u, expert_v):
    B, S, D = hn.shape
    tokens = hn.reshape(-1, PEER_CHUNK, D)

    def chunk_fn(xc):
        C = xc.shape[0]
        q = (xc @ w_query).reshape(C, PEER_HEADS, 2, PEER_HALF)
        sc = jnp.einsum('chpe,hpne->chpn', q, sub_keys).astype(jnp.float32)
        top_s, top_i = lax.top_k(sc, PEER_TOPK)
        cand_s = top_s[:, :, 0, :, None] + top_s[:, :, 1, None, :]
        cand_i = top_i[:, :, 0, :, None] * PEER_NKEYS + top_i[:, :, 1, None, :]
        best_s, best_j = lax.top_k(cand_s.reshape(C, PEER_HEADS, -1), PEER_TOPK)
        experts = jnp.take_along_axis(cand_i.reshape(C, PEER_HEADS, -1), best_j, axis=-1)
        gate = jax.nn.softmax(best_s, axis=-1)
        u = expert_u[experts]
        v = expert_v[experts]
        act = jax.nn.gelu(jnp.einsum('cd,chkd->chk', xc, u).astype(jnp.float32))
        return jnp.einsum('chk,chkd->cd', (gate * act).astype(xc.dtype), v)

    return lax.map(chunk_fn, tokens).reshape(B, S, D)


def setup_inputs(seed: int = 0) -> dict:
    key = jax.random.key(seed)
    ks = jax.random.split(key, 13)
    nrm = jax.random.normal
    return {
        "x": nrm(ks[0], (BATCH, SEQ, D_MODEL), jnp.float32),
        "norm1_g": 1.0 + 0.05 * nrm(ks[1], (DEPTH, D_MODEL), jnp.float32),
        "w_in": nrm(ks[2], (DEPTH, D_MODEL, IN_WIDTH), jnp.float32) * D_MODEL ** -0.5,
        "q_norm_g": 1.0 + 0.05 * nrm(ks[3], (DEPTH, HEAD_DIM), jnp.float32),
        "k_norm_g": 1.0 + 0.05 * nrm(ks[4], (DEPTH, HEAD_DIM), jnp.float32),
        "w_pool": nrm(ks[5], (DEPTH, POOL_GROUPS, POOL_IN, POOL_OUT), jnp.float32) * POOL_IN ** -0.5,
        "pool_scale": 1.0 + 0.1 * nrm(ks[6], (DEPTH, D_MODEL), jnp.float32),
        "w_out": nrm(ks[7], (DEPTH, D_MODEL, D_MODEL), jnp.float32) * D_MODEL ** -0.5,
        "norm2_g": 1.0 + 0.05 * nrm(ks[8], (DEPTH, D_MODEL), jnp.float32),
        "w_query": nrm(ks[9], (DEPTH, D_MODEL, PEER_HEADS * PEER_QDIM), jnp.float32) * D_MODEL ** -0.5,
        "sub_keys": nrm(ks[10], (DEPTH, PEER_HEADS, 2, PEER_NKEYS, PEER_HALF), jnp.float32) * PEER_HALF ** -0.5,
        "expert_u": nrm(ks[11], (DEPTH, PEER_N, D_MODEL), jnp.float32) * D_MODEL ** -0.5,
        "expert_v": nrm(ks[12], (DEPTH, PEER_N, D_MODEL), jnp.float32) * PEER_HEADS ** -0.5,
    }


def reference(x, norm1_g, w_in, q_norm_g, k_norm_g, w_pool, pool_scale, w_out, norm2_g, w_query, sub_keys, expert_u, expert_v):
    B, S, D = x.shape
    slopes = jnp.asarray(alibi_slopes(N_PATTERNS * ATT_HEADS)).reshape(N_PATTERNS, ATT_HEADS)
    splits = [POOL_WIDTH, POOL_WIDTH + Q_WIDTH, POOL_WIDTH + Q_WIDTH + KV_WIDTH,
              POOL_WIDTH + Q_WIDTH + 2 * KV_WIDTH]
    h = x
    for l in range(DEPTH):
        xn = rms_norm(h, norm1_g[l])
        proj = xn @ w_in[l]
        a_in, q, k, v, gate_pre = jnp.split(proj, splits, axis=-1)
        pool_out = pool_mixer(a_in.reshape(B, S, POOL_GROUPS, POOL_IN), w_pool[l], pool_scale[l])
        q = rms_norm(q.reshape(B, S, N_PATTERNS, ATT_HEADS, HEAD_DIM), q_norm_g[l]) * (HEAD_DIM ** -0.5)
        k = rms_norm(k.reshape(B, S, ATT_HEADS, HEAD_DIM), k_norm_g[l])
        v = v.reshape(B, S, ATT_HEADS, HEAD_DIM)
        attn_out = dilated_attention(q, k, v, slopes).astype(h.dtype).reshape(B, S, D)
        gates = jax.nn.sigmoid(gate_pre.astype(jnp.float32)).astype(h.dtype).reshape(B, S, N_BRANCHES, D)
        merged = gates[:, :, 0] * pool_out + gates[:, :, 1] * attn_out
        h = h + merged @ w_out[l]
        hn = rms_norm(h, norm2_g[l])
        h = h + peer(hn, w_query[l], sub_keys[l], expert_u[l], expert_v[l])
    return h
```

```cpp
#include <hip/hip_runtime.h>
#include <cstdio>
#include <cstdint>
namespace pg8 {
#define PG8_LAS __attribute__((address_space(3)))
typedef unsigned short bf16_t;
typedef short bf16x8 __attribute__((ext_vector_type(8)));
typedef float f32x4 __attribute__((ext_vector_type(4)));
typedef unsigned u32x4 __attribute__((ext_vector_type(4)));
constexpr int BM = 256, BK = 64, HALF = 128, HTB = HALF * BK * 2  , STAGE_BYTES = 8 * HTB, NXCD = 8, WGM = 8;

__host__ __device__ __forceinline__ int lds_byte(int r, int c) { const int st = (r >> 4) * 2 + (c >> 5), rr = r & 15, cc = c & 31, ob = rr * 64 + cc * 2; return st * 1024 + (ob ^ (((ob >> 9) & 1) << 5)); }
__host__ __device__ __forceinline__ void stage_rc(int b, int& R, int& C) { const int st = b / 1024, sb = b % 1024, swz = sb ^ (((sb >> 9) & 1) << 5); R = (st >> 1) * 16 + swz / 64; C = (st & 1) * 32 + (swz % 64) / 2; }
__host__ __device__ __forceinline__ int perm32(int rho) { const int n = rho >> 4, i = rho & 15; return 8 * (i >> 2) + 4 * n + (i & 3); }

struct Unit { int pm, pn; };
struct Gemm { const bf16_t* A; const bf16_t* Bt; int M, N, K; };

struct StaticOrder {
    int nM, nN, nwg, G, c;
    __host__ __device__ void init(int M, int N, int G_, int c_) { nM = M / BM; nN = N / BM; nwg = nM * nN; G = G_; c = c_; }
    __host__ __device__ bool next(int i, Unit& u) const {
        const long L = (long)i * G + c; if (L >= nwg) return false;
        int wgid = (int)L; { const int q = nwg / NXCD, r = nwg % NXCD, xcd = wgid % NXCD, off = wgid / NXCD; wgid = (xcd < r ? xcd * (q + 1) : r * (q + 1) + (xcd - r) * q) + off; }
        const int nig = WGM * nN, gid = wgid / nig, fm = gid * WGM, gsz = (nM - fm) < WGM ? (nM - fm) : WGM;
        u.pm = fm + ((wgid % nig) % gsz); u.pn = (wgid % nig) / gsz; return true;
    }
    __device__ __forceinline__ void a_ready(const Unit&) const {}
    __device__ __forceinline__ void done(const Unit&) const {}
};
__device__ __forceinline__ unsigned cvt_pk_bf16(float lo, float hi) { unsigned r; asm volatile("v_cvt_pk_bf16_f32 %0, %1, %2" : "=v"(r) : "v"(lo), "v"(hi)); return r; }

typedef float f32x2 __attribute__((ext_vector_type(2)));
__device__ __forceinline__ float xrow16_sum(float x) {
    auto s = __builtin_amdgcn_permlane16_swap(__float_as_uint(x), __float_as_uint(x), false, false);
    x = __uint_as_float(s[0]) + __uint_as_float(s[1]);
    auto t = __builtin_amdgcn_permlane32_swap(__float_as_uint(x), __float_as_uint(x), false, false);
    return __uint_as_float(t[0]) + __uint_as_float(t[1]);
}
struct EpiPlain {
    static constexpr bool PERM = true, AFTER_DRAIN = false;
    bf16_t* O; int ldc;
    __device__ __forceinline__ void operator()(const f32x4 (&acc)[2][2][4][2], const Unit& u, int wr, int wc, int fr, int fq) const {
        const int row0 = u.pm * BM + wr * 64 + fr; const int col0 = u.pn * BM + wc * 32 + 8 * fq;
#pragma unroll
        for (int ai = 0; ai < 2; ++ai)
#pragma unroll
            for (int m = 0; m < 4; ++m) { bf16_t* rowp = O + (size_t)(row0 + ai * HALF + m * 16) * ldc + col0;
#pragma unroll
                for (int bj = 0; bj < 2; ++bj) { const f32x4 v0 = acc[ai][bj][m][0], v1 = acc[ai][bj][m][1];
                    u32x4 w; w.x = cvt_pk_bf16(v0[0], v0[1]); w.y = cvt_pk_bf16(v0[2], v0[3]); w.z = cvt_pk_bf16(v1[0], v1[1]); w.w = cvt_pk_bf16(v1[2], v1[3]);
                    *(u32x4*)(rowp + bj * HALF) = w; } }
    }
};
struct EpiProj {
    static constexpr bool PERM = true, AFTER_DRAIN = false;
    bf16_t *AIN, *Q, *K, *V, *G; const float* s1; const float* qg; const float* kg;
    __device__ __forceinline__ void operator()(const f32x4 (&acc)[2][2][4][2], const Unit& u, int wr, int wc, int fr, int fq) const {
        const int pn = u.pn; int type, ldc, colt; bf16_t* base;
        if (pn < 2)       { type = 0; base = AIN; ldc = 512;  colt = pn * 256; }
        else if (pn < 14) { type = 1; base = Q;   ldc = 3072; colt = (pn - 2) * 256; }
        else if (pn < 18) { type = 2; base = K;   ldc = 1024; colt = (pn - 14) * 256; }
        else if (pn < 22) { type = 3; base = V;   ldc = 1024; colt = (pn - 18) * 256; }
        else              { type = 4; base = G;   ldc = 2048; colt = (pn - 22) * 256; }
        const int col0 = colt + 64 * wc + 8 * fq;
        const int row0 = u.pm * BM + wr * 64 + fr;
        f32x4 gn[2][2];
        const float* gp = (type == 2) ? kg : qg;
        const float gmul = (type == 1) ? 0.125f * 1.4426950408889634f : 1.0f;
#pragma unroll
        for (int bj = 0; bj < 2; ++bj)
#pragma unroll
            for (int n = 0; n < 2; ++n) gn[bj][n] = *(const f32x4*)(gp + 32 * bj + 8 * fq + 4 * n) * gmul;
#pragma unroll
        for (int ai = 0; ai < 2; ++ai)
#pragma unroll
            for (int m = 0; m < 4; ++m) {
                const int row = row0 + ai * HALF + m * 16; const float sc = s1[row];
                f32x4 v[2][2];
#pragma unroll
                for (int bj = 0; bj < 2; ++bj)
#pragma unroll
                    for (int n = 0; n < 2; ++n) v[bj][n] = acc[ai][bj][m][n] * sc;
                if (type == 1 || type == 2) {
                    float ss = 0.f;
#pragma unroll
                    for (int bj = 0; bj < 2; ++bj)
#pragma unroll
                        for (int n = 0; n < 2; ++n) { const f32x4 x = v[bj][n]; ss += (x[0] * x[0] + x[1] * x[1]) + (x[2] * x[2] + x[3] * x[3]); }
                    ss = xrow16_sum(ss);
                    const float rn = __builtin_amdgcn_rsqf(ss * (1.0f / 64.0f) + 1e-6f);
#pragma unroll
                    for (int bj = 0; bj < 2; ++bj)
#pragma unroll
                        for (int n = 0; n < 2; ++n) v[bj][n] = v[bj][n] * rn * gn[bj][n];
                } else if (type == 4) {
#pragma unroll
                    for (int bj = 0; bj < 2; ++bj)
#pragma unroll
                        for (int n = 0; n < 2; ++n)
#pragma unroll
                            for (int j = 0; j < 4; ++j) v[bj][n][j] = __builtin_amdgcn_rcpf(1.0f + __builtin_amdgcn_exp2f(-1.4426950408889634f * v[bj][n][j]));
                }
                bf16_t* rowp = base + (size_t)row * ldc + col0;
#pragma unroll
                for (int bj = 0; bj < 2; ++bj) { const f32x4 v0 = v[bj][0], v1 = v[bj][1];
                    u32x4 w; w.x = cvt_pk_bf16(v0[0], v0[1]); w.y = cvt_pk_bf16(v0[2], v0[3]); w.z = cvt_pk_bf16(v1[0], v1[1]); w.w = cvt_pk_bf16(v1[2], v1[3]);
                    *(u32x4*)(rowp + 32 * bj) = w; }
            }
    }
};
struct EpiOut {
    static constexpr bool PERM = true, AFTER_DRAIN = false;
    const float* x; float* out; bf16_t* hb;
    __device__ __forceinline__ void operator()(const f32x4 (&acc)[2][2][4][2], const Unit& u, int wr, int wc, int fr, int fq) const {
        const int row0 = u.pm * BM + wr * 64 + fr; const int col0 = u.pn * BM + wc * 32 + 8 * fq;
#pragma unroll
        for (int ai = 0; ai < 2; ++ai)
#pragma unroll
            for (int m = 0; m < 4; ++m) { const size_t off = (size_t)(row0 + ai * HALF + m * 16) * 1024 + col0;
#pragma unroll
                for (int bj = 0; bj < 2; ++bj) {
                    const f32x4 x0 = *(const f32x4*)(x + off + bj * HALF), x1 = *(const f32x4*)(x + off + bj * HALF + 4);
                    const f32x4 v0 = acc[ai][bj][m][0] + x0, v1 = acc[ai][bj][m][1] + x1;
                    *(f32x4*)(out + off + bj * HALF) = v0; *(f32x4*)(out + off + bj * HALF + 4) = v1;
                    u32x4 w; w.x = cvt_pk_bf16(v0[0], v0[1]); w.y = cvt_pk_bf16(v0[2], v0[3]); w.z = cvt_pk_bf16(v1[0], v1[1]); w.w = cvt_pk_bf16(v1[2], v1[3]);
                    *(u32x4*)(hb + off + bj * HALF) = w; } }
    }
};
template <class Epi, class Sched, bool ALIGN_EPI = false, bool SP2 = false>
__device__ __forceinline__ void gemm_phase(PG8_LAS unsigned char* lds, const Gemm g, const Sched& S, const Epi& E) {
    const int tid = threadIdx.x, wid = __builtin_amdgcn_readfirstlane(tid >> 6), lane = tid & 63, wr = wid >> 2, wc = wid & 3, fr = lane & 15, fq = lane >> 4;
    const int K = g.K, nt = K / BK;
    unsigned voffA[2], voffB[2];
#pragma unroll
    for (int i = 0; i < 2; ++i) { int R, C; stage_rc(tid * 16 + i * 8192, R, C); const int Rb = Epi::PERM ? ((R & ~31) + perm32(R & 31)) : R;
        voffA[i] = (unsigned)(R * K + C) * 2u; voffB[i] = (unsigned)(Rb * K + C) * 2u; }
    const size_t kstep = (size_t)(BK * 2);
    const size_t hstep = (size_t)HALF * K * 2;
    const size_t tstep = 2 * hstep;
    const unsigned ldsw = (unsigned)wid * 1024u;
    const int aoff = lds_byte(wr * 64 + fr, fq * 8), boff = lds_byte(wc * 32 + fr, fq * 8);
#define PG8_SA(b, h) (((b) * 2 + (h)) * HTB)
#define PG8_SB(b, h) ((4 + (b) * 2 + (h)) * HTB)
#define PG8_STAGE(bufoff, gbase, voff) do { _Pragma("unroll") for (int _i = 0; _i < 2; ++_i) \
        __builtin_amdgcn_global_load_lds((const unsigned*)((const char*)(gbase) + (voff)[_i]), (PG8_LAS unsigned*)(lds + (bufoff) + ldsw + _i * 8192), 16, 0, 0); } while (0)
#define PG8_LDA(dst, b, h) do { _Pragma("unroll") for (int m = 0; m < 4; ++m) _Pragma("unroll") for (int k = 0; k < 2; ++k) dst[m][k] = *(const PG8_LAS bf16x8*)(lds + PG8_SA(b, h) + aoff + m * 2048 + k * 1024); } while (0)
#define PG8_LDB(dst, b, h) do { _Pragma("unroll") for (int n = 0; n < 2; ++n) _Pragma("unroll") for (int k = 0; k < 2; ++k) dst[n][k] = *(const PG8_LAS bf16x8*)(lds + PG8_SB(b, h) + boff + n * 2048 + k * 1024); } while (0)
#define PG8_MMA(ai, bj, At, Bt) do { __builtin_amdgcn_s_setprio(1); _Pragma("unroll") for (int m = 0; m < 4; ++m) _Pragma("unroll") for (int n = 0; n < 2; ++n) _Pragma("unroll") for (int k = 0; k < 2; ++k) \
        acc[ai][bj][m][n] = __builtin_amdgcn_mfma_f32_16x16x32_bf16(Bt[n][k], At[m][k], acc[ai][bj][m][n], 0, 0, 0); __builtin_amdgcn_s_setprio(0); } while (0)
#define PG8_WAIT_V(n) asm volatile("s_waitcnt vmcnt(" #n ")" ::: "memory")
#define PG8_WAIT_L(n) asm volatile("s_waitcnt lgkmcnt(" #n ")" ::: "memory")
#define PG8_BAR __builtin_amdgcn_s_barrier()
#define PG8_SCHED __builtin_amdgcn_sched_barrier(0)
    Unit cur, nxt; int ui = 0;
    if (!S.next(0, cur)) return;
    f32x4 acc[2][2][4][2];
#pragma unroll
    for (int a = 0; a < 2; ++a)
#pragma unroll
        for (int b = 0; b < 2; ++b)
#pragma unroll
            for (int m = 0; m < 4; ++m)
#pragma unroll
                for (int n = 0; n < 2; ++n) acc[a][b][m][n] = (f32x4){0.f, 0.f, 0.f, 0.f};
    bf16x8 At[4][2], B0[2][2], B1[2][2];
    const char* cA = (const char*)g.A + (size_t)cur.pm * tstep; const char* cB = (const char*)g.Bt + (size_t)cur.pn * tstep;
    S.a_ready(cur);
    if constexpr (SP2) {
        PG8_STAGE(PG8_SB(0, 0), cB, voffB); PG8_STAGE(PG8_SB(0, 1), cB + hstep, voffB); PG8_STAGE(PG8_SA(0, 0), cA, voffA); PG8_STAGE(PG8_SA(0, 1), cA + hstep, voffA);
        if (wr == 1) PG8_BAR;
        PG8_WAIT_V(2); PG8_BAR;
        PG8_STAGE(PG8_SB(1, 0), cB + kstep, voffB); PG8_STAGE(PG8_SA(1, 0), cA + kstep, voffA); PG8_STAGE(PG8_SB(1, 1), cB + hstep + kstep, voffB);
        PG8_WAIT_V(6); PG8_BAR;
    } else {
        PG8_STAGE(PG8_SB(0, 0), cB, voffB); PG8_STAGE(PG8_SA(0, 0), cA, voffA); PG8_STAGE(PG8_SB(0, 1), cB + hstep, voffB); PG8_STAGE(PG8_SA(0, 1), cA + hstep, voffA);
        if (wr == 1) PG8_BAR;
        PG8_WAIT_V(4); PG8_BAR;
        PG8_STAGE(PG8_SB(1, 0), cB + kstep, voffB); PG8_STAGE(PG8_SA(1, 0), cA + kstep, voffA); PG8_STAGE(PG8_SB(1, 1), cB + hstep + kstep, voffB);
        PG8_WAIT_V(6); PG8_BAR;
    }
    for (;;) {
        const bool has_next = S.next(ui + 1, nxt);
        const char* nA = has_next ? (const char*)g.A + (size_t)nxt.pm * tstep : cA; const char* nB = has_next ? (const char*)g.Bt + (size_t)nxt.pn * tstep : cB;
        for (int t = 0; t < nt; t += 2) {
            const bool last = (t == nt - 2);
            const char* a1 = cA + (size_t)(t + 1) * kstep;
            const char* a2 = last ? nA : cA + (size_t)(t + 2) * kstep; const char* b2 = last ? nB : cB + (size_t)(t + 2) * kstep;
            const char* a3 = a2 + kstep; const char* b3 = b2 + kstep;
            if (last && has_next) S.a_ready(nxt);
            if constexpr (SP2) {
            PG8_LDB(B0, 0, 0); PG8_LDB(B1, 0, 1); PG8_SCHED; PG8_LDA(At, 0, 0); PG8_STAGE(PG8_SA(1, 1), a1 + hstep, voffA);
            PG8_WAIT_V(8); PG8_WAIT_L(0); PG8_BAR; PG8_MMA(0, 0, At, B0); PG8_MMA(0, 1, At, B1); PG8_BAR; PG8_SCHED;
            PG8_LDA(At, 0, 1); PG8_STAGE(PG8_SB(0, 0), b2, voffB); PG8_STAGE(PG8_SB(0, 1), b2 + hstep, voffB); PG8_STAGE(PG8_SA(0, 0), a2, voffA);
            PG8_WAIT_V(8); PG8_WAIT_L(0); PG8_BAR; PG8_MMA(1, 0, At, B0); PG8_MMA(1, 1, At, B1); PG8_BAR; PG8_SCHED;
            PG8_LDB(B0, 1, 0); PG8_LDB(B1, 1, 1); PG8_SCHED; PG8_LDA(At, 1, 0); PG8_STAGE(PG8_SA(0, 1), a2 + hstep, voffA);
            PG8_WAIT_V(8); PG8_WAIT_L(0); PG8_BAR; PG8_MMA(0, 0, At, B0); PG8_MMA(0, 1, At, B1); PG8_BAR; PG8_SCHED;
            PG8_LDA(At, 1, 1); PG8_STAGE(PG8_SB(1, 0), b3, voffB); PG8_STAGE(PG8_SB(1, 1), b3 + hstep, voffB); PG8_STAGE(PG8_SA(1, 0), a3, voffA);
            PG8_WAIT_V(8); PG8_WAIT_L(0); PG8_BAR; PG8_MMA(1, 0, At, B0); PG8_MMA(1, 1, At, B1); PG8_BAR; PG8_SCHED;
            } else {
            PG8_LDB(B0, 0, 0); PG8_SCHED; PG8_LDA(At, 0, 0); PG8_STAGE(PG8_SA(1, 1), a1 + hstep, voffA);
            PG8_WAIT_L(8); PG8_BAR; PG8_WAIT_L(0); PG8_MMA(0, 0, At, B0); PG8_BAR; PG8_SCHED;
            PG8_LDB(B1, 0, 1); PG8_STAGE(PG8_SB(0, 0), b2, voffB);
            PG8_BAR; PG8_WAIT_L(0); PG8_MMA(0, 1, At, B1); PG8_BAR;
            PG8_LDA(At, 0, 1); PG8_STAGE(PG8_SA(0, 0), a2, voffA);
            PG8_BAR; PG8_WAIT_L(0); PG8_MMA(1, 0, At, B0); PG8_BAR; PG8_SCHED;
            PG8_STAGE(PG8_SB(0, 1), b2 + hstep, voffB);
            PG8_WAIT_V(6); PG8_BAR; PG8_MMA(1, 1, At, B1); PG8_BAR;
            PG8_LDB(B0, 1, 0); PG8_SCHED; PG8_LDA(At, 1, 0); PG8_STAGE(PG8_SA(0, 1), a2 + hstep, voffA);
            PG8_WAIT_L(8); PG8_BAR; PG8_WAIT_L(0); PG8_MMA(0, 0, At, B0); PG8_BAR; PG8_SCHED;
            PG8_LDB(B1, 1, 1); PG8_STAGE(PG8_SB(1, 0), b3, voffB);
            PG8_BAR; PG8_WAIT_L(0); PG8_MMA(0, 1, At, B1); PG8_BAR;
            PG8_LDA(At, 1, 1); PG8_STAGE(PG8_SA(1, 0), a3, voffA);
            PG8_BAR; PG8_WAIT_L(0); PG8_MMA(1, 0, At, B0); PG8_BAR; PG8_SCHED;
            PG8_STAGE(PG8_SB(1, 1), b3 + hstep, voffB);
            PG8_WAIT_V(6); PG8_BAR; PG8_MMA(1, 1, At, B1); PG8_BAR;
            }
        }
        if constexpr (ALIGN_EPI) { if (wr == 0) PG8_BAR; }
        if constexpr (!Epi::AFTER_DRAIN) { E(acc, cur, wr, wc, fr, fq); S.done(cur); }
        if (!has_next) break;
#pragma unroll
        for (int a = 0; a < 2; ++a)
#pragma unroll
            for (int b = 0; b < 2; ++b)
#pragma unroll
                for (int m = 0; m < 4; ++m)
#pragma unroll
                    for (int n = 0; n < 2; ++n) acc[a][b][m][n] = (f32x4){0.f, 0.f, 0.f, 0.f};
        cur = nxt; cA = nA; cB = nB; ++ui;
        if constexpr (ALIGN_EPI) { if (wr == 1) PG8_BAR; }
    }
    PG8_WAIT_V(0);
    if constexpr (!ALIGN_EPI) { if (wr == 0) PG8_BAR; }
    PG8_BAR;
    if constexpr (Epi::AFTER_DRAIN) { E.fused(acc, cur, wr, wc, fr, fq, lds, wid, lane); S.done(cur); }
#undef PG8_SA
#undef PG8_SB
#undef PG8_STAGE
#undef PG8_LDA
#undef PG8_LDB
#undef PG8_MMA
#undef PG8_WAIT_V
#undef PG8_WAIT_L
#undef PG8_BAR
#undef PG8_SCHED
}
}

constexpr int NWAVES = 8;
constexpr int BATCH = 8, SEQ = 8192, DM = 1024, T = BATCH * SEQ;
constexpr int INW = 7680, QW = 3072, GATEW = 2048, POOLW = 512;
constexpr int NEXP = 16384;
constexpr float EPS = 1e-6f;
constexpr float LOG2E = 1.4426950408889634f;

constexpr size_t MiB = 1u << 20;
constexpr size_t WS_CTL = 0, CTL_ZERO_BYTES = 1 * MiB;
constexpr size_t WS_W1T = 2 * MiB;
constexpr size_t WS_WOT = 17 * MiB;
constexpr size_t WS_WQT = 19 * MiB;
constexpr size_t WS_WPT = 23 * MiB;
constexpr size_t WS_SKB = 23 * MiB + 512 * 1024;
constexpr size_t WS_S1 = 24 * MiB;
constexpr size_t WS_UB = 25 * MiB;
constexpr size_t WS_VB = 57 * MiB;
constexpr size_t WS_MD = 89 * MiB;
constexpr size_t WS_XB = 113 * MiB;
constexpr size_t WS_AIN = 241 * MiB;
constexpr size_t WS_Q = 305 * MiB;
constexpr size_t WS_G = 689 * MiB;
constexpr size_t WS_END = 945 * MiB;
constexpr size_t WS_HB = WS_AIN;

constexpr int CW_BAR = 4096;
constexpr int RING_OFF = 0, RING_BYTES = 131072;
constexpr int LDSCTL_OFF = RING_BYTES, MISC_OFF = LDSCTL_OFF + 320;
constexpr int LDS_BYTES = 147456;

#define GAS __attribute__((address_space(1)))
#define LAS __attribute__((address_space(3)))
typedef unsigned short bf16;
typedef unsigned v4u __attribute__((ext_vector_type(4)));
typedef unsigned v2u __attribute__((ext_vector_type(2)));
typedef float f32x4 __attribute__((ext_vector_type(4)));
typedef float f32x16 __attribute__((ext_vector_type(16)));
typedef short bf16x8 __attribute__((ext_vector_type(8)));
typedef short s16x4 __attribute__((ext_vector_type(4)));
typedef __bf16 bf16x2_t __attribute__((ext_vector_type(2)));
typedef GAS unsigned gu32;
#define RLX_AGENT __ATOMIC_RELAXED, __HIP_MEMORY_SCOPE_AGENT
#define LDS_WAIT() asm volatile("s_waitcnt lgkmcnt(0)" ::: "memory")
#define VM_WAIT() asm volatile("s_waitcnt vmcnt(0)" ::: "memory")
__device__ __forceinline__ unsigned f2bf(float f) { unsigned u = __builtin_bit_cast(unsigned, f); return (u + 0x7fffu + ((u >> 16) & 1u)) >> 16; }
__device__ __forceinline__ unsigned pk2(float lo, float hi) { return f2bf(lo) | (f2bf(hi) << 16); }
__device__ __forceinline__ float bflo(unsigned w) { return __uint_as_float(w << 16); }
__device__ __forceinline__ float bfhi(unsigned w) { return __uint_as_float(w & 0xffff0000u); }
__device__ __forceinline__ int crow(int r, int hi) { return (r & 3) + 8 * (r >> 2) + 4 * hi; }
__device__ __forceinline__ float xhalf_max(float x) { auto t = __builtin_amdgcn_permlane32_swap(__float_as_uint(x), __float_as_uint(x), false, false); return fmaxf(__uint_as_float(t[0]), __uint_as_float(t[1])); }
__device__ __forceinline__ float xhalf_sum(float x) { auto t = __builtin_amdgcn_permlane32_swap(__float_as_uint(x), __float_as_uint(x), false, false); return __uint_as_float(t[0]) + __uint_as_float(t[1]); }
__device__ __forceinline__ float wave_sum(float v) {
#pragma unroll
    for (int o = 1; o < 64; o <<= 1) v += __shfl_xor(v, o);
    return v;
}
__device__ __forceinline__ float dot2bf(unsigned a, unsigned b, float acc) { return __builtin_amdgcn_fdot2_f32_bf16(__builtin_bit_cast(bf16x2_t, a), __builtin_bit_cast(bf16x2_t, b), acc, false); }

#define XB_TMO      128
#define XB_XCNT(j)  (256  + 64 * (j))
#define XB_XSUB(j)  (1280 + 64 * (j))
#define XB_XGEN(j)  (2304 + 64 * (j))
#define XB_TOP      3328
#define XB_TOPGEN   3392
#define XCD_BAR_WORDS 3456
#define XB_SPIN_CAP (1u << 18)

__device__ __forceinline__ unsigned xb_ld(unsigned* p)              { return __hip_atomic_load(p, __ATOMIC_RELAXED, __HIP_MEMORY_SCOPE_AGENT); }
__device__ __forceinline__ unsigned xb_add(unsigned* p, unsigned v) { return __hip_atomic_fetch_add(p, v, __ATOMIC_RELAXED, __HIP_MEMORY_SCOPE_AGENT); }
__device__ __forceinline__ unsigned xb_xcc_id() { return (unsigned)__builtin_amdgcn_s_getreg((3 << 11) | 20) & 0xFu; }
#define XB_SPIN(cond, bar) do { unsigned _sp = 0; while (cond) { __builtin_amdgcn_s_sleep(1); \
    if ((++_sp & 255u) == 0u) { if (xb_ld(&(bar)[XB_TMO])) break; if (_sp > XB_SPIN_CAP) { atomicAdd(&(bar)[XB_TMO], 1u); break; } } } } while (0)

struct XcdBarrier {
    unsigned* bar; unsigned x;
    volatile LAS unsigned* st;
};

__device__ __forceinline__ XcdBarrier xcd_barrier_post(unsigned* bar, volatile LAS unsigned* st) {
    XcdBarrier b; b.bar = bar; b.x = xb_xcc_id(); b.st = st;
    if (threadIdx.x == 0) (void)xb_add(&bar[XB_XCNT(b.x)], 1u);
    return b;
}
__device__ __forceinline__ void xcd_barrier_complete(unsigned* bar, unsigned x, unsigned& nloc, unsigned& nx) {
    const unsigned G = gridDim.x * gridDim.y * gridDim.z;
    unsigned sum, cnt, mine, sp = 0u;
    for (;;) {
        sum = 0u; cnt = 0u; mine = 0u;
#pragma unroll
        for (unsigned j = 0; j < 16; ++j) { const unsigned c = xb_ld(&bar[XB_XCNT(j)]); sum += c; cnt += (c > 0u) ? 1u : 0u; mine = (j == x) ? c : mine; }
        if (sum == G) break;
        __builtin_amdgcn_s_sleep(1);
        if ((++sp & 255u) == 0u) { if (xb_ld(&bar[XB_TMO])) break; if (sp > XB_SPIN_CAP) { atomicAdd(&bar[XB_TMO], 1u); break; } }
    }
    nloc = mine > 0u ? mine : 1u; nx = cnt > 0u ? cnt : 1u;
}

__device__ __forceinline__ void xcd_barrier(const XcdBarrier& b) {
    asm volatile("s_waitcnt vmcnt(0)" ::: "memory");
    __syncthreads();
    if (threadIdx.x == 0) {
        unsigned* bar = b.bar;
        __builtin_amdgcn_s_waitcnt(0);
        unsigned nloc = b.st[0], nx = b.st[1];
        if (nloc == 0u) { xcd_barrier_complete(bar, b.x, nloc, nx); b.st[0] = nloc; b.st[1] = nx; }
        const unsigned old = xb_add(&bar[XB_XSUB(b.x)], 1u);
        const unsigned gen = old / nloc;
        if (old + 1u == (gen + 1u) * nloc) {
            __builtin_amdgcn_fence(__ATOMIC_RELEASE, "agent");
            asm volatile("s_waitcnt vmcnt(0)" ::: "memory");
            const unsigned og = xb_add(&bar[XB_TOP], 1u);
            const unsigned tg = og / nx;
            if (og + 1u == (tg + 1u) * nx) xb_add(&bar[XB_TOPGEN], 1u);
            else XB_SPIN(xb_ld(&bar[XB_TOPGEN]) == tg, bar);
            __builtin_amdgcn_fence(__ATOMIC_ACQUIRE, "agent");
            xb_add(&bar[XB_XGEN(b.x)], 1u);
            asm volatile("s_waitcnt vmcnt(0)" ::: "memory");
        } else {
            XB_SPIN(xb_ld(&bar[XB_XGEN(b.x)]) == gen, bar);
            __builtin_amdgcn_fence(__ATOMIC_ACQUIRE, "agent");
            asm volatile("s_waitcnt vmcnt(0)" ::: "memory");
        }
    }
    __syncthreads();
}

struct Frame {
    LAS unsigned char* lds;
    volatile LAS unsigned* MISC;
    gu32* ctl;
    int tid, lane, wave, G;
    const float *x, *norm1_g, *w_in, *q_norm_g, *k_norm_g, *w_pool, *pool_scale, *w_out, *norm2_g, *w_query, *sub_keys, *expert_u, *expert_v;
    float* out; unsigned char* ws;
};
template <int CTRL> __device__ __forceinline__ float dppf(float x) { return __builtin_bit_cast(float, __builtin_amdgcn_mov_dpp(__builtin_bit_cast(int, x), CTRL, 0xf, 0xf, true)); }
__device__ __forceinline__ float wave_sum_dpp(float x) {
    x += dppf<0xB1>(x);
    x += dppf<0x4E>(x);
    x += dppf<0x141>(x);
    x += dppf<0x128>(x);
    return pg8::xrow16_sum(x);
}

__device__ __forceinline__ void p0_transpose_item(const float* W, int K, int N, const float* rs, const float* cs, bf16* WT, int permute, LAS float* scr, int item, int lane) {
    const int nblk = N / 32, kb = item / nblk, nb = item % nblk, k0 = 64 * kb, n0 = 32 * nb;
    const float csv = cs ? cs[n0 + (lane & 31)] : 1.f;
#pragma unroll 8
    for (int i = 0; i < 32; ++i) { const int kk = 2 * i + (lane >> 5); const float r = rs ? rs[k0 + kk] : 1.f; scr[kk * 33 + (lane & 31)] = W[(size_t)(k0 + kk) * N + n0 + (lane & 31)] * r * csv; }
    LDS_WAIT(); asm volatile("" ::: "memory");
    int nout0 = n0;
    if (permute) { const int gl = (n0 & 255) >> 5; const int gp = 4 * (gl & 1) + (gl >> 1); nout0 = (n0 & ~255) + 32 * gp; }
    const int c = lane & 7;
#pragma unroll
    for (int j = 0; j < 4; ++j) { const int n = (lane >> 3) + 8 * j; const LAS float* s = scr + (8 * c) * 33 + n;
        v4u o; o.x = pk2(s[0 * 33], s[1 * 33]); o.y = pk2(s[2 * 33], s[3 * 33]); o.z = pk2(s[4 * 33], s[5 * 33]); o.w = pk2(s[6 * 33], s[7 * 33]);
        *(GAS v4u*)(WT + (size_t)(nout0 + n) * K + k0 + 8 * c) = o; }
    LDS_WAIT(); asm volatile("" ::: "memory");
}
__device__ __forceinline__ void p0_row(const float* xrow, const float* gain, bf16* orow, float* s1p, int lane) {
    const GAS f32x4* xr = (const GAS f32x4*)xrow + lane;
    f32x4 v[4]; float s = 0.f;
#pragma unroll
    for (int j = 0; j < 4; ++j) { v[j] = xr[64 * j]; s += (v[j].x * v[j].x + v[j].y * v[j].y) + (v[j].z * v[j].z + v[j].w * v[j].w); }
    if (s1p) { s = wave_sum(s); if (lane == 0) *s1p = 1.0f / sqrtf(s * (1.0f / 1024.0f) + EPS); }
    if (gain) {
#pragma unroll
        for (int j = 0; j < 4; ++j) v[j] = v[j] * ((const f32x4*)gain)[64 * j + lane];
    }
    GAS unsigned long long* o8 = (GAS unsigned long long*)orow + lane;
#pragma unroll
    for (int j = 0; j < 4; ++j) o8[64 * j] = (unsigned long long)pk2(v[j].x, v[j].y) | ((unsigned long long)pk2(v[j].z, v[j].w) << 32);
}
__device__ __forceinline__ void p0_prologue(Frame& F) {
    LAS float* scr = (LAS float*)(F.lds + RING_OFF + F.wave * 16384);
    const int gw = blockIdx.x * NWAVES + F.wave, NGW = F.G * NWAVES;
    unsigned char* ws = F.ws;
    constexpr int I_IN = (DM / 64) * (INW / 32), I_O = (DM / 64) * (DM / 32), I_Q = (DM / 64) * (2048 / 32), I_P = 4 * (128 / 64) * (256 / 32);
    constexpr int NITEMS = I_IN + I_O + I_Q + I_P;
    for (int it = gw; it < NITEMS; it += NGW) {
        int r = it;
        if (r < I_IN) { p0_transpose_item(F.w_in, DM, INW, F.norm1_g, nullptr, (bf16*)(ws + WS_W1T), 1, scr, r, F.lane); continue; } r -= I_IN;
        if (r < I_O) { p0_transpose_item(F.w_out, DM, DM, nullptr, nullptr, (bf16*)(ws + WS_WOT), 0, scr, r, F.lane); continue; } r -= I_O;
        if (r < I_Q) { p0_transpose_item(F.w_query, DM, 2048, F.norm2_g, nullptr, (bf16*)(ws + WS_WQT), 0, scr, r, F.lane); continue; } r -= I_Q;
        { const int g = r / 16, ri = r % 16;
          p0_transpose_item(F.w_pool + (size_t)g * 128 * 256, 128, 256, nullptr, F.pool_scale + g * 256, (bf16*)(ws + WS_WPT) + (size_t)g * 256 * 128, 0, scr, ri, F.lane); }
    }
    constexpr int NROWS = T + 2 * NEXP + 256;
    for (int m = gw; m < NROWS; m += NGW) {
        if (m < T) { p0_row(F.x + (size_t)m * DM, nullptr, (bf16*)(ws + WS_XB) + (size_t)m * DM, (float*)(ws + WS_S1) + m, F.lane); continue; }
        int r = m - T;
        if (r < NEXP) { p0_row(F.expert_u + (size_t)r * DM, F.norm2_g, (bf16*)(ws + WS_UB) + (size_t)r * DM, nullptr, F.lane); continue; } r -= NEXP;
        if (r < NEXP) { p0_row(F.expert_v + (size_t)r * DM, nullptr, (bf16*)(ws + WS_VB) + (size_t)r * DM, nullptr, F.lane); continue; } r -= NEXP;
        p0_row(F.sub_keys + (size_t)r * DM, nullptr, (bf16*)(ws + WS_SKB) + (size_t)r * DM, nullptr, F.lane);
    }
}

constexpr int ATT_NK = 384, ATT_K_OFF = 0, ATT_V_OFF = ATT_NK * 128;
typedef short v4i16_t __attribute__((ext_vector_type(4)));
__device__ __forceinline__ s16x4 vtr(unsigned ldsaddr) { return __builtin_bit_cast(s16x4, __builtin_amdgcn_ds_read_tr16_b64_v4i16((LAS v4i16_t*)(uintptr_t)ldsaddr)); }
__device__ __forceinline__ void attn_unit(Frame& F, int unit, const bf16* __restrict__ Kg, const bf16* __restrict__ Vg, bf16* Qg, float* MDm, float* MDd) {
    const int tid = F.tid, lane = F.lane, w = F.wave, c32 = lane & 31, hi = lane >> 5;
    const int idx = unit & 31; int t1 = unit >> 5; const int h = t1 & 15; t1 >>= 4; const int b = t1 & 7; const int p = t1 >> 3;
    const int dl = (p == 0) ? 0 : (p == 1 ? 2 : 4);
    const int dil = 1 << dl, nbp = 32 >> dl;
    const int r = idx >> (5 - dl), bp = idx & (nbp - 1);
    const long rowb = (long)b * SEQ;
    LAS unsigned char* lds = F.lds;
    {
        const int rsub = tid >> 3, ch = tid & 7;
        v4u kr[6], vr[6];
#pragma unroll
        for (int i = 0; i < 6; ++i) { const int ki = i * 64 + rsub; const int sidx = bp * 256 - 128 + ki; const bool ok = sidx >= 0;
            const long pos = ok ? ((long)sidx * dil + r) : 0; const size_t off = (size_t)(rowb + pos) * 1024 + h * 64 + ch * 8;
            kr[i] = *(const GAS v4u*)(Kg + off); vr[i] = *(const GAS v4u*)(Vg + off);
            if (!ok) { kr[i] = (v4u){0u, 0u, 0u, 0u}; vr[i] = (v4u){0u, 0u, 0u, 0u}; } }
#pragma unroll
        for (int i = 0; i < 6; ++i) { const int ki = i * 64 + rsub;
            *(LAS v4u*)(lds + ATT_K_OFF + ki * 128 + ((ch ^ ((ki >> 1) & 7)) * 16)) = kr[i];
            *(LAS v4u*)(lds + ATT_V_OFF + (ch >> 2) * (ATT_NK * 64) + ki * 64 + (ch & 3) * 16) = vr[i]; }
    }
    const int qi = 32 * w + c32; const long qrow = rowb + (long)(bp * 256 + qi) * dil + r;
    bf16* qp = Qg + (size_t)qrow * QW + p * 1024 + h * 64;
    bf16x8 qf[4];
#pragma unroll
    for (int d0 = 0; d0 < 4; ++d0) qf[d0] = *(const GAS bf16x8*)(qp + d0 * 16 + hi * 8);
    __syncthreads();
    f32x16 st[5];
#pragma unroll
    for (int kt = 0; kt < 5; ++kt) {
        const int key = 32 * (w + kt) + c32; const LAS unsigned char* kb = lds + ATT_K_OFF + key * 128; const int sw = (key >> 1) & 7;
        f32x16 a = {};
#pragma unroll
        for (int d0 = 0; d0 < 4; ++d0) { const bf16x8 kf = *(const LAS bf16x8*)(kb + (((2 * d0 + hi) ^ sw) * 16)); a = __builtin_amdgcn_mfma_f32_32x32x16_bf16(kf, qf[d0], a, 0, 0, 0); }
        st[kt] = a;
    }
    const int sidx = p * 16 + h; const float sexp = sidx < 32 ? 0.125f * (float)(sidx + 1) : 4.0f + 0.25f * (float)(sidx - 31);
    const float slope2 = exp2f(-sexp) * LOG2E * (float)dil;
    float mx = -1e30f;
#pragma unroll
    for (int kt = 0; kt < 5; ++kt)
#pragma unroll
        for (int rr = 0; rr < 16; ++rr) { const int row = crow(rr, hi); const int step = 128 + c32 - 32 * kt - row; const int ki = 32 * (w + kt) + row;
            const bool valid = (step >= 0) && (step <= 128) && (bp > 0 || ki >= 128);
            const float s = valid ? st[kt][rr] - slope2 * (float)step : -1e30f; st[kt][rr] = s; mx = fmaxf(mx, s); }
    mx = xhalf_max(mx);
    float l = 0.f;
#pragma unroll
    for (int kt = 0; kt < 5; ++kt)
#pragma unroll
        for (int rr = 0; rr < 16; ++rr) { const float e = __builtin_amdgcn_exp2f(st[kt][rr] - mx); st[kt][rr] = e; l += e; }
    l = xhalf_sum(l);
    f32x16 o[2]; o[0] = f32x16{}; o[1] = f32x16{};
    const int lam = lane & 15;
    const unsigned vbase = (unsigned)(uintptr_t)(lds + ATT_V_OFF) + (unsigned)((4 * hi + (lam >> 2)) * 64 + (16 * ((lane >> 4) & 1) + 4 * (lam & 3)) * 2);
#pragma unroll
    for (int kt = 0; kt < 5; ++kt)
#pragma unroll
        for (int s = 0; s < 2; ++s) {
            v4u pw; pw.x = pg8::cvt_pk_bf16(st[kt][8 * s + 0], st[kt][8 * s + 1]); pw.y = pg8::cvt_pk_bf16(st[kt][8 * s + 2], st[kt][8 * s + 3]);
            pw.z = pg8::cvt_pk_bf16(st[kt][8 * s + 4], st[kt][8 * s + 5]); pw.w = pg8::cvt_pk_bf16(st[kt][8 * s + 6], st[kt][8 * s + 7]);
            const bf16x8 pf = __builtin_bit_cast(bf16x8, pw);
#pragma unroll
            for (int dt = 0; dt < 2; ++dt) {
                const unsigned a = vbase + (unsigned)(dt * (ATT_NK * 64) + (32 * (w + kt) + 16 * s) * 64);
                const s16x4 lo = vtr(a), hi4 = vtr(a + 8 * 64);
                const bf16x8 vf = (bf16x8){lo[0], lo[1], lo[2], lo[3], hi4[0], hi4[1], hi4[2], hi4[3]};
                o[dt] = __builtin_amdgcn_mfma_f32_32x32x16_bf16(vf, pf, o[dt], 0, 0, 0);
            }
        }
    const float inv = 1.0f / l;
#pragma unroll
    for (int dt = 0; dt < 2; ++dt)
#pragma unroll
        for (int g = 0; g < 4; ++g) { v2u ow; ow.x = pg8::cvt_pk_bf16(o[dt][4 * g] * inv, o[dt][4 * g + 1] * inv); ow.y = pg8::cvt_pk_bf16(o[dt][4 * g + 2] * inv, o[dt][4 * g + 3] * inv);
            *(GAS v2u*)(qp + 32 * dt + 8 * g + 4 * hi) = ow; }
    if (hi == 0) { const size_t mi = ((size_t)p * T + (size_t)qrow) * 16 + h; MDm[mi] = mx; MDd[mi] = l; }
    __syncthreads();
}

constexpr int PB_AIN_PITCH = 272, PB_POOL_OFF = 40960, PB_POOL_PITCH = 528;
__device__ __forceinline__ void pool_merge_unit(Frame& F, int unit, const bf16* AIN, const bf16* Wpt, const bf16* OP, const bf16* Gt, const float* MDm, const float* MDd, bf16* MERGED) {
    const int tid = F.tid, lane = F.lane, w = F.wave, c32 = lane & 31, hi = lane >> 5;
    const int g = unit & 3, tile = unit >> 2, t0 = tile * 128, tin = t0 & (SEQ - 1), win = 2 << g;
    LAS unsigned char* lds = F.lds;
    for (int id = tid; id < 143 * 16; id += NWAVES * 64) { const int rr = id >> 4, ch = id & 15; v4u v = (v4u){0u, 0u, 0u, 0u};
        if (tin - 15 + rr >= 0) v = *(const GAS v4u*)(AIN + (size_t)(t0 - 15 + rr) * POOLW + g * 128 + ch * 8);
        *(LAS v4u*)(lds + rr * PB_AIN_PITCH + ch * 16) = v; }
    __syncthreads();
    {
        const int tq = w & 3, oh = w >> 2, tokl = 32 * tq + c32;
        const int cnt = (tin + tokl + 1) < win ? (tin + tokl + 1) : win; const float rc = 1.0f / (float)cnt;
        f32x16 acc[4]; acc[0] = f32x16{}; acc[1] = f32x16{}; acc[2] = f32x16{}; acc[3] = f32x16{};
        const bf16* wp = Wpt + (size_t)(g * 256 + oh * 128 + c32) * 128 + 8 * hi;
#pragma unroll 1
        for (int ks = 0; ks < 8; ++ks) {
            const LAS unsigned char* ap = lds + (15 + tokl) * PB_AIN_PITCH + (16 * ks + 8 * hi) * 2;
            const v4u own = *(const LAS v4u*)ap;
            float s[8] = {0.f, 0.f, 0.f, 0.f, 0.f, 0.f, 0.f, 0.f};
            for (int i = 0; i < win; ++i) { const v4u a = *(const LAS v4u*)(ap - i * PB_AIN_PITCH);
                s[0] += bflo(a.x); s[1] += bfhi(a.x); s[2] += bflo(a.y); s[3] += bfhi(a.y); s[4] += bflo(a.z); s[5] += bfhi(a.z); s[6] += bflo(a.w); s[7] += bfhi(a.w); }
            v4u dw; dw.x = pg8::cvt_pk_bf16(s[0] * rc - bflo(own.x), s[1] * rc - bfhi(own.x)); dw.y = pg8::cvt_pk_bf16(s[2] * rc - bflo(own.y), s[3] * rc - bfhi(own.y));
            dw.z = pg8::cvt_pk_bf16(s[4] * rc - bflo(own.z), s[5] * rc - bfhi(own.z)); dw.w = pg8::cvt_pk_bf16(s[6] * rc - bflo(own.w), s[7] * rc - bfhi(own.w));
            const bf16x8 df = __builtin_bit_cast(bf16x8, dw);
#pragma unroll
            for (int mt = 0; mt < 4; ++mt) { const bf16x8 wf = *(const GAS bf16x8*)(wp + (size_t)(32 * mt) * 128 + 16 * ks); acc[mt] = __builtin_amdgcn_mfma_f32_32x32x16_bf16(wf, df, acc[mt], 0, 0, 0); }
        }
#pragma unroll
        for (int mt = 0; mt < 4; ++mt)
#pragma unroll
            for (int gq = 0; gq < 4; ++gq) { v2u ow; ow.x = pg8::cvt_pk_bf16(acc[mt][4 * gq], acc[mt][4 * gq + 1]); ow.y = pg8::cvt_pk_bf16(acc[mt][4 * gq + 2], acc[mt][4 * gq + 3]);
                *(LAS v2u*)(lds + PB_POOL_OFF + tokl * PB_POOL_PITCH + (oh * 128 + 32 * mt + 8 * gq + 4 * hi) * 2) = ow; }
    }
    __syncthreads();
#pragma unroll 1
    for (int pass = 0; pass < 8; ++pass) {
        const int id = pass * 512 + tid, tok = id >> 5, cc = id & 31, col = g * 256 + 8 * cc, head = col >> 6; const size_t row = (size_t)t0 + tok;
        float m[3], dn[3];
#pragma unroll
        for (int p = 0; p < 3; ++p) { const size_t mi = ((size_t)p * T + row) * 16 + head; m[p] = MDm[mi]; dn[p] = MDd[mi]; }
        const float M = fmaxf(fmaxf(m[0], m[1]), m[2]);
        float wgt[3]; float ws_ = 0.f;
#pragma unroll
        for (int p = 0; p < 3; ++p) { wgt[p] = dn[p] * __builtin_amdgcn_exp2f(m[p] - M); ws_ += wgt[p]; }
        const float iw = 1.0f / ws_;
        const v4u o0 = *(const GAS v4u*)(OP + row * QW + col), o1 = *(const GAS v4u*)(OP + row * QW + 1024 + col), o2 = *(const GAS v4u*)(OP + row * QW + 2048 + col);
        const v4u g0 = *(const GAS v4u*)(Gt + row * GATEW + col), g1 = *(const GAS v4u*)(Gt + row * GATEW + 1024 + col);
        const v4u pl = *(const LAS v4u*)(lds + PB_POOL_OFF + tok * PB_POOL_PITCH + cc * 16);
        const float w0 = wgt[0] * iw, w1 = wgt[1] * iw, w2 = wgt[2] * iw;
        v4u res;
#define MRG(f) { const float alo = w0 * bflo(o0.f) + w1 * bflo(o1.f) + w2 * bflo(o2.f), ahi = w0 * bfhi(o0.f) + w1 * bfhi(o1.f) + w2 * bfhi(o2.f); \
                 res.f = pg8::cvt_pk_bf16(bflo(g0.f) * bflo(pl.f) + bflo(g1.f) * alo, bfhi(g0.f) * bfhi(pl.f) + bfhi(g1.f) * ahi); }
        MRG(x) MRG(y) MRG(z) MRG(w)
#undef MRG
        *(GAS v4u*)(MERGED + row * DM + col) = res;
    }
    __syncthreads();
}

constexpr int P5_S2_OFF = 0, P5_TL_OFF = 256, P5_LIST_OFF = 256 + 8192;
__device__ __forceinline__ float gelu_tanh(float x) {
    const float z = 0.7978845608028654f * (x + 0.044715f * x * x * x);
    const float e = __builtin_amdgcn_exp2f(2.0f * LOG2E * z);
    const float th = 1.0f - 2.0f * __builtin_amdgcn_rcpf(1.0f + e);
    return 0.5f * x * (1.0f + th);
}
__device__ __forceinline__ void peer_unit(Frame& F, int unit, const bf16* HB, const bf16* QP, const bf16* SKB, const bf16* UB, const bf16* VB, float* out) {
    const int lane = F.lane, w = F.wave, c32 = lane & 31, hi = lane >> 5;
    const int t0 = unit * 32;
    LAS unsigned char* lds = F.lds;
    LAS float* s2l = (LAS float*)(lds + P5_S2_OFF);
#pragma unroll 1
    for (int i = 0; i < 4; ++i) { const int tok = 4 * w + i; const GAS f32x4* xr = (const GAS f32x4*)(out + (size_t)(t0 + tok) * DM) + lane; float s = 0.f;
#pragma unroll
        for (int j = 0; j < 4; ++j) { const f32x4 v = xr[64 * j]; s += (v.x * v.x + v.y * v.y) + (v.z * v.z + v.w * v.w); }
        s = wave_sum_dpp(s); if (lane == 0) s2l[tok] = 1.0f / sqrtf(s * (1.0f / 1024.0f) + EPS); }
    __syncthreads();
    {
        float tops[2][16];
#pragma unroll
        for (int p = 0; p < 2; ++p) {
            f32x16 acc[4]; acc[0] = f32x16{}; acc[1] = f32x16{}; acc[2] = f32x16{}; acc[3] = f32x16{};
            const bf16* qrow = QP + (size_t)(t0 + c32) * 2048 + (w * 2 + p) * 128 + 8 * hi;
            const bf16* skp = SKB + (size_t)((w * 2 + p) * 128 + c32) * 128 + 8 * hi;
#pragma unroll 2
            for (int ks = 0; ks < 8; ++ks) { const bf16x8 bq = *(const GAS bf16x8*)(qrow + 16 * ks);
#pragma unroll
                for (int mt = 0; mt < 4; ++mt) { const bf16x8 a = *(const GAS bf16x8*)(skp + (size_t)(32 * mt) * 128 + 16 * ks); acc[mt] = __builtin_amdgcn_mfma_f32_32x32x16_bf16(a, bq, acc[mt], 0, 0, 0); } }
#pragma unroll
            for (int mt = 0; mt < 4; ++mt)
#pragma unroll
                for (int rr = 0; rr < 16; ++rr) acc[mt][rr] = __uint_as_float((__float_as_uint(acc[mt][rr]) & ~127u) | (unsigned)(32 * mt + crow(rr, hi)));
#pragma unroll
            for (int k = 0; k < 16; ++k) {
                float m = acc[0][0];
#pragma unroll
                for (int mt = 0; mt < 4; ++mt)
#pragma unroll
                    for (int rr = 0; rr < 16; ++rr) m = fmaxf(m, acc[mt][rr]);
                m = xhalf_max(m);
                tops[p][k] = m;
#pragma unroll
                for (int mt = 0; mt < 4; ++mt)
#pragma unroll
                    for (int rr = 0; rr < 16; ++rr) acc[mt][rr] = (acc[mt][rr] == m) ? -3.0e38f : acc[mt][rr];
            }
        }
        {
            v4u tb; unsigned b_[16];
#pragma unroll
            for (int k = 0; k < 16; ++k) b_[k] = __float_as_uint(hi ? tops[1][k] : tops[0][k]) & 127u;
            tb.x = b_[0] | (b_[1] << 8) | (b_[2] << 16) | (b_[3] << 24); tb.y = b_[4] | (b_[5] << 8) | (b_[6] << 16) | (b_[7] << 24);
            tb.z = b_[8] | (b_[9] << 8) | (b_[10] << 16) | (b_[11] << 24); tb.w = b_[12] | (b_[13] << 8) | (b_[14] << 16) | (b_[15] << 24);
            *(LAS v4u*)(lds + P5_TL_OFF + ((c32 * 8 + w) * 2 + hi) * 16) = tb;
        }
        float cv[25];
        {
            int c = 0;
#pragma unroll
            for (int i = 0; i < 16; ++i)
#pragma unroll
                for (int j = 0; j < 16; ++j)
                    if ((i + 1) * (j + 1) <= 16) {
                        const float val = tops[0][i] + tops[1][j];
                        const float pk = __uint_as_float((__float_as_uint(val) & ~255u) | (unsigned)(i * 16 + j));
                        if ((c & 1) == 0) cv[c >> 1] = pk; else cv[c >> 1] = hi ? pk : cv[c >> 1];
                        ++c;
                    }
        }
        float best[16];
#pragma unroll
        for (int k = 0; k < 16; ++k) {
            float m = cv[0];
#pragma unroll
            for (int s = 1; s < 25; ++s) m = fmaxf(m, cv[s]);
            m = xhalf_max(m);
            best[k] = m;
#pragma unroll
            for (int s = 0; s < 25; ++s) cv[s] = (cv[s] == m) ? -3.0e38f : cv[s];
        }
        const float s2v = s2l[c32] * LOG2E;
        float ge[16]; float gs = 0.f;
#pragma unroll
        for (int k = 0; k < 16; ++k) { ge[k] = __builtin_amdgcn_exp2f((best[k] - best[0]) * s2v); gs += ge[k]; }
        const float gi = 1.0f / gs;
        asm volatile("s_waitcnt lgkmcnt(0)" ::: "memory");
        const LAS unsigned char* tl0 = lds + P5_TL_OFF + ((c32 * 8 + w) * 2) * 16;
#pragma unroll
        for (int k = 0; k < 8; ++k) {
            const float bsel = hi ? best[k + 8] : best[k]; const float gsel = (hi ? ge[k + 8] : ge[k]) * gi;
            const unsigned code = __float_as_uint(bsel) & 255u; const unsigned e0 = tl0[code >> 4], e1 = tl0[16 + (code & 15u)];
            v2u ent; ent.x = e0 * 128u + e1; ent.y = __float_as_uint(gsel);
            *(LAS v2u*)(lds + P5_LIST_OFF + ((c32 * 128) + w * 16 + k + 8 * hi) * 8) = ent;
        }
    }
    __syncthreads();
#pragma unroll 1
    for (int i = 0; i < 4; ++i) {
        const int tok = 4 * w + i; const size_t row = (size_t)t0 + tok;
        const v4u h0 = *(const GAS v4u*)(HB + row * DM + 8 * lane), h1 = *(const GAS v4u*)(HB + row * DM + 512 + 8 * lane);
        const float s2v = s2l[tok];
        float acc[16];
#pragma unroll
        for (int j = 0; j < 16; ++j) acc[j] = 0.f;
        const LAS v2u* lst = (const LAS v2u*)(lds + P5_LIST_OFF + tok * 128 * 8);
#pragma unroll 1
        for (int g = 0; g < 32; ++g) {
            v4u u0[4], u1[4], v0[4], v1[4]; float gt[4];
#pragma unroll
            for (int q = 0; q < 4; ++q) { const v2u ent = lst[4 * g + q]; const unsigned e = (unsigned)__builtin_amdgcn_readfirstlane((int)ent.x); gt[q] = __uint_as_float((unsigned)__builtin_amdgcn_readfirstlane((int)ent.y));
                const bf16* up = UB + (size_t)e * DM + 8 * lane; const bf16* vp = VB + (size_t)e * DM + 8 * lane;
                u0[q] = *(const GAS v4u*)up; u1[q] = *(const GAS v4u*)(up + 512); v0[q] = *(const GAS v4u*)vp; v1[q] = *(const GAS v4u*)(vp + 512); }
#pragma unroll
            for (int q = 0; q < 4; ++q) {
                float d = 0.f;
                d = dot2bf(u0[q].x, h0.x, d); d = dot2bf(u0[q].y, h0.y, d); d = dot2bf(u0[q].z, h0.z, d); d = dot2bf(u0[q].w, h0.w, d);
                d = dot2bf(u1[q].x, h1.x, d); d = dot2bf(u1[q].y, h1.y, d); d = dot2bf(u1[q].z, h1.z, d); d = dot2bf(u1[q].w, h1.w, d);
                d = wave_sum_dpp(d);
                const float cf = gt[q] * gelu_tanh(d * s2v);
                acc[0] += cf * bflo(v0[q].x); acc[1] += cf * bfhi(v0[q].x); acc[2] += cf * bflo(v0[q].y); acc[3] += cf * bfhi(v0[q].y);
                acc[4] += cf * bflo(v0[q].z); acc[5] += cf * bfhi(v0[q].z); acc[6] += cf * bflo(v0[q].w); acc[7] += cf * bfhi(v0[q].w);
                acc[8] += cf * bflo(v1[q].x); acc[9] += cf * bfhi(v1[q].x); acc[10] += cf * bflo(v1[q].y); acc[11] += cf * bfhi(v1[q].y);
                acc[12] += cf * bflo(v1[q].z); acc[13] += cf * bfhi(v1[q].z); acc[14] += cf * bflo(v1[q].w); acc[15] += cf * bfhi(v1[q].w);
            }
        }
        float* orow = out + row * DM + 8 * lane;
#pragma unroll
        for (int j = 0; j < 2; ++j) { f32x4 a = *(const GAS f32x4*)(orow + 512 * j), b = *(const GAS f32x4*)(orow + 512 * j + 4);
            a.x += acc[8 * j + 0]; a.y += acc[8 * j + 1]; a.z += acc[8 * j + 2]; a.w += acc[8 * j + 3]; b.x += acc[8 * j + 4]; b.y += acc[8 * j + 5]; b.z += acc[8 * j + 6]; b.w += acc[8 * j + 7];
            *(GAS f32x4*)(orow + 512 * j) = a; *(GAS f32x4*)(orow + 512 * j + 4) = b; }
    }
    __syncthreads();
}

#ifndef MK_N_LAUNCHES
#define MK_N_LAUNCHES 1
#endif
constexpr int N_LAUNCHES = MK_N_LAUNCHES;
constexpr int PER_PHASE = 7;
struct Args { const float* in[13]; float* out; unsigned char* ws; int ph_lo, ph_hi; };
__global__ void __launch_bounds__(NWAVES * 64, 2) fwd_megakernel(Args args) {
    extern __shared__ __attribute__((aligned(16))) unsigned char lds[];
    Frame F;
    F.lds = (LAS unsigned char*)lds;
    F.MISC = (volatile LAS unsigned*)(F.lds + MISC_OFF);
    F.tid = threadIdx.x; F.lane = F.tid & 63; F.wave = __builtin_amdgcn_readfirstlane(F.tid >> 6);
    F.G = gridDim.x;
    unsigned char* ws = args.ws; F.ws = ws;
    F.ctl = (gu32*)(ws + WS_CTL);
    F.x = args.in[0]; F.norm1_g = args.in[1]; F.w_in = args.in[2]; F.q_norm_g = args.in[3]; F.k_norm_g = args.in[4]; F.w_pool = args.in[5]; F.pool_scale = args.in[6];
    F.w_out = args.in[7]; F.norm2_g = args.in[8]; F.w_query = args.in[9]; F.sub_keys = args.in[10]; F.expert_u = args.in[11]; F.expert_v = args.in[12]; F.out = args.out;
    for (int u = F.tid; u < (LDS_BYTES - LDSCTL_OFF) / 4; u += NWAVES * 64) ((LAS unsigned*)(F.lds + LDSCTL_OFF))[u] = 0u;
    __syncthreads();
    XcdBarrier bar; bar.bar = (unsigned*)(F.ctl + CW_BAR); bar.x = 0; bar.st = nullptr;
    if (N_LAUNCHES == 1) bar = xcd_barrier_post((unsigned*)(F.ctl + CW_BAR), F.MISC + 8);
#define GRID_BAR() do { if (N_LAUNCHES == 1) xcd_barrier(bar); } while (0)
    const int lo = args.ph_lo, hi = args.ph_hi;
#define IN(k) (lo <= (k) && (k) < hi)
    bf16* const XB = (bf16*)(ws + WS_XB); bf16* const W1T = (bf16*)(ws + WS_W1T); bf16* const WOT = (bf16*)(ws + WS_WOT); bf16* const WQT = (bf16*)(ws + WS_WQT);
    bf16* const AIN = (bf16*)(ws + WS_AIN); bf16* const Qb = (bf16*)(ws + WS_Q); bf16* const Gb = (bf16*)(ws + WS_G);
    bf16* const Kb = (bf16*)args.out; bf16* const Vb = (bf16*)args.out + (size_t)T * DM;
    float* const MDm = (float*)(ws + WS_MD); float* const MDd = MDm + (size_t)3 * T * 16;
    bf16* const MERGED = XB; bf16* const HB = (bf16*)(ws + WS_HB); bf16* const QP = Gb;

    if (IN(0)) { p0_prologue(F); GRID_BAR(); }
    if (IN(1)) {
        pg8::Gemm g{XB, W1T, T, INW, DM}; pg8::StaticOrder S; S.init(T, INW, F.G, (int)blockIdx.x);
        pg8::EpiProj E{AIN, Qb, Kb, Vb, Gb, (const float*)(ws + WS_S1), F.q_norm_g, F.k_norm_g};
        pg8::gemm_phase<pg8::EpiProj, pg8::StaticOrder, true, true>(F.lds + RING_OFF, g, S, E);
        GRID_BAR();
    }
    if (IN(2)) {
        constexpr int NU = 3 * BATCH * 16 * 32; const int per = (NU + F.G - 1) / F.G; const int u0 = blockIdx.x * per, u1 = (u0 + per) < NU ? (u0 + per) : NU;
        for (int u = u0; u < u1; ++u) attn_unit(F, u, Kb, Vb, Qb, MDm, MDd);
        GRID_BAR();
    }
    if (IN(3)) {
        constexpr int NU = (T / 128) * 4; const int per = (NU + F.G - 1) / F.G; const int u0 = blockIdx.x * per, u1 = (u0 + per) < NU ? (u0 + per) : NU;
        for (int u = u0; u < u1; ++u) pool_merge_unit(F, u, AIN, (const bf16*)(ws + WS_WPT), Qb, Gb, MDm, MDd, MERGED);
        GRID_BAR();
    }
    if (IN(4)) {
        pg8::Gemm g{MERGED, WOT, T, DM, DM}; pg8::StaticOrder S; S.init(T, DM, F.G, (int)blockIdx.x);
        pg8::EpiOut E{F.x, F.out, HB};
        pg8::gemm_phase<pg8::EpiOut, pg8::StaticOrder, true, true>(F.lds + RING_OFF, g, S, E);
        GRID_BAR();
    }
    if (IN(5)) {
        pg8::Gemm g{HB, WQT, T, 2048, DM}; pg8::StaticOrder S; S.init(T, 2048, F.G, (int)blockIdx.x);
        pg8::EpiPlain E{QP, 2048};
        pg8::gemm_phase<pg8::EpiPlain, pg8::StaticOrder, true, true>(F.lds + RING_OFF, g, S, E);
        GRID_BAR();
    }
    if (IN(6)) {
        constexpr int NU = T / 32; const int per = (NU + F.G - 1) / F.G; const int u0 = blockIdx.x * per, u1 = (u0 + per) < NU ? (u0 + per) : NU;
        for (int u = u0; u < u1; ++u) peer_unit(F, u, HB, QP, (const bf16*)(ws + WS_SKB), (const bf16*)(ws + WS_UB), (const bf16*)(ws + WS_VB), F.out);
    }
#undef IN
#undef GRID_BAR
}

extern "C" void kernel_launch(void* const* d_in, const int* in_sizes, int n_in, void* d_out, int out_size, void* d_ws, size_t ws_size, hipStream_t stream) {
    static int grid = 0;
    if (grid == 0) {
        if (n_in != 13 || in_sizes[0] != T * DM || out_size != T * DM || ws_size < WS_END) {
            fprintf(stderr, "kernel_launch: unexpected shapes (n_in %d, in0 %d, out %d, ws %zu, need %zu); nothing launched\n", n_in, n_in > 0 ? in_sizes[0] : -1, out_size, ws_size, (size_t)WS_END); grid = -1; return; }
        int dev = 0, cus = 0, per_cu = 0;
        if (hipGetDevice(&dev) != hipSuccess || hipDeviceGetAttribute(&cus, hipDeviceAttributeMultiprocessorCount, dev) != hipSuccess) { grid = -1; return; }
        if (hipFuncSetAttribute((const void*)fwd_megakernel, hipFuncAttributeMaxDynamicSharedMemorySize, LDS_BYTES) != hipSuccess) { fprintf(stderr, "kernel_launch: hipFuncSetAttribute failed\n"); grid = -1; return; }
        if (hipOccupancyMaxActiveBlocksPerMultiprocessor(&per_cu, (const void*)fwd_megakernel, NWAVES * 64, LDS_BYTES) != hipSuccess || per_cu < 1) { fprintf(stderr, "kernel_launch: occupancy query reports %d workgroups per CU\n", per_cu); grid = -1; (void)hipGetLastError(); return; }
        (void)hipGetLastError();
        grid = cus;
    }
    if (grid < 0) return;
    if (hipMemsetAsync((char*)d_ws + WS_CTL, 0, CTL_ZERO_BYTES, stream) != hipSuccess) return;
    Args a{};
    for (int i = 0; i < 13; ++i) a.in[i] = (const float*)d_in[i];
    a.out = (float*)d_out; a.ws = (unsigned char*)d_ws;
    for (int li = 0; li < N_LAUNCHES; ++li) {
        a.ph_lo = (N_LAUNCHES == 1) ? 0 : li; a.ph_hi = (N_LAUNCHES == 1) ? PER_PHASE : li + 1;
        hipLaunchKernelGGL(fwd_megakernel, dim3(grid), dim3(NWAVES * 64), LDS_BYTES, stream, a);
    }
}
```

```cpp
#include <hip/hip_runtime.h>
#include <cstdio>
#include <cstdint>
namespace pg8 {
#define PG8_LAS __attribute__((address_space(3)))
typedef unsigned short bf16_t;
typedef short bf16x8 __attribute__((ext_vector_type(8)));
typedef float f32x4 __attribute__((ext_vector_type(4)));
typedef unsigned u32x4 __attribute__((ext_vector_type(4)));
constexpr int BM = 256, BK = 64, HALF = 128, HTB = HALF * BK * 2  , STAGE_BYTES = 8 * HTB, NXCD = 8, WGM = 8;

__host__ __device__ __forceinline__ int lds_byte(int r, int c) { const int st = (r >> 4) * 2 + (c >> 5), rr = r & 15, cc = c & 31, ob = rr * 64 + cc * 2; return st * 1024 + (ob ^ (((ob >> 9) & 1) << 5)); }
__host__ __device__ __forceinline__ void stage_rc(int b, int& R, int& C) { const int st = b / 1024, sb = b % 1024, swz = sb ^ (((sb >> 9) & 1) << 5); R = (st >> 1) * 16 + swz / 64; C = (st & 1) * 32 + (swz % 64) / 2; }
__host__ __device__ __forceinline__ int perm32(int rho) { const int n = rho >> 4, i = rho & 15; return 8 * (i >> 2) + 4 * n + (i & 3); }

struct Unit { int pm, pn; };
struct Gemm { const bf16_t* A; const bf16_t* Bt; int M, N, K; };

struct StaticOrder {
    int nM, nN, nwg, G, c;
    __host__ __device__ void init(int M, int N, int G_, int c_) { nM = M / BM; nN = N / BM; nwg = nM * nN; G = G_; c = c_; }
    __host__ __device__ bool next(int i, Unit& u) const {
        const long L = (long)i * G + c; if (L >= nwg) return false;
        int wgid = (int)L; { const int q = nwg / NXCD, r = nwg % NXCD, xcd = wgid % NXCD, off = wgid / NXCD; wgid = (xcd < r ? xcd * (q + 1) : r * (q + 1) + (xcd - r) * q) + off; }
        const int nig = WGM * nN, gid = wgid / nig, fm = gid * WGM, gsz = (nM - fm) < WGM ? (nM - fm) : WGM;
        u.pm = fm + ((wgid % nig) % gsz); u.pn = (wgid % nig) / gsz; return true;
    }
    __device__ __forceinline__ void a_ready(const Unit&) const {}
    __device__ __forceinline__ void done(const Unit&) const {}
};
__device__ __forceinline__ unsigned cvt_pk_bf16(float lo, float hi) { unsigned r; asm volatile("v_cvt_pk_bf16_f32 %0, %1, %2" : "=v"(r) : "v"(lo), "v"(hi)); return r; }

typedef float f32x2 __attribute__((ext_vector_type(2)));
__device__ __forceinline__ float xrow16_sum(float x) {
    auto s = __builtin_amdgcn_permlane16_swap(__float_as_uint(x), __float_as_uint(x), false, false);
    x = __uint_as_float(s[0]) + __uint_as_float(s[1]);
    auto t = __builtin_amdgcn_permlane32_swap(__float_as_uint(x), __float_as_uint(x), false, false);
    return __uint_as_float(t[0]) + __uint_as_float(t[1]);
}
struct EpiPlain {
    static constexpr bool PERM = true, AFTER_DRAIN = false;
    bf16_t* O; int ldc;
    __device__ __forceinline__ void operator()(const f32x4 (&acc)[2][2][4][2], const Unit& u, int wr, int wc, int fr, int fq) const {
        const int row0 = u.pm * BM + wr * 64 + fr; const int col0 = u.pn * BM + wc * 32 + 8 * fq;
#pragma unroll
        for (int ai = 0; ai < 2; ++ai)
#pragma unroll
            for (int m = 0; m < 4; ++m) { bf16_t* rowp = O + (size_t)(row0 + ai * HALF + m * 16) * ldc + col0;
#pragma unroll
                for (int bj = 0; bj < 2; ++bj) { const f32x4 v0 = acc[ai][bj][m][0], v1 = acc[ai][bj][m][1];
                    u32x4 w; w.x = cvt_pk_bf16(v0[0], v0[1]); w.y = cvt_pk_bf16(v0[2], v0[3]); w.z = cvt_pk_bf16(v1[0], v1[1]); w.w = cvt_pk_bf16(v1[2], v1[3]);
                    *(u32x4*)(rowp + bj * HALF) = w; } }
    }
};
struct EpiProj {
    static constexpr bool PERM = true, AFTER_DRAIN = false;
    bf16_t *AIN, *Q, *K, *V, *G; const float* s1; const float* qg; const float* kg;
    __device__ __forceinline__ void operator()(const f32x4 (&acc)[2][2][4][2], const Unit& u, int wr, int wc, int fr, int fq) const {
        const int pn = u.pn; int type, ldc, colt; bf16_t* base;
        if (pn < 2)       { type = 0; base = AIN; ldc = 512;  colt = pn * 256; }
        else if (pn < 14) { type = 1; base = Q;   ldc = 3072; colt = (pn - 2) * 256; }
        else if (pn < 18) { type = 2; base = K;   ldc = 1024; colt = (pn - 14) * 256; }
        else if (pn < 22) { type = 3; base = V;   ldc = 1024; colt = (pn - 18) * 256; }
        else              { type = 4; base = G;   ldc = 2048; colt = (pn - 22) * 256; }
        const int col0 = colt + 64 * wc + 8 * fq;
        const int row0 = u.pm * BM + wr * 64 + fr;
        f32x4 gn[2][2];
        const float* gp = (type == 2) ? kg : qg;
        const float gmul = (type == 1) ? 0.125f * 1.4426950408889634f : 1.0f;
#pragma unroll
        for (int bj = 0; bj < 2; ++bj)
#pragma unroll
            for (int n = 0; n < 2; ++n) gn[bj][n] = *(const f32x4*)(gp + 32 * bj + 8 * fq + 4 * n) * gmul;
#pragma unroll
        for (int ai = 0; ai < 2; ++ai)
#pragma unroll
            for (int m = 0; m < 4; ++m) {
                const int row = row0 + ai * HALF + m * 16; const float sc = s1[row];
                f32x4 v[2][2];
#pragma unroll
                for (int bj = 0; bj < 2; ++bj)
#pragma unroll
                    for (int n = 0; n < 2; ++n) v[bj][n] = acc[ai][bj][m][n] * sc;
                if (type == 1 || type == 2) {
                    float ss = 0.f;
#pragma unroll
                    for (int bj = 0; bj < 2; ++bj)
#pragma unroll
                        for (int n = 0; n < 2; ++n) { const f32x4 x = v[bj][n]; ss += (x[0] * x[0] + x[1] * x[1]) + (x[2] * x[2] + x[3] * x[3]); }
                    ss = xrow16_sum(ss);
                    const float rn = __builtin_amdgcn_rsqf(ss * (1.0f / 64.0f) + 1e-6f);
#pragma unroll
                    for (int bj = 0; bj < 2; ++bj)
#pragma unroll
                        for (int n = 0; n < 2; ++n) v[bj][n] = v[bj][n] * rn * gn[bj][n];
                } else if (type == 4) {
#pragma unroll
                    for (int bj = 0; bj < 2; ++bj)
#pragma unroll
                        for (int n = 0; n < 2; ++n)
#pragma unroll
                            for (int j = 0; j < 4; ++j) v[bj][n][j] = __builtin_amdgcn_rcpf(1.0f + __builtin_amdgcn_exp2f(-1.4426950408889634f * v[bj][n][j]));
                }
                bf16_t* rowp = base + (size_t)row * ldc + col0;
#pragma unroll
                for (int bj = 0; bj < 2; ++bj) { const f32x4 v0 = v[bj][0], v1 = v[bj][1];
                    u32x4 w; w.x = cvt_pk_bf16(v0[0], v0[1]); w.y = cvt_pk_bf16(v0[2], v0[3]); w.z = cvt_pk_bf16(v1[0], v1[1]); w.w = cvt_pk_bf16(v1[2], v1[3]);
                    *(u32x4*)(rowp + 32 * bj) = w; }
            }
    }
};
struct EpiOut {
    static constexpr bool PERM = true, AFTER_DRAIN = false;
    const float* x; float* out; bf16_t* hb;
    __device__ __forceinline__ void operator()(const f32x4 (&acc)[2][2][4][2], const Unit& u, int wr, int wc, int fr, int fq) const {
        const int row0 = u.pm * BM + wr * 64 + fr; const int col0 = u.pn * BM + wc * 32 + 8 * fq;
#pragma unroll
        for (int ai = 0; ai < 2; ++ai)
#pragma unroll
            for (int m = 0; m < 4; ++m) { const size_t off = (size_t)(row0 + ai * HALF + m * 16) * 1024 + col0;
#pragma unroll
                for (int bj = 0; bj < 2; ++bj) {
                    const f32x4 x0 = *(const f32x4*)(x + off + bj * HALF), x1 = *(const f32x4*)(x + off + bj * HALF + 4);
                    const f32x4 v0 = acc[ai][bj][m][0] + x0, v1 = acc[ai][bj][m][1] + x1;
                    *(f32x4*)(out + off + bj * HALF) = v0; *(f32x4*)(out + off + bj * HALF + 4) = v1;
                    u32x4 w; w.x = cvt_pk_bf16(v0[0], v0[1]); w.y = cvt_pk_bf16(v0[2], v0[3]); w.z = cvt_pk_bf16(v1[0], v1[1]); w.w = cvt_pk_bf16(v1[2], v1[3]);
                    *(u32x4*)(hb + off + bj * HALF) = w; } }
    }
};
template <class Epi, class Sched, bool ALIGN_EPI = false, bool SP2 = false>
__device__ __forceinline__ void gemm_phase(PG8_LAS unsigned char* lds, const Gemm g, const Sched& S, const Epi& E) {
    const int tid = threadIdx.x, wid = __builtin_amdgcn_readfirstlane(tid >> 6), lane = tid & 63, wr = wid >> 2, wc = wid & 3, fr = lane & 15, fq = lane >> 4;
    const int K = g.K, nt = K / BK;
    unsigned voffA[2], voffB[2];
#pragma unroll
    for (int i = 0; i < 2; ++i) { int R, C; stage_rc(tid * 16 + i * 8192, R, C); const int Rb = Epi::PERM ? ((R & ~31) + perm32(R & 31)) : R;
        voffA[i] = (unsigned)(R * K + C) * 2u; voffB[i] = (unsigned)(Rb * K + C) * 2u; }
    const size_t kstep = (size_t)(BK * 2);
    const size_t hstep = (size_t)HALF * K * 2;
    const size_t tstep = 2 * hstep;
    const unsigned ldsw = (unsigned)wid * 1024u;
    const int aoff = lds_byte(wr * 64 + fr, fq * 8), boff = lds_byte(wc * 32 + fr, fq * 8);
#define PG8_SA(b, h) (((b) * 2 + (h)) * HTB)
#define PG8_SB(b, h) ((4 + (b) * 2 + (h)) * HTB)
#define PG8_STAGE(bufoff, gbase, voff) do { _Pragma("unroll") for (int _i = 0; _i < 2; ++_i) \
        __builtin_amdgcn_global_load_lds((const unsigned*)((const char*)(gbase) + (voff)[_i]), (PG8_LAS unsigned*)(lds + (bufoff) + ldsw + _i * 8192), 16, 0, 0); } while (0)
#define PG8_LDA(dst, b, h) do { _Pragma("unroll") for (int m = 0; m < 4; ++m) _Pragma("unroll") for (int k = 0; k < 2; ++k) dst[m][k] = *(const PG8_LAS bf16x8*)(lds + PG8_SA(b, h) + aoff + m * 2048 + k * 1024); } while (0)
#define PG8_LDB(dst, b, h) do { _Pragma("unroll") for (int n = 0; n < 2; ++n) _Pragma("unroll") for (int k = 0; k < 2; ++k) dst[n][k] = *(const PG8_LAS bf16x8*)(lds + PG8_SB(b, h) + boff + n * 2048 + k * 1024); } while (0)
#define PG8_MMA(ai, bj, At, Bt) do { __builtin_amdgcn_s_setprio(1); _Pragma("unroll") for (int m = 0; m < 4; ++m) _Pragma("unroll") for (int n = 0; n < 2; ++n) _Pragma("unroll") for (int k = 0; k < 2; ++k) \
        acc[ai][bj][m][n] = __builtin_amdgcn_mfma_f32_16x16x32_bf16(Bt[n][k], At[m][k], acc[ai][bj][m][n], 0, 0, 0); __builtin_amdgcn_s_setprio(0); } while (0)
#define PG8_WAIT_V(n) asm volatile("s_waitcnt vmcnt(" #n ")" ::: "memory")
#define PG8_WAIT_L(n) asm volatile("s_waitcnt lgkmcnt(" #n ")" ::: "memory")
#define PG8_BAR __builtin_amdgcn_s_barrier()
#define PG8_SCHED __builtin_amdgcn_sched_barrier(0)
    Unit cur, nxt; int ui = 0;
    if (!S.next(0, cur)) return;
    f32x4 acc[2][2][4][2];
#pragma unroll
    for (int a = 0; a < 2; ++a)
#pragma unroll
        for (int b = 0; b < 2; ++b)
#pragma unroll
            for (int m = 0; m < 4; ++m)
#pragma unroll
                for (int n = 0; n < 2; ++n) acc[a][b][m][n] = (f32x4){0.f, 0.f, 0.f, 0.f};
    bf16x8 At[4][2], B0[2][2], B1[2][2];
    const char* cA = (const char*)g.A + (size_t)cur.pm * tstep; const char* cB = (const char*)g.Bt + (size_t)cur.pn * tstep;
    S.a_ready(cur);
    if constexpr (SP2) {
        PG8_STAGE(PG8_SB(0, 0), cB, voffB); PG8_STAGE(PG8_SB(0, 1), cB + hstep, voffB); PG8_STAGE(PG8_SA(0, 0), cA, voffA); PG8_STAGE(PG8_SA(0, 1), cA + hstep, voffA);
        if (wr == 1) PG8_BAR;
        PG8_WAIT_V(2); PG8_BAR;
        PG8_STAGE(PG8_SB(1, 0), cB + kstep, voffB); PG8_STAGE(PG8_SA(1, 0), cA + kstep, voffA); PG8_STAGE(PG8_SB(1, 1), cB + hstep + kstep, voffB);
        PG8_WAIT_V(6); PG8_BAR;
    } else {
        PG8_STAGE(PG8_SB(0, 0), cB, voffB); PG8_STAGE(PG8_SA(0, 0), cA, voffA); PG8_STAGE(PG8_SB(0, 1), cB + hstep, voffB); PG8_STAGE(PG8_SA(0, 1), cA + hstep, voffA);
        if (wr == 1) PG8_BAR;
        PG8_WAIT_V(4); PG8_BAR;
        PG8_STAGE(PG8_SB(1, 0), cB + kstep, voffB); PG8_STAGE(PG8_SA(1, 0), cA + kstep, voffA); PG8_STAGE(PG8_SB(1, 1), cB + hstep + kstep, voffB);
        PG8_WAIT_V(6); PG8_BAR;
    }
    for (;;) {
        const bool has_next = S.next(ui + 1, nxt);
        const char* nA = has_next ? (const char*)g.A + (size_t)nxt.pm * tstep : cA; const char* nB = has_next ? (const char*)g.Bt + (size_t)nxt.pn * tstep : cB;
        for (int t = 0; t < nt; t += 2) {
            const bool last = (t == nt - 2);
            const char* a1 = cA + (size_t)(t + 1) * kstep;
            const char* a2 = last ? nA : cA + (size_t)(t + 2) * kstep; const char* b2 = last ? nB : cB + (size_t)(t + 2) * kstep;
            const char* a3 = a2 + kstep; const char* b3 = b2 + kstep;
            if (last && has_next) S.a_ready(nxt);
            if constexpr (SP2) {
            PG8_LDB(B0, 0, 0); PG8_LDB(B1, 0, 1); PG8_SCHED; PG8_LDA(At, 0, 0); PG8_STAGE(PG8_SA(1, 1), a1 + hstep, voffA);
            PG8_WAIT_V(8); PG8_WAIT_L(0); PG8_BAR; PG8_MMA(0, 0, At, B0); PG8_MMA(0, 1, At, B1); PG8_BAR; PG8_SCHED;
            PG8_LDA(At, 0, 1); PG8_STAGE(PG8_SB(0, 0), b2, voffB); PG8_STAGE(PG8_SB(0, 1), b2 + hstep, voffB); PG8_STAGE(PG8_SA(0, 0), a2, voffA);
            PG8_WAIT_V(8); PG8_WAIT_L(0); PG8_BAR; PG8_MMA(1, 0, At, B0); PG8_MMA(1, 1, At, B1); PG8_BAR; PG8_SCHED;
            PG8_LDB(B0, 1, 0); PG8_LDB(B1, 1, 1); PG8_SCHED; PG8_LDA(At, 1, 0); PG8_STAGE(PG8_SA(0, 1), a2 + hstep, voffA);
            PG8_WAIT_V(8); PG8_WAIT_L(0); PG8_BAR; PG8_MMA(0, 0, At, B0); PG8_MMA(0, 1, At, B1); PG8_BAR; PG8_SCHED;
            PG8_LDA(At, 1, 1); PG8_STAGE(PG8_SB(1, 0), b3, voffB); PG8_STAGE(PG8_SB(1, 1), b3 + hstep, voffB); PG8_STAGE(PG8_SA(1, 0), a3, voffA);
            PG8_WAIT_V(8); PG8_WAIT_L(0); PG8_BAR; PG8_MMA(1, 0, At, B0); PG8_MMA(1, 1, At, B1); PG8_BAR; PG8_SCHED;
            } else {
            PG8_LDB(B0, 0, 0); PG8_SCHED; PG8_LDA(At, 0, 0); PG8_STAGE(PG8_SA(1, 1), a1 + hstep, voffA);
            PG8_WAIT_L(8); PG8_BAR; PG8_WAIT_L(0); PG8_MMA(0, 0, At, B0); PG8_BAR; PG8_SCHED;
            PG8_LDB(B1, 0, 1); PG8_STAGE(PG8_SB(0, 0), b2, voffB);
            PG8_BAR; PG8_WAIT_L(0); PG8_MMA(0, 1, At, B1); PG8_BAR;
            PG8_LDA(At, 0, 1); PG8_STAGE(PG8_SA(0, 0), a2, voffA);
            PG8_BAR; PG8_WAIT_L(0); PG8_MMA(1, 0, At, B0); PG8_BAR; PG8_SCHED;
            PG8_STAGE(PG8_SB(0, 1), b2 + hstep, voffB);
            PG8_WAIT_V(6); PG8_BAR; PG8_MMA(1, 1, At, B1); PG8_BAR;
            PG8_LDB(B0, 1, 0); PG8_SCHED; PG8_LDA(At, 1, 0); PG8_STAGE(PG8_SA(0, 1), a2 + hstep, voffA);
            PG8_WAIT_L(8); PG8_BAR; PG8_WAIT_L(0); PG8_MMA(0, 0, At, B0); PG8_BAR; PG8_SCHED;
            PG8_LDB(B1, 1, 1); PG8_STAGE(PG8_SB(1, 0), b3, voffB);
            PG8_BAR; PG8_WAIT_L(0); PG8_MMA(0, 1, At, B1); PG8_BAR;
            PG8_LDA(At, 1, 1); PG8_STAGE(PG8_SA(1, 0), a3, voffA);
            PG8_BAR; PG8_WAIT_L(0); PG8_MMA(1, 0, At, B0); PG8_BAR; PG8_SCHED;
            PG8_STAGE(PG8_SB(1, 1), b3 + hstep, voffB);
            PG8_WAIT_V(6); PG8_BAR; PG8_MMA(1, 1, At, B1); PG8_BAR;
            }
        }
        if constexpr (ALIGN_EPI) { if (wr == 0) PG8_BAR; }
        if constexpr (!Epi::AFTER_DRAIN) { E(acc, cur, wr, wc, fr, fq); S.done(cur); }
        if (!has_next) break;
#pragma unroll
        for (int a = 0; a < 2; ++a)
#pragma unroll
            for (int b = 0; b < 2; ++b)
#pragma unroll
                for (int m = 0; m < 4; ++m)
#pragma unroll
                    for (int n = 0; n < 2; ++n) acc[a][b][m][n] = (f32x4){0.f, 0.f, 0.f, 0.f};
        cur = nxt; cA = nA; cB = nB; ++ui;
        if constexpr (ALIGN_EPI) { if (wr == 1) PG8_BAR; }
    }
    PG8_WAIT_V(0);
    if constexpr (!ALIGN_EPI) { if (wr == 0) PG8_BAR; }
    PG8_BAR;
    if constexpr (Epi::AFTER_DRAIN) { E.fused(acc, cur, wr, wc, fr, fq, lds, wid, lane); S.done(cur); }
#undef PG8_SA
#undef PG8_SB
#undef PG8_STAGE
#undef PG8_LDA
#undef PG8_LDB
#undef PG8_MMA
#undef PG8_WAIT_V
#undef PG8_WAIT_L
#undef PG8_BAR
#undef PG8_SCHED
}
}

constexpr int NWAVES = 8;
constexpr int BATCH = 8, SEQ = 8192, DM = 1024, T = BATCH * SEQ;
constexpr int INW = 7680, QW = 3072, GATEW = 2048, POOLW = 512;
constexpr int NEXP = 16384;
constexpr float EPS = 1e-6f;
constexpr float LOG2E = 1.4426950408889634f;

constexpr size_t MiB = 1u << 20;
constexpr size_t WS_CTL = 0, CTL_ZERO_BYTES = 1 * MiB;
constexpr size_t WS_W1T = 2 * MiB;
constexpr size_t WS_WOT = 17 * MiB;
constexpr size_t WS_WQT = 19 * MiB;
constexpr size_t WS_WPT = 23 * MiB;
constexpr size_t WS_SKB = 23 * MiB + 512 * 1024;
constexpr size_t WS_S1 = 24 * MiB;
constexpr size_t WS_SU = 24 * MiB + 256 * 1024, WS_SV = 24 * MiB + 512 * 1024;
constexpr size_t WS_UB = 25 * MiB;
constexpr size_t WS_VB = 57 * MiB;
constexpr size_t WS_MD = 89 * MiB;
constexpr size_t WS_XB = 113 * MiB;
constexpr size_t WS_AIN = 241 * MiB;
constexpr size_t WS_Q = 305 * MiB;
constexpr size_t WS_G = 689 * MiB;
constexpr size_t WS_END = 945 * MiB;
constexpr size_t WS_HB = WS_AIN;

constexpr int CW_BAR = 4096;
constexpr int RING_OFF = 0, RING_BYTES = 131072;
constexpr int LDSCTL_OFF = 162816, MISC_OFF = LDSCTL_OFF + 320;
constexpr int LDS_BYTES = 163840;

#define GAS __attribute__((address_space(1)))
#define LAS __attribute__((address_space(3)))
typedef unsigned short bf16;
typedef unsigned v4u __attribute__((ext_vector_type(4)));
typedef unsigned v2u __attribute__((ext_vector_type(2)));
typedef float f32x4 __attribute__((ext_vector_type(4)));
typedef float f32x16 __attribute__((ext_vector_type(16)));
typedef short bf16x8 __attribute__((ext_vector_type(8)));
typedef short s16x4 __attribute__((ext_vector_type(4)));
typedef __bf16 bf16x2_t __attribute__((ext_vector_type(2)));
typedef GAS unsigned gu32;
#define RLX_AGENT __ATOMIC_RELAXED, __HIP_MEMORY_SCOPE_AGENT
#define LDS_WAIT() asm volatile("s_waitcnt lgkmcnt(0)" ::: "memory")
#define VM_WAIT() asm volatile("s_waitcnt vmcnt(0)" ::: "memory")
__device__ __forceinline__ unsigned f2bf(float f) { unsigned u = __builtin_bit_cast(unsigned, f); return (u + 0x7fffu + ((u >> 16) & 1u)) >> 16; }
__device__ __forceinline__ unsigned pk2(float lo, float hi) { return f2bf(lo) | (f2bf(hi) << 16); }
__device__ __forceinline__ float bflo(unsigned w) { return __uint_as_float(w << 16); }
__device__ __forceinline__ float bfhi(unsigned w) { return __uint_as_float(w & 0xffff0000u); }
__device__ __forceinline__ int crow(int r, int hi) { return (r & 3) + 8 * (r >> 2) + 4 * hi; }
__device__ __forceinline__ float xhalf_max(float x) { auto t = __builtin_amdgcn_permlane32_swap(__float_as_uint(x), __float_as_uint(x), false, false); return fmaxf(__uint_as_float(t[0]), __uint_as_float(t[1])); }
__device__ __forceinline__ float xhalf_sum(float x) { auto t = __builtin_amdgcn_permlane32_swap(__float_as_uint(x), __float_as_uint(x), false, false); return __uint_as_float(t[0]) + __uint_as_float(t[1]); }
__device__ __forceinline__ float wave_sum(float v) {
#pragma unroll
    for (int o = 1; o < 64; o <<= 1) v += __shfl_xor(v, o);
    return v;
}
__device__ __forceinline__ float dot2bf(unsigned a, unsigned b, float acc) { return __builtin_amdgcn_fdot2_f32_bf16(__builtin_bit_cast(bf16x2_t, a), __builtin_bit_cast(bf16x2_t, b), acc, false); }

#define XB_TMO      128
#define XB_XCNT(j)  (256  + 64 * (j))
#define XB_XSUB(j)  (1280 + 64 * (j))
#define XB_XGEN(j)  (2304 + 64 * (j))
#define XB_TOP      3328
#define XB_TOPGEN   3392
#define XCD_BAR_WORDS 3456
#define XB_SPIN_CAP (1u << 18)

__device__ __forceinline__ unsigned xb_ld(unsigned* p)              { return __hip_atomic_load(p, __ATOMIC_RELAXED, __HIP_MEMORY_SCOPE_AGENT); }
__device__ __forceinline__ unsigned xb_add(unsigned* p, unsigned v) { return __hip_atomic_fetch_add(p, v, __ATOMIC_RELAXED, __HIP_MEMORY_SCOPE_AGENT); }
__device__ __forceinline__ unsigned xb_xcc_id() { return (unsigned)__builtin_amdgcn_s_getreg((3 << 11) | 20) & 0xFu; }
#define XB_SPIN(cond, bar) do { unsigned _sp = 0; while (cond) { __builtin_amdgcn_s_sleep(1); \
    if ((++_sp & 255u) == 0u) { if (xb_ld(&(bar)[XB_TMO])) break; if (_sp > XB_SPIN_CAP) { atomicAdd(&(bar)[XB_TMO], 1u); break; } } } } while (0)

struct XcdBarrier {
    unsigned* bar; unsigned x;
    volatile LAS unsigned* st;
};

__device__ __forceinline__ XcdBarrier xcd_barrier_post(unsigned* bar, volatile LAS unsigned* st) {
    XcdBarrier b; b.bar = bar; b.x = xb_xcc_id(); b.st = st;
    if (threadIdx.x == 0) (void)xb_add(&bar[XB_XCNT(b.x)], 1u);
    return b;
}
__device__ __forceinline__ void xcd_barrier_complete(unsigned* bar, unsigned x, unsigned& nloc, unsigned& nx) {
    const unsigned G = gridDim.x * gridDim.y * gridDim.z;
    unsigned sum, cnt, mine, sp = 0u;
    for (;;) {
        sum = 0u; cnt = 0u; mine = 0u;
#pragma unroll
        for (unsigned j = 0; j < 16; ++j) { const unsigned c = xb_ld(&bar[XB_XCNT(j)]); sum += c; cnt += (c > 0u) ? 1u : 0u; mine = (j == x) ? c : mine; }
        if (sum == G) break;
        __builtin_amdgcn_s_sleep(1);
        if ((++sp & 255u) == 0u) { if (xb_ld(&bar[XB_TMO])) break; if (sp > XB_SPIN_CAP) { atomicAdd(&bar[XB_TMO], 1u); break; } }
    }
    nloc = mine > 0u ? mine : 1u; nx = cnt > 0u ? cnt : 1u;
}

__device__ __forceinline__ void xcd_barrier(const XcdBarrier& b) {
    asm volatile("s_waitcnt vmcnt(0)" ::: "memory");
    __syncthreads();
    if (threadIdx.x == 0) {
        unsigned* bar = b.bar;
        __builtin_amdgcn_s_waitcnt(0);
        unsigned nloc = b.st[0], nx = b.st[1];
        if (nloc == 0u) { xcd_barrier_complete(bar, b.x, nloc, nx); b.st[0] = nloc; b.st[1] = nx; }
        const unsigned old = xb_add(&bar[XB_XSUB(b.x)], 1u);
        const unsigned gen = old / nloc;
        if (old + 1u == (gen + 1u) * nloc) {
            __builtin_amdgcn_fence(__ATOMIC_RELEASE, "agent");
            asm volatile("s_waitcnt vmcnt(0)" ::: "memory");
            const unsigned og = xb_add(&bar[XB_TOP], 1u);
            const unsigned tg = og / nx;
            if (og + 1u == (tg + 1u) * nx) xb_add(&bar[XB_TOPGEN], 1u);
            else XB_SPIN(xb_ld(&bar[XB_TOPGEN]) == tg, bar);
            __builtin_amdgcn_fence(__ATOMIC_ACQUIRE, "agent");
            xb_add(&bar[XB_XGEN(b.x)], 1u);
            asm volatile("s_waitcnt vmcnt(0)" ::: "memory");
        } else {
            XB_SPIN(xb_ld(&bar[XB_XGEN(b.x)]) == gen, bar);
            __builtin_amdgcn_fence(__ATOMIC_ACQUIRE, "agent");
            asm volatile("s_waitcnt vmcnt(0)" ::: "memory");
        }
    }
    __syncthreads();
}

struct Frame {
    LAS unsigned char* lds;
    volatile LAS unsigned* MISC;
    gu32* ctl;
    int tid, lane, wave, G;
    const float *x, *norm1_g, *w_in, *q_norm_g, *k_norm_g, *w_pool, *pool_scale, *w_out, *norm2_g, *w_query, *sub_keys, *expert_u, *expert_v;
    float* out; unsigned char* ws;
};
template <int CTRL> __device__ __forceinline__ float dppf(float x) { return __builtin_bit_cast(float, __builtin_amdgcn_mov_dpp(__builtin_bit_cast(int, x), CTRL, 0xf, 0xf, true)); }
__device__ __forceinline__ float wave_sum_dpp(float x) {
    x += dppf<0xB1>(x);
    x += dppf<0x4E>(x);
    x += dppf<0x141>(x);
    x += dppf<0x128>(x);
    return pg8::xrow16_sum(x);
}

__device__ __forceinline__ float wave_max_dpp(float x) {
    x = fmaxf(x, dppf<0xB1>(x)); x = fmaxf(x, dppf<0x4E>(x)); x = fmaxf(x, dppf<0x141>(x)); x = fmaxf(x, dppf<0x128>(x));
    auto s = __builtin_amdgcn_permlane16_swap(__float_as_uint(x), __float_as_uint(x), false, false);
    x = fmaxf(__uint_as_float(s[0]), __uint_as_float(s[1]));
    auto t = __builtin_amdgcn_permlane32_swap(__float_as_uint(x), __float_as_uint(x), false, false);
    return fmaxf(__uint_as_float(t[0]), __uint_as_float(t[1]));
}
template <int CTRL> __device__ __forceinline__ int dppi(int x) { return __builtin_amdgcn_mov_dpp(x, CTRL, 0xf, 0xf, true); }
__device__ __forceinline__ int wave_sum_dpp_i(int x) {
    x += dppi<0xB1>(x); x += dppi<0x4E>(x); x += dppi<0x141>(x); x += dppi<0x128>(x);
    auto s = __builtin_amdgcn_permlane16_swap((unsigned)x, (unsigned)x, false, false); x = (int)(s[0] + s[1]);
    auto t = __builtin_amdgcn_permlane32_swap((unsigned)x, (unsigned)x, false, false); return (int)(t[0] + t[1]);
}
__device__ __forceinline__ v4u quant16(const f32x4 (&v)[4], float inv, int off) {
    v4u o;
#pragma unroll
    for (int j = 0; j < 4; ++j) {
        const int a = (int)__builtin_rintf(v[j].x * inv) + off, b = (int)__builtin_rintf(v[j].y * inv) + off, c = (int)__builtin_rintf(v[j].z * inv) + off, d = (int)__builtin_rintf(v[j].w * inv) + off;
        o[j] = (unsigned)(a & 255) | ((unsigned)(b & 255) << 8) | ((unsigned)(c & 255) << 16) | ((unsigned)(d & 255) << 24);
    }
    return o;
}
__device__ __forceinline__ void p0_quant_row(const float* xrow, const float* gain, unsigned char* orow, float* scale_out, int off, int lane) {
    const GAS f32x4* xr = (const GAS f32x4*)xrow + lane;
    f32x4 v[4]; float mx = 0.f;
#pragma unroll
    for (int j = 0; j < 4; ++j) { v[j] = xr[64 * j]; if (gain) v[j] = v[j] * ((const f32x4*)gain)[64 * j + lane];
        mx = fmaxf(mx, fmaxf(fmaxf(fabsf(v[j].x), fabsf(v[j].y)), fmaxf(fabsf(v[j].z), fabsf(v[j].w)))); }
    mx = wave_max_dpp(mx);
    const float sc = mx > 0.f ? mx * (1.0f / 127.0f) : 1.0f, inv = 1.0f / sc;
    *(GAS v4u*)(orow + 16 * lane) = quant16(v, inv, off);
    if (lane == 0) *scale_out = sc;
}
__device__ __forceinline__ void p0_fp8_row(const float* xrow, unsigned char* orow, float* scale_out, int lane) {
    const GAS f32x4* xr = (const GAS f32x4*)xrow + lane;
    f32x4 v[4]; float mx = 0.f;
#pragma unroll
    for (int j = 0; j < 4; ++j) { v[j] = xr[64 * j]; mx = fmaxf(mx, fmaxf(fmaxf(fabsf(v[j].x), fabsf(v[j].y)), fmaxf(fabsf(v[j].z), fabsf(v[j].w)))); }
    mx = wave_max_dpp(mx);
    const float sc = mx > 0.f ? mx * (1.0f / 400.0f) : 1.0f, inv = 1.0f / sc;
    v4u o;
#pragma unroll
    for (int j = 0; j < 4; ++j) { int pk = __builtin_amdgcn_cvt_pk_fp8_f32(v[j].x * inv, v[j].y * inv, 0, false); pk = __builtin_amdgcn_cvt_pk_fp8_f32(v[j].z * inv, v[j].w * inv, pk, true); o[j] = (unsigned)pk; }
    *(GAS v4u*)(orow + 16 * lane) = o;
    if (lane == 0) *scale_out = sc;
}
__device__ __forceinline__ void p0_transpose_item(const float* W, int K, int N, const float* rs, const float* cs, bf16* WT, int permute, LAS float* scr, int item, int lane) {
    const int nblk = N / 32, kb = item / nblk, nb = item % nblk, k0 = 64 * kb, n0 = 32 * nb;
    const float csv = cs ? cs[n0 + (lane & 31)] : 1.f;
#pragma unroll 8
    for (int i = 0; i < 32; ++i) { const int kk = 2 * i + (lane >> 5); const float r = rs ? rs[k0 + kk] : 1.f; scr[kk * 33 + (lane & 31)] = W[(size_t)(k0 + kk) * N + n0 + (lane & 31)] * r * csv; }
    LDS_WAIT(); asm volatile("" ::: "memory");
    int nout0 = n0;
    if (permute) { const int gl = (n0 & 255) >> 5; const int gp = 4 * (gl & 1) + (gl >> 1); nout0 = (n0 & ~255) + 32 * gp; }
    const int c = lane & 7;
#pragma unroll
    for (int j = 0; j < 4; ++j) { const int n = (lane >> 3) + 8 * j; const LAS float* s = scr + (8 * c) * 33 + n;
        v4u o; o.x = pk2(s[0 * 33], s[1 * 33]); o.y = pk2(s[2 * 33], s[3 * 33]); o.z = pk2(s[4 * 33], s[5 * 33]); o.w = pk2(s[6 * 33], s[7 * 33]);
        *(GAS v4u*)(WT + (size_t)(nout0 + n) * K + k0 + 8 * c) = o; }
    LDS_WAIT(); asm volatile("" ::: "memory");
}
__device__ __forceinline__ void p0_row(const float* xrow, const float* gain, bf16* orow, float* s1p, int lane) {
    const GAS f32x4* xr = (const GAS f32x4*)xrow + lane;
    f32x4 v[4]; float s = 0.f;
#pragma unroll
    for (int j = 0; j < 4; ++j) { v[j] = xr[64 * j]; s += (v[j].x * v[j].x + v[j].y * v[j].y) + (v[j].z * v[j].z + v[j].w * v[j].w); }
    if (s1p) { s = wave_sum(s); if (lane == 0) *s1p = 1.0f / sqrtf(s * (1.0f / 1024.0f) + EPS); }
    if (gain) {
#pragma unroll
        for (int j = 0; j < 4; ++j) v[j] = v[j] * ((const f32x4*)gain)[64 * j + lane];
    }
    GAS unsigned long long* o8 = (GAS unsigned long long*)orow + lane;
#pragma unroll
    for (int j = 0; j < 4; ++j) o8[64 * j] = (unsigned long long)pk2(v[j].x, v[j].y) | ((unsigned long long)pk2(v[j].z, v[j].w) << 32);
}
__device__ __forceinline__ void p0_prologue(Frame& F) {
    LAS float* scr = (LAS float*)(F.lds + RING_OFF + F.wave * 16384);
    const int gw = blockIdx.x * NWAVES + F.wave, NGW = F.G * NWAVES;
    unsigned char* ws = F.ws;
    constexpr int I_IN = (DM / 64) * (INW / 32), I_O = (DM / 64) * (DM / 32), I_Q = (DM / 64) * (2048 / 32), I_P = 4 * (128 / 64) * (256 / 32);
    constexpr int NITEMS = I_IN + I_O + I_Q + I_P;
    for (int it = gw; it < NITEMS; it += NGW) {
        int r = it;
        if (r < I_IN) { p0_transpose_item(F.w_in, DM, INW, F.norm1_g, nullptr, (bf16*)(ws + WS_W1T), 1, scr, r, F.lane); continue; } r -= I_IN;
        if (r < I_O) { p0_transpose_item(F.w_out, DM, DM, nullptr, nullptr, (bf16*)(ws + WS_WOT), 0, scr, r, F.lane); continue; } r -= I_O;
        if (r < I_Q) { p0_transpose_item(F.w_query, DM, 2048, F.norm2_g, nullptr, (bf16*)(ws + WS_WQT), 0, scr, r, F.lane); continue; } r -= I_Q;
        { const int g = r / 16, ri = r % 16;
          p0_transpose_item(F.w_pool + (size_t)g * 128 * 256, 128, 256, nullptr, F.pool_scale + g * 256, (bf16*)(ws + WS_WPT) + (size_t)g * 256 * 128, 0, scr, ri, F.lane); }
    }
    constexpr int NROWS = T + 2 * NEXP + 256;
    for (int m = gw; m < NROWS; m += NGW) {
        if (m < T) { p0_row(F.x + (size_t)m * DM, nullptr, (bf16*)(ws + WS_XB) + (size_t)m * DM, (float*)(ws + WS_S1) + m, F.lane); continue; }
        int r = m - T;
        if (r < NEXP) { p0_quant_row(F.expert_u + (size_t)r * DM, F.norm2_g, ws + WS_UB + (size_t)r * 2048, (float*)(ws + WS_SU) + r, 0, F.lane); continue; } r -= NEXP;
        if (r < NEXP) { p0_fp8_row(F.expert_v + (size_t)r * DM, ws + WS_UB + (size_t)r * 2048 + 1024, (float*)(ws + WS_SV) + r, F.lane); continue; } r -= NEXP;
        p0_row(F.sub_keys + (size_t)r * DM, nullptr, (bf16*)(ws + WS_SKB) + (size_t)r * DM, nullptr, F.lane);
    }
}

constexpr int ATT_NK = 384, ATT_K_OFF = 0, ATT_V_OFF = ATT_NK * 128;
typedef short v4i16_t __attribute__((ext_vector_type(4)));
__device__ __forceinline__ s16x4 vtr(unsigned ldsaddr) { return __builtin_bit_cast(s16x4, __builtin_amdgcn_ds_read_tr16_b64_v4i16((LAS v4i16_t*)(uintptr_t)ldsaddr)); }
__device__ __forceinline__ void attn_unit(Frame& F, int unit, const bf16* __restrict__ Kg, const bf16* __restrict__ Vg, bf16* Qg, float* MDm, float* MDd) {
    const int tid = F.tid, lane = F.lane, w = F.wave, c32 = lane & 31, hi = lane >> 5;
    const int idx = unit & 31; int t1 = unit >> 5; const int h = t1 & 15; t1 >>= 4; const int b = t1 & 7; const int p = t1 >> 3;
    const int dl = (p == 0) ? 0 : (p == 1 ? 2 : 4);
    const int dil = 1 << dl, nbp = 32 >> dl;
    const int r = idx >> (5 - dl), bp = idx & (nbp - 1);
    const long rowb = (long)b * SEQ;
    LAS unsigned char* lds = F.lds;
    {
        const int rsub = tid >> 3, ch = tid & 7;
        v4u kr[6], vr[6];
#pragma unroll
        for (int i = 0; i < 6; ++i) { const int ki = i * 64 + rsub; const int sidx = bp * 256 - 128 + ki; const bool ok = sidx >= 0;
            const long pos = ok ? ((long)sidx * dil + r) : 0; const size_t off = (size_t)(rowb + pos) * 1024 + h * 64 + ch * 8;
            kr[i] = *(const GAS v4u*)(Kg + off); vr[i] = *(const GAS v4u*)(Vg + off);
            if (!ok) { kr[i] = (v4u){0u, 0u, 0u, 0u}; vr[i] = (v4u){0u, 0u, 0u, 0u}; } }
#pragma unroll
        for (int i = 0; i < 6; ++i) { const int ki = i * 64 + rsub;
            *(LAS v4u*)(lds + ATT_K_OFF + ki * 128 + ((ch ^ ((ki >> 1) & 7)) * 16)) = kr[i];
            *(LAS v4u*)(lds + ATT_V_OFF + (ch >> 2) * (ATT_NK * 64) + ki * 64 + (ch & 3) * 16) = vr[i]; }
    }
    const int qi = 32 * w + c32; const long qrow = rowb + (long)(bp * 256 + qi) * dil + r;
    bf16* qp = Qg + (size_t)qrow * QW + p * 1024 + h * 64;
    bf16x8 qf[4];
#pragma unroll
    for (int d0 = 0; d0 < 4; ++d0) qf[d0] = *(const GAS bf16x8*)(qp + d0 * 16 + hi * 8);
    __syncthreads();
    f32x16 st[5];
#pragma unroll
    for (int kt = 0; kt < 5; ++kt) {
        const int key = 32 * (w + kt) + c32; const LAS unsigned char* kb = lds + ATT_K_OFF + key * 128; const int sw = (key >> 1) & 7;
        f32x16 a = {};
#pragma unroll
        for (int d0 = 0; d0 < 4; ++d0) { const bf16x8 kf = *(const LAS bf16x8*)(kb + (((2 * d0 + hi) ^ sw) * 16)); a = __builtin_amdgcn_mfma_f32_32x32x16_bf16(kf, qf[d0], a, 0, 0, 0); }
        st[kt] = a;
    }
    const int sidx = p * 16 + h; const float sexp = sidx < 32 ? 0.125f * (float)(sidx + 1) : 4.0f + 0.25f * (float)(sidx - 31);
    const float slope2 = exp2f(-sexp) * LOG2E * (float)dil;
    float mx = -1e30f;
#pragma unroll
    for (int kt = 0; kt < 5; ++kt)
#pragma unroll
        for (int rr = 0; rr < 16; ++rr) { const int row = crow(rr, hi); const int step = 128 + c32 - 32 * kt - row; const int ki = 32 * (w + kt) + row;
            const bool valid = (step >= 0) && (step <= 128) && (bp > 0 || ki >= 128);
            const float s = valid ? st[kt][rr] - slope2 * (float)step : -1e30f; st[kt][rr] = s; mx = fmaxf(mx, s); }
    mx = xhalf_max(mx);
    float l = 0.f;
#pragma unroll
    for (int kt = 0; kt < 5; ++kt)
#pragma unroll
        for (int rr = 0; rr < 16; ++rr) { const float e = __builtin_amdgcn_exp2f(st[kt][rr] - mx); st[kt][rr] = e; l += e; }
    l = xhalf_sum(l);
    f32x16 o[2]; o[0] = f32x16{}; o[1] = f32x16{};
    const int lam = lane & 15;
    const unsigned vbase = (unsigned)(uintptr_t)(lds + ATT_V_OFF) + (unsigned)((4 * hi + (lam >> 2)) * 64 + (16 * ((lane >> 4) & 1) + 4 * (lam & 3)) * 2);
#pragma unroll
    for (int kt = 0; kt < 5; ++kt)
#pragma unroll
        for (int s = 0; s < 2; ++s) {
            v4u pw; pw.x = pg8::cvt_pk_bf16(st[kt][8 * s + 0], st[kt][8 * s + 1]); pw.y = pg8::cvt_pk_bf16(st[kt][8 * s + 2], st[kt][8 * s + 3]);
            pw.z = pg8::cvt_pk_bf16(st[kt][8 * s + 4], st[kt][8 * s + 5]); pw.w = pg8::cvt_pk_bf16(st[kt][8 * s + 6], st[kt][8 * s + 7]);
            const bf16x8 pf = __builtin_bit_cast(bf16x8, pw);
#pragma unroll
            for (int dt = 0; dt < 2; ++dt) {
                const unsigned a = vbase + (unsigned)(dt * (ATT_NK * 64) + (32 * (w + kt) + 16 * s) * 64);
                const s16x4 lo = vtr(a), hi4 = vtr(a + 8 * 64);
                const bf16x8 vf = (bf16x8){lo[0], lo[1], lo[2], lo[3], hi4[0], hi4[1], hi4[2], hi4[3]};
                o[dt] = __builtin_amdgcn_mfma_f32_32x32x16_bf16(vf, pf, o[dt], 0, 0, 0);
            }
        }
    const float inv = 1.0f / l;
#pragma unroll
    for (int dt = 0; dt < 2; ++dt)
#pragma unroll
        for (int g = 0; g < 4; ++g) { v2u ow; ow.x = pg8::cvt_pk_bf16(o[dt][4 * g] * inv, o[dt][4 * g + 1] * inv); ow.y = pg8::cvt_pk_bf16(o[dt][4 * g + 2] * inv, o[dt][4 * g + 3] * inv);
            *(GAS v2u*)(qp + 32 * dt + 8 * g + 4 * hi) = ow; }
    if (hi == 0) { const size_t mi = ((size_t)p * T + (size_t)qrow) * 16 + h; MDm[mi] = mx; MDd[mi] = l; }
    __syncthreads();
}

constexpr int PB_AIN_PITCH = 272, PB_POOL_OFF = 40960, PB_POOL_PITCH = 528;
__device__ __forceinline__ void pool_merge_unit(Frame& F, int unit, const bf16* AIN, const bf16* Wpt, const bf16* OP, const bf16* Gt, const float* MDm, const float* MDd, bf16* MERGED) {
    const int tid = F.tid, lane = F.lane, w = F.wave, c32 = lane & 31, hi = lane >> 5;
    const int g = unit & 3, tile = unit >> 2, t0 = tile * 128, tin = t0 & (SEQ - 1), win = 2 << g;
    LAS unsigned char* lds = F.lds;
    for (int id = tid; id < 143 * 16; id += NWAVES * 64) { const int rr = id >> 4, ch = id & 15; v4u v = (v4u){0u, 0u, 0u, 0u};
        if (tin - 15 + rr >= 0) v = *(const GAS v4u*)(AIN + (size_t)(t0 - 15 + rr) * POOLW + g * 128 + ch * 8);
        *(LAS v4u*)(lds + rr * PB_AIN_PITCH + ch * 16) = v; }
    __syncthreads();
    {
        const int tq = w & 3, oh = w >> 2, tokl = 32 * tq + c32;
        const int cnt = (tin + tokl + 1) < win ? (tin + tokl + 1) : win; const float rc = 1.0f / (float)cnt;
        f32x16 acc[4]; acc[0] = f32x16{}; acc[1] = f32x16{}; acc[2] = f32x16{}; acc[3] = f32x16{};
        const bf16* wp = Wpt + (size_t)(g * 256 + oh * 128 + c32) * 128 + 8 * hi;
#pragma unroll 1
        for (int ks = 0; ks < 8; ++ks) {
            const LAS unsigned char* ap = lds + (15 + tokl) * PB_AIN_PITCH + (16 * ks + 8 * hi) * 2;
            const v4u own = *(const LAS v4u*)ap;
            float s[8] = {0.f, 0.f, 0.f, 0.f, 0.f, 0.f, 0.f, 0.f};
            for (int i = 0; i < win; ++i) { const v4u a = *(const LAS v4u*)(ap - i * PB_AIN_PITCH);
                s[0] += bflo(a.x); s[1] += bfhi(a.x); s[2] += bflo(a.y); s[3] += bfhi(a.y); s[4] += bflo(a.z); s[5] += bfhi(a.z); s[6] += bflo(a.w); s[7] += bfhi(a.w); }
            v4u dw; dw.x = pg8::cvt_pk_bf16(s[0] * rc - bflo(own.x), s[1] * rc - bfhi(own.x)); dw.y = pg8::cvt_pk_bf16(s[2] * rc - bflo(own.y), s[3] * rc - bfhi(own.y));
            dw.z = pg8::cvt_pk_bf16(s[4] * rc - bflo(own.z), s[5] * rc - bfhi(own.z)); dw.w = pg8::cvt_pk_bf16(s[6] * rc - bflo(own.w), s[7] * rc - bfhi(own.w));
            const bf16x8 df = __builtin_bit_cast(bf16x8, dw);
#pragma unroll
            for (int mt = 0; mt < 4; ++mt) { const bf16x8 wf = *(const GAS bf16x8*)(wp + (size_t)(32 * mt) * 128 + 16 * ks); acc[mt] = __builtin_amdgcn_mfma_f32_32x32x16_bf16(wf, df, acc[mt], 0, 0, 0); }
        }
#pragma unroll
        for (int mt = 0; mt < 4; ++mt)
#pragma unroll
            for (int gq = 0; gq < 4; ++gq) { v2u ow; ow.x = pg8::cvt_pk_bf16(acc[mt][4 * gq], acc[mt][4 * gq + 1]); ow.y = pg8::cvt_pk_bf16(acc[mt][4 * gq + 2], acc[mt][4 * gq + 3]);
                *(LAS v2u*)(lds + PB_POOL_OFF + tokl * PB_POOL_PITCH + (oh * 128 + 32 * mt + 8 * gq + 4 * hi) * 2) = ow; }
    }
    __syncthreads();
#pragma unroll 1
    for (int pass = 0; pass < 8; ++pass) {
        const int id = pass * 512 + tid, tok = id >> 5, cc = id & 31, col = g * 256 + 8 * cc, head = col >> 6; const size_t row = (size_t)t0 + tok;
        float m[3], dn[3];
#pragma unroll
        for (int p = 0; p < 3; ++p) { const size_t mi = ((size_t)p * T + row) * 16 + head; m[p] = MDm[mi]; dn[p] = MDd[mi]; }
        const float M = fmaxf(fmaxf(m[0], m[1]), m[2]);
        float wgt[3]; float ws_ = 0.f;
#pragma unroll
        for (int p = 0; p < 3; ++p) { wgt[p] = dn[p] * __builtin_amdgcn_exp2f(m[p] - M); ws_ += wgt[p]; }
        const float iw = 1.0f / ws_;
        const v4u o0 = *(const GAS v4u*)(OP + row * QW + col), o1 = *(const GAS v4u*)(OP + row * QW + 1024 + col), o2 = *(const GAS v4u*)(OP + row * QW + 2048 + col);
        const v4u g0 = *(const GAS v4u*)(Gt + row * GATEW + col), g1 = *(const GAS v4u*)(Gt + row * GATEW + 1024 + col);
        const v4u pl = *(const LAS v4u*)(lds + PB_POOL_OFF + tok * PB_POOL_PITCH + cc * 16);
        const float w0 = wgt[0] * iw, w1 = wgt[1] * iw, w2 = wgt[2] * iw;
        v4u res;
#define MRG(f) { const float alo = w0 * bflo(o0.f) + w1 * bflo(o1.f) + w2 * bflo(o2.f), ahi = w0 * bfhi(o0.f) + w1 * bfhi(o1.f) + w2 * bfhi(o2.f); \
                 res.f = pg8::cvt_pk_bf16(bflo(g0.f) * bflo(pl.f) + bflo(g1.f) * alo, bfhi(g0.f) * bfhi(pl.f) + bfhi(g1.f) * ahi); }
        MRG(x) MRG(y) MRG(z) MRG(w)
#undef MRG
        *(GAS v4u*)(MERGED + row * DM + col) = res;
    }
    __syncthreads();
}

constexpr int P5_LIST_OFF = 0, P5_RING_OFF = 65536, P5_RING_WAVE = 10240, P5_NSLOT = 5, P5_TL_OFF = 147456, P5_S2_OFF = 155648, P5_SH_OFF = 155904, P5_CNT_OFF = 147456  ;
constexpr int P5_DUMMY_OFF = 158720;
constexpr float P5_GSCALE = 1024.0f;
__device__ __forceinline__ float gelu_tanh(float x) {
    const float z = 0.7978845608028654f * (x + 0.044715f * x * x * x);
    const float e = __builtin_amdgcn_exp2f(2.0f * LOG2E * z);
    const float th = 1.0f - 2.0f * __builtin_amdgcn_rcpf(1.0f + e);
    return 0.5f * x * (1.0f + th);
}
__device__ __forceinline__ void peer_stage_a(Frame& F, int t0, int hh, const bf16* QP, const bf16* SKB, const float* SU, const float* SV) {
    int lane = F.lane; asm volatile("" : "+v"(lane));
    const int w = F.wave, c32 = lane & 31, hi = lane >> 5;
    LAS unsigned char* lds = F.lds;
    const LAS float* s2l = (const LAS float*)(lds + P5_S2_OFF);
    float tops[2][16];
#pragma unroll
    for (int p = 0; p < 2; ++p) {
        f32x16 acc[4]; acc[0] = f32x16{}; acc[1] = f32x16{}; acc[2] = f32x16{}; acc[3] = f32x16{};
        const bf16* qrow = QP + (size_t)(t0 + 32 * hh + c32) * 2048 + (w * 2 + p) * 128 + 8 * hi;
        const bf16* skp = SKB + (size_t)((w * 2 + p) * 128 + c32) * 128 + 8 * hi;
#pragma unroll 2
        for (int ks = 0; ks < 8; ++ks) { const bf16x8 bq = *(const GAS bf16x8*)(qrow + 16 * ks);
#pragma unroll
            for (int mt = 0; mt < 4; ++mt) { const bf16x8 a = *(const GAS bf16x8*)(skp + (size_t)(32 * mt) * 128 + 16 * ks); acc[mt] = __builtin_amdgcn_mfma_f32_32x32x16_bf16(a, bq, acc[mt], 0, 0, 0); } }
#pragma unroll
        for (int mt = 0; mt < 4; ++mt)
#pragma unroll
            for (int rr = 0; rr < 16; ++rr) acc[mt][rr] = __uint_as_float((__float_as_uint(acc[mt][rr]) & ~127u) | (unsigned)(32 * mt + crow(rr, hi)));
#pragma unroll
        for (int k = 0; k < 16; ++k) {
            float m = acc[0][0];
#pragma unroll
            for (int mt = 0; mt < 4; ++mt)
#pragma unroll
                for (int rr = 0; rr < 16; ++rr) m = fmaxf(m, acc[mt][rr]);
            m = xhalf_max(m);
            tops[p][k] = m;
#pragma unroll
            for (int mt = 0; mt < 4; ++mt)
#pragma unroll
                for (int rr = 0; rr < 16; ++rr) acc[mt][rr] = (acc[mt][rr] == m) ? -3.0e38f : acc[mt][rr];
        }
    }
    {
        v4u tb; unsigned b_[16];
#pragma unroll
        for (int k = 0; k < 16; ++k) b_[k] = __float_as_uint(hi ? tops[1][k] : tops[0][k]) & 127u;
        tb.x = b_[0] | (b_[1] << 8) | (b_[2] << 16) | (b_[3] << 24); tb.y = b_[4] | (b_[5] << 8) | (b_[6] << 16) | (b_[7] << 24);
        tb.z = b_[8] | (b_[9] << 8) | (b_[10] << 16) | (b_[11] << 24); tb.w = b_[12] | (b_[13] << 8) | (b_[14] << 16) | (b_[15] << 24);
        *(LAS v4u*)(lds + P5_TL_OFF + ((c32 * 8 + w) * 2 + hi) * 16) = tb;
    }
    float cv[25];
    {
        int c = 0;
#pragma unroll
        for (int i = 0; i < 16; ++i)
#pragma unroll
            for (int j = 0; j < 16; ++j)
                if ((i + 1) * (j + 1) <= 16) {
                    const float val = tops[0][i] + tops[1][j];
                    const float pk = __uint_as_float((__float_as_uint(val) & ~255u) | (unsigned)(i * 16 + j));
                    if ((c & 1) == 0) cv[c >> 1] = pk; else cv[c >> 1] = hi ? pk : cv[c >> 1];
                    ++c;
                }
    }
    float best[16];
#pragma unroll
    for (int k = 0; k < 16; ++k) {
        float m = cv[0];
#pragma unroll
        for (int s = 1; s < 25; ++s) m = fmaxf(m, cv[s]);
        m = xhalf_max(m);
        best[k] = m;
#pragma unroll
        for (int s = 0; s < 25; ++s) cv[s] = (cv[s] == m) ? -3.0e38f : cv[s];
    }
    const int tokc = 32 * hh + c32;
    const float s2v = s2l[tokc] * LOG2E;
    float ge[16]; float gs = 0.f;
#pragma unroll
    for (int k = 0; k < 16; ++k) { ge[k] = __builtin_amdgcn_exp2f((best[k] - best[0]) * s2v); gs += ge[k]; }
    const float gi = 1.0f / gs;
    asm volatile("s_waitcnt lgkmcnt(0)" ::: "memory");
    const LAS unsigned char* tl0 = lds + P5_TL_OFF + ((c32 * 8 + w) * 2) * 16;
    LAS v2u* lst = (LAS v2u*)(lds + P5_LIST_OFF) + (tokc >> 3) * 1024 + (tokc & 7) * 128 + w * 16 + 8 * hi;
#pragma unroll
    for (int k = 0; k < 8; ++k) {
        const float bsel = hi ? best[k + 8] : best[k]; const float gsel = (hi ? ge[k + 8] : ge[k]) * gi;
        const unsigned code = __float_as_uint(bsel) & 255u; const unsigned e0 = tl0[code >> 4], e1 = tl0[16 + (code & 15u)];
        const unsigned e = e0 * 128u + e1;
        const unsigned g16 = (unsigned)__builtin_bit_cast(unsigned short, (_Float16)(gsel * SV[e] * P5_GSCALE)) & 0x7fffu;
        v2u ent; ent.x = (e << 18) | ((unsigned)(tokc & 7) << 15) | g16; ent.y = __float_as_uint(SU[e]);
        lst[k] = ent;
    }
}
#define P5_BODY(S) { int d_ = 0; \
        d_ = __builtin_amdgcn_sdot4((int)uq.x, (int)hq[S].x, d_, false); d_ = __builtin_amdgcn_sdot4((int)uq.y, (int)hq[S].y, d_, false); \
        d_ = __builtin_amdgcn_sdot4((int)uq.z, (int)hq[S].z, d_, false); d_ = __builtin_amdgcn_sdot4((int)uq.w, (int)hq[S].w, d_, false); \
        d_ += dppi<0xB1>(d_); d_ += dppi<0x4E>(d_); d_ += dppi<0x141>(d_); d_ += dppi<0x140>(d_);              \
        d_ += __builtin_amdgcn_update_dpp(0, d_, 0x142, 0xA, 0xF, false); d_ += __builtin_amdgcn_update_dpp(0, d_, 0x143, 0xC, 0xF, false);     \
        const float x_ = (float)__builtin_amdgcn_readlane(d_, 63) * (su * kx[S]); \
        const float t_ = x_ * fmaf(x_ * x_, -0.10294324f, -2.30220819f);                                        \
        const float cf = gate * x_ * __builtin_amdgcn_rcpf(1.0f + __builtin_amdgcn_exp2f(t_)); \
        _Pragma("unroll") for (int j_ = 0; j_ < 4; ++j_) { const f32x2v lo_ = __builtin_amdgcn_cvt_pk_f32_fp8((int)vq[j_], false), hi_ = __builtin_amdgcn_cvt_pk_f32_fp8((int)vq[j_], true); \
        acc[S][4 * j_ + 0] = fmaf(cf, lo_.x, acc[S][4 * j_ + 0]); acc[S][4 * j_ + 1] = fmaf(cf, lo_.y, acc[S][4 * j_ + 1]); \
        acc[S][4 * j_ + 2] = fmaf(cf, hi_.x, acc[S][4 * j_ + 2]); acc[S][4 * j_ + 3] = fmaf(cf, hi_.y, acc[S][4 * j_ + 3]); } }
typedef float f32x2v __attribute__((ext_vector_type(2)));
__device__ __forceinline__ void peer_unit(Frame& F, int unit, const bf16* QP, const bf16* SKB, const unsigned char* UQ, const unsigned char* VQ, const float* SU, const float* SV, float* out) {
    int lane = F.lane; asm volatile("" : "+v"(lane));
    const int w = F.wave;
    const int t0 = unit * 64;
    LAS unsigned char* lds = F.lds;
    LAS float* s2l = (LAS float*)(lds + P5_S2_OFF); LAS float* shl = (LAS float*)(lds + P5_SH_OFF);
#pragma unroll 1
    for (int i = 0; i < 8; ++i) { const int tok = 8 * w + i; const GAS f32x4* xr = (const GAS f32x4*)(out + (size_t)(t0 + tok) * DM) + lane; float s = 0.f, mx = 0.f;
#pragma unroll
        for (int j = 0; j < 4; ++j) { const f32x4 v = xr[64 * j]; s += (v.x * v.x + v.y * v.y) + (v.z * v.z + v.w * v.w);
            mx = fmaxf(mx, fmaxf(fmaxf(fabsf(v.x), fabsf(v.y)), fmaxf(fabsf(v.z), fabsf(v.w)))); }
        s = wave_sum_dpp(s); mx = wave_max_dpp(mx);
        if (lane == 0) { s2l[tok] = 1.0f / sqrtf(s * (1.0f / 1024.0f) + EPS); shl[tok] = mx > 0.f ? mx * (1.0f / 127.0f) : 1.0f; } }
    __syncthreads();
#pragma unroll 1
    for (int hh = 0; hh < 2; ++hh) { peer_stage_a(F, t0, hh, QP, SKB, SU, SV); __syncthreads(); }
    lane = F.lane; asm volatile("" : "+v"(lane));
    LAS v2u* lw = (LAS v2u*)(lds + P5_LIST_OFF) + w * 1024;
    LAS unsigned* cnt = (LAS unsigned*)(lds + P5_CNT_OFF) + w * 256;
    {
        v2u e16[16];
#pragma unroll
        for (int i = 0; i < 16; ++i) e16[i] = lw[64 * i + lane];
        *(LAS v4u*)(cnt + 4 * lane) = (v4u){0u, 0u, 0u, 0u};
        asm volatile("s_waitcnt lgkmcnt(0)" ::: "memory");
        unsigned rk[16];
#pragma unroll
        for (int i = 0; i < 16; ++i) { const unsigned bin = ((e16[i].x >> 26) << 3) | ((e16[i].x >> 15) & 7u); const unsigned sh = (bin & 1u) * 16u;
            const unsigned old = __hip_atomic_fetch_add(cnt + (bin >> 1), 1u << sh, __ATOMIC_RELAXED, __HIP_MEMORY_SCOPE_WORKGROUP); rk[i] = (old >> sh) & 0xffffu; }
        asm volatile("s_waitcnt lgkmcnt(0)" ::: "memory");
        const v4u cw = *(const LAS v4u*)(cnt + 4 * lane);
        unsigned c8[8] = {cw.x & 0xffffu, cw.x >> 16, cw.y & 0xffffu, cw.y >> 16, cw.z & 0xffffu, cw.z >> 16, cw.w & 0xffffu, cw.w >> 16};
        unsigned tot = 0;
#pragma unroll
        for (int k = 0; k < 8; ++k) tot += c8[k];
        unsigned incl = tot;
#pragma unroll
        for (int o = 1; o < 64; o <<= 1) { const unsigned t = (unsigned)__shfl_up((int)incl, o); if (lane >= o) incl += t; }
        unsigned run = incl - tot; unsigned st[8];
#pragma unroll
        for (int k = 0; k < 8; ++k) { st[k] = run; run += c8[k]; }
        asm volatile("s_waitcnt lgkmcnt(0)" ::: "memory");
        *(LAS v4u*)(cnt + 4 * lane) = (v4u){st[0] | (st[1] << 16), st[2] | (st[3] << 16), st[4] | (st[5] << 16), st[6] | (st[7] << 16)};
        asm volatile("s_waitcnt lgkmcnt(0)" ::: "memory");
#pragma unroll
        for (int i = 0; i < 16; ++i) { const unsigned bin = ((e16[i].x >> 26) << 3) | ((e16[i].x >> 15) & 7u);
            const unsigned base = (cnt[bin >> 1] >> ((bin & 1u) * 16u)) & 0xffffu; lw[base + rk[i]] = e16[i]; }
        asm volatile("s_waitcnt lgkmcnt(0)" ::: "memory");
    }
    lane = F.lane; asm volatile("" : "+v"(lane));
    v4u hq[8]; float kx[8];
#pragma unroll
    for (int s = 0; s < 8; ++s) { const int tok = 8 * w + s; const GAS f32x4* xr = (const GAS f32x4*)(out + (size_t)(t0 + tok) * DM) + lane; f32x4 v[4];
#pragma unroll
        for (int j = 0; j < 4; ++j) v[j] = xr[64 * j];
        const float sh = shl[tok]; hq[s] = quant16(v, 1.0f / sh, 0); kx[s] = sh * s2l[tok]; }
    float acc[8][16];
#pragma unroll
    for (int s = 0; s < 8; ++s)
#pragma unroll
        for (int j = 0; j < 16; ++j) acc[s][j] = 0.f;
    asm volatile("s_waitcnt vmcnt(0)" ::: "memory");
    LAS unsigned char* ring = lds + P5_RING_OFF + w * P5_RING_WAVE;
    const unsigned char* uvgl = UQ + 16 * lane;
#define P5_ISSUE(idx, slot_) { const v2u en_ = lw[(idx) & 1023]; const unsigned e_ = (unsigned)__builtin_amdgcn_readfirstlane((int)en_.x) >> 18; \
        const unsigned* gp_ = (const unsigned*)(uvgl + (size_t)e_ * 2048); \
        __builtin_amdgcn_global_load_lds(gp_, (LAS unsigned*)(ring + (slot_) * 2048), 16, 0, 0); \
        __builtin_amdgcn_global_load_lds(gp_, (LAS unsigned*)(ring + (slot_) * 2048), 16, 1024, 0); }
#pragma unroll
    for (int i = 0; i < P5_NSLOT; ++i) P5_ISSUE(i, i)
    int slot = 0, i = 0;
    const unsigned xw = (unsigned)(((blockIdx.x >> 3) & 31) * 8 + w);
#define P5_PAIR(S) { const v2u ent = lw[i]; \
        const unsigned key = (unsigned)__builtin_amdgcn_readfirstlane((int)ent.x); const float su = __uint_as_float((unsigned)__builtin_amdgcn_readfirstlane((int)ent.y)); \
        asm volatile("s_waitcnt vmcnt(8)" ::: "memory"); \
        const v4u uq = *(const LAS v4u*)(ring + slot * 2048 + 16 * lane), vq = *(const LAS v4u*)(ring + slot * 2048 + 1024 + 16 * lane); \
        asm volatile("s_waitcnt lgkmcnt(0)" ::: "memory"); \
        P5_ISSUE(i + P5_NSLOT, slot) \
        slot = (slot == P5_NSLOT - 1) ? 0 : slot + 1; \
        const float gate = (float)__builtin_bit_cast(_Float16, (unsigned short)(key & 0x7fffu)); \
        P5_BODY(S) }
#pragma unroll 1
    for (int b = 0; b < 64; ++b) {
        {
            const unsigned pe = (unsigned)(((b + 2) & 63) * 256) + xw;
            const unsigned* gp = (const unsigned*)(uvgl + (size_t)pe * 2048);
            __builtin_amdgcn_global_load_lds(gp, (LAS unsigned*)(lds + P5_DUMMY_OFF), 16, 0, 0);
            __builtin_amdgcn_global_load_lds(gp, (LAS unsigned*)(lds + P5_DUMMY_OFF), 16, 1024, 0); }
        const v4u sw = *(const LAS v4u*)(cnt + 4 * b);
        const unsigned w0 = (unsigned)__builtin_amdgcn_readfirstlane((int)sw.x), w1 = (unsigned)__builtin_amdgcn_readfirstlane((int)sw.y), w2 = (unsigned)__builtin_amdgcn_readfirstlane((int)sw.z), w3 = (unsigned)__builtin_amdgcn_readfirstlane((int)sw.w);
        const unsigned nb = (b == 63) ? 1024u : ((unsigned)__builtin_amdgcn_readfirstlane((int)cnt[4 * b + 4]) & 0xffffu);
        const int e0 = (int)(w0 >> 16), e1 = (int)(w1 & 0xffffu), e2 = (int)(w1 >> 16), e3 = (int)(w2 & 0xffffu), e4 = (int)(w2 >> 16), e5 = (int)(w3 & 0xffffu), e6 = (int)(w3 >> 16), e7 = (int)nb;
#pragma unroll 1
        for (; i < e0; ++i) P5_PAIR(0)
#pragma unroll 1
        for (; i < e1; ++i) P5_PAIR(1)
#pragma unroll 1
        for (; i < e2; ++i) P5_PAIR(2)
#pragma unroll 1
        for (; i < e3; ++i) P5_PAIR(3)
#pragma unroll 1
        for (; i < e4; ++i) P5_PAIR(4)
#pragma unroll 1
        for (; i < e5; ++i) P5_PAIR(5)
#pragma unroll 1
        for (; i < e6; ++i) P5_PAIR(6)
#pragma unroll 1
        for (; i < e7; ++i) P5_PAIR(7)
    }
#undef P5_PAIR
    asm volatile("s_waitcnt vmcnt(0)" ::: "memory");
    lane = F.lane; asm volatile("" : "+v"(lane));
#pragma unroll
    for (int s = 0; s < 8; ++s) { GAS f32x4* orow = (GAS f32x4*)(out + (size_t)(t0 + 8 * w + s) * DM) + lane;
#pragma unroll
        for (int j = 0; j < 4; ++j) { f32x4 a = orow[64 * j]; const float c = 1.0f / P5_GSCALE;
            a.x += acc[s][4 * j] * c; a.y += acc[s][4 * j + 1] * c; a.z += acc[s][4 * j + 2] * c; a.w += acc[s][4 * j + 3] * c; orow[64 * j] = a; } }
    __syncthreads();
}
#undef P5_ISSUE
#undef P5_BODY

#ifndef MK_N_LAUNCHES
#define MK_N_LAUNCHES 1
#endif
constexpr int N_LAUNCHES = MK_N_LAUNCHES;
constexpr int PER_PHASE = 7;
struct Args { const float* in[13]; float* out; unsigned char* ws; int ph_lo, ph_hi; };
__global__ void __launch_bounds__(NWAVES * 64, 2) fwd_megakernel(Args args) {
    extern __shared__ __attribute__((aligned(16))) unsigned char lds[];
    Frame F;
    F.lds = (LAS unsigned char*)lds;
    F.MISC = (volatile LAS unsigned*)(F.lds + MISC_OFF);
    F.tid = threadIdx.x; F.lane = F.tid & 63; F.wave = __builtin_amdgcn_readfirstlane(F.tid >> 6);
    F.G = gridDim.x;
    unsigned char* ws = args.ws; F.ws = ws;
    F.ctl = (gu32*)(ws + WS_CTL);
    F.x = args.in[0]; F.norm1_g = args.in[1]; F.w_in = args.in[2]; F.q_norm_g = args.in[3]; F.k_norm_g = args.in[4]; F.w_pool = args.in[5]; F.pool_scale = args.in[6];
    F.w_out = args.in[7]; F.norm2_g = args.in[8]; F.w_query = args.in[9]; F.sub_keys = args.in[10]; F.expert_u = args.in[11]; F.expert_v = args.in[12]; F.out = args.out;
    for (int u = F.tid; u < (LDS_BYTES - LDSCTL_OFF) / 4; u += NWAVES * 64) ((LAS unsigned*)(F.lds + LDSCTL_OFF))[u] = 0u;
    __syncthreads();
    XcdBarrier bar; bar.bar = (unsigned*)(F.ctl + CW_BAR); bar.x = 0; bar.st = nullptr;
    if (N_LAUNCHES == 1) bar = xcd_barrier_post((unsigned*)(F.ctl + CW_BAR), F.MISC + 8);
#define GRID_BAR() do { if (N_LAUNCHES == 1) xcd_barrier(bar); } while (0)
    const int lo = args.ph_lo, hi = args.ph_hi;
#define IN(k) (lo <= (k) && (k) < hi)
    bf16* const XB = (bf16*)(ws + WS_XB); bf16* const W1T = (bf16*)(ws + WS_W1T); bf16* const WOT = (bf16*)(ws + WS_WOT); bf16* const WQT = (bf16*)(ws + WS_WQT);
    bf16* const AIN = (bf16*)(ws + WS_AIN); bf16* const Qb = (bf16*)(ws + WS_Q); bf16* const Gb = (bf16*)(ws + WS_G);
    bf16* const Kb = (bf16*)args.out; bf16* const Vb = (bf16*)args.out + (size_t)T * DM;
    float* const MDm = (float*)(ws + WS_MD); float* const MDd = MDm + (size_t)3 * T * 16;
    bf16* const MERGED = XB; bf16* const HB = (bf16*)(ws + WS_HB); bf16* const QP = Gb;

    if (IN(0)) { p0_prologue(F); GRID_BAR(); }
    if (IN(1)) {
        pg8::Gemm g{XB, W1T, T, INW, DM}; pg8::StaticOrder S; S.init(T, INW, F.G, (int)blockIdx.x);
        pg8::EpiProj E{AIN, Qb, Kb, Vb, Gb, (const float*)(ws + WS_S1), F.q_norm_g, F.k_norm_g};
        pg8::gemm_phase<pg8::EpiProj, pg8::StaticOrder, true, true>(F.lds + RING_OFF, g, S, E);
        GRID_BAR();
    }
    if (IN(2)) {
        constexpr int NU = 3 * BATCH * 16 * 32; const int per = (NU + F.G - 1) / F.G; const int u0 = blockIdx.x * per, u1 = (u0 + per) < NU ? (u0 + per) : NU;
        for (int u = u0; u < u1; ++u) attn_unit(F, u, Kb, Vb, Qb, MDm, MDd);
        GRID_BAR();
    }
    if (IN(3)) {
        constexpr int NU = (T / 128) * 4; const int per = (NU + F.G - 1) / F.G; const int u0 = blockIdx.x * per, u1 = (u0 + per) < NU ? (u0 + per) : NU;
        for (int u = u0; u < u1; ++u) pool_merge_unit(F, u, AIN, (const bf16*)(ws + WS_WPT), Qb, Gb, MDm, MDd, MERGED);
        GRID_BAR();
    }
    if (IN(4)) {
        pg8::Gemm g{MERGED, WOT, T, DM, DM}; pg8::StaticOrder S; S.init(T, DM, F.G, (int)blockIdx.x);
        pg8::EpiOut E{F.x, F.out, HB};
        pg8::gemm_phase<pg8::EpiOut, pg8::StaticOrder, true, true>(F.lds + RING_OFF, g, S, E);
        GRID_BAR();
    }
    if (IN(5)) {
        pg8::Gemm g{HB, WQT, T, 2048, DM}; pg8::StaticOrder S; S.init(T, 2048, F.G, (int)blockIdx.x);
        pg8::EpiPlain E{QP, 2048};
        pg8::gemm_phase<pg8::EpiPlain, pg8::StaticOrder, true, true>(F.lds + RING_OFF, g, S, E);
        GRID_BAR();
    }
    if (IN(6)) {
        constexpr int NU = T / 64; const int per = (NU + F.G - 1) / F.G; const int u0 = blockIdx.x * per, u1 = (u0 + per) < NU ? (u0 + per) : NU;
        for (int u = u0; u < u1; ++u) peer_unit(F, u, QP, (const bf16*)(ws + WS_SKB), ws + WS_UB, ws + WS_VB, (const float*)(ws + WS_SU), (const float*)(ws + WS_SV), F.out);
    }
#undef IN
#undef GRID_BAR
}

extern "C" void kernel_launch(void* const* d_in, const int* in_sizes, int n_in, void* d_out, int out_size, void* d_ws, size_t ws_size, hipStream_t stream) {
    static int grid = 0;
    if (grid == 0) {
        if (n_in != 13 || in_sizes[0] != T * DM || out_size != T * DM || ws_size < WS_END) {
            fprintf(stderr, "kernel_launch: unexpected shapes (n_in %d, in0 %d, out %d, ws %zu, need %zu); nothing launched\n", n_in, n_in > 0 ? in_sizes[0] : -1, out_size, ws_size, (size_t)WS_END); grid = -1; return; }
        int dev = 0, cus = 0, per_cu = 0;
        if (hipGetDevice(&dev) != hipSuccess || hipDeviceGetAttribute(&cus, hipDeviceAttributeMultiprocessorCount, dev) != hipSuccess) { grid = -1; return; }
        if (hipFuncSetAttribute((const void*)fwd_megakernel, hipFuncAttributeMaxDynamicSharedMemorySize, LDS_BYTES) != hipSuccess) { fprintf(stderr, "kernel_launch: hipFuncSetAttribute failed\n"); grid = -1; return; }
        if (hipOccupancyMaxActiveBlocksPerMultiprocessor(&per_cu, (const void*)fwd_megakernel, NWAVES * 64, LDS_BYTES) != hipSuccess || per_cu < 1) { fprintf(stderr, "kernel_launch: occupancy query reports %d workgroups per CU\n", per_cu); grid = -1; (void)hipGetLastError(); return; }
        (void)hipGetLastError();
        grid = cus;
    }
    if (grid < 0) return;
    if (hipMemsetAsync((char*)d_ws + WS_CTL, 0, CTL_ZERO_BYTES, stream) != hipSuccess) return;
    Args a{};
    for (int i = 0; i < 13; ++i) a.in[i] = (const float*)d_in[i];
    a.out = (float*)d_out; a.ws = (unsigned char*)d_ws;
    for (int li = 0; li < N_LAUNCHES; ++li) {
        a.ph_lo = (N_LAUNCHES == 1) ? 0 : li; a.ph_hi = (N_LAUNCHES == 1) ? PER_PHASE : li + 1;
        hipLaunchKernelGGL(fwd_megakernel, dim3(grid), dim3(NWAVES * 64), LDS_BYTES, stream, a);
    }
}
```

```cpp
#include <hip/hip_runtime.h>
#include <cstdio>
#include <cstdint>
namespace pg8 {
#define PG8_LAS __attribute__((address_space(3)))
typedef unsigned short bf16_t;
typedef short bf16x8 __attribute__((ext_vector_type(8)));
typedef float f32x4 __attribute__((ext_vector_type(4)));
typedef unsigned u32x4 __attribute__((ext_vector_type(4)));
constexpr int BM = 256, BK = 64, HALF = 128, HTB = HALF * BK * 2  , STAGE_BYTES = 8 * HTB, NXCD = 8, WGM = 8;

__host__ __device__ __forceinline__ int lds_byte(int r, int c) { const int st = (r >> 4) * 2 + (c >> 5), rr = r & 15, cc = c & 31, ob = rr * 64 + cc * 2; return st * 1024 + (ob ^ (((ob >> 9) & 1) << 5)); }
__host__ __device__ __forceinline__ void stage_rc(int b, int& R, int& C) { const int st = b / 1024, sb = b % 1024, swz = sb ^ (((sb >> 9) & 1) << 5); R = (st >> 1) * 16 + swz / 64; C = (st & 1) * 32 + (swz % 64) / 2; }
__host__ __device__ __forceinline__ int perm32(int rho) { const int n = rho >> 4, i = rho & 15; return 8 * (i >> 2) + 4 * n + (i & 3); }

struct Unit { int pm, pn; };
struct Gemm { const bf16_t* A; const bf16_t* Bt; int M, N, K; };

struct StaticOrder {
    int nM, nN, nwg, G, c;
    __host__ __device__ void init(int M, int N, int G_, int c_) { nM = M / BM; nN = N / BM; nwg = nM * nN; G = G_; c = c_; }
    __host__ __device__ bool next(int i, Unit& u) const {
        const long L = (long)i * G + c; if (L >= nwg) return false;
        int wgid = (int)L; { const int q = nwg / NXCD, r = nwg % NXCD, xcd = wgid % NXCD, off = wgid / NXCD; wgid = (xcd < r ? xcd * (q + 1) : r * (q + 1) + (xcd - r) * q) + off; }
        const int nig = WGM * nN, gid = wgid / nig, fm = gid * WGM, gsz = (nM - fm) < WGM ? (nM - fm) : WGM;
        u.pm = fm + ((wgid % nig) % gsz); u.pn = (wgid % nig) / gsz; return true;
    }
    __device__ __forceinline__ void a_ready(const Unit&) const {}
    __device__ __forceinline__ void done(const Unit&) const {}
};
__device__ __forceinline__ unsigned cvt_pk_bf16(float lo, float hi) { unsigned r; asm volatile("v_cvt_pk_bf16_f32 %0, %1, %2" : "=v"(r) : "v"(lo), "v"(hi)); return r; }

typedef float f32x2 __attribute__((ext_vector_type(2)));
__device__ __forceinline__ float xrow16_sum(float x) {
    auto s = __builtin_amdgcn_permlane16_swap(__float_as_uint(x), __float_as_uint(x), false, false);
    x = __uint_as_float(s[0]) + __uint_as_float(s[1]);
    auto t = __builtin_amdgcn_permlane32_swap(__float_as_uint(x), __float_as_uint(x), false, false);
    return __uint_as_float(t[0]) + __uint_as_float(t[1]);
}
struct EpiPlain {
    static constexpr bool PERM = true, AFTER_DRAIN = false;
    bf16_t* O; int ldc;
    __device__ __forceinline__ void operator()(const f32x4 (&acc)[2][2][4][2], const Unit& u, int wr, int wc, int fr, int fq) const {
        const int row0 = u.pm * BM + wr * 64 + fr; const int col0 = u.pn * BM + wc * 32 + 8 * fq;
#pragma unroll
        for (int ai = 0; ai < 2; ++ai)
#pragma unroll
            for (int m = 0; m < 4; ++m) { bf16_t* rowp = O + (size_t)(row0 + ai * HALF + m * 16) * ldc + col0;
#pragma unroll
                for (int bj = 0; bj < 2; ++bj) { const f32x4 v0 = acc[ai][bj][m][0], v1 = acc[ai][bj][m][1];
                    u32x4 w; w.x = cvt_pk_bf16(v0[0], v0[1]); w.y = cvt_pk_bf16(v0[2], v0[3]); w.z = cvt_pk_bf16(v1[0], v1[1]); w.w = cvt_pk_bf16(v1[2], v1[3]);
                    *(u32x4*)(rowp + bj * HALF) = w; } }
    }
};
struct EpiProj {
    static constexpr bool PERM = true, AFTER_DRAIN = false;
    bf16_t *AIN, *Q, *K, *V, *G; const float* s1; const float* qg; const float* kg;
    __device__ __forceinline__ void operator()(const f32x4 (&acc)[2][2][4][2], const Unit& u, int wr, int wc, int fr, int fq) const {
        const int pn = u.pn; int type, ldc, colt; bf16_t* base;
        if (pn < 2)       { type = 0; base = AIN; ldc = 512;  colt = pn * 256; }
        else if (pn < 14) { type = 1; base = Q;   ldc = 3072; colt = (pn - 2) * 256; }
        else if (pn < 18) { type = 2; base = K;   ldc = 1024; colt = (pn - 14) * 256; }
        else if (pn < 22) { type = 3; base = V;   ldc = 1024; colt = (pn - 18) * 256; }
        else              { type = 4; base = G;   ldc = 2048; colt = (pn - 22) * 256; }
        const int col0 = colt + 64 * wc + 8 * fq;
        const int row0 = u.pm * BM + wr * 64 + fr;
        f32x4 gn[2][2];
        const float* gp = (type == 2) ? kg : qg;
        const float gmul = (type == 1) ? 0.125f * 1.4426950408889634f : 1.0f;
#pragma unroll
        for (int bj = 0; bj < 2; ++bj)
#pragma unroll
            for (int n = 0; n < 2; ++n) gn[bj][n] = *(const f32x4*)(gp + 32 * bj + 8 * fq + 4 * n) * gmul;
#pragma unroll
        for (int ai = 0; ai < 2; ++ai)
#pragma unroll
            for (int m = 0; m < 4; ++m) {
                const int row = row0 + ai * HALF + m * 16; const float sc = s1[row];
                f32x4 v[2][2];
#pragma unroll
                for (int bj = 0; bj < 2; ++bj)
#pragma unroll
                    for (int n = 0; n < 2; ++n) v[bj][n] = acc[ai][bj][m][n] * sc;
                if (type == 1 || type == 2) {
                    float ss = 0.f;
#pragma unroll
                    for (int bj = 0; bj < 2; ++bj)
#pragma unroll
                        for (int n = 0; n < 2; ++n) { const f32x4 x = v[bj][n]; ss += (x[0] * x[0] + x[1] * x[1]) + (x[2] * x[2] + x[3] * x[3]); }
                    ss = xrow16_sum(ss);
                    const float rn = __builtin_amdgcn_rsqf(ss * (1.0f / 64.0f) + 1e-6f);
#pragma unroll
                    for (int bj = 0; bj < 2; ++bj)
#pragma unroll
                        for (int n = 0; n < 2; ++n) v[bj][n] = v[bj][n] * rn * gn[bj][n];
                } else if (type == 4) {
#pragma unroll
                    for (int bj = 0; bj < 2; ++bj)
#pragma unroll
                        for (int n = 0; n < 2; ++n)
#pragma unroll
                            for (int j = 0; j < 4; ++j) v[bj][n][j] = __builtin_amdgcn_rcpf(1.0f + __builtin_amdgcn_exp2f(-1.4426950408889634f * v[bj][n][j]));
                }
                bf16_t* rowp = base + (size_t)row * ldc + col0;
                if (type >= 1 && type <= 3) {
                    const int hh = (colt >> 6) + wc;
                    const int bb = row >> 13, tt = row & 8191;
                    const size_t slab = (type == 1) ? (size_t)((hh >> 4) * 8 + bb) * 16 + (hh & 15) : (size_t)bb * 16 + hh;
                    rowp = base + (slab * 8192 + tt) * 64 + 8 * fq; }
#pragma unroll
                for (int bj = 0; bj < 2; ++bj) { const f32x4 v0 = v[bj][0], v1 = v[bj][1];
                    u32x4 w; w.x = cvt_pk_bf16(v0[0], v0[1]); w.y = cvt_pk_bf16(v0[2], v0[3]); w.z = cvt_pk_bf16(v1[0], v1[1]); w.w = cvt_pk_bf16(v1[2], v1[3]);
                    *(u32x4*)(rowp + 32 * bj) = w; }
            }
    }
};
struct EpiOut {
    static constexpr bool PERM = true, AFTER_DRAIN = false;
    const float* x; float* out; bf16_t* hb;
    __device__ __forceinline__ void operator()(const f32x4 (&acc)[2][2][4][2], const Unit& u, int wr, int wc, int fr, int fq) const {
        const int row0 = u.pm * BM + wr * 64 + fr; const int col0 = u.pn * BM + wc * 32 + 8 * fq;
#pragma unroll
        for (int ai = 0; ai < 2; ++ai)
#pragma unroll
            for (int m = 0; m < 4; ++m) { const size_t off = (size_t)(row0 + ai * HALF + m * 16) * 1024 + col0;
#pragma unroll
                for (int bj = 0; bj < 2; ++bj) {
                    const f32x4 x0 = *(const f32x4*)(x + off + bj * HALF), x1 = *(const f32x4*)(x + off + bj * HALF + 4);
                    const f32x4 v0 = acc[ai][bj][m][0] + x0, v1 = acc[ai][bj][m][1] + x1;
                    *(f32x4*)(out + off + bj * HALF) = v0; *(f32x4*)(out + off + bj * HALF + 4) = v1;
                    u32x4 w; w.x = cvt_pk_bf16(v0[0], v0[1]); w.y = cvt_pk_bf16(v0[2], v0[3]); w.z = cvt_pk_bf16(v1[0], v1[1]); w.w = cvt_pk_bf16(v1[2], v1[3]);
                    *(u32x4*)(hb + off + bj * HALF) = w; } }
    }
};
template <class Epi, class Sched, bool ALIGN_EPI = false, bool SP2 = false>
__device__ __forceinline__ void gemm_phase(PG8_LAS unsigned char* lds, const Gemm g, const Sched& S, const Epi& E) {
    const int tid = threadIdx.x, wid = __builtin_amdgcn_readfirstlane(tid >> 6), lane = tid & 63, wr = wid >> 2, wc = wid & 3, fr = lane & 15, fq = lane >> 4;
    const int K = g.K, nt = K / BK;
    unsigned voffA[2], voffB[2];
#pragma unroll
    for (int i = 0; i < 2; ++i) { int R, C; stage_rc(tid * 16 + i * 8192, R, C); const int Rb = Epi::PERM ? ((R & ~31) + perm32(R & 31)) : R;
        voffA[i] = (unsigned)(R * K + C) * 2u; voffB[i] = (unsigned)(Rb * K + C) * 2u; }
    const size_t kstep = (size_t)(BK * 2);
    const size_t hstep = (size_t)HALF * K * 2;
    const size_t tstep = 2 * hstep;
    const unsigned ldsw = (unsigned)wid * 1024u;
    const int aoff = lds_byte(wr * 64 + fr, fq * 8), boff = lds_byte(wc * 32 + fr, fq * 8);
#define PG8_SA(b, h) (((b) * 2 + (h)) * HTB)
#define PG8_SB(b, h) ((4 + (b) * 2 + (h)) * HTB)
#define PG8_STAGE(bufoff, gbase, voff) do { _Pragma("unroll") for (int _i = 0; _i < 2; ++_i) \
        __builtin_amdgcn_global_load_lds((const unsigned*)((const char*)(gbase) + (voff)[_i]), (PG8_LAS unsigned*)(lds + (bufoff) + ldsw + _i * 8192), 16, 0, 0); } while (0)
#define PG8_LDA(dst, b, h) do { _Pragma("unroll") for (int m = 0; m < 4; ++m) _Pragma("unroll") for (int k = 0; k < 2; ++k) dst[m][k] = *(const PG8_LAS bf16x8*)(lds + PG8_SA(b, h) + aoff + m * 2048 + k * 1024); } while (0)
#define PG8_LDB(dst, b, h) do { _Pragma("unroll") for (int n = 0; n < 2; ++n) _Pragma("unroll") for (int k = 0; k < 2; ++k) dst[n][k] = *(const PG8_LAS bf16x8*)(lds + PG8_SB(b, h) + boff + n * 2048 + k * 1024); } while (0)
#define PG8_MMA(ai, bj, At, Bt) do { __builtin_amdgcn_s_setprio(1); _Pragma("unroll") for (int m = 0; m < 4; ++m) _Pragma("unroll") for (int n = 0; n < 2; ++n) _Pragma("unroll") for (int k = 0; k < 2; ++k) \
        acc[ai][bj][m][n] = __builtin_amdgcn_mfma_f32_16x16x32_bf16(Bt[n][k], At[m][k], acc[ai][bj][m][n], 0, 0, 0); __builtin_amdgcn_s_setprio(0); } while (0)
#define PG8_WAIT_V(n) asm volatile("s_waitcnt vmcnt(" #n ")" ::: "memory")
#define PG8_WAIT_L(n) asm volatile("s_waitcnt lgkmcnt(" #n ")" ::: "memory")
#define PG8_BAR __builtin_amdgcn_s_barrier()
#define PG8_SCHED __builtin_amdgcn_sched_barrier(0)
    Unit cur, nxt; int ui = 0;
    if (!S.next(0, cur)) return;
    f32x4 acc[2][2][4][2];
#pragma unroll
    for (int a = 0; a < 2; ++a)
#pragma unroll
        for (int b = 0; b < 2; ++b)
#pragma unroll
            for (int m = 0; m < 4; ++m)
#pragma unroll
                for (int n = 0; n < 2; ++n) acc[a][b][m][n] = (f32x4){0.f, 0.f, 0.f, 0.f};
    bf16x8 At[4][2], B0[2][2], B1[2][2];
    const char* cA = (const char*)g.A + (size_t)cur.pm * tstep; const char* cB = (const char*)g.Bt + (size_t)cur.pn * tstep;
    S.a_ready(cur);
    if constexpr (SP2) {
        PG8_STAGE(PG8_SB(0, 0), cB, voffB); PG8_STAGE(PG8_SB(0, 1), cB + hstep, voffB); PG8_STAGE(PG8_SA(0, 0), cA, voffA); PG8_STAGE(PG8_SA(0, 1), cA + hstep, voffA);
        if (wr == 1) PG8_BAR;
        PG8_WAIT_V(2); PG8_BAR;
        PG8_STAGE(PG8_SB(1, 0), cB + kstep, voffB); PG8_STAGE(PG8_SA(1, 0), cA + kstep, voffA); PG8_STAGE(PG8_SB(1, 1), cB + hstep + kstep, voffB);
        PG8_WAIT_V(6); PG8_BAR;
    } else {
        PG8_STAGE(PG8_SB(0, 0), cB, voffB); PG8_STAGE(PG8_SA(0, 0), cA, voffA); PG8_STAGE(PG8_SB(0, 1), cB + hstep, voffB); PG8_STAGE(PG8_SA(0, 1), cA + hstep, voffA);
        if (wr == 1) PG8_BAR;
        PG8_WAIT_V(4); PG8_BAR;
        PG8_STAGE(PG8_SB(1, 0), cB + kstep, voffB); PG8_STAGE(PG8_SA(1, 0), cA + kstep, voffA); PG8_STAGE(PG8_SB(1, 1), cB + hstep + kstep, voffB);
        PG8_WAIT_V(6); PG8_BAR;
    }
    for (;;) {
        const bool has_next = S.next(ui + 1, nxt);
        const char* nA = has_next ? (const char*)g.A + (size_t)nxt.pm * tstep : cA; const char* nB = has_next ? (const char*)g.Bt + (size_t)nxt.pn * tstep : cB;
        for (int t = 0; t < nt; t += 2) {
            const bool last = (t == nt - 2);
            const char* a1 = cA + (size_t)(t + 1) * kstep;
            const char* a2 = last ? nA : cA + (size_t)(t + 2) * kstep; const char* b2 = last ? nB : cB + (size_t)(t + 2) * kstep;
            const char* a3 = a2 + kstep; const char* b3 = b2 + kstep;
            if (last && has_next) S.a_ready(nxt);
            if constexpr (SP2) {
            PG8_LDB(B0, 0, 0); PG8_LDB(B1, 0, 1); PG8_SCHED; PG8_LDA(At, 0, 0); PG8_STAGE(PG8_SA(1, 1), a1 + hstep, voffA);
            PG8_WAIT_V(8); PG8_WAIT_L(0); PG8_BAR; PG8_MMA(0, 0, At, B0); PG8_MMA(0, 1, At, B1); PG8_BAR; PG8_SCHED;
            PG8_LDA(At, 0, 1); PG8_STAGE(PG8_SB(0, 0), b2, voffB); PG8_STAGE(PG8_SB(0, 1), b2 + hstep, voffB); PG8_STAGE(PG8_SA(0, 0), a2, voffA);
            PG8_WAIT_V(8); PG8_WAIT_L(0); PG8_BAR; PG8_MMA(1, 0, At, B0); PG8_MMA(1, 1, At, B1); PG8_BAR; PG8_SCHED;
            PG8_LDB(B0, 1, 0); PG8_LDB(B1, 1, 1); PG8_SCHED; PG8_LDA(At, 1, 0); PG8_STAGE(PG8_SA(0, 1), a2 + hstep, voffA);
            PG8_WAIT_V(8); PG8_WAIT_L(0); PG8_BAR; PG8_MMA(0, 0, At, B0); PG8_MMA(0, 1, At, B1); PG8_BAR; PG8_SCHED;
            PG8_LDA(At, 1, 1); PG8_STAGE(PG8_SB(1, 0), b3, voffB); PG8_STAGE(PG8_SB(1, 1), b3 + hstep, voffB); PG8_STAGE(PG8_SA(1, 0), a3, voffA);
            PG8_WAIT_V(8); PG8_WAIT_L(0); PG8_BAR; PG8_MMA(1, 0, At, B0); PG8_MMA(1, 1, At, B1); PG8_BAR; PG8_SCHED;
            } else {
            PG8_LDB(B0, 0, 0); PG8_SCHED; PG8_LDA(At, 0, 0); PG8_STAGE(PG8_SA(1, 1), a1 + hstep, voffA);
            PG8_WAIT_L(8); PG8_BAR; PG8_WAIT_L(0); PG8_MMA(0, 0, At, B0); PG8_BAR; PG8_SCHED;
            PG8_LDB(B1, 0, 1); PG8_STAGE(PG8_SB(0, 0), b2, voffB);
            PG8_BAR; PG8_WAIT_L(0); PG8_MMA(0, 1, At, B1); PG8_BAR;
            PG8_LDA(At, 0, 1); PG8_STAGE(PG8_SA(0, 0), a2, voffA);
            PG8_BAR; PG8_WAIT_L(0); PG8_MMA(1, 0, At, B0); PG8_BAR; PG8_SCHED;
            PG8_STAGE(PG8_SB(0, 1), b2 + hstep, voffB);
            PG8_WAIT_V(6); PG8_BAR; PG8_MMA(1, 1, At, B1); PG8_BAR;
            PG8_LDB(B0, 1, 0); PG8_SCHED; PG8_LDA(At, 1, 0); PG8_STAGE(PG8_SA(0, 1), a2 + hstep, voffA);
            PG8_WAIT_L(8); PG8_BAR; PG8_WAIT_L(0); PG8_MMA(0, 0, At, B0); PG8_BAR; PG8_SCHED;
            PG8_LDB(B1, 1, 1); PG8_STAGE(PG8_SB(1, 0), b3, voffB);
            PG8_BAR; PG8_WAIT_L(0); PG8_MMA(0, 1, At, B1); PG8_BAR;
            PG8_LDA(At, 1, 1); PG8_STAGE(PG8_SA(1, 0), a3, voffA);
            PG8_BAR; PG8_WAIT_L(0); PG8_MMA(1, 0, At, B0); PG8_BAR; PG8_SCHED;
            PG8_STAGE(PG8_SB(1, 1), b3 + hstep, voffB);
            PG8_WAIT_V(6); PG8_BAR; PG8_MMA(1, 1, At, B1); PG8_BAR;
            }
        }
        if constexpr (ALIGN_EPI) { if (wr == 0) PG8_BAR; }
        if constexpr (!Epi::AFTER_DRAIN) { E(acc, cur, wr, wc, fr, fq); S.done(cur); }
        if (!has_next) break;
#pragma unroll
        for (int a = 0; a < 2; ++a)
#pragma unroll
            for (int b = 0; b < 2; ++b)
#pragma unroll
                for (int m = 0; m < 4; ++m)
#pragma unroll
                    for (int n = 0; n < 2; ++n) acc[a][b][m][n] = (f32x4){0.f, 0.f, 0.f, 0.f};
        cur = nxt; cA = nA; cB = nB; ++ui;
        if constexpr (ALIGN_EPI) { if (wr == 1) PG8_BAR; }
    }
    PG8_WAIT_V(0);
    if constexpr (!ALIGN_EPI) { if (wr == 0) PG8_BAR; }
    PG8_BAR;
    if constexpr (Epi::AFTER_DRAIN) { E.fused(acc, cur, wr, wc, fr, fq, lds, wid, lane); S.done(cur); }
#undef PG8_SA
#undef PG8_SB
#undef PG8_STAGE
#undef PG8_LDA
#undef PG8_LDB
#undef PG8_MMA
#undef PG8_WAIT_V
#undef PG8_WAIT_L
#undef PG8_BAR
#undef PG8_SCHED
}
}

constexpr int NWAVES = 8;
constexpr int BATCH = 8, SEQ = 8192, DM = 1024, T = BATCH * SEQ;
constexpr int INW = 7680, QW = 3072, GATEW = 2048, POOLW = 512;
constexpr int NEXP = 16384;
constexpr float EPS = 1e-6f;
constexpr float LOG2E = 1.4426950408889634f;

constexpr size_t MiB = 1u << 20;
constexpr size_t WS_CTL = 0, CTL_ZERO_BYTES = 1 * MiB;
constexpr size_t WS_W1T = 2 * MiB;
constexpr size_t WS_WOT = 17 * MiB;
constexpr size_t WS_WQT = 19 * MiB;
constexpr size_t WS_WPT = 23 * MiB;
constexpr size_t WS_SKB = 23 * MiB + 512 * 1024;
constexpr size_t WS_S1 = 24 * MiB;
constexpr size_t WS_SU = 24 * MiB + 256 * 1024, WS_SV = 24 * MiB + 512 * 1024;
constexpr size_t WS_UB = 25 * MiB;
constexpr size_t WS_VB = 57 * MiB;
constexpr size_t WS_MD = 89 * MiB;
constexpr size_t WS_XB = 113 * MiB;
constexpr size_t WS_AIN = 241 * MiB;
constexpr size_t WS_Q = 305 * MiB;
constexpr size_t WS_G = 689 * MiB;
constexpr size_t WS_END = 945 * MiB;
constexpr size_t WS_HB = WS_AIN;

constexpr int CW_BAR = 4096;
constexpr int RING_OFF = 0, RING_BYTES = 131072;
constexpr int LDSCTL_OFF = 162816, MISC_OFF = LDSCTL_OFF + 320;
constexpr int LDS_BYTES = 163840;

#define GAS __attribute__((address_space(1)))
#define LAS __attribute__((address_space(3)))
typedef unsigned short bf16;
typedef unsigned v4u __attribute__((ext_vector_type(4)));
typedef unsigned v2u __attribute__((ext_vector_type(2)));
typedef float f32x4 __attribute__((ext_vector_type(4)));
typedef float f32x16 __attribute__((ext_vector_type(16)));
typedef short bf16x8 __attribute__((ext_vector_type(8)));
typedef short s16x4 __attribute__((ext_vector_type(4)));
typedef __bf16 bf16x2_t __attribute__((ext_vector_type(2)));
typedef GAS unsigned gu32;
#define RLX_AGENT __ATOMIC_RELAXED, __HIP_MEMORY_SCOPE_AGENT
#define LDS_WAIT() asm volatile("s_waitcnt lgkmcnt(0)" ::: "memory")
#define VM_WAIT() asm volatile("s_waitcnt vmcnt(0)" ::: "memory")
__device__ __forceinline__ unsigned f2bf(float f) { unsigned u = __builtin_bit_cast(unsigned, f); return (u + 0x7fffu + ((u >> 16) & 1u)) >> 16; }
__device__ __forceinline__ unsigned pk2(float lo, float hi) { return f2bf(lo) | (f2bf(hi) << 16); }
__device__ __forceinline__ float bflo(unsigned w) { return __uint_as_float(w << 16); }
__device__ __forceinline__ float bfhi(unsigned w) { return __uint_as_float(w & 0xffff0000u); }
__device__ __forceinline__ int crow(int r, int hi) { return (r & 3) + 8 * (r >> 2) + 4 * hi; }
__device__ __forceinline__ float xhalf_max(float x) { auto t = __builtin_amdgcn_permlane32_swap(__float_as_uint(x), __float_as_uint(x), false, false); return fmaxf(__uint_as_float(t[0]), __uint_as_float(t[1])); }
__device__ __forceinline__ float xhalf_sum(float x) { auto t = __builtin_amdgcn_permlane32_swap(__float_as_uint(x), __float_as_uint(x), false, false); return __uint_as_float(t[0]) + __uint_as_float(t[1]); }
__device__ __forceinline__ float wave_sum(float v) {
#pragma unroll
    for (int o = 1; o < 64; o <<= 1) v += __shfl_xor(v, o);
    return v;
}
__device__ __forceinline__ float dot2bf(unsigned a, unsigned b, float acc) { return __builtin_amdgcn_fdot2_f32_bf16(__builtin_bit_cast(bf16x2_t, a), __builtin_bit_cast(bf16x2_t, b), acc, false); }

#define XB_TMO      128
#define XB_XCNT(j)  (256  + 64 * (j))
#define XB_XSUB(j)  (1280 + 64 * (j))
#define XB_XGEN(j)  (2304 + 64 * (j))
#define XB_TOP      3328
#define XB_TOPGEN   3392
#define XCD_BAR_WORDS 3456
#define XB_SPIN_CAP (1u << 18)

__device__ __forceinline__ unsigned xb_ld(unsigned* p)              { return __hip_atomic_load(p, __ATOMIC_RELAXED, __HIP_MEMORY_SCOPE_AGENT); }
__device__ __forceinline__ unsigned xb_add(unsigned* p, unsigned v) { return __hip_atomic_fetch_add(p, v, __ATOMIC_RELAXED, __HIP_MEMORY_SCOPE_AGENT); }
__device__ __forceinline__ unsigned xb_xcc_id() { return (unsigned)__builtin_amdgcn_s_getreg((3 << 11) | 20) & 0xFu; }
#define XB_SPIN(cond, bar) do { unsigned _sp = 0; while (cond) { __builtin_amdgcn_s_sleep(1); \
    if ((++_sp & 255u) == 0u) { if (xb_ld(&(bar)[XB_TMO])) break; if (_sp > XB_SPIN_CAP) { atomicAdd(&(bar)[XB_TMO], 1u); break; } } } } while (0)

struct XcdBarrier {
    unsigned* bar; unsigned x;
    volatile LAS unsigned* st;
};

__device__ __forceinline__ XcdBarrier xcd_barrier_post(unsigned* bar, volatile LAS unsigned* st) {
    XcdBarrier b; b.bar = bar; b.x = xb_xcc_id(); b.st = st;
    if (threadIdx.x == 0) (void)xb_add(&bar[XB_XCNT(b.x)], 1u);
    return b;
}
__device__ __forceinline__ void xcd_barrier_complete(unsigned* bar, unsigned x, unsigned& nloc, unsigned& nx) {
    const unsigned G = gridDim.x * gridDim.y * gridDim.z;
    unsigned sum, cnt, mine, sp = 0u;
    for (;;) {
        sum = 0u; cnt = 0u; mine = 0u;
#pragma unroll
        for (unsigned j = 0; j < 16; ++j) { const unsigned c = xb_ld(&bar[XB_XCNT(j)]); sum += c; cnt += (c > 0u) ? 1u : 0u; mine = (j == x) ? c : mine; }
        if (sum == G) break;
        __builtin_amdgcn_s_sleep(1);
        if ((++sp & 255u) == 0u) { if (xb_ld(&bar[XB_TMO])) break; if (sp > XB_SPIN_CAP) { atomicAdd(&bar[XB_TMO], 1u); break; } }
    }
    nloc = mine > 0u ? mine : 1u; nx = cnt > 0u ? cnt : 1u;
}

__device__ __forceinline__ void xcd_barrier(const XcdBarrier& b) {
    asm volatile("s_waitcnt vmcnt(0)" ::: "memory");
    __syncthreads();
    if (threadIdx.x == 0) {
        unsigned* bar = b.bar;
        __builtin_amdgcn_s_waitcnt(0);
        unsigned nloc = b.st[0], nx = b.st[1];
        if (nloc == 0u) { xcd_barrier_complete(bar, b.x, nloc, nx); b.st[0] = nloc; b.st[1] = nx; }
        const unsigned old = xb_add(&bar[XB_XSUB(b.x)], 1u);
        const unsigned gen = old / nloc;
        if (old + 1u == (gen + 1u) * nloc) {
            __builtin_amdgcn_fence(__ATOMIC_RELEASE, "agent");
            asm volatile("s_waitcnt vmcnt(0)" ::: "memory");
            const unsigned og = xb_add(&bar[XB_TOP], 1u);
            const unsigned tg = og / nx;
            if (og + 1u == (tg + 1u) * nx) xb_add(&bar[XB_TOPGEN], 1u);
            else XB_SPIN(xb_ld(&bar[XB_TOPGEN]) == tg, bar);
            __builtin_amdgcn_fence(__ATOMIC_ACQUIRE, "agent");
            xb_add(&bar[XB_XGEN(b.x)], 1u);
            asm volatile("s_waitcnt vmcnt(0)" ::: "memory");
        } else {
            XB_SPIN(xb_ld(&bar[XB_XGEN(b.x)]) == gen, bar);
            __builtin_amdgcn_fence(__ATOMIC_ACQUIRE, "agent");
            asm volatile("s_waitcnt vmcnt(0)" ::: "memory");
        }
    }
    __syncthreads();
}

struct Frame {
    LAS unsigned char* lds;
    volatile LAS unsigned* MISC;
    gu32* ctl;
    int tid, lane, wave, G;
    const float *x, *norm1_g, *w_in, *q_norm_g, *k_norm_g, *w_pool, *pool_scale, *w_out, *norm2_g, *w_query, *sub_keys, *expert_u, *expert_v;
    float* out; unsigned char* ws;
};
template <int CTRL> __device__ __forceinline__ float dppf(float x) { return __builtin_bit_cast(float, __builtin_amdgcn_mov_dpp(__builtin_bit_cast(int, x), CTRL, 0xf, 0xf, true)); }
__device__ __forceinline__ float wave_sum_dpp(float x) {
    x += dppf<0xB1>(x);
    x += dppf<0x4E>(x);
    x += dppf<0x141>(x);
    x += dppf<0x128>(x);
    return pg8::xrow16_sum(x);
}

__device__ __forceinline__ float wave_max_dpp(float x) {
    x = fmaxf(x, dppf<0xB1>(x)); x = fmaxf(x, dppf<0x4E>(x)); x = fmaxf(x, dppf<0x141>(x)); x = fmaxf(x, dppf<0x128>(x));
    auto s = __builtin_amdgcn_permlane16_swap(__float_as_uint(x), __float_as_uint(x), false, false);
    x = fmaxf(__uint_as_float(s[0]), __uint_as_float(s[1]));
    auto t = __builtin_amdgcn_permlane32_swap(__float_as_uint(x), __float_as_uint(x), false, false);
    return fmaxf(__uint_as_float(t[0]), __uint_as_float(t[1]));
}
template <int CTRL> __device__ __forceinline__ int dppi(int x) { return __builtin_amdgcn_mov_dpp(x, CTRL, 0xf, 0xf, true); }
__device__ __forceinline__ int wave_sum_dpp_i(int x) {
    x += dppi<0xB1>(x); x += dppi<0x4E>(x); x += dppi<0x141>(x); x += dppi<0x128>(x);
    auto s = __builtin_amdgcn_permlane16_swap((unsigned)x, (unsigned)x, false, false); x = (int)(s[0] + s[1]);
    auto t = __builtin_amdgcn_permlane32_swap((unsigned)x, (unsigned)x, false, false); return (int)(t[0] + t[1]);
}
__device__ __forceinline__ v4u quant16(const f32x4 (&v)[4], float inv, int off) {
    v4u o;
#pragma unroll
    for (int j = 0; j < 4; ++j) {
        const int a = (int)__builtin_rintf(v[j].x * inv) + off, b = (int)__builtin_rintf(v[j].y * inv) + off, c = (int)__builtin_rintf(v[j].z * inv) + off, d = (int)__builtin_rintf(v[j].w * inv) + off;
        o[j] = (unsigned)(a & 255) | ((unsigned)(b & 255) << 8) | ((unsigned)(c & 255) << 16) | ((unsigned)(d & 255) << 24);
    }
    return o;
}
__device__ __forceinline__ void p0_quant_row(const float* xrow, const float* gain, unsigned char* orow, float* scale_out, int off, int lane) {
    const GAS f32x4* xr = (const GAS f32x4*)xrow + lane;
    f32x4 v[4]; float mx = 0.f;
#pragma unroll
    for (int j = 0; j < 4; ++j) { v[j] = xr[64 * j]; if (gain) v[j] = v[j] * ((const f32x4*)gain)[64 * j + lane];
        mx = fmaxf(mx, fmaxf(fmaxf(fabsf(v[j].x), fabsf(v[j].y)), fmaxf(fabsf(v[j].z), fabsf(v[j].w)))); }
    mx = wave_max_dpp(mx);
    const float sc = mx > 0.f ? mx * (1.0f / 127.0f) : 1.0f, inv = 1.0f / sc;
    *(GAS v4u*)(orow + 16 * lane) = quant16(v, inv, off);
    if (lane == 0) *scale_out = sc;
}
__device__ __forceinline__ void p0_fp8_row(const float* xrow, unsigned char* orow, float* scale_out, int lane) {
    const GAS f32x4* xr = (const GAS f32x4*)xrow + lane;
    f32x4 v[4]; float mx = 0.f;
#pragma unroll
    for (int j = 0; j < 4; ++j) { v[j] = xr[64 * j]; mx = fmaxf(mx, fmaxf(fmaxf(fabsf(v[j].x), fabsf(v[j].y)), fmaxf(fabsf(v[j].z), fabsf(v[j].w)))); }
    mx = wave_max_dpp(mx);
    const float sc = mx > 0.f ? mx * (1.0f / 400.0f) : 1.0f, inv = 1.0f / sc;
    v4u o;
#pragma unroll
    for (int j = 0; j < 4; ++j) { int pk = __builtin_amdgcn_cvt_pk_fp8_f32(v[j].x * inv, v[j].y * inv, 0, false); pk = __builtin_amdgcn_cvt_pk_fp8_f32(v[j].z * inv, v[j].w * inv, pk, true); o[j] = (unsigned)pk; }
    *(GAS v4u*)(orow + 16 * lane) = o;
    if (lane == 0) *scale_out = sc;
}
__device__ __forceinline__ void p0_transpose_item(const float* W, int K, int N, const float* rs, const float* cs, bf16* WT, int permute, LAS float* scr, int item, int lane) {
    const int nblk = N / 32, kb = item / nblk, nb = item % nblk, k0 = 64 * kb, n0 = 32 * nb;
    const float csv = cs ? cs[n0 + (lane & 31)] : 1.f;
#pragma unroll 8
    for (int i = 0; i < 32; ++i) { const int kk = 2 * i + (lane >> 5); const float r = rs ? rs[k0 + kk] : 1.f; scr[kk * 33 + (lane & 31)] = W[(size_t)(k0 + kk) * N + n0 + (lane & 31)] * r * csv; }
    LDS_WAIT(); asm volatile("" ::: "memory");
    int nout0 = n0;
    if (permute) { const int gl = (n0 & 255) >> 5; const int gp = 4 * (gl & 1) + (gl >> 1); nout0 = (n0 & ~255) + 32 * gp; }
    const int c = lane & 7;
#pragma unroll
    for (int j = 0; j < 4; ++j) { const int n = (lane >> 3) + 8 * j; const LAS float* s = scr + (8 * c) * 33 + n;
        v4u o; o.x = pk2(s[0 * 33], s[1 * 33]); o.y = pk2(s[2 * 33], s[3 * 33]); o.z = pk2(s[4 * 33], s[5 * 33]); o.w = pk2(s[6 * 33], s[7 * 33]);
        *(GAS v4u*)(WT + (size_t)(nout0 + n) * K + k0 + 8 * c) = o; }
    LDS_WAIT(); asm volatile("" ::: "memory");
}
__device__ __forceinline__ void p0_row(const float* xrow, const float* gain, bf16* orow, float* s1p, int lane) {
    const GAS f32x4* xr = (const GAS f32x4*)xrow + lane;
    f32x4 v[4]; float s = 0.f;
#pragma unroll
    for (int j = 0; j < 4; ++j) { v[j] = xr[64 * j]; s += (v[j].x * v[j].x + v[j].y * v[j].y) + (v[j].z * v[j].z + v[j].w * v[j].w); }
    if (s1p) { s = wave_sum(s); if (lane == 0) *s1p = 1.0f / sqrtf(s * (1.0f / 1024.0f) + EPS); }
    if (gain) {
#pragma unroll
        for (int j = 0; j < 4; ++j) v[j] = v[j] * ((const f32x4*)gain)[64 * j + lane];
    }
    GAS unsigned long long* o8 = (GAS unsigned long long*)orow + lane;
#pragma unroll
    for (int j = 0; j < 4; ++j) o8[64 * j] = (unsigned long long)pk2(v[j].x, v[j].y) | ((unsigned long long)pk2(v[j].z, v[j].w) << 32);
}
__device__ __forceinline__ void p0_prologue(Frame& F) {
    LAS float* scr = (LAS float*)(F.lds + RING_OFF + F.wave * 16384);
    const int gw = blockIdx.x * NWAVES + F.wave, NGW = F.G * NWAVES;
    unsigned char* ws = F.ws;
    constexpr int I_IN = (DM / 64) * (INW / 32), I_O = (DM / 64) * (DM / 32), I_Q = (DM / 64) * (2048 / 32), I_P = 4 * (128 / 64) * (256 / 32);
    constexpr int NITEMS = I_IN + I_O + I_Q + I_P;
    for (int it = gw; it < NITEMS; it += NGW) {
        int r = it;
        if (r < I_IN) { p0_transpose_item(F.w_in, DM, INW, F.norm1_g, nullptr, (bf16*)(ws + WS_W1T), 1, scr, r, F.lane); continue; } r -= I_IN;
        if (r < I_O) { p0_transpose_item(F.w_out, DM, DM, nullptr, nullptr, (bf16*)(ws + WS_WOT), 0, scr, r, F.lane); continue; } r -= I_O;
        if (r < I_Q) { p0_transpose_item(F.w_query, DM, 2048, F.norm2_g, nullptr, (bf16*)(ws + WS_WQT), 0, scr, r, F.lane); continue; } r -= I_Q;
        { const int g = r / 16, ri = r % 16;
          p0_transpose_item(F.w_pool + (size_t)g * 128 * 256, 128, 256, nullptr, F.pool_scale + g * 256, (bf16*)(ws + WS_WPT) + (size_t)g * 256 * 128, 0, scr, ri, F.lane); }
    }
    constexpr int NROWS = T + 2 * NEXP + 256;
    for (int m = gw; m < NROWS; m += NGW) {
        if (m < T) { p0_row(F.x + (size_t)m * DM, nullptr, (bf16*)(ws + WS_XB) + (size_t)m * DM, (float*)(ws + WS_S1) + m, F.lane); continue; }
        int r = m - T;
        if (r < NEXP) { p0_quant_row(F.expert_u + (size_t)r * DM, F.norm2_g, ws + WS_UB + (size_t)r * 2048, (float*)(ws + WS_SU) + r, 0, F.lane); continue; } r -= NEXP;
        if (r < NEXP) { p0_fp8_row(F.expert_v + (size_t)r * DM, ws + WS_UB + (size_t)r * 2048 + 1024, (float*)(ws + WS_SV) + r, F.lane); continue; } r -= NEXP;
        p0_row(F.sub_keys + (size_t)r * DM, nullptr, (bf16*)(ws + WS_SKB) + (size_t)r * DM, nullptr, F.lane);
    }
}

constexpr int ATT_NK = 384, ATT_K_OFF = 0, ATT_V_OFF = ATT_NK * 128;
typedef short v4i16_t __attribute__((ext_vector_type(4)));
__device__ __forceinline__ s16x4 vtr(unsigned ldsaddr) { return __builtin_bit_cast(s16x4, __builtin_amdgcn_ds_read_tr16_b64_v4i16((LAS v4i16_t*)(uintptr_t)ldsaddr)); }
struct AttnU { int p, b, h, dil, r, bp; };
__device__ __forceinline__ AttnU attn_decode(int unit) {
    AttnU u; const int idx = unit & 31; int t1 = unit >> 5; u.h = t1 & 15; t1 >>= 4; u.b = t1 & 7; u.p = t1 >> 3;
    const int dl = (u.p == 0) ? 0 : (u.p == 1 ? 2 : 4); u.dil = 1 << dl; const int nbp = 32 >> dl; u.r = idx >> (5 - dl); u.bp = idx & (nbp - 1); return u;
}
__device__ __forceinline__ void attn_load(const AttnU& u, int tid, int w, int c32, int hi, const bf16* __restrict__ Kg, const bf16* __restrict__ Vg, const bf16* Qg, v4u (&kr)[6], v4u (&vr)[6], bf16x8 (&qf)[4]) {
    const int rsub = tid >> 3, ch = tid & 7;
#pragma unroll
    for (int i = 0; i < 6; ++i) { const int ki = i * 64 + rsub; const int sidx = u.bp * 256 - 128 + ki; const bool ok = sidx >= 0;
        const long pos = ok ? ((long)sidx * u.dil + u.r) : 0; const size_t off = ((size_t)(u.b * 16 + u.h) * 8192 + pos) * 64 + ch * 8;
        kr[i] = *(const GAS v4u*)(Kg + off); vr[i] = *(const GAS v4u*)(Vg + off);
        if (!ok) { kr[i] = (v4u){0u, 0u, 0u, 0u}; vr[i] = (v4u){0u, 0u, 0u, 0u}; } }
    const long qt = (long)(u.bp * 256 + 32 * w + c32) * u.dil + u.r;
    const bf16* qp = Qg + ((size_t)((u.p * 8 + u.b) * 16 + u.h) * 8192 + qt) * 64;
#pragma unroll
    for (int d0 = 0; d0 < 4; ++d0) qf[d0] = *(const GAS bf16x8*)(qp + d0 * 16 + hi * 8);
}
__device__ __forceinline__ void attn_phase(Frame& F, int u0, int u1, const bf16* __restrict__ Kg, const bf16* __restrict__ Vg, bf16* Qg, float* MDm, float* MDd) {
    if (u0 >= u1) return;
    const int tid = F.tid, lane = F.lane, w = F.wave, c32 = lane & 31, hi = lane >> 5;
    LAS unsigned char* lds = F.lds;
    v4u kr[6], vr[6]; bf16x8 qn[4];
    AttnU un = attn_decode(u0);
    attn_load(un, tid, w, c32, hi, Kg, Vg, Qg, kr, vr, qn);
    const int rsub = tid >> 3, ch = tid & 7;
    const int lam = lane & 15;
    const unsigned vbase = (unsigned)(uintptr_t)(lds + ATT_V_OFF) + (unsigned)((4 * hi + (lam >> 2)) * 64 + (16 * ((lane >> 4) & 1) + 4 * (lam & 3)) * 2);
    const int cz = c32 - 4 * hi;
#pragma unroll 1
    for (int uu = u0; uu < u1; ++uu) {
        const AttnU u = un;
#pragma unroll
        for (int i = 0; i < 6; ++i) { const int ki = i * 64 + rsub;
            *(LAS v4u*)(lds + ATT_K_OFF + ki * 128 + ((ch ^ ((ki >> 1) & 7)) * 16)) = kr[i];
            *(LAS v4u*)(lds + ATT_V_OFF + (ch >> 2) * (ATT_NK * 64) + ki * 64 + (ch & 3) * 16) = vr[i]; }
        bf16x8 qf[4];
#pragma unroll
        for (int d0 = 0; d0 < 4; ++d0) qf[d0] = qn[d0];
        __syncthreads();
        if (uu + 1 < u1) { un = attn_decode(uu + 1); attn_load(un, tid, w, c32, hi, Kg, Vg, Qg, kr, vr, qn); }
        const int sidx = u.p * 16 + u.h; const float sexp = sidx < 32 ? 0.125f * (float)(sidx + 1) : 4.0f + 0.25f * (float)(sidx - 31);
        const float slope2 = exp2f(-sexp) * LOG2E * (float)u.dil;
        const float a0 = -slope2 * (float)(128 + cz);
        f32x16 st[5];
#pragma unroll
        for (int kt = 0; kt < 5; ++kt) {
            const int key = 32 * (w + kt) + c32; const LAS unsigned char* kb = lds + ATT_K_OFF + key * 128; const int sw = (key >> 1) & 7;
            f32x16 a;
#pragma unroll
            for (int rr = 0; rr < 16; ++rr) a[rr] = a0;
#pragma unroll
            for (int d0 = 0; d0 < 4; ++d0) { const bf16x8 kf = *(const LAS bf16x8*)(kb + (((2 * d0 + hi) ^ sw) * 16)); a = __builtin_amdgcn_mfma_f32_32x32x16_bf16(kf, qf[d0], a, 0, 0, 0); }
            st[kt] = a;
        }
        float mx = -1e30f;
#pragma unroll
        for (int kt = 0; kt < 5; ++kt) {
            const bool dead = (u.bp == 0) && (w + kt < 4);
#pragma unroll
            for (int rr = 0; rr < 16; ++rr) { const int rc = (rr & 3) + 8 * (rr >> 2);
                float sv = fmaf(slope2, (float)(32 * kt + rc), st[kt][rr]);
                if (kt == 0) sv = (rc >= cz) ? sv : -1e30f;
                if (kt == 4) sv = (rc <= cz) ? sv : -1e30f;
                if (dead) sv = -1e30f;
                st[kt][rr] = sv; mx = fmaxf(mx, sv); }
        }
        mx = xhalf_max(mx);
        float l = 0.f;
#pragma unroll
        for (int kt = 0; kt < 5; ++kt)
#pragma unroll
            for (int rr = 0; rr < 16; ++rr) { const float e = __builtin_amdgcn_exp2f(st[kt][rr] - mx); st[kt][rr] = e; l += e; }
        l = xhalf_sum(l);
        f32x16 o[2]; o[0] = f32x16{}; o[1] = f32x16{};
#pragma unroll
        for (int kt = 0; kt < 5; ++kt)
#pragma unroll
            for (int s2 = 0; s2 < 2; ++s2) {
                v4u pw; pw.x = pg8::cvt_pk_bf16(st[kt][8 * s2 + 0], st[kt][8 * s2 + 1]); pw.y = pg8::cvt_pk_bf16(st[kt][8 * s2 + 2], st[kt][8 * s2 + 3]);
                pw.z = pg8::cvt_pk_bf16(st[kt][8 * s2 + 4], st[kt][8 * s2 + 5]); pw.w = pg8::cvt_pk_bf16(st[kt][8 * s2 + 6], st[kt][8 * s2 + 7]);
                const bf16x8 pf = __builtin_bit_cast(bf16x8, pw);
#pragma unroll
                for (int dt = 0; dt < 2; ++dt) {
                    const unsigned a = vbase + (unsigned)(dt * (ATT_NK * 64) + (32 * (w + kt) + 16 * s2) * 64);
                    const s16x4 lo = vtr(a), hi4 = vtr(a + 8 * 64);
                    const bf16x8 vf = (bf16x8){lo[0], lo[1], lo[2], lo[3], hi4[0], hi4[1], hi4[2], hi4[3]};
                    o[dt] = __builtin_amdgcn_mfma_f32_32x32x16_bf16(vf, pf, o[dt], 0, 0, 0);
                }
            }
        const float inv = 1.0f / l;
        const long qt = (long)(u.bp * 256 + 32 * w + c32) * u.dil + u.r; const long qrow = (long)u.b * SEQ + qt;
        bf16* qp = Qg + ((size_t)((u.p * 8 + u.b) * 16 + u.h) * 8192 + qt) * 64;
#pragma unroll
        for (int dt = 0; dt < 2; ++dt)
#pragma unroll
            for (int g = 0; g < 4; ++g) { v2u ow; ow.x = pg8::cvt_pk_bf16(o[dt][4 * g] * inv, o[dt][4 * g + 1] * inv); ow.y = pg8::cvt_pk_bf16(o[dt][4 * g + 2] * inv, o[dt][4 * g + 3] * inv);
                *(GAS v2u*)(qp + 32 * dt + 8 * g + 4 * hi) = ow; }
        if (hi == 0) { const size_t mi = ((size_t)u.p * T + (size_t)qrow) * 16 + u.h; MDm[mi] = mx; MDd[mi] = l; }
        __syncthreads();
    }
}

constexpr int PB_AIN_PITCH = 272, PB_POOL_OFF = 40960, PB_POOL_PITCH = 528;
__device__ __forceinline__ void pool_merge_unit(Frame& F, int unit, const bf16* AIN, const bf16* Wpt, const bf16* OP, const bf16* Gt, const float* MDm, const float* MDd, bf16* MERGED) {
    const int tid = F.tid, lane = F.lane, w = F.wave, c32 = lane & 31, hi = lane >> 5;
    const int g = unit & 3, tile = unit >> 2, t0 = tile * 128, tin = t0 & (SEQ - 1), win = 2 << g;
    LAS unsigned char* lds = F.lds;
    for (int id = tid; id < 143 * 16; id += NWAVES * 64) { const int rr = id >> 4, ch = id & 15; v4u v = (v4u){0u, 0u, 0u, 0u};
        if (tin - 15 + rr >= 0) v = *(const GAS v4u*)(AIN + (size_t)(t0 - 15 + rr) * POOLW + g * 128 + ch * 8);
        *(LAS v4u*)(lds + rr * PB_AIN_PITCH + ch * 16) = v; }
    __syncthreads();
    {
        const int tq = w & 3, oh = w >> 2, tokl = 32 * tq + c32;
        const int cnt = (tin + tokl + 1) < win ? (tin + tokl + 1) : win; const float rc = 1.0f / (float)cnt;
        f32x16 acc[4]; acc[0] = f32x16{}; acc[1] = f32x16{}; acc[2] = f32x16{}; acc[3] = f32x16{};
        const bf16* wp = Wpt + (size_t)(g * 256 + oh * 128 + c32) * 128 + 8 * hi;
#pragma unroll 1
        for (int ks = 0; ks < 8; ++ks) {
            const LAS unsigned char* ap = lds + (15 + tokl) * PB_AIN_PITCH + (16 * ks + 8 * hi) * 2;
            const v4u own = *(const LAS v4u*)ap;
            float s[8] = {0.f, 0.f, 0.f, 0.f, 0.f, 0.f, 0.f, 0.f};
            for (int i = 0; i < win; ++i) { const v4u a = *(const LAS v4u*)(ap - i * PB_AIN_PITCH);
                s[0] += bflo(a.x); s[1] += bfhi(a.x); s[2] += bflo(a.y); s[3] += bfhi(a.y); s[4] += bflo(a.z); s[5] += bfhi(a.z); s[6] += bflo(a.w); s[7] += bfhi(a.w); }
            v4u dw; dw.x = pg8::cvt_pk_bf16(s[0] * rc - bflo(own.x), s[1] * rc - bfhi(own.x)); dw.y = pg8::cvt_pk_bf16(s[2] * rc - bflo(own.y), s[3] * rc - bfhi(own.y));
            dw.z = pg8::cvt_pk_bf16(s[4] * rc - bflo(own.z), s[5] * rc - bfhi(own.z)); dw.w = pg8::cvt_pk_bf16(s[6] * rc - bflo(own.w), s[7] * rc - bfhi(own.w));
            const bf16x8 df = __builtin_bit_cast(bf16x8, dw);
#pragma unroll
            for (int mt = 0; mt < 4; ++mt) { const bf16x8 wf = *(const GAS bf16x8*)(wp + (size_t)(32 * mt) * 128 + 16 * ks); acc[mt] = __builtin_amdgcn_mfma_f32_32x32x16_bf16(wf, df, acc[mt], 0, 0, 0); }
        }
#pragma unroll
        for (int mt = 0; mt < 4; ++mt)
#pragma unroll
            for (int gq = 0; gq < 4; ++gq) { v2u ow; ow.x = pg8::cvt_pk_bf16(acc[mt][4 * gq], acc[mt][4 * gq + 1]); ow.y = pg8::cvt_pk_bf16(acc[mt][4 * gq + 2], acc[mt][4 * gq + 3]);
                *(LAS v2u*)(lds + PB_POOL_OFF + tokl * PB_POOL_PITCH + (oh * 128 + 32 * mt + 8 * gq + 4 * hi) * 2) = ow; }
    }
    __syncthreads();
#pragma unroll 1
    for (int pass = 0; pass < 8; ++pass) {
        const int id = pass * 512 + tid, tok = id >> 5, cc = id & 31, col = g * 256 + 8 * cc, head = col >> 6; const size_t row = (size_t)t0 + tok;
        float m[3], dn[3];
#pragma unroll
        for (int p = 0; p < 3; ++p) { const size_t mi = ((size_t)p * T + row) * 16 + head; m[p] = MDm[mi]; dn[p] = MDd[mi]; }
        const float M = fmaxf(fmaxf(m[0], m[1]), m[2]);
        float wgt[3]; float ws_ = 0.f;
#pragma unroll
        for (int p = 0; p < 3; ++p) { wgt[p] = dn[p] * __builtin_amdgcn_exp2f(m[p] - M); ws_ += wgt[p]; }
        const float iw = 1.0f / ws_;
        const size_t ob = ((size_t)((row >> 13) * 16 + head) * 8192 + (row & 8191)) * 64 + (col & 63); constexpr size_t PST = (size_t)8 * 16 * 8192 * 64;
        const v4u o0 = *(const GAS v4u*)(OP + ob), o1 = *(const GAS v4u*)(OP + PST + ob), o2 = *(const GAS v4u*)(OP + 2 * PST + ob);
        const v4u g0 = *(const GAS v4u*)(Gt + row * GATEW + col), g1 = *(const GAS v4u*)(Gt + row * GATEW + 1024 + col);
        const v4u pl = *(const LAS v4u*)(lds + PB_POOL_OFF + tok * PB_POOL_PITCH + cc * 16);
        const float w0 = wgt[0] * iw, w1 = wgt[1] * iw, w2 = wgt[2] * iw;
        v4u res;
#define MRG(f) { const float alo = w0 * bflo(o0.f) + w1 * bflo(o1.f) + w2 * bflo(o2.f), ahi = w0 * bfhi(o0.f) + w1 * bfhi(o1.f) + w2 * bfhi(o2.f); \
                 res.f = pg8::cvt_pk_bf16(bflo(g0.f) * bflo(pl.f) + bflo(g1.f) * alo, bfhi(g0.f) * bfhi(pl.f) + bfhi(g1.f) * ahi); }
        MRG(x) MRG(y) MRG(z) MRG(w)
#undef MRG
        *(GAS v4u*)(MERGED + row * DM + col) = res;
    }
    __syncthreads();
}

constexpr int P5_LIST_OFF = 0, P5_RING_OFF = 65536, P5_RING_WAVE = 10240, P5_NSLOT = 5, P5_TL_OFF = 147456, P5_S2_OFF = 155648, P5_SH_OFF = 155904, P5_CNT_OFF = 147456  ;
constexpr int P5_DUMMY_OFF = 158720;
constexpr float P5_GSCALE = 1024.0f;
__device__ __forceinline__ float gelu_tanh(float x) {
    const float z = 0.7978845608028654f * (x + 0.044715f * x * x * x);
    const float e = __builtin_amdgcn_exp2f(2.0f * LOG2E * z);
    const float th = 1.0f - 2.0f * __builtin_amdgcn_rcpf(1.0f + e);
    return 0.5f * x * (1.0f + th);
}
#define P5_CE(a, b) { const float hi__ = fmaxf(a, b), lo__ = fminf(a, b); a = hi__; b = lo__; }
__device__ __forceinline__ void sort16_desc(float (&v)[16]) {
#pragma unroll
    for (int k = 2; k <= 16; k <<= 1)
#pragma unroll
        for (int j = k >> 1; j > 0; j >>= 1)
#pragma unroll
            for (int i = 0; i < 16; ++i) { const int l = i ^ j; if (l > i) { if ((i & k) == 0) P5_CE(v[i], v[l]) else P5_CE(v[l], v[i]) } }
}
__device__ __forceinline__ void merge_top16(float (&a)[16], const float (&b)[16]) {
#pragma unroll
    for (int i = 0; i < 16; ++i) a[i] = fmaxf(a[i], b[15 - i]);
#pragma unroll
    for (int j = 8; j > 0; j >>= 1)
#pragma unroll
        for (int i = 0; i < 16; ++i) { const int l = i ^ j; if (l > i) P5_CE(a[i], a[l]) }
}
__device__ __forceinline__ void pair_merge_top16(float (&a)[16]) {
    float lo[16], hi[16];
#pragma unroll
    for (int i = 0; i < 16; ++i) { auto t = __builtin_amdgcn_permlane32_swap(__float_as_uint(a[i]), __float_as_uint(a[i]), false, false); lo[i] = __uint_as_float(t[0]); hi[i] = __uint_as_float(t[1]); }
    merge_top16(lo, hi);
#pragma unroll
    for (int i = 0; i < 16; ++i) a[i] = lo[i];
}
__device__ __forceinline__ void peer_stage_a(Frame& F, int t0, int hh, const bf16* QP, const bf16* SKB, const float* SU, const float* SV) {
    int lane = F.lane; asm volatile("" : "+v"(lane));
    const int w = F.wave, c32 = lane & 31, hi = lane >> 5;
    LAS unsigned char* lds = F.lds;
    const LAS float* s2l = (const LAS float*)(lds + P5_S2_OFF);
    float tops[2][16];
#pragma unroll
    for (int p = 0; p < 2; ++p) {
        f32x16 acc[4]; acc[0] = f32x16{}; acc[1] = f32x16{}; acc[2] = f32x16{}; acc[3] = f32x16{};
        const bf16* qrow = QP + (size_t)(t0 + 32 * hh + c32) * 2048 + (w * 2 + p) * 128 + 8 * hi;
        const bf16* skp = SKB + (size_t)((w * 2 + p) * 128 + c32) * 128 + 8 * hi;
#pragma unroll 2
        for (int ks = 0; ks < 8; ++ks) { const bf16x8 bq = *(const GAS bf16x8*)(qrow + 16 * ks);
#pragma unroll
            for (int mt = 0; mt < 4; ++mt) { const bf16x8 a = *(const GAS bf16x8*)(skp + (size_t)(32 * mt) * 128 + 16 * ks); acc[mt] = __builtin_amdgcn_mfma_f32_32x32x16_bf16(a, bq, acc[mt], 0, 0, 0); } }
#pragma unroll
        for (int mt = 0; mt < 4; ++mt)
#pragma unroll
            for (int rr = 0; rr < 16; ++rr) acc[mt][rr] = __uint_as_float((__float_as_uint(acc[mt][rr]) & ~127u) | (unsigned)(32 * mt + crow(rr, hi)));
        {   float g0[16], g1[16], g2[16], g3[16];
#pragma unroll
            for (int rr = 0; rr < 16; ++rr) { g0[rr] = acc[0][rr]; g1[rr] = acc[1][rr]; g2[rr] = acc[2][rr]; g3[rr] = acc[3][rr]; }
            sort16_desc(g0); sort16_desc(g1); sort16_desc(g2); sort16_desc(g3);
            merge_top16(g0, g1); merge_top16(g2, g3); merge_top16(g0, g2);
            pair_merge_top16(g0);
#pragma unroll
            for (int k = 0; k < 16; ++k) tops[p][k] = g0[k];
        }
    }
    {
        v4u tb; unsigned b_[16];
#pragma unroll
        for (int k = 0; k < 16; ++k) b_[k] = __float_as_uint(hi ? tops[1][k] : tops[0][k]) & 127u;
        tb.x = b_[0] | (b_[1] << 8) | (b_[2] << 16) | (b_[3] << 24); tb.y = b_[4] | (b_[5] << 8) | (b_[6] << 16) | (b_[7] << 24);
        tb.z = b_[8] | (b_[9] << 8) | (b_[10] << 16) | (b_[11] << 24); tb.w = b_[12] | (b_[13] << 8) | (b_[14] << 16) | (b_[15] << 24);
        *(LAS v4u*)(lds + P5_TL_OFF + ((c32 * 8 + w) * 2 + hi) * 16) = tb;
    }
    float best[16];
    {   float ca[16], cb[16];
#pragma unroll
        for (int i = 0; i < 16; ++i) { ca[i] = -3.0e38f; cb[i] = -3.0e38f; }
        int c = 0;
#pragma unroll
        for (int i = 0; i < 16; ++i)
#pragma unroll
            for (int j = 0; j < 16; ++j)
                if ((i + 1) * (j + 1) <= 16) {
                    const float val = tops[0][i] + tops[1][j];
                    const float pk = __uint_as_float((__float_as_uint(val) & ~255u) | (unsigned)(i * 16 + j));
                    const int sl = c >> 1;
                    if (sl < 16) { if ((c & 1) == 0) ca[sl] = pk; else ca[sl] = hi ? pk : ca[sl]; }
                    else         { if ((c & 1) == 0) cb[sl - 16] = pk; else cb[sl - 16] = hi ? pk : cb[sl - 16]; }
                    ++c;
                }
        sort16_desc(ca); sort16_desc(cb); merge_top16(ca, cb); pair_merge_top16(ca);
#pragma unroll
        for (int k = 0; k < 16; ++k) best[k] = ca[k];
    }
    const int tokc = 32 * hh + c32;
    const float s2v = s2l[tokc] * LOG2E;
    float ge[16]; float gs = 0.f;
#pragma unroll
    for (int k = 0; k < 16; ++k) { ge[k] = __builtin_amdgcn_exp2f((best[k] - best[0]) * s2v); gs += ge[k]; }
    const float gi = 1.0f / gs;
    asm volatile("s_waitcnt lgkmcnt(0)" ::: "memory");
    const LAS unsigned char* tl0 = lds + P5_TL_OFF + ((c32 * 8 + w) * 2) * 16;
    LAS v2u* lst = (LAS v2u*)(lds + P5_LIST_OFF) + (tokc >> 3) * 1024 + (tokc & 7) * 128 + w * 16 + 8 * hi;
#pragma unroll
    for (int k = 0; k < 8; ++k) {
        const float bsel = hi ? best[k + 8] : best[k]; const float gsel = (hi ? ge[k + 8] : ge[k]) * gi;
        const unsigned code = __float_as_uint(bsel) & 255u; const unsigned e0 = tl0[code >> 4], e1 = tl0[16 + (code & 15u)];
        const unsigned e = e0 * 128u + e1;
        const unsigned g16 = (unsigned)__builtin_bit_cast(unsigned short, (_Float16)(gsel * SV[e] * P5_GSCALE)) & 0x7fffu;
        v2u ent; ent.x = (e << 18) | ((unsigned)(tokc & 7) << 15) | g16; ent.y = __float_as_uint(SU[e]);
        lst[k] = ent;
    }
}
#define P5_BODY(S) { int d_ = 0; \
        d_ = __builtin_amdgcn_sdot4((int)uq.x, (int)hq[S].x, d_, false); d_ = __builtin_amdgcn_sdot4((int)uq.y, (int)hq[S].y, d_, false); \
        d_ = __builtin_amdgcn_sdot4((int)uq.z, (int)hq[S].z, d_, false); d_ = __builtin_amdgcn_sdot4((int)uq.w, (int)hq[S].w, d_, false); \
        d_ += dppi<0xB1>(d_); d_ += dppi<0x4E>(d_); d_ += dppi<0x141>(d_); d_ += dppi<0x140>(d_);              \
        d_ += __builtin_amdgcn_update_dpp(0, d_, 0x142, 0xA, 0xF, false); d_ += __builtin_amdgcn_update_dpp(0, d_, 0x143, 0xC, 0xF, false);     \
        const float x_ = (float)__builtin_amdgcn_readlane(d_, 63) * (su * kx[S]); \
        const float t_ = x_ * fmaf(x_ * x_, -0.10294324f, -2.30220819f);                                        \
        const float cf = gate * x_ * __builtin_amdgcn_rcpf(1.0f + __builtin_amdgcn_exp2f(t_)); \
        _Pragma("unroll") for (int j_ = 0; j_ < 4; ++j_) { const f32x2v lo_ = __builtin_amdgcn_cvt_pk_f32_fp8((int)vq[j_], false), hi_ = __builtin_amdgcn_cvt_pk_f32_fp8((int)vq[j_], true); \
        acc[S][4 * j_ + 0] = fmaf(cf, lo_.x, acc[S][4 * j_ + 0]); acc[S][4 * j_ + 1] = fmaf(cf, lo_.y, acc[S][4 * j_ + 1]); \
        acc[S][4 * j_ + 2] = fmaf(cf, hi_.x, acc[S][4 * j_ + 2]); acc[S][4 * j_ + 3] = fmaf(cf, hi_.y, acc[S][4 * j_ + 3]); } }
typedef float f32x2v __attribute__((ext_vector_type(2)));
__device__ __forceinline__ void peer_unit(Frame& F, int unit, const bf16* QP, const bf16* SKB, const unsigned char* UQ, const unsigned char* VQ, const float* SU, const float* SV, float* out) {
    int lane = F.lane; asm volatile("" : "+v"(lane));
    const int w = F.wave;
    const int t0 = unit * 64;
    LAS unsigned char* lds = F.lds;
    LAS float* s2l = (LAS float*)(lds + P5_S2_OFF); LAS float* shl = (LAS float*)(lds + P5_SH_OFF);
#pragma unroll 1
    for (int i = 0; i < 8; ++i) { const int tok = 8 * w + i; const GAS f32x4* xr = (const GAS f32x4*)(out + (size_t)(t0 + tok) * DM) + lane; float s = 0.f, mx = 0.f;
#pragma unroll
        for (int j = 0; j < 4; ++j) { const f32x4 v = xr[64 * j]; s += (v.x * v.x + v.y * v.y) + (v.z * v.z + v.w * v.w);
            mx = fmaxf(mx, fmaxf(fmaxf(fabsf(v.x), fabsf(v.y)), fmaxf(fabsf(v.z), fabsf(v.w)))); }
        s = wave_sum_dpp(s); mx = wave_max_dpp(mx);
        if (lane == 0) { s2l[tok] = 1.0f / sqrtf(s * (1.0f / 1024.0f) + EPS); shl[tok] = mx > 0.f ? mx * (1.0f / 127.0f) : 1.0f; } }
    __syncthreads();
#pragma unroll 1
    for (int hh = 0; hh < 2; ++hh) { peer_stage_a(F, t0, hh, QP, SKB, SU, SV); __syncthreads(); }
    lane = F.lane; asm volatile("" : "+v"(lane));
    LAS v2u* lw = (LAS v2u*)(lds + P5_LIST_OFF) + w * 1024;
    LAS unsigned* cnt = (LAS unsigned*)(lds + P5_CNT_OFF) + w * 128;
#define P5_BIN(x) ((((x) >> 27) << 3) | (((x) >> 15) & 7u))
    {
        v2u e16[16];
#pragma unroll
        for (int i = 0; i < 16; ++i) e16[i] = lw[64 * i + lane];
        *(LAS v2u*)(cnt + 2 * lane) = (v2u){0u, 0u};
        asm volatile("s_waitcnt lgkmcnt(0)" ::: "memory");
        unsigned rk[16];
#pragma unroll
        for (int i = 0; i < 16; ++i) { const unsigned bin = P5_BIN(e16[i].x); const unsigned sh = (bin & 1u) * 16u;
            const unsigned old = __hip_atomic_fetch_add(cnt + (bin >> 1), 1u << sh, __ATOMIC_RELAXED, __HIP_MEMORY_SCOPE_WORKGROUP); rk[i] = (old >> sh) & 0xffffu; }
        asm volatile("s_waitcnt lgkmcnt(0)" ::: "memory");
        const v2u cw = *(const LAS v2u*)(cnt + 2 * lane);
        unsigned c4[4] = {cw.x & 0xffffu, cw.x >> 16, cw.y & 0xffffu, cw.y >> 16};
        const unsigned tot = (c4[0] + c4[1]) + (c4[2] + c4[3]);
        unsigned incl = tot;
#pragma unroll
        for (int o = 1; o < 64; o <<= 1) { const unsigned t = (unsigned)__shfl_up((int)incl, o); if (lane >= o) incl += t; }
        unsigned run = incl - tot; unsigned st[4];
#pragma unroll
        for (int k = 0; k < 4; ++k) { st[k] = run; run += c4[k]; }
        asm volatile("s_waitcnt lgkmcnt(0)" ::: "memory");
        *(LAS v2u*)(cnt + 2 * lane) = (v2u){st[0] | (st[1] << 16), st[2] | (st[3] << 16)};
        asm volatile("s_waitcnt lgkmcnt(0)" ::: "memory");
#pragma unroll
        for (int i = 0; i < 16; ++i) { const unsigned bin = P5_BIN(e16[i].x);
            const unsigned base = (cnt[bin >> 1] >> ((bin & 1u) * 16u)) & 0xffffu; lw[base + rk[i]] = e16[i]; }
        asm volatile("s_waitcnt lgkmcnt(0)" ::: "memory");
    }
#undef P5_BIN
    lane = F.lane; asm volatile("" : "+v"(lane));
    v4u hq[8]; float kx[8];
#pragma unroll
    for (int s = 0; s < 8; ++s) { const int tok = 8 * w + s; const GAS f32x4* xr = (const GAS f32x4*)(out + (size_t)(t0 + tok) * DM) + lane; f32x4 v[4];
#pragma unroll
        for (int j = 0; j < 4; ++j) v[j] = xr[64 * j];
        const float sh = shl[tok]; hq[s] = quant16(v, 1.0f / sh, 0); kx[s] = sh * s2l[tok]; }
    float acc[8][16];
#pragma unroll
    for (int s = 0; s < 8; ++s)
#pragma unroll
        for (int j = 0; j < 16; ++j) acc[s][j] = 0.f;
    asm volatile("s_waitcnt vmcnt(0)" ::: "memory");
    LAS unsigned char* ring = lds + P5_RING_OFF + w * P5_RING_WAVE;
    const unsigned char* uvgl = UQ + 16 * lane;
#define P5_ISSUE(idx, slot_) { const v2u en_ = lw[(idx) & 1023]; const unsigned e_ = (unsigned)__builtin_amdgcn_readfirstlane((int)en_.x) >> 18; \
        const unsigned* gp_ = (const unsigned*)(uvgl + (size_t)e_ * 2048); \
        __builtin_amdgcn_global_load_lds(gp_, (LAS unsigned*)(ring + (slot_) * 2048), 16, 0, 0); \
        __builtin_amdgcn_global_load_lds(gp_, (LAS unsigned*)(ring + (slot_) * 2048), 16, 1024, 0); }
#pragma unroll
    for (int i = 0; i < P5_NSLOT; ++i) P5_ISSUE(i, i)
    int slot = 0, i = 0;
    const unsigned xw = (unsigned)(((blockIdx.x >> 3) & 31) * 8 + w);
    const bool hih = lane >= 32;
#define P5_PAIR(S) { const v2u ent = lw[i]; \
        const unsigned key = (unsigned)__builtin_amdgcn_readfirstlane((int)ent.x); const float su = __uint_as_float((unsigned)__builtin_amdgcn_readfirstlane((int)ent.y)); \
        asm volatile("s_waitcnt vmcnt(8)" ::: "memory"); \
        const v4u uq = *(const LAS v4u*)(ring + slot * 2048 + 16 * lane), vq = *(const LAS v4u*)(ring + slot * 2048 + 1024 + 16 * lane); \
        asm volatile("s_waitcnt lgkmcnt(0)" ::: "memory"); \
        P5_ISSUE(i + P5_NSLOT, slot) \
        slot = (slot == P5_NSLOT - 1) ? 0 : slot + 1; \
        const float gate = (float)__builtin_bit_cast(_Float16, (unsigned short)(key & 0x7fffu)); \
        P5_BODY(S) }
#define P5_PAIR2(S) { const v2u entA = lw[i], entB = lw[i + 1]; \
        const unsigned keyA = (unsigned)__builtin_amdgcn_readfirstlane((int)entA.x), keyB = (unsigned)__builtin_amdgcn_readfirstlane((int)entB.x); \
        const float suA = __uint_as_float((unsigned)__builtin_amdgcn_readfirstlane((int)entA.y)), suB = __uint_as_float((unsigned)__builtin_amdgcn_readfirstlane((int)entB.y)); \
        asm volatile("s_waitcnt vmcnt(6)" ::: "memory"); \
        const int slotB = (slot == P5_NSLOT - 1) ? 0 : slot + 1; \
        const v4u uqA = *(const LAS v4u*)(ring + slot * 2048 + 16 * lane), vqA = *(const LAS v4u*)(ring + slot * 2048 + 1024 + 16 * lane); \
        const v4u uqB = *(const LAS v4u*)(ring + slotB * 2048 + 16 * lane), vqB = *(const LAS v4u*)(ring + slotB * 2048 + 1024 + 16 * lane); \
        asm volatile("s_waitcnt lgkmcnt(0)" ::: "memory"); \
        P5_ISSUE(i + P5_NSLOT, slot) P5_ISSUE(i + P5_NSLOT + 1, slotB) \
        slot = (slotB == P5_NSLOT - 1) ? 0 : slotB + 1; \
        int dA_ = 0, dB_ = 0; \
        dA_ = __builtin_amdgcn_sdot4((int)uqA.x, (int)hq[S].x, dA_, false); dB_ = __builtin_amdgcn_sdot4((int)uqB.x, (int)hq[S].x, dB_, false); \
        dA_ = __builtin_amdgcn_sdot4((int)uqA.y, (int)hq[S].y, dA_, false); dB_ = __builtin_amdgcn_sdot4((int)uqB.y, (int)hq[S].y, dB_, false); \
        dA_ = __builtin_amdgcn_sdot4((int)uqA.z, (int)hq[S].z, dA_, false); dB_ = __builtin_amdgcn_sdot4((int)uqB.z, (int)hq[S].z, dB_, false); \
        dA_ = __builtin_amdgcn_sdot4((int)uqA.w, (int)hq[S].w, dA_, false); dB_ = __builtin_amdgcn_sdot4((int)uqB.w, (int)hq[S].w, dB_, false); \
        auto sw_ = __builtin_amdgcn_permlane32_swap((unsigned)dA_, (unsigned)dB_, false, false); int e_ = (int)(sw_[0] + sw_[1]);        \
        e_ += dppi<0xB1>(e_); e_ += dppi<0x4E>(e_); e_ += dppi<0x141>(e_); e_ += dppi<0x140>(e_); \
        auto s16_ = __builtin_amdgcn_permlane16_swap((unsigned)e_, (unsigned)e_, false, false); e_ = (int)(s16_[0] + s16_[1]);          \
        const float x_ = (float)e_ * ((hih ? suB : suA) * kx[S]); \
        const float t_ = x_ * fmaf(x_ * x_, -0.10294324f, -2.30220819f); \
        const float gA_ = (float)__builtin_bit_cast(_Float16, (unsigned short)(keyA & 0x7fffu)), gB_ = (float)__builtin_bit_cast(_Float16, (unsigned short)(keyB & 0x7fffu)); \
        const float cfv_ = (hih ? gB_ : gA_) * x_ * __builtin_amdgcn_rcpf(1.0f + __builtin_amdgcn_exp2f(t_)); \
        const float cfA = __uint_as_float((unsigned)__builtin_amdgcn_readlane((int)__float_as_uint(cfv_), 0)), cfB = __uint_as_float((unsigned)__builtin_amdgcn_readlane((int)__float_as_uint(cfv_), 32)); \
        _Pragma("unroll") for (int j_ = 0; j_ < 4; ++j_) { \
        const f32x2v la_ = __builtin_amdgcn_cvt_pk_f32_fp8((int)vqA[j_], false), ha_ = __builtin_amdgcn_cvt_pk_f32_fp8((int)vqA[j_], true); \
        const f32x2v lb_ = __builtin_amdgcn_cvt_pk_f32_fp8((int)vqB[j_], false), hb_ = __builtin_amdgcn_cvt_pk_f32_fp8((int)vqB[j_], true); \
        acc[S][4 * j_ + 0] = fmaf(cfB, lb_.x, fmaf(cfA, la_.x, acc[S][4 * j_ + 0])); acc[S][4 * j_ + 1] = fmaf(cfB, lb_.y, fmaf(cfA, la_.y, acc[S][4 * j_ + 1])); \
        acc[S][4 * j_ + 2] = fmaf(cfB, hb_.x, fmaf(cfA, ha_.x, acc[S][4 * j_ + 2])); acc[S][4 * j_ + 3] = fmaf(cfB, hb_.y, fmaf(cfA, ha_.y, acc[S][4 * j_ + 3])); } }
#define P5_RUN(S, END) { _Pragma("unroll 1") for (; i + 1 < (END); i += 2) P5_PAIR2(S) if (i < (END)) { P5_PAIR(S) ++i; } }
#pragma unroll 1
    for (int b = 0; b < 32; ++b) {
        {
            const unsigned pe = (unsigned)(((b + 2) & 31) * 512) + xw;
            const unsigned* gp = (const unsigned*)(uvgl + (size_t)pe * 2048);
            __builtin_amdgcn_global_load_lds(gp, (LAS unsigned*)(lds + P5_DUMMY_OFF), 16, 0, 0);
            __builtin_amdgcn_global_load_lds(gp, (LAS unsigned*)(lds + P5_DUMMY_OFF), 16, 1024, 0);
            const unsigned* gq = (const unsigned*)(uvgl + (size_t)(pe + 256) * 2048);
            __builtin_amdgcn_global_load_lds(gq, (LAS unsigned*)(lds + P5_DUMMY_OFF), 16, 0, 0);
            __builtin_amdgcn_global_load_lds(gq, (LAS unsigned*)(lds + P5_DUMMY_OFF), 16, 1024, 0); }
        const v4u sw = *(const LAS v4u*)(cnt + 4 * b);
        const unsigned w0 = (unsigned)__builtin_amdgcn_readfirstlane((int)sw.x), w1 = (unsigned)__builtin_amdgcn_readfirstlane((int)sw.y), w2 = (unsigned)__builtin_amdgcn_readfirstlane((int)sw.z), w3 = (unsigned)__builtin_amdgcn_readfirstlane((int)sw.w);
        const unsigned nb = (b == 31) ? 1024u : ((unsigned)__builtin_amdgcn_readfirstlane((int)cnt[4 * b + 4]) & 0xffffu);
        const int e0 = (int)(w0 >> 16), e1 = (int)(w1 & 0xffffu), e2 = (int)(w1 >> 16), e3 = (int)(w2 & 0xffffu), e4 = (int)(w2 >> 16), e5 = (int)(w3 & 0xffffu), e6 = (int)(w3 >> 16), e7 = (int)nb;
        P5_RUN(0, e0) P5_RUN(1, e1) P5_RUN(2, e2) P5_RUN(3, e3) P5_RUN(4, e4) P5_RUN(5, e5) P5_RUN(6, e6) P5_RUN(7, e7)
    }
#undef P5_RUN
#undef P5_PAIR2
#undef P5_PAIR
    asm volatile("s_waitcnt vmcnt(0)" ::: "memory");
    lane = F.lane; asm volatile("" : "+v"(lane));
#pragma unroll
    for (int s = 0; s < 8; ++s) { GAS f32x4* orow = (GAS f32x4*)(out + (size_t)(t0 + 8 * w + s) * DM) + lane;
#pragma unroll
        for (int j = 0; j < 4; ++j) { f32x4 a = orow[64 * j]; const float c = 1.0f / P5_GSCALE;
            a.x += acc[s][4 * j] * c; a.y += acc[s][4 * j + 1] * c; a.z += acc[s][4 * j + 2] * c; a.w += acc[s][4 * j + 3] * c; orow[64 * j] = a; } }
    __syncthreads();
}
#undef P5_ISSUE
#undef P5_BODY

#ifndef MK_N_LAUNCHES
#define MK_N_LAUNCHES 1
#endif
constexpr int N_LAUNCHES = MK_N_LAUNCHES;
constexpr int PER_PHASE = 7;
struct Args { const float* in[13]; float* out; unsigned char* ws; int ph_lo, ph_hi; };
__global__ void __launch_bounds__(NWAVES * 64, 2) fwd_megakernel(Args args) {
    extern __shared__ __attribute__((aligned(16))) unsigned char lds[];
    Frame F;
    F.lds = (LAS unsigned char*)lds;
    F.MISC = (volatile LAS unsigned*)(F.lds + MISC_OFF);
    F.tid = threadIdx.x; F.lane = F.tid & 63; F.wave = __builtin_amdgcn_readfirstlane(F.tid >> 6);
    F.G = gridDim.x;
    unsigned char* ws = args.ws; F.ws = ws;
    F.ctl = (gu32*)(ws + WS_CTL);
    F.x = args.in[0]; F.norm1_g = args.in[1]; F.w_in = args.in[2]; F.q_norm_g = args.in[3]; F.k_norm_g = args.in[4]; F.w_pool = args.in[5]; F.pool_scale = args.in[6];
    F.w_out = args.in[7]; F.norm2_g = args.in[8]; F.w_query = args.in[9]; F.sub_keys = args.in[10]; F.expert_u = args.in[11]; F.expert_v = args.in[12]; F.out = args.out;
    for (int u = F.tid; u < (LDS_BYTES - LDSCTL_OFF) / 4; u += NWAVES * 64) ((LAS unsigned*)(F.lds + LDSCTL_OFF))[u] = 0u;
    __syncthreads();
    XcdBarrier bar; bar.bar = (unsigned*)(F.ctl + CW_BAR); bar.x = 0; bar.st = nullptr;
    if (N_LAUNCHES == 1) bar = xcd_barrier_post((unsigned*)(F.ctl + CW_BAR), F.MISC + 8);
#define GRID_BAR() do { if (N_LAUNCHES == 1) xcd_barrier(bar); } while (0)
    const int lo = args.ph_lo, hi = args.ph_hi;
#define IN(k) (lo <= (k) && (k) < hi)
    bf16* const XB = (bf16*)(ws + WS_XB); bf16* const W1T = (bf16*)(ws + WS_W1T); bf16* const WOT = (bf16*)(ws + WS_WOT); bf16* const WQT = (bf16*)(ws + WS_WQT);
    bf16* const AIN = (bf16*)(ws + WS_AIN); bf16* const Qb = (bf16*)(ws + WS_Q); bf16* const Gb = (bf16*)(ws + WS_G);
    bf16* const Kb = (bf16*)args.out; bf16* const Vb = (bf16*)args.out + (size_t)T * DM;
    float* const MDm = (float*)(ws + WS_MD); float* const MDd = MDm + (size_t)3 * T * 16;
    bf16* const MERGED = XB; bf16* const HB = (bf16*)(ws + WS_HB); bf16* const QP = Gb;

    if (IN(0)) { p0_prologue(F); GRID_BAR(); }
    if (IN(1)) {
        pg8::Gemm g{XB, W1T, T, INW, DM}; pg8::StaticOrder S; S.init(T, INW, F.G, (int)blockIdx.x);
        pg8::EpiProj E{AIN, Qb, Kb, Vb, Gb, (const float*)(ws + WS_S1), F.q_norm_g, F.k_norm_g};
        pg8::gemm_phase<pg8::EpiProj, pg8::StaticOrder, true, true>(F.lds + RING_OFF, g, S, E);
        GRID_BAR();
    }
    if (IN(2)) {
        constexpr int NU = 3 * BATCH * 16 * 32; const int per = (NU + F.G - 1) / F.G; const int u0 = blockIdx.x * per, u1 = (u0 + per) < NU ? (u0 + per) : NU;
        attn_phase(F, u0, u1, Kb, Vb, Qb, MDm, MDd);
        GRID_BAR();
    }
    if (IN(3)) {
        constexpr int NU = (T / 128) * 4; const int per = (NU + F.G - 1) / F.G; const int u0 = blockIdx.x * per, u1 = (u0 + per) < NU ? (u0 + per) : NU;
        for (int u = u0; u < u1; ++u) pool_merge_unit(F, u, AIN, (const bf16*)(ws + WS_WPT), Qb, Gb, MDm, MDd, MERGED);
        GRID_BAR();
    }
    if (IN(4)) {
        pg8::Gemm g{MERGED, WOT, T, DM, DM}; pg8::StaticOrder S; S.init(T, DM, F.G, (int)blockIdx.x);
        pg8::EpiOut E{F.x, F.out, HB};
        pg8::gemm_phase<pg8::EpiOut, pg8::StaticOrder, true, true>(F.lds + RING_OFF, g, S, E);
        GRID_BAR();
    }
    if (IN(5)) {
        pg8::Gemm g{HB, WQT, T, 2048, DM}; pg8::StaticOrder S; S.init(T, 2048, F.G, (int)blockIdx.x);
        pg8::EpiPlain E{QP, 2048};
        pg8::gemm_phase<pg8::EpiPlain, pg8::StaticOrder, true, true>(F.lds + RING_OFF, g, S, E);
        GRID_BAR();
    }
    if (IN(6)) {
        constexpr int NU = T / 64; const int per = (NU + F.G - 1) / F.G; const int u0 = blockIdx.x * per, u1 = (u0 + per) < NU ? (u0 + per) : NU;
        for (int u = u0; u < u1; ++u) peer_unit(F, u, QP, (const bf16*)(ws + WS_SKB), ws + WS_UB, ws + WS_VB, (const float*)(ws + WS_SU), (const float*)(ws + WS_SV), F.out);
    }
#undef IN
#undef GRID_BAR
}

extern "C" void kernel_launch(void* const* d_in, const int* in_sizes, int n_in, void* d_out, int out_size, void* d_ws, size_t ws_size, hipStream_t stream) {
    static int grid = 0;
    if (grid == 0) {
        if (n_in != 13 || in_sizes[0] != T * DM || out_size != T * DM || ws_size < WS_END) {
            fprintf(stderr, "kernel_launch: unexpected shapes (n_in %d, in0 %d, out %d, ws %zu, need %zu); nothing launched\n", n_in, n_in > 0 ? in_sizes[0] : -1, out_size, ws_size, (size_t)WS_END); grid = -1; return; }
        int dev = 0, cus = 0, per_cu = 0;
        if (hipGetDevice(&dev) != hipSuccess || hipDeviceGetAttribute(&cus, hipDeviceAttributeMultiprocessorCount, dev) != hipSuccess) { grid = -1; return; }
        if (hipFuncSetAttribute((const void*)fwd_megakernel, hipFuncAttributeMaxDynamicSharedMemorySize, LDS_BYTES) != hipSuccess) { fprintf(stderr, "kernel_launch: hipFuncSetAttribute failed\n"); grid = -1; return; }
        if (hipOccupancyMaxActiveBlocksPerMultiprocessor(&per_cu, (const void*)fwd_megakernel, NWAVES * 64, LDS_BYTES) != hipSuccess || per_cu < 1) { fprintf(stderr, "kernel_launch: occupancy query reports %d workgroups per CU\n", per_cu); grid = -1; (void)hipGetLastError(); return; }
        (void)hipGetLastError();
        grid = cus;
    }
    if (grid < 0) return;
    if (hipMemsetAsync((char*)d_ws + WS_CTL, 0, CTL_ZERO_BYTES, stream) != hipSuccess) return;
    Args a{};
    for (int i = 0; i < 13; ++i) a.in[i] = (const float*)d_in[i];
    a.out = (float*)d_out; a.ws = (unsigned char*)d_ws;
    for (int li = 0; li < N_LAUNCHES; ++li) {
        a.ph_lo = (N_LAUNCHES == 1) ? 0 : li; a.ph_hi = (N_LAUNCHES == 1) ? PER_PHASE : li + 1;
        hipLaunchKernelGGL(fwd_megakernel, dim3(grid), dim3(NWAVES * 64), LDS_BYTES, stream, a);
    }
}
```

```cpp
#include <hip/hip_runtime.h>
#include <cstdio>
#include <cstdint>
namespace pg8 {
#define PG8_LAS __attribute__((address_space(3)))
typedef unsigned short bf16_t;
typedef short bf16x8 __attribute__((ext_vector_type(8)));
typedef float f32x4 __attribute__((ext_vector_type(4)));
typedef unsigned u32x4 __attribute__((ext_vector_type(4)));
constexpr int BM = 256, BK = 64, HALF = 128, HTB = HALF * BK * 2  , STAGE_BYTES = 8 * HTB, NXCD = 8, WGM = 8;

__host__ __device__ __forceinline__ int lds_byte(int r, int c) { const int st = (r >> 4) * 2 + (c >> 5), rr = r & 15, cc = c & 31, ob = rr * 64 + cc * 2; return st * 1024 + (ob ^ (((ob >> 9) & 1) << 5)); }
__host__ __device__ __forceinline__ void stage_rc(int b, int& R, int& C) { const int st = b / 1024, sb = b % 1024, swz = sb ^ (((sb >> 9) & 1) << 5); R = (st >> 1) * 16 + swz / 64; C = (st & 1) * 32 + (swz % 64) / 2; }
__host__ __device__ __forceinline__ int perm32(int rho) { const int n = rho >> 4, i = rho & 15; return 8 * (i >> 2) + 4 * n + (i & 3); }

struct Unit { int pm, pn; };
struct Gemm { const bf16_t* A; const bf16_t* Bt; int M, N, K; };

struct StaticOrder {
    int nM, nN, nwg, G, c;
    __host__ __device__ void init(int M, int N, int G_, int c_) { nM = M / BM; nN = N / BM; nwg = nM * nN; G = G_; c = c_; }
    __host__ __device__ bool next(int i, Unit& u) const {
        const long L = (long)i * G + c; if (L >= nwg) return false;
        int wgid = (int)L; { const int q = nwg / NXCD, r = nwg % NXCD, xcd = wgid % NXCD, off = wgid / NXCD; wgid = (xcd < r ? xcd * (q + 1) : r * (q + 1) + (xcd - r) * q) + off; }
        const int nig = WGM * nN, gid = wgid / nig, fm = gid * WGM, gsz = (nM - fm) < WGM ? (nM - fm) : WGM;
        u.pm = fm + ((wgid % nig) % gsz); u.pn = (wgid % nig) / gsz; return true;
    }
    __device__ __forceinline__ void a_ready(const Unit&) const {}
    __device__ __forceinline__ void done(const Unit&) const {}
};
__device__ __forceinline__ unsigned cvt_pk_bf16(float lo, float hi) { unsigned r; asm volatile("v_cvt_pk_bf16_f32 %0, %1, %2" : "=v"(r) : "v"(lo), "v"(hi)); return r; }

typedef float f32x2 __attribute__((ext_vector_type(2)));
__device__ __forceinline__ float xrow16_sum(float x) {
    auto s = __builtin_amdgcn_permlane16_swap(__float_as_uint(x), __float_as_uint(x), false, false);
    x = __uint_as_float(s[0]) + __uint_as_float(s[1]);
    auto t = __builtin_amdgcn_permlane32_swap(__float_as_uint(x), __float_as_uint(x), false, false);
    return __uint_as_float(t[0]) + __uint_as_float(t[1]);
}
struct EpiPlain {
    static constexpr bool PERM = true, AFTER_DRAIN = false;
    bf16_t* O; int ldc;
    __device__ __forceinline__ void operator()(const f32x4 (&acc)[2][2][4][2], const Unit& u, int wr, int wc, int fr, int fq) const {
        const int row0 = u.pm * BM + wr * 64 + fr; const int col0 = u.pn * BM + wc * 32 + 8 * fq;
#pragma unroll
        for (int ai = 0; ai < 2; ++ai)
#pragma unroll
            for (int m = 0; m < 4; ++m) { bf16_t* rowp = O + (size_t)(row0 + ai * HALF + m * 16) * ldc + col0;
#pragma unroll
                for (int bj = 0; bj < 2; ++bj) { const f32x4 v0 = acc[ai][bj][m][0], v1 = acc[ai][bj][m][1];
                    u32x4 w; w.x = cvt_pk_bf16(v0[0], v0[1]); w.y = cvt_pk_bf16(v0[2], v0[3]); w.z = cvt_pk_bf16(v1[0], v1[1]); w.w = cvt_pk_bf16(v1[2], v1[3]);
                    *(u32x4*)(rowp + bj * HALF) = w; } }
    }
};
struct EpiProj {
    static constexpr bool PERM = true, AFTER_DRAIN = false;
    bf16_t *AIN, *Q, *K, *V, *G; const float* qg; const float* kg;
    __device__ __forceinline__ void operator()(const f32x4 (&acc)[2][2][4][2], const Unit& u, int wr, int wc, int fr, int fq) const {
        const int pn = u.pn; int type, ldc, colt; bf16_t* base;
        if (pn < 2)       { type = 0; base = AIN; ldc = 512;  colt = pn * 256; }
        else if (pn < 14) { type = 1; base = Q;   ldc = 3072; colt = (pn - 2) * 256; }
        else if (pn < 18) { type = 2; base = K;   ldc = 1024; colt = (pn - 14) * 256; }
        else if (pn < 22) { type = 3; base = V;   ldc = 1024; colt = (pn - 18) * 256; }
        else              { type = 4; base = G;   ldc = 2048; colt = (pn - 22) * 256; }
        const int col0 = colt + 64 * wc + 8 * fq;
        const int row0 = u.pm * BM + wr * 64 + fr;
        f32x4 gn[2][2];
        const float* gp = (type == 2) ? kg : qg;
        const float gmul = (type == 1) ? 0.125f * 1.4426950408889634f : 1.0f;
#pragma unroll
        for (int bj = 0; bj < 2; ++bj)
#pragma unroll
            for (int n = 0; n < 2; ++n) gn[bj][n] = *(const f32x4*)(gp + 32 * bj + 8 * fq + 4 * n) * gmul;
#pragma unroll
        for (int ai = 0; ai < 2; ++ai)
#pragma unroll
            for (int m = 0; m < 4; ++m) {
                const int row = row0 + ai * HALF + m * 16;
                f32x4 v[2][2];
#pragma unroll
                for (int bj = 0; bj < 2; ++bj)
#pragma unroll
                    for (int n = 0; n < 2; ++n) v[bj][n] = acc[ai][bj][m][n];
                if (type == 1 || type == 2) {
                    float ss = 0.f;
#pragma unroll
                    for (int bj = 0; bj < 2; ++bj)
#pragma unroll
                        for (int n = 0; n < 2; ++n) { const f32x4 x = v[bj][n]; ss += (x[0] * x[0] + x[1] * x[1]) + (x[2] * x[2] + x[3] * x[3]); }
                    ss = xrow16_sum(ss);
                    const float rn = __builtin_amdgcn_rsqf(ss * (1.0f / 64.0f) + 1e-6f);
#pragma unroll
                    for (int bj = 0; bj < 2; ++bj)
#pragma unroll
                        for (int n = 0; n < 2; ++n) v[bj][n] = v[bj][n] * rn * gn[bj][n];
                }
                bf16_t* rowp = base + (size_t)row * ldc + col0;
                if (type >= 1 && type <= 3) {
                    const int hh = (colt >> 6) + wc;
                    const int bb = row >> 13, tt = row & 8191;
                    const size_t slab = (type == 1) ? (size_t)((hh >> 4) * 8 + bb) * 16 + (hh & 15) : (size_t)bb * 16 + hh;
                    rowp = base + (slab * 8192 + tt) * 64 + 8 * fq; }
#pragma unroll
                for (int bj = 0; bj < 2; ++bj) { const f32x4 v0 = v[bj][0], v1 = v[bj][1];
                    u32x4 w; w.x = cvt_pk_bf16(v0[0], v0[1]); w.y = cvt_pk_bf16(v0[2], v0[3]); w.z = cvt_pk_bf16(v1[0], v1[1]); w.w = cvt_pk_bf16(v1[2], v1[3]);
                    *(u32x4*)(rowp + 32 * bj) = w; }
            }
    }
};
struct EpiOut {
    static constexpr bool PERM = true, AFTER_DRAIN = false;
    const float* x; float* out; bf16_t* hb;
    __device__ __forceinline__ void operator()(const f32x4 (&acc)[2][2][4][2], const Unit& u, int wr, int wc, int fr, int fq) const {
        const int row0 = u.pm * BM + wr * 64 + fr; const int col0 = u.pn * BM + wc * 32 + 8 * fq;
#pragma unroll
        for (int ai = 0; ai < 2; ++ai)
#pragma unroll
            for (int m = 0; m < 4; ++m) { const size_t off = (size_t)(row0 + ai * HALF + m * 16) * 1024 + col0;
#pragma unroll
                for (int bj = 0; bj < 2; ++bj) {
                    const f32x4 x0 = *(const f32x4*)(x + off + bj * HALF), x1 = *(const f32x4*)(x + off + bj * HALF + 4);
                    const f32x4 v0 = acc[ai][bj][m][0] + x0, v1 = acc[ai][bj][m][1] + x1;
                    *(f32x4*)(out + off + bj * HALF) = v0; *(f32x4*)(out + off + bj * HALF + 4) = v1;
                    u32x4 w; w.x = cvt_pk_bf16(v0[0], v0[1]); w.y = cvt_pk_bf16(v0[2], v0[3]); w.z = cvt_pk_bf16(v1[0], v1[1]); w.w = cvt_pk_bf16(v1[2], v1[3]);
                    *(u32x4*)(hb + off + bj * HALF) = w; } }
    }
};
template <class Epi, class Sched, bool ALIGN_EPI = false, bool SP2 = false>
__device__ __forceinline__ void gemm_phase(PG8_LAS unsigned char* lds, const Gemm g, const Sched& S, const Epi& E) {
    const int tid = threadIdx.x, wid = __builtin_amdgcn_readfirstlane(tid >> 6), lane = tid & 63, wr = wid >> 2, wc = wid & 3, fr = lane & 15, fq = lane >> 4;
    const int K = g.K, nt = K / BK;
    unsigned voffA[2], voffB[2];
#pragma unroll
    for (int i = 0; i < 2; ++i) { int R, C; stage_rc(tid * 16 + i * 8192, R, C); const int Rb = Epi::PERM ? ((R & ~31) + perm32(R & 31)) : R;
        voffA[i] = (unsigned)(R * K + C) * 2u; voffB[i] = (unsigned)(Rb * K + C) * 2u; }
    const size_t kstep = (size_t)(BK * 2);
    const size_t hstep = (size_t)HALF * K * 2;
    const size_t tstep = 2 * hstep;
    const unsigned ldsw = (unsigned)wid * 1024u;
    const int aoff = lds_byte(wr * 64 + fr, fq * 8), boff = lds_byte(wc * 32 + fr, fq * 8);
#define PG8_SA(b, h) (((b) * 2 + (h)) * HTB)
#define PG8_SB(b, h) ((4 + (b) * 2 + (h)) * HTB)
#define PG8_STAGE(bufoff, gbase, voff) do { _Pragma("unroll") for (int _i = 0; _i < 2; ++_i) \
        __builtin_amdgcn_global_load_lds((const unsigned*)((const char*)(gbase) + (voff)[_i]), (PG8_LAS unsigned*)(lds + (bufoff) + ldsw + _i * 8192), 16, 0, 0); } while (0)
#define PG8_LDA(dst, b, h) do { _Pragma("unroll") for (int m = 0; m < 4; ++m) _Pragma("unroll") for (int k = 0; k < 2; ++k) dst[m][k] = *(const PG8_LAS bf16x8*)(lds + PG8_SA(b, h) + aoff + m * 2048 + k * 1024); } while (0)
#define PG8_LDB(dst, b, h) do { _Pragma("unroll") for (int n = 0; n < 2; ++n) _Pragma("unroll") for (int k = 0; k < 2; ++k) dst[n][k] = *(const PG8_LAS bf16x8*)(lds + PG8_SB(b, h) + boff + n * 2048 + k * 1024); } while (0)
#define PG8_MMA(ai, bj, At, Bt) do { __builtin_amdgcn_s_setprio(1); _Pragma("unroll") for (int m = 0; m < 4; ++m) _Pragma("unroll") for (int n = 0; n < 2; ++n) _Pragma("unroll") for (int k = 0; k < 2; ++k) \
        acc[ai][bj][m][n] = __builtin_amdgcn_mfma_f32_16x16x32_bf16(Bt[n][k], At[m][k], acc[ai][bj][m][n], 0, 0, 0); __builtin_amdgcn_s_setprio(0); } while (0)
#define PG8_WAIT_V(n) asm volatile("s_waitcnt vmcnt(" #n ")" ::: "memory")
#define PG8_WAIT_L(n) asm volatile("s_waitcnt lgkmcnt(" #n ")" ::: "memory")
#define PG8_BAR __builtin_amdgcn_s_barrier()
#define PG8_SCHED __builtin_amdgcn_sched_barrier(0)
    Unit cur, nxt; int ui = 0;
    if (!S.next(0, cur)) return;
    f32x4 acc[2][2][4][2];
#pragma unroll
    for (int a = 0; a < 2; ++a)
#pragma unroll
        for (int b = 0; b < 2; ++b)
#pragma unroll
            for (int m = 0; m < 4; ++m)
#pragma unroll
                for (int n = 0; n < 2; ++n) acc[a][b][m][n] = (f32x4){0.f, 0.f, 0.f, 0.f};
    bf16x8 At[4][2], B0[2][2], B1[2][2];
    const char* cA = (const char*)g.A + (size_t)cur.pm * tstep; const char* cB = (const char*)g.Bt + (size_t)cur.pn * tstep;
    S.a_ready(cur);
    if constexpr (SP2) {
        PG8_STAGE(PG8_SB(0, 0), cB, voffB); PG8_STAGE(PG8_SB(0, 1), cB + hstep, voffB); PG8_STAGE(PG8_SA(0, 0), cA, voffA); PG8_STAGE(PG8_SA(0, 1), cA + hstep, voffA);
        if (wr == 1) PG8_BAR;
        PG8_WAIT_V(2); PG8_BAR;
        PG8_STAGE(PG8_SB(1, 0), cB + kstep, voffB); PG8_STAGE(PG8_SA(1, 0), cA + kstep, voffA); PG8_STAGE(PG8_SB(1, 1), cB + hstep + kstep, voffB);
        PG8_WAIT_V(6); PG8_BAR;
    } else {
        PG8_STAGE(PG8_SB(0, 0), cB, voffB); PG8_STAGE(PG8_SA(0, 0), cA, voffA); PG8_STAGE(PG8_SB(0, 1), cB + hstep, voffB); PG8_STAGE(PG8_SA(0, 1), cA + hstep, voffA);
        if (wr == 1) PG8_BAR;
        PG8_WAIT_V(4); PG8_BAR;
        PG8_STAGE(PG8_SB(1, 0), cB + kstep, voffB); PG8_STAGE(PG8_SA(1, 0), cA + kstep, voffA); PG8_STAGE(PG8_SB(1, 1), cB + hstep + kstep, voffB);
        PG8_WAIT_V(6); PG8_BAR;
    }
    for (;;) {
        const bool has_next = S.next(ui + 1, nxt);
        const char* nA = has_next ? (const char*)g.A + (size_t)nxt.pm * tstep : cA; const char* nB = has_next ? (const char*)g.Bt + (size_t)nxt.pn * tstep : cB;
        for (int t = 0; t < nt; t += 2) {
            const bool last = (t == nt - 2);
            const char* a1 = cA + (size_t)(t + 1) * kstep;
            const char* a2 = last ? nA : cA + (size_t)(t + 2) * kstep; const char* b2 = last ? nB : cB + (size_t)(t + 2) * kstep;
            const char* a3 = a2 + kstep; const char* b3 = b2 + kstep;
            if (last && has_next) S.a_ready(nxt);
            if constexpr (SP2) {
            PG8_LDB(B0, 0, 0); PG8_LDB(B1, 0, 1); PG8_SCHED; PG8_LDA(At, 0, 0); PG8_STAGE(PG8_SA(1, 1), a1 + hstep, voffA);
            PG8_WAIT_V(8); PG8_WAIT_L(0); PG8_BAR; PG8_MMA(0, 0, At, B0); PG8_MMA(0, 1, At, B1); PG8_BAR; PG8_SCHED;
            PG8_LDA(At, 0, 1); PG8_STAGE(PG8_SB(0, 0), b2, voffB); PG8_STAGE(PG8_SB(0, 1), b2 + hstep, voffB); PG8_STAGE(PG8_SA(0, 0), a2, voffA);
            PG8_WAIT_V(8); PG8_WAIT_L(0); PG8_BAR; PG8_MMA(1, 0, At, B0); PG8_MMA(1, 1, At, B1); PG8_BAR; PG8_SCHED;
            PG8_LDB(B0, 1, 0); PG8_LDB(B1, 1, 1); PG8_SCHED; PG8_LDA(At, 1, 0); PG8_STAGE(PG8_SA(0, 1), a2 + hstep, voffA);
            PG8_WAIT_V(8); PG8_WAIT_L(0); PG8_BAR; PG8_MMA(0, 0, At, B0); PG8_MMA(0, 1, At, B1); PG8_BAR; PG8_SCHED;
            PG8_LDA(At, 1, 1); PG8_STAGE(PG8_SB(1, 0), b3, voffB); PG8_STAGE(PG8_SB(1, 1), b3 + hstep, voffB); PG8_STAGE(PG8_SA(1, 0), a3, voffA);
            PG8_WAIT_V(8); PG8_WAIT_L(0); PG8_BAR; PG8_MMA(1, 0, At, B0); PG8_MMA(1, 1, At, B1); PG8_BAR; PG8_SCHED;
            } else {
            PG8_LDB(B0, 0, 0); PG8_SCHED; PG8_LDA(At, 0, 0); PG8_STAGE(PG8_SA(1, 1), a1 + hstep, voffA);
            PG8_WAIT_L(8); PG8_BAR; PG8_WAIT_L(0); PG8_MMA(0, 0, At, B0); PG8_BAR; PG8_SCHED;
            PG8_LDB(B1, 0, 1); PG8_STAGE(PG8_SB(0, 0), b2, voffB);
            PG8_BAR; PG8_WAIT_L(0); PG8_MMA(0, 1, At, B1); PG8_BAR;
            PG8_LDA(At, 0, 1); PG8_STAGE(PG8_SA(0, 0), a2, voffA);
            PG8_BAR; PG8_WAIT_L(0); PG8_MMA(1, 0, At, B0); PG8_BAR; PG8_SCHED;
            PG8_STAGE(PG8_SB(0, 1), b2 + hstep, voffB);
            PG8_WAIT_V(6); PG8_BAR; PG8_MMA(1, 1, At, B1); PG8_BAR;
            PG8_LDB(B0, 1, 0); PG8_SCHED; PG8_LDA(At, 1, 0); PG8_STAGE(PG8_SA(0, 1), a2 + hstep, voffA);
            PG8_WAIT_L(8); PG8_BAR; PG8_WAIT_L(0); PG8_MMA(0, 0, At, B0); PG8_BAR; PG8_SCHED;
            PG8_LDB(B1, 1, 1); PG8_STAGE(PG8_SB(1, 0), b3, voffB);
            PG8_BAR; PG8_WAIT_L(0); PG8_MMA(0, 1, At, B1); PG8_BAR;
            PG8_LDA(At, 1, 1); PG8_STAGE(PG8_SA(1, 0), a3, voffA);
            PG8_BAR; PG8_WAIT_L(0); PG8_MMA(1, 0, At, B0); PG8_BAR; PG8_SCHED;
            PG8_STAGE(PG8_SB(1, 1), b3 + hstep, voffB);
            PG8_WAIT_V(6); PG8_BAR; PG8_MMA(1, 1, At, B1); PG8_BAR;
            }
        }
        if constexpr (ALIGN_EPI) { if (wr == 0) PG8_BAR; }
        if constexpr (!Epi::AFTER_DRAIN) { E(acc, cur, wr, wc, fr, fq); S.done(cur); }
        if (!has_next) break;
#pragma unroll
        for (int a = 0; a < 2; ++a)
#pragma unroll
            for (int b = 0; b < 2; ++b)
#pragma unroll
                for (int m = 0; m < 4; ++m)
#pragma unroll
                    for (int n = 0; n < 2; ++n) acc[a][b][m][n] = (f32x4){0.f, 0.f, 0.f, 0.f};
        cur = nxt; cA = nA; cB = nB; ++ui;
        if constexpr (ALIGN_EPI) { if (wr == 1) PG8_BAR; }
    }
    PG8_WAIT_V(0);
    if constexpr (!ALIGN_EPI) { if (wr == 0) PG8_BAR; }
    PG8_BAR;
    if constexpr (Epi::AFTER_DRAIN) { E.fused(acc, cur, wr, wc, fr, fq, lds, wid, lane); S.done(cur); }
#undef PG8_SA
#undef PG8_SB
#undef PG8_STAGE
#undef PG8_LDA
#undef PG8_LDB
#undef PG8_MMA
#undef PG8_WAIT_V
#undef PG8_WAIT_L
#undef PG8_BAR
#undef PG8_SCHED
}
}

constexpr int NWAVES = 8;
constexpr int BATCH = 8, SEQ = 8192, DM = 1024, T = BATCH * SEQ;
constexpr int INW = 7680, QW = 3072, GATEW = 2048, POOLW = 512;
constexpr int NEXP = 16384;
constexpr float EPS = 1e-6f;
constexpr float LOG2E = 1.4426950408889634f;

constexpr size_t MiB = 1u << 20;
constexpr size_t WS_CTL = 0, CTL_ZERO_BYTES = 1 * MiB;
constexpr size_t WS_W1T = 2 * MiB;
constexpr size_t WS_WOT = 17 * MiB;
constexpr size_t WS_WQT = 19 * MiB;
constexpr size_t WS_WPT = 23 * MiB;
constexpr size_t WS_SKB = 23 * MiB + 512 * 1024;
constexpr size_t WS_S1 = 24 * MiB;
constexpr size_t WS_SU = 24 * MiB + 256 * 1024, WS_SV = 24 * MiB + 512 * 1024;
constexpr size_t WS_UB = 25 * MiB;
constexpr size_t WS_VB = 57 * MiB;
constexpr size_t WS_MD = 89 * MiB;
constexpr size_t WS_XB = 113 * MiB;
constexpr size_t WS_AIN = 241 * MiB;
constexpr size_t WS_Q = 305 * MiB;
constexpr size_t WS_G = 689 * MiB;
constexpr size_t WS_END = 945 * MiB;
constexpr size_t WS_HB = WS_AIN;

constexpr int CW_BAR = 4096;
constexpr int RING_OFF = 0, RING_BYTES = 131072;
constexpr int LDSCTL_OFF = 162816, MISC_OFF = LDSCTL_OFF + 320;
constexpr int LDS_BYTES = 163840;

#define GAS __attribute__((address_space(1)))
#define LAS __attribute__((address_space(3)))
typedef unsigned short bf16;
typedef unsigned v4u __attribute__((ext_vector_type(4)));
typedef unsigned v2u __attribute__((ext_vector_type(2)));
typedef float f32x4 __attribute__((ext_vector_type(4)));
typedef float f32x16 __attribute__((ext_vector_type(16)));
typedef short bf16x8 __attribute__((ext_vector_type(8)));
typedef short s16x4 __attribute__((ext_vector_type(4)));
typedef __bf16 bf16x2_t __attribute__((ext_vector_type(2)));
typedef GAS unsigned gu32;
#define RLX_AGENT __ATOMIC_RELAXED, __HIP_MEMORY_SCOPE_AGENT
#define LDS_WAIT() asm volatile("s_waitcnt lgkmcnt(0)" ::: "memory")
#define VM_WAIT() asm volatile("s_waitcnt vmcnt(0)" ::: "memory")
__device__ __forceinline__ unsigned f2bf(float f) { unsigned u = __builtin_bit_cast(unsigned, f); return (u + 0x7fffu + ((u >> 16) & 1u)) >> 16; }
__device__ __forceinline__ unsigned pk2(float lo, float hi) { return f2bf(lo) | (f2bf(hi) << 16); }
__device__ __forceinline__ float bflo(unsigned w) { return __uint_as_float(w << 16); }
__device__ __forceinline__ float bfhi(unsigned w) { return __uint_as_float(w & 0xffff0000u); }
__device__ __forceinline__ int crow(int r, int hi) { return (r & 3) + 8 * (r >> 2) + 4 * hi; }
__device__ __forceinline__ float xhalf_max(float x) { auto t = __builtin_amdgcn_permlane32_swap(__float_as_uint(x), __float_as_uint(x), false, false); return fmaxf(__uint_as_float(t[0]), __uint_as_float(t[1])); }
__device__ __forceinline__ float xhalf_sum(float x) { auto t = __builtin_amdgcn_permlane32_swap(__float_as_uint(x), __float_as_uint(x), false, false); return __uint_as_float(t[0]) + __uint_as_float(t[1]); }
__device__ __forceinline__ float wave_sum(float v) {
#pragma unroll
    for (int o = 1; o < 64; o <<= 1) v += __shfl_xor(v, o);
    return v;
}
__device__ __forceinline__ float dot2bf(unsigned a, unsigned b, float acc) { return __builtin_amdgcn_fdot2_f32_bf16(__builtin_bit_cast(bf16x2_t, a), __builtin_bit_cast(bf16x2_t, b), acc, false); }

#define XB_TMO      128
#define XB_XCNT(j)  (256  + 64 * (j))
#define XB_XSUB(j)  (1280 + 64 * (j))
#define XB_XGEN(j)  (2304 + 64 * (j))
#define XB_TOP      3328
#define XB_TOPGEN   3392
#define XCD_BAR_WORDS 3456
#define XB_SPIN_CAP (1u << 18)

__device__ __forceinline__ unsigned xb_ld(unsigned* p)              { return __hip_atomic_load(p, __ATOMIC_RELAXED, __HIP_MEMORY_SCOPE_AGENT); }
__device__ __forceinline__ unsigned xb_add(unsigned* p, unsigned v) { return __hip_atomic_fetch_add(p, v, __ATOMIC_RELAXED, __HIP_MEMORY_SCOPE_AGENT); }
__device__ __forceinline__ unsigned xb_xcc_id() { return (unsigned)__builtin_amdgcn_s_getreg((3 << 11) | 20) & 0xFu; }
#define XB_SPIN(cond, bar) do { unsigned _sp = 0; while (cond) { __builtin_amdgcn_s_sleep(1); \
    if ((++_sp & 255u) == 0u) { if (xb_ld(&(bar)[XB_TMO])) break; if (_sp > XB_SPIN_CAP) { atomicAdd(&(bar)[XB_TMO], 1u); break; } } } } while (0)

struct XcdBarrier {
    unsigned* bar; unsigned x;
    volatile LAS unsigned* st;
};

__device__ __forceinline__ XcdBarrier xcd_barrier_post(unsigned* bar, volatile LAS unsigned* st) {
    XcdBarrier b; b.bar = bar; b.x = xb_xcc_id(); b.st = st;
    if (threadIdx.x == 0) (void)xb_add(&bar[XB_XCNT(b.x)], 1u);
    return b;
}
__device__ __forceinline__ void xcd_barrier_complete(unsigned* bar, unsigned x, unsigned& nloc, unsigned& nx) {
    const unsigned G = gridDim.x * gridDim.y * gridDim.z;
    unsigned sum, cnt, mine, sp = 0u;
    for (;;) {
        sum = 0u; cnt = 0u; mine = 0u;
#pragma unroll
        for (unsigned j = 0; j < 16; ++j) { const unsigned c = xb_ld(&bar[XB_XCNT(j)]); sum += c; cnt += (c > 0u) ? 1u : 0u; mine = (j == x) ? c : mine; }
        if (sum == G) break;
        __builtin_amdgcn_s_sleep(1);
        if ((++sp & 255u) == 0u) { if (xb_ld(&bar[XB_TMO])) break; if (sp > XB_SPIN_CAP) { atomicAdd(&bar[XB_TMO], 1u); break; } }
    }
    nloc = mine > 0u ? mine : 1u; nx = cnt > 0u ? cnt : 1u;
}

__device__ __forceinline__ void xcd_barrier(const XcdBarrier& b) {
    asm volatile("s_waitcnt vmcnt(0)" ::: "memory");
    __syncthreads();
    if (threadIdx.x == 0) {
        unsigned* bar = b.bar;
        __builtin_amdgcn_s_waitcnt(0);
        unsigned nloc = b.st[0], nx = b.st[1];
        if (nloc == 0u) { xcd_barrier_complete(bar, b.x, nloc, nx); b.st[0] = nloc; b.st[1] = nx; }
        const unsigned old = xb_add(&bar[XB_XSUB(b.x)], 1u);
        const unsigned gen = old / nloc;
        if (old + 1u == (gen + 1u) * nloc) {
            __builtin_amdgcn_fence(__ATOMIC_RELEASE, "agent");
            asm volatile("s_waitcnt vmcnt(0)" ::: "memory");
            const unsigned og = xb_add(&bar[XB_TOP], 1u);
            const unsigned tg = og / nx;
            if (og + 1u == (tg + 1u) * nx) xb_add(&bar[XB_TOPGEN], 1u);
            else XB_SPIN(xb_ld(&bar[XB_TOPGEN]) == tg, bar);
            __builtin_amdgcn_fence(__ATOMIC_ACQUIRE, "agent");
            xb_add(&bar[XB_XGEN(b.x)], 1u);
            asm volatile("s_waitcnt vmcnt(0)" ::: "memory");
        } else {
            XB_SPIN(xb_ld(&bar[XB_XGEN(b.x)]) == gen, bar);
            __builtin_amdgcn_fence(__ATOMIC_ACQUIRE, "agent");
            asm volatile("s_waitcnt vmcnt(0)" ::: "memory");
        }
    }
    __syncthreads();
}

struct Frame {
    LAS unsigned char* lds;
    volatile LAS unsigned* MISC;
    gu32* ctl;
    int tid, lane, wave, G;
    const float *x, *norm1_g, *w_in, *q_norm_g, *k_norm_g, *w_pool, *pool_scale, *w_out, *norm2_g, *w_query, *sub_keys, *expert_u, *expert_v;
    float* out; unsigned char* ws;
};
template <int CTRL> __device__ __forceinline__ float dppf(float x) { return __builtin_bit_cast(float, __builtin_amdgcn_mov_dpp(__builtin_bit_cast(int, x), CTRL, 0xf, 0xf, true)); }
__device__ __forceinline__ float wave_sum_dpp(float x) {
    x += dppf<0xB1>(x);
    x += dppf<0x4E>(x);
    x += dppf<0x141>(x);
    x += dppf<0x128>(x);
    return pg8::xrow16_sum(x);
}

__device__ __forceinline__ float wave_max_dpp(float x) {
    x = fmaxf(x, dppf<0xB1>(x)); x = fmaxf(x, dppf<0x4E>(x)); x = fmaxf(x, dppf<0x141>(x)); x = fmaxf(x, dppf<0x128>(x));
    auto s = __builtin_amdgcn_permlane16_swap(__float_as_uint(x), __float_as_uint(x), false, false);
    x = fmaxf(__uint_as_float(s[0]), __uint_as_float(s[1]));
    auto t = __builtin_amdgcn_permlane32_swap(__float_as_uint(x), __float_as_uint(x), false, false);
    return fmaxf(__uint_as_float(t[0]), __uint_as_float(t[1]));
}
template <int CTRL> __device__ __forceinline__ int dppi(int x) { return __builtin_amdgcn_mov_dpp(x, CTRL, 0xf, 0xf, true); }
__device__ __forceinline__ int wave_sum_dpp_i(int x) {
    x += dppi<0xB1>(x); x += dppi<0x4E>(x); x += dppi<0x141>(x); x += dppi<0x128>(x);
    auto s = __builtin_amdgcn_permlane16_swap((unsigned)x, (unsigned)x, false, false); x = (int)(s[0] + s[1]);
    auto t = __builtin_amdgcn_permlane32_swap((unsigned)x, (unsigned)x, false, false); return (int)(t[0] + t[1]);
}
__device__ __forceinline__ v4u quant16(const f32x4 (&v)[4], float inv, int off) {
    v4u o;
#pragma unroll
    for (int j = 0; j < 4; ++j) {
        const int a = (int)__builtin_rintf(v[j].x * inv) + off, b = (int)__builtin_rintf(v[j].y * inv) + off, c = (int)__builtin_rintf(v[j].z * inv) + off, d = (int)__builtin_rintf(v[j].w * inv) + off;
        o[j] = (unsigned)(a & 255) | ((unsigned)(b & 255) << 8) | ((unsigned)(c & 255) << 16) | ((unsigned)(d & 255) << 24);
    }
    return o;
}
__device__ __forceinline__ void p0_quant_row(const float* xrow, const float* gain, unsigned char* orow, float* scale_out, int off, int lane) {
    const GAS f32x4* xr = (const GAS f32x4*)xrow + lane;
    f32x4 v[4]; float mx = 0.f;
#pragma unroll
    for (int j = 0; j < 4; ++j) { v[j] = xr[64 * j]; if (gain) v[j] = v[j] * ((const f32x4*)gain)[64 * j + lane];
        mx = fmaxf(mx, fmaxf(fmaxf(fabsf(v[j].x), fabsf(v[j].y)), fmaxf(fabsf(v[j].z), fabsf(v[j].w)))); }
    mx = wave_max_dpp(mx);
    const float sc = mx > 0.f ? mx * (1.0f / 127.0f) : 1.0f, inv = 1.0f / sc;
    *(GAS v4u*)(orow + 16 * lane) = quant16(v, inv, off);
    if (lane == 0) *scale_out = sc;
}
__device__ __forceinline__ void p0_fp8_row(const float* xrow, unsigned char* orow, float* scale_out, int lane) {
    const GAS f32x4* xr = (const GAS f32x4*)xrow + lane;
    f32x4 v[4]; float mx = 0.f;
#pragma unroll
    for (int j = 0; j < 4; ++j) { v[j] = xr[64 * j]; mx = fmaxf(mx, fmaxf(fmaxf(fabsf(v[j].x), fabsf(v[j].y)), fmaxf(fabsf(v[j].z), fabsf(v[j].w)))); }
    mx = wave_max_dpp(mx);
    const float sc = mx > 0.f ? mx * (1.0f / 400.0f) : 1.0f, inv = 1.0f / sc;
    v4u o;
#pragma unroll
    for (int j = 0; j < 4; ++j) { int pk = __builtin_amdgcn_cvt_pk_fp8_f32(v[j].x * inv, v[j].y * inv, 0, false); pk = __builtin_amdgcn_cvt_pk_fp8_f32(v[j].z * inv, v[j].w * inv, pk, true); o[j] = (unsigned)pk; }
    *(GAS v4u*)(orow + 16 * lane) = o;
    if (lane == 0) *scale_out = sc;
}
__device__ __forceinline__ void p0_transpose_item(const float* W, int K, int N, const float* rs, const float* cs, bf16* WT, int permute, LAS float* scr, int item, int lane) {
    const int nblk = N / 32, kb = item / nblk, nb = item % nblk, k0 = 64 * kb, n0 = 32 * nb;
    const float csv = cs ? cs[n0 + (lane & 31)] : 1.f;
#pragma unroll 8
    for (int i = 0; i < 32; ++i) { const int kk = 2 * i + (lane >> 5); const float r = rs ? rs[k0 + kk] : 1.f; scr[kk * 33 + (lane & 31)] = W[(size_t)(k0 + kk) * N + n0 + (lane & 31)] * r * csv; }
    LDS_WAIT(); asm volatile("" ::: "memory");
    int nout0 = n0;
    if (permute) { const int gl = (n0 & 255) >> 5; const int gp = 4 * (gl & 1) + (gl >> 1); nout0 = (n0 & ~255) + 32 * gp; }
    const int c = lane & 7;
#pragma unroll
    for (int j = 0; j < 4; ++j) { const int n = (lane >> 3) + 8 * j; const LAS float* s = scr + (8 * c) * 33 + n;
        v4u o; o.x = pk2(s[0 * 33], s[1 * 33]); o.y = pk2(s[2 * 33], s[3 * 33]); o.z = pk2(s[4 * 33], s[5 * 33]); o.w = pk2(s[6 * 33], s[7 * 33]);
        *(GAS v4u*)(WT + (size_t)(nout0 + n) * K + k0 + 8 * c) = o; }
    LDS_WAIT(); asm volatile("" ::: "memory");
}
__device__ __forceinline__ void p0_row(const float* xrow, const float* gain, bf16* orow, bool rms, int lane) {
    const GAS f32x4* xr = (const GAS f32x4*)xrow + lane;
    f32x4 v[4]; float s = 0.f;
#pragma unroll
    for (int j = 0; j < 4; ++j) { v[j] = xr[64 * j]; s += (v[j].x * v[j].x + v[j].y * v[j].y) + (v[j].z * v[j].z + v[j].w * v[j].w); }
    if (rms) { s = wave_sum(s); const float r = 1.0f / sqrtf(s * (1.0f / 1024.0f) + EPS);
#pragma unroll
        for (int j = 0; j < 4; ++j) v[j] = v[j] * r; }
    if (gain) {
#pragma unroll
        for (int j = 0; j < 4; ++j) v[j] = v[j] * ((const f32x4*)gain)[64 * j + lane];
    }
    GAS unsigned long long* o8 = (GAS unsigned long long*)orow + lane;
#pragma unroll
    for (int j = 0; j < 4; ++j) o8[64 * j] = (unsigned long long)pk2(v[j].x, v[j].y) | ((unsigned long long)pk2(v[j].z, v[j].w) << 32);
}
__device__ __forceinline__ void p0_prologue(Frame& F) {
    LAS float* scr = (LAS float*)(F.lds + RING_OFF + F.wave * 16384);
    const int gw = blockIdx.x * NWAVES + F.wave, NGW = F.G * NWAVES;
    unsigned char* ws = F.ws;
    constexpr int I_IN = (DM / 64) * (INW / 32), I_O = (DM / 64) * (DM / 32), I_Q = (DM / 64) * (2048 / 32), I_P = 4 * (128 / 64) * (256 / 32);
    constexpr int NITEMS = I_IN + I_O + I_Q + I_P;
    for (int it = gw; it < NITEMS; it += NGW) {
        int r = it;
        if (r < I_IN) { p0_transpose_item(F.w_in, DM, INW, F.norm1_g, nullptr, (bf16*)(ws + WS_W1T), 1, scr, r, F.lane); continue; } r -= I_IN;
        if (r < I_O) { p0_transpose_item(F.w_out, DM, DM, nullptr, nullptr, (bf16*)(ws + WS_WOT), 0, scr, r, F.lane); continue; } r -= I_O;
        if (r < I_Q) { p0_transpose_item(F.w_query, DM, 2048, F.norm2_g, nullptr, (bf16*)(ws + WS_WQT), 0, scr, r, F.lane); continue; } r -= I_Q;
        { const int g = r / 16, ri = r % 16;
          p0_transpose_item(F.w_pool + (size_t)g * 128 * 256, 128, 256, nullptr, F.pool_scale + g * 256, (bf16*)(ws + WS_WPT) + (size_t)g * 256 * 128, 0, scr, ri, F.lane); }
    }
    constexpr int NROWS = T + 2 * NEXP + 256;
    for (int m = gw; m < NROWS; m += NGW) {
        if (m < T) { p0_row(F.x + (size_t)m * DM, nullptr, (bf16*)(ws + WS_XB) + (size_t)m * DM, true, F.lane); continue; }
        int r = m - T;
        if (r < NEXP) { p0_quant_row(F.expert_u + (size_t)r * DM, F.norm2_g, ws + WS_UB + (size_t)r * 2048, (float*)(ws + WS_SU) + r, 0, F.lane); continue; } r -= NEXP;
        if (r < NEXP) { p0_fp8_row(F.expert_v + (size_t)r * DM, ws + WS_UB + (size_t)r * 2048 + 1024, (float*)(ws + WS_SV) + r, F.lane); continue; } r -= NEXP;
        p0_row(F.sub_keys + (size_t)r * DM, nullptr, (bf16*)(ws + WS_SKB) + (size_t)r * DM, false, F.lane);
    }
}

constexpr int ATT_NK = 384, ATT_K_OFF = 0, ATT_V_OFF = ATT_NK * 128;
typedef short v4i16_t __attribute__((ext_vector_type(4)));
__device__ __forceinline__ s16x4 vtr(unsigned ldsaddr) { return __builtin_bit_cast(s16x4, __builtin_amdgcn_ds_read_tr16_b64_v4i16((LAS v4i16_t*)(uintptr_t)ldsaddr)); }
struct AttnU { int p, b, h, dil, r, bp; };
__device__ __forceinline__ AttnU attn_decode(int unit) {
    AttnU u; const int idx = unit & 31; int t1 = unit >> 5; u.h = t1 & 15; t1 >>= 4; u.b = t1 & 7; u.p = t1 >> 3;
    const int dl = (u.p == 0) ? 0 : (u.p == 1 ? 2 : 4); u.dil = 1 << dl; const int nbp = 32 >> dl; u.r = idx >> (5 - dl); u.bp = idx & (nbp - 1); return u;
}
__device__ __forceinline__ void attn_load(const AttnU& u, int tid, int w, int c32, int hi, const bf16* __restrict__ Kg, const bf16* __restrict__ Vg, const bf16* Qg, v4u (&kr)[6], v4u (&vr)[6], bf16x8 (&qf)[4]) {
    const int rsub = tid >> 3, ch = tid & 7;
#pragma unroll
    for (int i = 0; i < 6; ++i) { const int ki = i * 64 + rsub; const int sidx = u.bp * 256 - 128 + ki; const bool ok = sidx >= 0;
        const long pos = ok ? ((long)sidx * u.dil + u.r) : 0; const size_t off = ((size_t)(u.b * 16 + u.h) * 8192 + pos) * 64 + ch * 8;
        kr[i] = *(const GAS v4u*)(Kg + off); vr[i] = *(const GAS v4u*)(Vg + off);
        if (!ok) { kr[i] = (v4u){0u, 0u, 0u, 0u}; vr[i] = (v4u){0u, 0u, 0u, 0u}; } }
    const long qt = (long)(u.bp * 256 + 32 * w + c32) * u.dil + u.r;
    const bf16* qp = Qg + ((size_t)((u.p * 8 + u.b) * 16 + u.h) * 8192 + qt) * 64;
#pragma unroll
    for (int d0 = 0; d0 < 4; ++d0) qf[d0] = *(const GAS bf16x8*)(qp + d0 * 16 + hi * 8);
}
__device__ __forceinline__ void attn_phase(Frame& F, int u0, int u1, const bf16* __restrict__ Kg, const bf16* __restrict__ Vg, bf16* Qg, float* MDm, float* MDd) {
    if (u0 >= u1) return;
    const int tid = F.tid, lane = F.lane, w = F.wave, c32 = lane & 31, hi = lane >> 5;
    LAS unsigned char* lds = F.lds;
    v4u kr[6], vr[6]; bf16x8 qn[4];
    AttnU un = attn_decode(u0);
    attn_load(un, tid, w, c32, hi, Kg, Vg, Qg, kr, vr, qn);
    const int rsub = tid >> 3, ch = tid & 7;
    const int lam = lane & 15;
    const unsigned vbase = (unsigned)(uintptr_t)(lds + ATT_V_OFF) + (unsigned)((4 * hi + (lam >> 2)) * 64 + (16 * ((lane >> 4) & 1) + 4 * (lam & 3)) * 2);
    const int cz = c32 - 4 * hi;
#pragma unroll 1
    for (int uu = u0; uu < u1; ++uu) {
        const AttnU u = un;
#pragma unroll
        for (int i = 0; i < 6; ++i) { const int ki = i * 64 + rsub;
            *(LAS v4u*)(lds + ATT_K_OFF + ki * 128 + ((ch ^ ((ki >> 1) & 7)) * 16)) = kr[i];
            *(LAS v4u*)(lds + ATT_V_OFF + (ch >> 2) * (ATT_NK * 64) + ki * 64 + (ch & 3) * 16) = vr[i]; }
        bf16x8 qf[4];
#pragma unroll
        for (int d0 = 0; d0 < 4; ++d0) qf[d0] = qn[d0];
        __syncthreads();
        if (uu + 1 < u1) { un = attn_decode(uu + 1); attn_load(un, tid, w, c32, hi, Kg, Vg, Qg, kr, vr, qn); }
        const int sidx = u.p * 16 + u.h; const float sexp = sidx < 32 ? 0.125f * (float)(sidx + 1) : 4.0f + 0.25f * (float)(sidx - 31);
        const float slope2 = exp2f(-sexp) * LOG2E * (float)u.dil;
        const float a0 = -slope2 * (float)(128 + cz);
        f32x16 st[5];
#pragma unroll
        for (int kt = 0; kt < 5; ++kt) {
            const int key = 32 * (w + kt) + c32; const LAS unsigned char* kb = lds + ATT_K_OFF + key * 128; const int sw = (key >> 1) & 7;
            f32x16 a;
#pragma unroll
            for (int rr = 0; rr < 16; ++rr) a[rr] = a0;
#pragma unroll
            for (int d0 = 0; d0 < 4; ++d0) { const bf16x8 kf = *(const LAS bf16x8*)(kb + (((2 * d0 + hi) ^ sw) * 16)); a = __builtin_amdgcn_mfma_f32_32x32x16_bf16(kf, qf[d0], a, 0, 0, 0); }
            st[kt] = a;
        }
        float mx = -1e30f;
#pragma unroll
        for (int kt = 0; kt < 5; ++kt) {
            const bool dead = (u.bp == 0) && (w + kt < 4);
#pragma unroll
            for (int rr = 0; rr < 16; ++rr) { const int rc = (rr & 3) + 8 * (rr >> 2);
                float sv = fmaf(slope2, (float)(32 * kt + rc), st[kt][rr]);
                if (kt == 0) sv = (rc >= cz) ? sv : -1e30f;
                if (kt == 4) sv = (rc <= cz) ? sv : -1e30f;
                if (dead) sv = -1e30f;
                st[kt][rr] = sv; mx = fmaxf(mx, sv); }
        }
        mx = xhalf_max(mx);
        float l = 0.f;
#pragma unroll
        for (int kt = 0; kt < 5; ++kt)
#pragma unroll
            for (int rr = 0; rr < 16; ++rr) { const float e = __builtin_amdgcn_exp2f(st[kt][rr] - mx); st[kt][rr] = e; l += e; }
        l = xhalf_sum(l);
        f32x16 o[2]; o[0] = f32x16{}; o[1] = f32x16{};
#pragma unroll
        for (int kt = 0; kt < 5; ++kt)
#pragma unroll
            for (int s2 = 0; s2 < 2; ++s2) {
                v4u pw; pw.x = pg8::cvt_pk_bf16(st[kt][8 * s2 + 0], st[kt][8 * s2 + 1]); pw.y = pg8::cvt_pk_bf16(st[kt][8 * s2 + 2], st[kt][8 * s2 + 3]);
                pw.z = pg8::cvt_pk_bf16(st[kt][8 * s2 + 4], st[kt][8 * s2 + 5]); pw.w = pg8::cvt_pk_bf16(st[kt][8 * s2 + 6], st[kt][8 * s2 + 7]);
                const bf16x8 pf = __builtin_bit_cast(bf16x8, pw);
#pragma unroll
                for (int dt = 0; dt < 2; ++dt) {
                    const unsigned a = vbase + (unsigned)(dt * (ATT_NK * 64) + (32 * (w + kt) + 16 * s2) * 64);
                    const s16x4 lo = vtr(a), hi4 = vtr(a + 8 * 64);
                    const bf16x8 vf = (bf16x8){lo[0], lo[1], lo[2], lo[3], hi4[0], hi4[1], hi4[2], hi4[3]};
                    o[dt] = __builtin_amdgcn_mfma_f32_32x32x16_bf16(vf, pf, o[dt], 0, 0, 0);
                }
            }
        const float inv = 1.0f / l;
        const long qt = (long)(u.bp * 256 + 32 * w + c32) * u.dil + u.r; const long qrow = (long)u.b * SEQ + qt;
        bf16* qp = Qg + ((size_t)((u.p * 8 + u.b) * 16 + u.h) * 8192 + qt) * 64;
#pragma unroll
        for (int dt = 0; dt < 2; ++dt)
#pragma unroll
            for (int g = 0; g < 4; ++g) { v2u ow; ow.x = pg8::cvt_pk_bf16(o[dt][4 * g] * inv, o[dt][4 * g + 1] * inv); ow.y = pg8::cvt_pk_bf16(o[dt][4 * g + 2] * inv, o[dt][4 * g + 3] * inv);
                *(GAS v2u*)(qp + 32 * dt + 8 * g + 4 * hi) = ow; }
        if (hi == 0) { const size_t mi = ((size_t)u.p * T + (size_t)qrow) * 16 + u.h; MDm[mi] = mx; MDd[mi] = l; }
        __syncthreads();
    }
}

constexpr int PB_AIN_PITCH = 272, PB_POOL_OFF = 40960, PB_POOL_PITCH = 528;
__device__ __forceinline__ void pool_merge_unit(Frame& F, int unit, const bf16* AIN, const bf16* Wpt, const bf16* OP, const bf16* Gt, const float* MDm, const float* MDd, bf16* MERGED) {
    const int tid = F.tid, lane = F.lane, w = F.wave, c32 = lane & 31, hi = lane >> 5;
    const int g = unit & 3, tile = unit >> 2, t0 = tile * 128, tin = t0 & (SEQ - 1), win = 2 << g;
    LAS unsigned char* lds = F.lds;
    for (int id = tid; id < 143 * 16; id += NWAVES * 64) { const int rr = id >> 4, ch = id & 15; v4u v = (v4u){0u, 0u, 0u, 0u};
        if (tin - 15 + rr >= 0) v = *(const GAS v4u*)(AIN + (size_t)(t0 - 15 + rr) * POOLW + g * 128 + ch * 8);
        *(LAS v4u*)(lds + rr * PB_AIN_PITCH + ch * 16) = v; }
    __syncthreads();
    {
        const int tq = w & 3, oh = w >> 2, tokl = 32 * tq + c32;
        const int cnt = (tin + tokl + 1) < win ? (tin + tokl + 1) : win; const float rc = 1.0f / (float)cnt;
        f32x16 acc[4]; acc[0] = f32x16{}; acc[1] = f32x16{}; acc[2] = f32x16{}; acc[3] = f32x16{};
        const bf16* wp = Wpt + (size_t)(g * 256 + oh * 128 + c32) * 128 + 8 * hi;
#pragma unroll 1
        for (int ks = 0; ks < 8; ++ks) {
            const LAS unsigned char* ap = lds + (15 + tokl) * PB_AIN_PITCH + (16 * ks + 8 * hi) * 2;
            const v4u own = *(const LAS v4u*)ap;
            float s[8] = {0.f, 0.f, 0.f, 0.f, 0.f, 0.f, 0.f, 0.f};
            for (int i = 0; i < win; ++i) { const v4u a = *(const LAS v4u*)(ap - i * PB_AIN_PITCH);
                s[0] += bflo(a.x); s[1] += bfhi(a.x); s[2] += bflo(a.y); s[3] += bfhi(a.y); s[4] += bflo(a.z); s[5] += bfhi(a.z); s[6] += bflo(a.w); s[7] += bfhi(a.w); }
            v4u dw; dw.x = pg8::cvt_pk_bf16(s[0] * rc - bflo(own.x), s[1] * rc - bfhi(own.x)); dw.y = pg8::cvt_pk_bf16(s[2] * rc - bflo(own.y), s[3] * rc - bfhi(own.y));
            dw.z = pg8::cvt_pk_bf16(s[4] * rc - bflo(own.z), s[5] * rc - bfhi(own.z)); dw.w = pg8::cvt_pk_bf16(s[6] * rc - bflo(own.w), s[7] * rc - bfhi(own.w));
            const bf16x8 df = __builtin_bit_cast(bf16x8, dw);
#pragma unroll
            for (int mt = 0; mt < 4; ++mt) { const bf16x8 wf = *(const GAS bf16x8*)(wp + (size_t)(32 * mt) * 128 + 16 * ks); acc[mt] = __builtin_amdgcn_mfma_f32_32x32x16_bf16(wf, df, acc[mt], 0, 0, 0); }
        }
#pragma unroll
        for (int mt = 0; mt < 4; ++mt)
#pragma unroll
            for (int gq = 0; gq < 4; ++gq) { v2u ow; ow.x = pg8::cvt_pk_bf16(acc[mt][4 * gq], acc[mt][4 * gq + 1]); ow.y = pg8::cvt_pk_bf16(acc[mt][4 * gq + 2], acc[mt][4 * gq + 3]);
                *(LAS v2u*)(lds + PB_POOL_OFF + tokl * PB_POOL_PITCH + (oh * 128 + 32 * mt + 8 * gq + 4 * hi) * 2) = ow; }
    }
    __syncthreads();
#pragma unroll 1
    for (int pass = 0; pass < 8; ++pass) {
        const int id = pass * 512 + tid, tok = id >> 5, cc = id & 31, col = g * 256 + 8 * cc, head = col >> 6; const size_t row = (size_t)t0 + tok;
        float m[3], dn[3];
#pragma unroll
        for (int p = 0; p < 3; ++p) { const size_t mi = ((size_t)p * T + row) * 16 + head; m[p] = MDm[mi]; dn[p] = MDd[mi]; }
        const float M = fmaxf(fmaxf(m[0], m[1]), m[2]);
        float wgt[3]; float ws_ = 0.f;
#pragma unroll
        for (int p = 0; p < 3; ++p) { wgt[p] = dn[p] * __builtin_amdgcn_exp2f(m[p] - M); ws_ += wgt[p]; }
        const float iw = 1.0f / ws_;
        const size_t ob = ((size_t)((row >> 13) * 16 + head) * 8192 + (row & 8191)) * 64 + (col & 63); constexpr size_t PST = (size_t)8 * 16 * 8192 * 64;
        const v4u o0 = *(const GAS v4u*)(OP + ob), o1 = *(const GAS v4u*)(OP + PST + ob), o2 = *(const GAS v4u*)(OP + 2 * PST + ob);
        const v4u g0 = *(const GAS v4u*)(Gt + row * GATEW + col), g1 = *(const GAS v4u*)(Gt + row * GATEW + 1024 + col);
        const v4u pl = *(const LAS v4u*)(lds + PB_POOL_OFF + tok * PB_POOL_PITCH + cc * 16);
        const float w0 = wgt[0] * iw, w1 = wgt[1] * iw, w2 = wgt[2] * iw;
        v4u res;
#define SIG(x_) __builtin_amdgcn_rcpf(1.0f + __builtin_amdgcn_exp2f(-LOG2E * (x_)))
#define MRG(f) { const float alo = w0 * bflo(o0.f) + w1 * bflo(o1.f) + w2 * bflo(o2.f), ahi = w0 * bfhi(o0.f) + w1 * bfhi(o1.f) + w2 * bfhi(o2.f); \
                 res.f = pg8::cvt_pk_bf16(SIG(bflo(g0.f)) * bflo(pl.f) + SIG(bflo(g1.f)) * alo, SIG(bfhi(g0.f)) * bfhi(pl.f) + SIG(bfhi(g1.f)) * ahi); }
        MRG(x) MRG(y) MRG(z) MRG(w)
#undef MRG
#undef SIG
        *(GAS v4u*)(MERGED + row * DM + col) = res;
    }
    __syncthreads();
}

constexpr int P5_LIST_WAVE = 1032  , P5_LIST_OFF = 0, P5_RING_OFF = 66048, P5_RING_WAVE = 10240, P5_NSLOT = 5, P5_TL_OFF = 147968, P5_S2_OFF = 156160, P5_SH_OFF = 156416, P5_CNT_OFF = 147968  ;
constexpr int P5_DUMMY_OFF = 158720;
constexpr float P5_GSCALE = 256.0f;
__device__ __forceinline__ float gelu_tanh(float x) {
    const float z = 0.7978845608028654f * (x + 0.044715f * x * x * x);
    const float e = __builtin_amdgcn_exp2f(2.0f * LOG2E * z);
    const float th = 1.0f - 2.0f * __builtin_amdgcn_rcpf(1.0f + e);
    return 0.5f * x * (1.0f + th);
}
#define P5_CE(a, b) { const float hi__ = fmaxf(a, b), lo__ = fminf(a, b); a = hi__; b = lo__; }
__device__ __forceinline__ void sort16_desc(float (&v)[16]) {
#pragma unroll
    for (int k = 2; k <= 16; k <<= 1)
#pragma unroll
        for (int j = k >> 1; j > 0; j >>= 1)
#pragma unroll
            for (int i = 0; i < 16; ++i) { const int l = i ^ j; if (l > i) { if ((i & k) == 0) P5_CE(v[i], v[l]) else P5_CE(v[l], v[i]) } }
}
__device__ __forceinline__ void merge_top16(float (&a)[16], const float (&b)[16]) {
#pragma unroll
    for (int i = 0; i < 16; ++i) a[i] = fmaxf(a[i], b[15 - i]);
#pragma unroll
    for (int j = 8; j > 0; j >>= 1)
#pragma unroll
        for (int i = 0; i < 16; ++i) { const int l = i ^ j; if (l > i) P5_CE(a[i], a[l]) }
}
__device__ __forceinline__ void pair_merge_top16(float (&a)[16]) {
    float lo[16], hi[16];
#pragma unroll
    for (int i = 0; i < 16; ++i) { auto t = __builtin_amdgcn_permlane32_swap(__float_as_uint(a[i]), __float_as_uint(a[i]), false, false); lo[i] = __uint_as_float(t[0]); hi[i] = __uint_as_float(t[1]); }
    merge_top16(lo, hi);
#pragma unroll
    for (int i = 0; i < 16; ++i) a[i] = lo[i];
}
__device__ __forceinline__ void peer_stage_a(Frame& F, int t0, int hh, const bf16* QP, const bf16* SKB, const float* SU, const float* SV) {
    int lane = F.lane; asm volatile("" : "+v"(lane));
    const int w = F.wave, c32 = lane & 31, hi = lane >> 5;
    LAS unsigned char* lds = F.lds;
    const LAS float* s2l = (const LAS float*)(lds + P5_S2_OFF);
    float tops[2][16];
#pragma unroll
    for (int p = 0; p < 2; ++p) {
        f32x16 acc[4]; acc[0] = f32x16{}; acc[1] = f32x16{}; acc[2] = f32x16{}; acc[3] = f32x16{};
        const bf16* qrow = QP + (size_t)(t0 + 32 * hh + c32) * 2048 + (w * 2 + p) * 128 + 8 * hi;
        const bf16* skp = SKB + (size_t)((w * 2 + p) * 128 + c32) * 128 + 8 * hi;
#pragma unroll 2
        for (int ks = 0; ks < 8; ++ks) { const bf16x8 bq = *(const GAS bf16x8*)(qrow + 16 * ks);
#pragma unroll
            for (int mt = 0; mt < 4; ++mt) { const bf16x8 a = *(const GAS bf16x8*)(skp + (size_t)(32 * mt) * 128 + 16 * ks); acc[mt] = __builtin_amdgcn_mfma_f32_32x32x16_bf16(a, bq, acc[mt], 0, 0, 0); } }
#pragma unroll
        for (int mt = 0; mt < 4; ++mt)
#pragma unroll
            for (int rr = 0; rr < 16; ++rr) acc[mt][rr] = __uint_as_float((__float_as_uint(acc[mt][rr]) & ~127u) | (unsigned)(32 * mt + crow(rr, hi)));
        {   float g0[16], g1[16], g2[16], g3[16];
#pragma unroll
            for (int rr = 0; rr < 16; ++rr) { g0[rr] = acc[0][rr]; g1[rr] = acc[1][rr]; g2[rr] = acc[2][rr]; g3[rr] = acc[3][rr]; }
            sort16_desc(g0); sort16_desc(g1); sort16_desc(g2); sort16_desc(g3);
            merge_top16(g0, g1); merge_top16(g2, g3); merge_top16(g0, g2);
            pair_merge_top16(g0);
#pragma unroll
            for (int k = 0; k < 16; ++k) tops[p][k] = g0[k];
        }
    }
    {
        v4u tb; unsigned b_[16];
#pragma unroll
        for (int k = 0; k < 16; ++k) b_[k] = __float_as_uint(hi ? tops[1][k] : tops[0][k]) & 127u;
        tb.x = b_[0] | (b_[1] << 8) | (b_[2] << 16) | (b_[3] << 24); tb.y = b_[4] | (b_[5] << 8) | (b_[6] << 16) | (b_[7] << 24);
        tb.z = b_[8] | (b_[9] << 8) | (b_[10] << 16) | (b_[11] << 24); tb.w = b_[12] | (b_[13] << 8) | (b_[14] << 16) | (b_[15] << 24);
        *(LAS v4u*)(lds + P5_TL_OFF + ((c32 * 8 + w) * 2 + hi) * 16) = tb;
    }
    float best[16];
    {   float ca[16], cb[16];
#pragma unroll
        for (int i = 0; i < 16; ++i) { ca[i] = -3.0e38f; cb[i] = -3.0e38f; }
        int c = 0;
#pragma unroll
        for (int i = 0; i < 16; ++i)
#pragma unroll
            for (int j = 0; j < 16; ++j)
                if ((i + 1) * (j + 1) <= 16) {
                    const float val = tops[0][i] + tops[1][j];
                    const float pk = __uint_as_float((__float_as_uint(val) & ~255u) | (unsigned)(i * 16 + j));
                    const int sl = c >> 1;
                    if (sl < 16) { if ((c & 1) == 0) ca[sl] = pk; else ca[sl] = hi ? pk : ca[sl]; }
                    else         { if ((c & 1) == 0) cb[sl - 16] = pk; else cb[sl - 16] = hi ? pk : cb[sl - 16]; }
                    ++c;
                }
        sort16_desc(ca); sort16_desc(cb); merge_top16(ca, cb); pair_merge_top16(ca);
#pragma unroll
        for (int k = 0; k < 16; ++k) best[k] = ca[k];
    }
    const int tokc = 32 * hh + c32;
    const float s2v = s2l[tokc] * LOG2E;
    float ge[16]; float gs = 0.f;
#pragma unroll
    for (int k = 0; k < 16; ++k) { ge[k] = __builtin_amdgcn_exp2f((best[k] - best[0]) * s2v); gs += ge[k]; }
    const float gi = 1.0f / gs;
    asm volatile("s_waitcnt lgkmcnt(0)" ::: "memory");
    const LAS unsigned char* tl0 = lds + P5_TL_OFF + ((c32 * 8 + w) * 2) * 16;
    LAS v2u* lst = (LAS v2u*)(lds + P5_LIST_OFF) + (tokc >> 3) * P5_LIST_WAVE + (tokc & 7) * 128 + w * 16 + 8 * hi;
#pragma unroll
    for (int k = 0; k < 8; ++k) {
        const float bsel = hi ? best[k + 8] : best[k]; const float gsel = (hi ? ge[k + 8] : ge[k]) * gi;
        const unsigned code = __float_as_uint(bsel) & 255u; const unsigned e0 = tl0[code >> 4], e1 = tl0[16 + (code & 15u)];
        const unsigned e = e0 * 128u + e1;
        const unsigned g16 = (unsigned)__builtin_bit_cast(unsigned short, (_Float16)(gsel * SV[e] * P5_GSCALE)) & 0x7fffu;
        v2u ent; ent.x = (e << 18) | ((unsigned)(tokc & 7) << 15) | g16; ent.y = __float_as_uint(SU[e]);
        lst[k] = ent;
    }
}
#define P5_BODY(S) { int d_ = 0; \
        d_ = __builtin_amdgcn_sdot4((int)uq.x, (int)hq[S].x, d_, false); d_ = __builtin_amdgcn_sdot4((int)uq.y, (int)hq[S].y, d_, false); \
        d_ = __builtin_amdgcn_sdot4((int)uq.z, (int)hq[S].z, d_, false); d_ = __builtin_amdgcn_sdot4((int)uq.w, (int)hq[S].w, d_, false); \
        d_ += dppi<0xB1>(d_); d_ += dppi<0x4E>(d_); d_ += dppi<0x141>(d_); d_ += dppi<0x140>(d_);              \
        d_ += __builtin_amdgcn_update_dpp(0, d_, 0x142, 0xA, 0xF, false); d_ += __builtin_amdgcn_update_dpp(0, d_, 0x143, 0xC, 0xF, false);     \
        const float x_ = (float)__builtin_amdgcn_readlane(d_, 63) * (su * kx[S]); \
        const float t_ = x_ * fmaf(x_ * x_, -0.10294324f, -2.30220819f);                                        \
        const float cf = gate * x_ * __builtin_amdgcn_rcpf(1.0f + __builtin_amdgcn_exp2f(t_)); \
        const _Float16 ch_ = (_Float16)cf; const h2v cp_ = (h2v){ch_, ch_}; \
        _Pragma("unroll") for (int j_ = 0; j_ < 4; ++j_) { \
        acc[S][2 * j_ + 0] = __builtin_elementwise_fma(cp_, f8h<false>(vq[j_]), acc[S][2 * j_ + 0]); \
        acc[S][2 * j_ + 1] = __builtin_elementwise_fma(cp_, f8h<true>(vq[j_]), acc[S][2 * j_ + 1]); } }
typedef _Float16 h2v __attribute__((ext_vector_type(2)));
template <bool HI> __device__ __forceinline__ h2v f8h(unsigned w) { return __builtin_bit_cast(h2v, __builtin_amdgcn_cvt_scalef32_pk_f16_fp8((int)w, 1.0f, HI)); }
typedef float f32x2v __attribute__((ext_vector_type(2)));
__device__ __forceinline__ void peer_unit(Frame& F, int unit, const bf16* QP, const bf16* SKB, const unsigned char* UQ, const unsigned char* VQ, const float* SU, const float* SV, float* out) {
    int lane = F.lane; asm volatile("" : "+v"(lane));
    const int w = F.wave;
    const int t0 = unit * 64;
    LAS unsigned char* lds = F.lds;
    LAS float* s2l = (LAS float*)(lds + P5_S2_OFF);
    LAS unsigned char* ringw = lds + P5_RING_OFF + w * P5_RING_WAVE; LAS float* kxl = (LAS float*)(lds + P5_SH_OFF);
#pragma unroll
    for (int hf = 0; hf < 2; ++hf) {
        f32x4 v[4][4];
#pragma unroll
        for (int q = 0; q < 4; ++q) { const GAS f32x4* xr = (const GAS f32x4*)(out + (size_t)(t0 + 8 * w + 4 * hf + q) * DM) + lane;
#pragma unroll
            for (int j = 0; j < 4; ++j) v[q][j] = xr[64 * j]; }
#pragma unroll
        for (int q = 0; q < 4; ++q) { float s = 0.f, mx = 0.f;
#pragma unroll
            for (int j = 0; j < 4; ++j) { const f32x4 x = v[q][j]; s += (x.x * x.x + x.y * x.y) + (x.z * x.z + x.w * x.w); mx = fmaxf(mx, fmaxf(fmaxf(fabsf(x.x), fabsf(x.y)), fmaxf(fabsf(x.z), fabsf(x.w)))); }
            s = wave_sum_dpp(s); mx = wave_max_dpp(mx);
            const float s2 = 1.0f / sqrtf(s * (1.0f / 1024.0f) + EPS), sh = mx > 0.f ? mx * (1.0f / 127.0f) : 1.0f;
            *(LAS v4u*)(ringw + (4 * hf + q) * 1024 + 16 * lane) = quant16(v[q], 1.0f / sh, 0);
            if (lane == 0) { s2l[8 * w + 4 * hf + q] = s2; kxl[8 * w + 4 * hf + q] = sh * s2; } }
    }
    __syncthreads();
#pragma unroll 1
    for (int hh = 0; hh < 2; ++hh) { peer_stage_a(F, t0, hh, QP, SKB, SU, SV); __syncthreads(); }
    lane = F.lane; asm volatile("" : "+v"(lane));
    LAS v2u* lw = (LAS v2u*)(lds + P5_LIST_OFF) + w * P5_LIST_WAVE;
    LAS unsigned* cnt = (LAS unsigned*)(lds + P5_CNT_OFF) + w * 128;
#define P5_BIN(x) ((((x) >> 27) << 3) | (((x) >> 15) & 7u))
    {
        v2u e16[16];
#pragma unroll
        for (int i = 0; i < 16; ++i) e16[i] = lw[64 * i + lane];
        *(LAS v2u*)(cnt + 2 * lane) = (v2u){0u, 0u};
        asm volatile("s_waitcnt lgkmcnt(0)" ::: "memory");
        unsigned rk[16];
#pragma unroll
        for (int i = 0; i < 16; ++i) { const unsigned bin = P5_BIN(e16[i].x); const unsigned sh = (bin & 1u) * 16u;
            const unsigned old = __hip_atomic_fetch_add(cnt + (bin >> 1), 1u << sh, __ATOMIC_RELAXED, __HIP_MEMORY_SCOPE_WORKGROUP); rk[i] = (old >> sh) & 0xffffu; }
        asm volatile("s_waitcnt lgkmcnt(0)" ::: "memory");
        const v2u cw = *(const LAS v2u*)(cnt + 2 * lane);
        unsigned c4[4] = {cw.x & 0xffffu, cw.x >> 16, cw.y & 0xffffu, cw.y >> 16};
        const unsigned tot = (c4[0] + c4[1]) + (c4[2] + c4[3]);
        unsigned incl = tot;
#pragma unroll
        for (int o = 1; o < 64; o <<= 1) { const unsigned t = (unsigned)__shfl_up((int)incl, o); if (lane >= o) incl += t; }
        unsigned run = incl - tot; unsigned st[4];
#pragma unroll
        for (int k = 0; k < 4; ++k) { st[k] = run; run += c4[k]; }
        asm volatile("s_waitcnt lgkmcnt(0)" ::: "memory");
        *(LAS v2u*)(cnt + 2 * lane) = (v2u){st[0] | (st[1] << 16), st[2] | (st[3] << 16)};
        asm volatile("s_waitcnt lgkmcnt(0)" ::: "memory");
#pragma unroll
        for (int i = 0; i < 16; ++i) { const unsigned bin = P5_BIN(e16[i].x);
            const unsigned base = (cnt[bin >> 1] >> ((bin & 1u) * 16u)) & 0xffffu; lw[base + rk[i]] = e16[i]; }
        asm volatile("s_waitcnt lgkmcnt(0)" ::: "memory");
        if (lane < 8) lw[1024 + lane] = lw[lane];
        asm volatile("s_waitcnt lgkmcnt(0)" ::: "memory");
    }
#undef P5_BIN
    lane = F.lane; asm volatile("" : "+v"(lane));
    v4u hq[8]; float kx[8];
#pragma unroll
    for (int s = 0; s < 8; ++s) { hq[s] = *(const LAS v4u*)(lds + P5_RING_OFF + w * P5_RING_WAVE + s * 1024 + 16 * lane); kx[s] = ((const LAS float*)(lds + P5_SH_OFF))[8 * w + s]; }
    asm volatile("s_waitcnt lgkmcnt(0)" : "+v"(hq[0]), "+v"(hq[1]), "+v"(hq[2]), "+v"(hq[3]), "+v"(hq[4]), "+v"(hq[5]), "+v"(hq[6]), "+v"(hq[7]) :: "memory");
    h2v acc[8][8];
#pragma unroll
    for (int s = 0; s < 8; ++s)
#pragma unroll
        for (int j = 0; j < 8; ++j) acc[s][j] = (h2v){(_Float16)0.f, (_Float16)0.f};
    asm volatile("s_waitcnt vmcnt(0)" ::: "memory");
    LAS unsigned char* ring = lds + P5_RING_OFF + w * P5_RING_WAVE;
    const unsigned char* uvgl = UQ + 16 * lane;
#define P5_ISSUE(idx, slot_) { const v2u en_ = lw[(idx) & 1023]; const unsigned e_ = (unsigned)__builtin_amdgcn_readfirstlane((int)en_.x) >> 18; \
        const unsigned* gp_ = (const unsigned*)(uvgl + (size_t)e_ * 2048); \
        __builtin_amdgcn_global_load_lds(gp_, (LAS unsigned*)(ring + (slot_) * 2048), 16, 0, 0); \
        __builtin_amdgcn_global_load_lds(gp_, (LAS unsigned*)(ring + (slot_) * 2048), 16, 1024, 0); }
#pragma unroll
    for (int i = 0; i < P5_NSLOT; ++i) P5_ISSUE(i, i)
    int slot = 0, i = 0;
    const unsigned xw = (unsigned)(((blockIdx.x >> 3) & 31) * 8 + w);
    const bool hih = lane >= 32; const unsigned lane16 = 16u * (unsigned)lane; const unsigned ringa = (unsigned)(uintptr_t)ring;
    const unsigned lwa = (unsigned)(uintptr_t)lw;
    const unsigned lwah = lwa + (hih ? 8u : 0u);
#define P5_DMA(e_, slot_) { const unsigned char* rb_ = UQ + (size_t)(e_) * 2048; const unsigned la_ = ringa + (unsigned)(slot_) * 2048u; unsigned keep_; \
        asm volatile("s_mov_b32 %0, m0\n\ts_mov_b32 m0, %3\n\ts_nop 0\n\tglobal_load_lds_dwordx4 %1, %2\n\tglobal_load_lds_dwordx4 %1, %2 offset:1024\n\ts_mov_b32 m0, %0" \
                     : "=&s"(keep_) : "v"(lane16), "s"(rb_), "s"(la_) : "memory"); }
#define P5_PAIR(S) { v2u ent; unsigned nx_;     \
        asm volatile("ds_read_b64 %0, %2\n\tds_read_b32 %1, %2 offset:40" : "=&v"(ent), "=&v"(nx_) : "v"(lwa + 8u * (unsigned)i) : "memory"); \
        asm volatile("s_waitcnt vmcnt(8)" ::: "memory"); \
        const v4u uq = *(const LAS v4u*)(ring + slot * 2048 + 16 * lane), vq = *(const LAS v4u*)(ring + slot * 2048 + 1024 + 16 * lane); \
        asm volatile("s_waitcnt lgkmcnt(0)" : "+v"(ent), "+v"(nx_) :: "memory");         \
        const unsigned key = (unsigned)__builtin_amdgcn_readfirstlane((int)ent.x); const float su = __uint_as_float((unsigned)__builtin_amdgcn_readfirstlane((int)ent.y)); \
        P5_DMA((unsigned)__builtin_amdgcn_readfirstlane((int)nx_) >> 18, slot) \
        slot = (slot == P5_NSLOT - 1) ? 0 : slot + 1; \
        const float gate = (float)__builtin_bit_cast(_Float16, (unsigned short)(key & 0x7fffu)); \
        P5_BODY(S) }
#define P5_PAIR2(S) { v2u entl_; v4u nab_;                  \
        asm volatile("ds_read_b64 %0, %2\n\tds_read2_b64 %1, %3 offset0:5 offset1:6" : "=&v"(entl_), "=&v"(nab_) : "v"(lwah + 8u * (unsigned)i), "v"(lwa + 8u * (unsigned)i) : "memory"); \
        asm volatile("s_waitcnt vmcnt(6)" ::: "memory"); \
        const int slotB = (slot == P5_NSLOT - 1) ? 0 : slot + 1; \
        const v4u uqA = *(const LAS v4u*)(ring + slot * 2048 + 16 * lane), vqA = *(const LAS v4u*)(ring + slot * 2048 + 1024 + 16 * lane); \
        const v4u uqB = *(const LAS v4u*)(ring + slotB * 2048 + 16 * lane), vqB = *(const LAS v4u*)(ring + slotB * 2048 + 1024 + 16 * lane); \
        asm volatile("s_waitcnt lgkmcnt(0)" : "+v"(entl_), "+v"(nab_) :: "memory"); \
        P5_DMA((unsigned)__builtin_amdgcn_readfirstlane((int)nab_.x) >> 18, slot) P5_DMA((unsigned)__builtin_amdgcn_readfirstlane((int)nab_.z) >> 18, slotB) \
        slot = (slotB == P5_NSLOT - 1) ? 0 : slotB + 1; \
        int dA_ = 0, dB_ = 0; \
        dA_ = __builtin_amdgcn_sdot4((int)uqA.x, (int)hq[S].x, dA_, false); dB_ = __builtin_amdgcn_sdot4((int)uqB.x, (int)hq[S].x, dB_, false); \
        dA_ = __builtin_amdgcn_sdot4((int)uqA.y, (int)hq[S].y, dA_, false); dB_ = __builtin_amdgcn_sdot4((int)uqB.y, (int)hq[S].y, dB_, false); \
        dA_ = __builtin_amdgcn_sdot4((int)uqA.z, (int)hq[S].z, dA_, false); dB_ = __builtin_amdgcn_sdot4((int)uqB.z, (int)hq[S].z, dB_, false); \
        dA_ = __builtin_amdgcn_sdot4((int)uqA.w, (int)hq[S].w, dA_, false); dB_ = __builtin_amdgcn_sdot4((int)uqB.w, (int)hq[S].w, dB_, false); \
        auto sw_ = __builtin_amdgcn_permlane32_swap((unsigned)dA_, (unsigned)dB_, false, false); int e_ = (int)(sw_[0] + sw_[1]);        \
        e_ += dppi<0xB1>(e_); e_ += dppi<0x4E>(e_); e_ += dppi<0x141>(e_); e_ += dppi<0x140>(e_); \
        e_ += __builtin_amdgcn_update_dpp(0, e_, 0x142, 0xA, 0xF, false);                   \
        const float x_ = (float)e_ * (__uint_as_float(entl_.y) * kx[S]); \
        const float t_ = x_ * fmaf(x_ * x_, -0.10294324f, -2.30220819f); \
        const float cfv_ = (float)__builtin_bit_cast(_Float16, (unsigned short)(entl_.x & 0x7fffu)) * x_ * __builtin_amdgcn_rcpf(1.0f + __builtin_amdgcn_exp2f(t_)); \
        const _Float16 ch_ = (_Float16)cfv_; const unsigned cpk_ = __builtin_bit_cast(unsigned, (h2v){ch_, ch_}); \
        const h2v cpA = __builtin_bit_cast(h2v, (unsigned)__builtin_amdgcn_readlane((int)cpk_, 31)), cpB = __builtin_bit_cast(h2v, (unsigned)__builtin_amdgcn_readlane((int)cpk_, 63)); \
        _Pragma("unroll") for (int j_ = 0; j_ < 4; ++j_) { \
        acc[S][2 * j_ + 0] = __builtin_elementwise_fma(cpB, f8h<false>(vqB[j_]), __builtin_elementwise_fma(cpA, f8h<false>(vqA[j_]), acc[S][2 * j_ + 0])); \
        acc[S][2 * j_ + 1] = __builtin_elementwise_fma(cpB, f8h<true>(vqB[j_]), __builtin_elementwise_fma(cpA, f8h<true>(vqA[j_]), acc[S][2 * j_ + 1])); } }
#define P5_RUN(S, END) { _Pragma("unroll 1") for (; i + 1 < (END); i += 2) P5_PAIR2(S) if (i < (END)) { P5_PAIR(S) ++i; } }
#pragma unroll 1
    for (int b = 0; b < 32; ++b) {
        {
            const unsigned pe = (unsigned)(((b + 2) & 31) * 512) + xw;
            const unsigned* gp = (const unsigned*)(uvgl + (size_t)pe * 2048);
            __builtin_amdgcn_global_load_lds(gp, (LAS unsigned*)(lds + P5_DUMMY_OFF), 16, 0, 0);
            __builtin_amdgcn_global_load_lds(gp, (LAS unsigned*)(lds + P5_DUMMY_OFF), 16, 1024, 0);
            const unsigned* gq = (const unsigned*)(uvgl + (size_t)(pe + 256) * 2048);
            __builtin_amdgcn_global_load_lds(gq, (LAS unsigned*)(lds + P5_DUMMY_OFF), 16, 0, 0);
            __builtin_amdgcn_global_load_lds(gq, (LAS unsigned*)(lds + P5_DUMMY_OFF), 16, 1024, 0); }
        const v4u sw = *(const LAS v4u*)(cnt + 4 * b);
        const unsigned w0 = (unsigned)__builtin_amdgcn_readfirstlane((int)sw.x), w1 = (unsigned)__builtin_amdgcn_readfirstlane((int)sw.y), w2 = (unsigned)__builtin_amdgcn_readfirstlane((int)sw.z), w3 = (unsigned)__builtin_amdgcn_readfirstlane((int)sw.w);
        const unsigned nb = (b == 31) ? 1024u : ((unsigned)__builtin_amdgcn_readfirstlane((int)cnt[4 * b + 4]) & 0xffffu);
        const int e0 = (int)(w0 >> 16), e1 = (int)(w1 & 0xffffu), e2 = (int)(w1 >> 16), e3 = (int)(w2 & 0xffffu), e4 = (int)(w2 >> 16), e5 = (int)(w3 & 0xffffu), e6 = (int)(w3 >> 16), e7 = (int)nb;
        P5_RUN(0, e0) P5_RUN(1, e1) P5_RUN(2, e2) P5_RUN(3, e3) P5_RUN(4, e4) P5_RUN(5, e5) P5_RUN(6, e6) P5_RUN(7, e7)
    }
#undef P5_RUN
#undef P5_PAIR2
#undef P5_PAIR
#undef P5_DMA
    asm volatile("s_waitcnt vmcnt(0)" ::: "memory");
    lane = F.lane; asm volatile("" : "+v"(lane));
#pragma unroll
    for (int s = 0; s < 8; ++s) { GAS f32x4* orow = (GAS f32x4*)(out + (size_t)(t0 + 8 * w + s) * DM) + lane;
#pragma unroll
        for (int j = 0; j < 4; ++j) { f32x4 a = orow[64 * j]; const float c = 1.0f / P5_GSCALE;
            a.x += (float)acc[s][2 * j][0] * c; a.y += (float)acc[s][2 * j][1] * c; a.z += (float)acc[s][2 * j + 1][0] * c; a.w += (float)acc[s][2 * j + 1][1] * c; orow[64 * j] = a; } }
    __syncthreads();
}
#undef P5_ISSUE
#undef P5_BODY

#ifndef MK_N_LAUNCHES
#define MK_N_LAUNCHES 1
#endif
constexpr int N_LAUNCHES = MK_N_LAUNCHES;
constexpr int PER_PHASE = 7;
struct Args { const float* in[13]; float* out; unsigned char* ws; int ph_lo, ph_hi; };
__global__ void __launch_bounds__(NWAVES * 64, 2) fwd_megakernel(Args args) {
    extern __shared__ __attribute__((aligned(16))) unsigned char lds[];
    Frame F;
    F.lds = (LAS unsigned char*)lds;
    F.MISC = (volatile LAS unsigned*)(F.lds + MISC_OFF);
    F.tid = threadIdx.x; F.lane = F.tid & 63; F.wave = __builtin_amdgcn_readfirstlane(F.tid >> 6);
    F.G = gridDim.x;
    unsigned char* ws = args.ws; F.ws = ws;
    F.ctl = (gu32*)(ws + WS_CTL);
    F.x = args.in[0]; F.norm1_g = args.in[1]; F.w_in = args.in[2]; F.q_norm_g = args.in[3]; F.k_norm_g = args.in[4]; F.w_pool = args.in[5]; F.pool_scale = args.in[6];
    F.w_out = args.in[7]; F.norm2_g = args.in[8]; F.w_query = args.in[9]; F.sub_keys = args.in[10]; F.expert_u = args.in[11]; F.expert_v = args.in[12]; F.out = args.out;
    for (int u = F.tid; u < (LDS_BYTES - LDSCTL_OFF) / 4; u += NWAVES * 64) ((LAS unsigned*)(F.lds + LDSCTL_OFF))[u] = 0u;
    __syncthreads();
    XcdBarrier bar; bar.bar = (unsigned*)(F.ctl + CW_BAR); bar.x = 0; bar.st = nullptr;
    if (N_LAUNCHES == 1) bar = xcd_barrier_post((unsigned*)(F.ctl + CW_BAR), F.MISC + 8);
#define GRID_BAR() do { if (N_LAUNCHES == 1) xcd_barrier(bar); } while (0)
    const int lo = args.ph_lo, hi = args.ph_hi;
#define IN(k) (lo <= (k) && (k) < hi)
    bf16* const XB = (bf16*)(ws + WS_XB); bf16* const W1T = (bf16*)(ws + WS_W1T); bf16* const WOT = (bf16*)(ws + WS_WOT); bf16* const WQT = (bf16*)(ws + WS_WQT);
    bf16* const AIN = (bf16*)(ws + WS_AIN); bf16* const Qb = (bf16*)(ws + WS_Q); bf16* const Gb = (bf16*)(ws + WS_G);
    bf16* const Kb = (bf16*)args.out; bf16* const Vb = (bf16*)args.out + (size_t)T * DM;
    float* const MDm = (float*)(ws + WS_MD); float* const MDd = MDm + (size_t)3 * T * 16;
    bf16* const MERGED = XB; bf16* const HB = (bf16*)(ws + WS_HB); bf16* const QP = Gb;

    if (IN(0)) { p0_prologue(F); GRID_BAR(); }
    if (IN(1)) {
        pg8::Gemm g{XB, W1T, T, INW, DM}; pg8::StaticOrder S; S.init(T, INW, F.G, (int)blockIdx.x);
        pg8::EpiProj E{AIN, Qb, Kb, Vb, Gb, F.q_norm_g, F.k_norm_g};
        pg8::gemm_phase<pg8::EpiProj, pg8::StaticOrder, true, true>(F.lds + RING_OFF, g, S, E);
        GRID_BAR();
    }
    if (IN(2)) {
        constexpr int NU = 3 * BATCH * 16 * 32; const int per = (NU + F.G - 1) / F.G; const int u0 = blockIdx.x * per, u1 = (u0 + per) < NU ? (u0 + per) : NU;
        attn_phase(F, u0, u1, Kb, Vb, Qb, MDm, MDd);
        GRID_BAR();
    }
    if (IN(3)) {
        constexpr int NU = (T / 128) * 4; const int per = (NU + F.G - 1) / F.G; const int u0 = blockIdx.x * per, u1 = (u0 + per) < NU ? (u0 + per) : NU;
        for (int u = u0; u < u1; ++u) pool_merge_unit(F, u, AIN, (const bf16*)(ws + WS_WPT), Qb, Gb, MDm, MDd, MERGED);
        GRID_BAR();
    }
    if (IN(4)) {
        pg8::Gemm g{MERGED, WOT, T, DM, DM}; pg8::StaticOrder S; S.init(T, DM, F.G, (int)blockIdx.x);
        pg8::EpiOut E{F.x, F.out, HB};
        pg8::gemm_phase<pg8::EpiOut, pg8::StaticOrder, true, true>(F.lds + RING_OFF, g, S, E);
        GRID_BAR();
    }
    if (IN(5)) {
        pg8::Gemm g{HB, WQT, T, 2048, DM}; pg8::StaticOrder S; S.init(T, 2048, F.G, (int)blockIdx.x);
        pg8::EpiPlain E{QP, 2048};
        pg8::gemm_phase<pg8::EpiPlain, pg8::StaticOrder, true, true>(F.lds + RING_OFF, g, S, E);
        GRID_BAR();
    }
    if (IN(6)) {
        constexpr int NU = T / 64; const int per = (NU + F.G - 1) / F.G; const int u0 = blockIdx.x * per, u1 = (u0 + per) < NU ? (u0 + per) : NU;
        for (int u = u0; u < u1; ++u) peer_unit(F, u, QP, (const bf16*)(ws + WS_SKB), ws + WS_UB, ws + WS_VB, (const float*)(ws + WS_SU), (const float*)(ws + WS_SV), F.out);
    }
#undef IN
#undef GRID_BAR
}

extern "C" void kernel_launch(void* const* d_in, const int* in_sizes, int n_in, void* d_out, int out_size, void* d_ws, size_t ws_size, hipStream_t stream) {
    static int grid = 0;
    if (grid == 0) {
        if (n_in != 13 || in_sizes[0] != T * DM || out_size != T * DM || ws_size < WS_END) {
            fprintf(stderr, "kernel_launch: unexpected shapes (n_in %d, in0 %d, out %d, ws %zu, need %zu); nothing launched\n", n_in, n_in > 0 ? in_sizes[0] : -1, out_size, ws_size, (size_t)WS_END); grid = -1; return; }
        int dev = 0, cus = 0, per_cu = 0;
        if (hipGetDevice(&dev) != hipSuccess || hipDeviceGetAttribute(&cus, hipDeviceAttributeMultiprocessorCount, dev) != hipSuccess) { grid = -1; return; }
        if (hipFuncSetAttribute((const void*)fwd_megakernel, hipFuncAttributeMaxDynamicSharedMemorySize, LDS_BYTES) != hipSuccess) { fprintf(stderr, "kernel_launch: hipFuncSetAttribute failed\n"); grid = -1; return; }
        if (hipOccupancyMaxActiveBlocksPerMultiprocessor(&per_cu, (const void*)fwd_megakernel, NWAVES * 64, LDS_BYTES) != hipSuccess || per_cu < 1) { fprintf(stderr, "kernel_launch: occupancy query reports %d workgroups per CU\n", per_cu); grid = -1; (void)hipGetLastError(); return; }
        (void)hipGetLastError();
        grid = cus;
    }
    if (grid < 0) return;
    if (hipMemsetAsync((char*)d_ws + WS_CTL, 0, CTL_ZERO_BYTES, stream) != hipSuccess) return;
    Args a{};
    for (int i = 0; i < 13; ++i) a.in[i] = (const float*)d_in[i];
    a.out = (float*)d_out; a.ws = (unsigned char*)d_ws;
    for (int li = 0; li < N_LAUNCHES; ++li) {
        a.ph_lo = (N_LAUNCHES == 1) ? 0 : li; a.ph_hi = (N_LAUNCHES == 1) ? PER_PHASE : li + 1;
        hipLaunchKernelGGL(fwd_megakernel, dim3(grid), dim3(NWAVES * 64), LDS_BYTES, stream, a);
    }
}
```

```cpp
#include <hip/hip_runtime.h>
#include <cstdio>
#include <cstdint>
namespace pg8 {
#define PG8_LAS __attribute__((address_space(3)))
typedef unsigned short bf16_t;
typedef short bf16x8 __attribute__((ext_vector_type(8)));
typedef float f32x4 __attribute__((ext_vector_type(4)));
typedef unsigned u32x4 __attribute__((ext_vector_type(4)));
typedef int i32x4 __attribute__((ext_vector_type(4)));
constexpr int BM = 256, BK = 64, HALF = 128, HTB = HALF * BK * 2  , STAGE_BYTES = 8 * HTB, NXCD = 8;

__host__ __device__ __forceinline__ int lds_byte(int r, int c) { const int st = (r >> 4) * 2 + (c >> 5), rr = r & 15, cc = c & 31, ob = rr * 64 + cc * 2; return st * 1024 + (ob ^ (((ob >> 9) & 1) << 5)); }
__host__ __device__ __forceinline__ void stage_rc(int b, int& R, int& C) { const int st = b / 1024, sb = b % 1024, swz = sb ^ (((sb >> 9) & 1) << 5); R = (st >> 1) * 16 + swz / 64; C = (st & 1) * 32 + (swz % 64) / 2; }
__host__ __device__ __forceinline__ int perm32(int rho) { const int n = rho >> 4, i = rho & 15; return 8 * (i >> 2) + 4 * n + (i & 3); }

struct Unit { int pm, pn; };
struct Gemm { const bf16_t* A; const bf16_t* Bt; int M, N, K; };

struct StaticOrder {
    int nM, nN, nwg, G, c, WGM;
    __host__ __device__ void init(int M, int N, int G_, int c_, int wgm_ = 8) { nM = M / BM; nN = N / BM; nwg = nM * nN; G = G_; c = c_; WGM = wgm_; }
    __host__ __device__ bool next(int i, Unit& u) const {
        const long L = (long)i * G + c; if (L >= nwg) return false;
        int wgid = (int)L; { const int q = nwg / NXCD, r = nwg % NXCD, xcd = wgid % NXCD, off = wgid / NXCD; wgid = (xcd < r ? xcd * (q + 1) : r * (q + 1) + (xcd - r) * q) + off; }
        const int nig = WGM * nN, gid = wgid / nig, fm = gid * WGM, gsz = (nM - fm) < WGM ? (nM - fm) : WGM;
        u.pm = fm + ((wgid % nig) % gsz); u.pn = (wgid % nig) / gsz; return true;
    }
    __device__ __forceinline__ void a_ready(const Unit&) const {}
    __device__ __forceinline__ void done(const Unit&) const {}
};
__device__ __forceinline__ unsigned cvt_pk_bf16(float lo, float hi) { unsigned r; asm volatile("v_cvt_pk_bf16_f32 %0, %1, %2" : "=v"(r) : "v"(lo), "v"(hi)); return r; }

typedef float f32x2 __attribute__((ext_vector_type(2)));
__device__ __forceinline__ float xrow16_sum(float x) {
    auto s = __builtin_amdgcn_permlane16_swap(__float_as_uint(x), __float_as_uint(x), false, false);
    x = __uint_as_float(s[0]) + __uint_as_float(s[1]);
    auto t = __builtin_amdgcn_permlane32_swap(__float_as_uint(x), __float_as_uint(x), false, false);
    return __uint_as_float(t[0]) + __uint_as_float(t[1]);
}
struct EpiPlain {
    static constexpr bool PERM = true, AFTER_DRAIN = false;
    bf16_t* O; int ldc;
    __device__ __forceinline__ void operator()(const f32x4 (&acc)[2][2][4][2], const Unit& u, int wr, int wc, int fr, int fq) const {
        const int row0 = u.pm * BM + wr * 64 + fr; const int col0 = u.pn * BM + wc * 32 + 8 * fq;
#pragma unroll
        for (int ai = 0; ai < 2; ++ai)
#pragma unroll
            for (int m = 0; m < 4; ++m) { bf16_t* rowp = O + (size_t)(row0 + ai * HALF + m * 16) * ldc + col0;
#pragma unroll
                for (int bj = 0; bj < 2; ++bj) { const f32x4 v0 = acc[ai][bj][m][0], v1 = acc[ai][bj][m][1];
                    u32x4 w; w.x = cvt_pk_bf16(v0[0], v0[1]); w.y = cvt_pk_bf16(v0[2], v0[3]); w.z = cvt_pk_bf16(v1[0], v1[1]); w.w = cvt_pk_bf16(v1[2], v1[3]);
                    *(u32x4*)(rowp + bj * HALF) = w; } }
    }
};
struct EpiPlainI8 {
    static constexpr bool PERM = true, AFTER_DRAIN = false;
    bf16_t* O; int ldc; const float* xm; const float* cs;
    __device__ __forceinline__ void operator()(const f32x4 (&acc)[2][2][4][2], const Unit& u, int wr, int wc, int fr, int fq) const;
};
struct EpiProj {
    static constexpr bool PERM = true, AFTER_DRAIN = false;
    bf16_t *AIN, *Q, *K, *V, *G; const float* qg; const float* kg; const float* rs; const float* cs;
    __device__ __forceinline__ void operator()(const f32x4 (&acc)[2][2][4][2], const Unit& u, int wr, int wc, int fr, int fq) const {
        const int pn = u.pn; int type, ldc, colt; bf16_t* base;
        if (pn < 2)       { type = 0; base = AIN; ldc = 512;  colt = pn * 256; }
        else if (pn < 14) { type = 1; base = Q;   ldc = 3072; colt = (pn - 2) * 256; }
        else if (pn < 18) { type = 2; base = K;   ldc = 1024; colt = (pn - 14) * 256; }
        else if (pn < 22) { type = 3; base = V;   ldc = 1024; colt = (pn - 18) * 256; }
        else              { type = 4; base = G;   ldc = 2048; colt = (pn - 22) * 256; }
        const int col0 = colt + 64 * wc + 8 * fq;
        const int row0 = u.pm * BM + wr * 64 + fr;
        f32x4 gn[2][2], csv[2][2];
        const float* csp = cs + pn * 256 + 64 * wc + 8 * fq;
#pragma unroll
        for (int bj = 0; bj < 2; ++bj)
#pragma unroll
            for (int n = 0; n < 2; ++n) csv[bj][n] = *(const f32x4*)(csp + 32 * bj + 4 * n);
        float rs8[2][4];
#pragma unroll
        for (int ai = 0; ai < 2; ++ai)
#pragma unroll
            for (int m = 0; m < 4; ++m) rs8[ai][m] = rs[row0 + ai * HALF + m * 16];
        const float* gp = (type == 2) ? kg : qg;
        const float gmul = (type == 1) ? 0.125f * 1.4426950408889634f : 1.0f;
#pragma unroll
        for (int bj = 0; bj < 2; ++bj)
#pragma unroll
            for (int n = 0; n < 2; ++n) gn[bj][n] = *(const f32x4*)(gp + 32 * bj + 8 * fq + 4 * n) * gmul;
#pragma unroll
        for (int ai = 0; ai < 2; ++ai)
#pragma unroll
            for (int m = 0; m < 4; ++m) {
                const int row = row0 + ai * HALF + m * 16;
                f32x4 v[2][2];
#pragma unroll
                for (int bj = 0; bj < 2; ++bj)
#pragma unroll
                    for (int n = 0; n < 2; ++n) { const i32x4 iv = __builtin_bit_cast(i32x4, acc[ai][bj][m][n]); v[bj][n] = (f32x4){(float)iv[0], (float)iv[1], (float)iv[2], (float)iv[3]} * csv[bj][n]; }
                const float rsv = rs8[ai][m];
                if (type == 1 || type == 2) {
                    float ss = 0.f;
#pragma unroll
                    for (int bj = 0; bj < 2; ++bj)
#pragma unroll
                        for (int n = 0; n < 2; ++n) { const f32x4 x = v[bj][n]; ss += (x[0] * x[0] + x[1] * x[1]) + (x[2] * x[2] + x[3] * x[3]); }
                    ss = xrow16_sum(ss);
                    const float rn = __builtin_amdgcn_rsqf(ss * (rsv * rsv * (1.0f / 64.0f)) + 1e-6f) * rsv;
#pragma unroll
                    for (int bj = 0; bj < 2; ++bj)
#pragma unroll
                        for (int n = 0; n < 2; ++n) v[bj][n] = v[bj][n] * rn * gn[bj][n];
                } else {
#pragma unroll
                    for (int bj = 0; bj < 2; ++bj)
#pragma unroll
                        for (int n = 0; n < 2; ++n) v[bj][n] = v[bj][n] * rsv;
                }
                bf16_t* rowp = base + (size_t)row * ldc + col0;
                if (type >= 1 && type <= 3) {
                    const int hh = (colt >> 6) + wc;
                    const int bb = row >> 13, tt = row & 8191;
                    const size_t slab = (type == 1) ? (size_t)((hh >> 4) * 8 + bb) * 16 + (hh & 15) : (size_t)bb * 16 + hh;
                    rowp = base + (slab * 8192 + tt) * 64 + 8 * fq; }
                if (type >= 2) {
                    unsigned char* gp8 = (type == 4) ? (unsigned char*)G + (size_t)row * 2048 + col0 : (unsigned char*)(type == 2 ? K : V) + (((size_t)(row >> 13) * 16 + ((colt >> 6) + wc)) * 8192 + (row & 8191)) * 64 + 8 * fq;
                    typedef unsigned u32x2 __attribute__((ext_vector_type(2)));
#pragma unroll
                    for (int bj = 0; bj < 2; ++bj) { const f32x4 v0 = v[bj][0], v1 = v[bj][1];
                        int p0 = __builtin_amdgcn_cvt_pk_fp8_f32(v0[0], v0[1], 0, false); p0 = __builtin_amdgcn_cvt_pk_fp8_f32(v0[2], v0[3], p0, true);
                        int p1 = __builtin_amdgcn_cvt_pk_fp8_f32(v1[0], v1[1], 0, false); p1 = __builtin_amdgcn_cvt_pk_fp8_f32(v1[2], v1[3], p1, true);
                        *(u32x2*)(gp8 + 32 * bj) = (u32x2){(unsigned)p0, (unsigned)p1}; }
                } else {
#pragma unroll
                for (int bj = 0; bj < 2; ++bj) { const f32x4 v0 = v[bj][0], v1 = v[bj][1];
                    u32x4 w; w.x = cvt_pk_bf16(v0[0], v0[1]); w.y = cvt_pk_bf16(v0[2], v0[3]); w.z = cvt_pk_bf16(v1[0], v1[1]); w.w = cvt_pk_bf16(v1[2], v1[3]);
                    *(u32x4*)(rowp + 32 * bj) = w; }
                }
            }
    }
};
__device__ __forceinline__ float hscale(float xmax) { return (1.25f * xmax + 1.0f) * (1.0f / 127.0f); }
struct EpiOut {
    static constexpr bool PERM = true, AFTER_DRAIN = false;
    const float* x; float* out; bf16_t* hb; const float* xm; unsigned char* hq; const float* ms; const float* cs;
    __device__ __forceinline__ void operator()(const f32x4 (&acc)[2][2][4][2], const Unit& u, int wr, int wc, int fr, int fq) const {
        const int row0 = u.pm * BM + wr * 64 + fr; const int col0 = u.pn * BM + wc * 32 + 8 * fq;
        typedef unsigned u32x2 __attribute__((ext_vector_type(2)));
        float xm8[8], ms8[8];
#pragma unroll
        for (int it = 0; it < 8; ++it) { xm8[it] = xm[row0 + (it >> 2) * HALF + (it & 3) * 16]; ms8[it] = ms[row0 + (it >> 2) * HALF + (it & 3) * 16]; }
        f32x4 csv[2][2];
#pragma unroll
        for (int bj = 0; bj < 2; ++bj)
#pragma unroll
            for (int n = 0; n < 2; ++n) csv[bj][n] = *(const f32x4*)(cs + col0 + bj * HALF + 4 * n);
        f32x4 xc[2][2], xn[2][2];
#pragma unroll
        for (int bj = 0; bj < 2; ++bj) { xc[bj][0] = *(const f32x4*)(x + (size_t)row0 * 1024 + col0 + bj * HALF); xc[bj][1] = *(const f32x4*)(x + (size_t)row0 * 1024 + col0 + bj * HALF + 4); }
#pragma unroll
        for (int it = 0; it < 8; ++it) { const int ai = it >> 2, m = it & 3; const int row = row0 + ai * HALF + m * 16; const size_t off = (size_t)row * 1024 + col0;
            if (it < 7) { const size_t offn = (size_t)(row0 + ((it + 1) >> 2) * HALF + ((it + 1) & 3) * 16) * 1024 + col0;
#pragma unroll
                for (int bj = 0; bj < 2; ++bj) { xn[bj][0] = *(const f32x4*)(x + offn + bj * HALF); xn[bj][1] = *(const f32x4*)(x + offn + bj * HALF + 4); } }
            const float inv = 1.0f / hscale(xm8[it]);
#pragma unroll
            for (int bj = 0; bj < 2; ++bj) {
                const i32x4 i0 = __builtin_bit_cast(i32x4, acc[ai][bj][m][0]), i1 = __builtin_bit_cast(i32x4, acc[ai][bj][m][1]);
                const f32x4 v0 = (f32x4){(float)i0[0], (float)i0[1], (float)i0[2], (float)i0[3]} * (csv[bj][0] * ms8[it]) + xc[bj][0], v1 = (f32x4){(float)i1[0], (float)i1[1], (float)i1[2], (float)i1[3]} * (csv[bj][1] * ms8[it]) + xc[bj][1];
                u32x4 w; w.x = cvt_pk_bf16(v0[0], v0[1]); w.y = cvt_pk_bf16(v0[2], v0[3]); w.z = cvt_pk_bf16(v1[0], v1[1]); w.w = cvt_pk_bf16(v1[2], v1[3]);
                *(u32x4*)(hb + off + bj * HALF) = w;
                unsigned q0 = 0u, q1 = 0u;
#pragma unroll
                for (int e = 0; e < 4; ++e) { q0 = __builtin_amdgcn_cvt_pk_u8_f32(__builtin_amdgcn_fmed3f(__builtin_rintf(fmaf(v0[e], inv, 128.0f)), 1.0f, 255.0f), e, q0);
                                              q1 = __builtin_amdgcn_cvt_pk_u8_f32(__builtin_amdgcn_fmed3f(__builtin_rintf(fmaf(v1[e], inv, 128.0f)), 1.0f, 255.0f), e, q1); }
                *(u32x2*)(hq + off + bj * HALF) = (u32x2){q0 ^ 0x80808080u, q1 ^ 0x80808080u}; }
#pragma unroll
            for (int bj = 0; bj < 2; ++bj) { xc[bj][0] = xn[bj][0]; xc[bj][1] = xn[bj][1]; } }
    }
};
__device__ __forceinline__ void EpiPlainI8::operator()(const f32x4 (&acc)[2][2][4][2], const Unit& u, int wr, int wc, int fr, int fq) const {
    const int row0 = u.pm * BM + wr * 64 + fr; const int col0 = u.pn * BM + wc * 32 + 8 * fq;
    f32x4 csv[2][2];
#pragma unroll
    for (int bj = 0; bj < 2; ++bj)
#pragma unroll
        for (int n = 0; n < 2; ++n) csv[bj][n] = *(const f32x4*)(cs + col0 + bj * HALF + 4 * n);
    float xm8[2][4];
#pragma unroll
    for (int ai = 0; ai < 2; ++ai)
#pragma unroll
        for (int m = 0; m < 4; ++m) xm8[ai][m] = xm[row0 + ai * HALF + m * 16];
#pragma unroll
    for (int ai = 0; ai < 2; ++ai)
#pragma unroll
        for (int m = 0; m < 4; ++m) { const int row = row0 + ai * HALF + m * 16; const float rsv = hscale(xm8[ai][m]);
            bf16_t* rowp = O + ((size_t)(row >> 5) * 16 * 8 * 64 + (size_t)(row & 31)) * 8;
#pragma unroll
            for (int bj = 0; bj < 2; ++bj) { const i32x4 i0 = __builtin_bit_cast(i32x4, acc[ai][bj][m][0]), i1 = __builtin_bit_cast(i32x4, acc[ai][bj][m][1]);
                const f32x4 v0 = (f32x4){(float)i0[0], (float)i0[1], (float)i0[2], (float)i0[3]} * csv[bj][0] * rsv, v1 = (f32x4){(float)i1[0], (float)i1[1], (float)i1[2], (float)i1[3]} * csv[bj][1] * rsv;
                u32x4 w; w.x = cvt_pk_bf16(v0[0], v0[1]); w.y = cvt_pk_bf16(v0[2], v0[3]); w.z = cvt_pk_bf16(v1[0], v1[1]); w.w = cvt_pk_bf16(v1[2], v1[3]);
                { const int col = col0 + bj * HALF; *(u32x4*)(rowp + ((size_t)((col >> 7) * 8 + ((col & 127) >> 4)) * 64 + 32 * ((col >> 3) & 1)) * 8) = w; } } }
}
template <class Epi, class Sched, bool ALIGN_EPI = false, bool SP2 = false, bool I8 = false>
__device__ __forceinline__ void gemm_phase(PG8_LAS unsigned char* lds, const Gemm g, const Sched& S, const Epi& E) {
    const int tid = threadIdx.x, wid = __builtin_amdgcn_readfirstlane(tid >> 6), lane = tid & 63, wr = wid >> 2, wc = wid & 3, fr = lane & 15, fq = lane >> 4;
    const int K = g.K, nt = K / BK;
    unsigned voffA[2], voffB[2];
#pragma unroll
    for (int i = 0; i < 2; ++i) { int R, C; stage_rc(tid * 16 + i * 8192, R, C); const int Rb = Epi::PERM ? ((R & ~31) + perm32(R & 31)) : R;
        voffA[i] = (unsigned)(R * K + C) * 2u; voffB[i] = (unsigned)(Rb * K + C) * 2u; }
    const size_t kstep = (size_t)(BK * 2);
    const size_t hstep = (size_t)HALF * K * 2;
    const size_t tstep = 2 * hstep;
    const unsigned ldsw = (unsigned)wid * 1024u;
    const int aoff = lds_byte(wr * 64 + fr, fq * 8), boff = lds_byte(wc * 32 + fr, fq * 8);
#define PG8_SA(b, h) (((b) * 2 + (h)) * HTB)
#define PG8_SB(b, h) ((4 + (b) * 2 + (h)) * HTB)
#define PG8_STAGE(bufoff, gbase, voff) do { _Pragma("unroll") for (int _i = 0; _i < 2; ++_i) \
        __builtin_amdgcn_global_load_lds((const unsigned*)((const char*)(gbase) + (voff)[_i]), (PG8_LAS unsigned*)(lds + (bufoff) + ldsw + _i * 8192), 16, 0, 0); } while (0)
#define PG8_LDA(dst, b, h) do { _Pragma("unroll") for (int m = 0; m < 4; ++m) _Pragma("unroll") for (int k = 0; k < 2; ++k) dst[m][k] = *(const PG8_LAS bf16x8*)(lds + PG8_SA(b, h) + aoff + m * 2048 + k * 1024); } while (0)
#define PG8_LDB(dst, b, h) do { _Pragma("unroll") for (int n = 0; n < 2; ++n) _Pragma("unroll") for (int k = 0; k < 2; ++k) dst[n][k] = *(const PG8_LAS bf16x8*)(lds + PG8_SB(b, h) + boff + n * 2048 + k * 1024); } while (0)
#define PG8_MMA(ai, bj, At, Bt) do { __builtin_amdgcn_s_setprio(1); _Pragma("unroll") for (int m = 0; m < 4; ++m) _Pragma("unroll") for (int n = 0; n < 2; ++n) _Pragma("unroll") for (int k = 0; k < 2; ++k) \
        { if constexpr (I8) acc[ai][bj][m][n] = __builtin_bit_cast(f32x4, __builtin_amdgcn_mfma_i32_16x16x64_i8(__builtin_bit_cast(i32x4, Bt[n][k]), __builtin_bit_cast(i32x4, At[m][k]), __builtin_bit_cast(i32x4, acc[ai][bj][m][n]), 0, 0, 0)); \
          else acc[ai][bj][m][n] = __builtin_amdgcn_mfma_f32_16x16x32_bf16(Bt[n][k], At[m][k], acc[ai][bj][m][n], 0, 0, 0); } __builtin_amdgcn_s_setprio(0); } while (0)
#define PG8_WAIT_V(n) asm volatile("s_waitcnt vmcnt(" #n ")" ::: "memory")
#define PG8_WAIT_L(n) asm volatile("s_waitcnt lgkmcnt(" #n ")" ::: "memory")
#define PG8_BAR __builtin_amdgcn_s_barrier()
#define PG8_SCHED __builtin_amdgcn_sched_barrier(0)
    Unit cur, nxt; int ui = 0;
    if (!S.next(0, cur)) return;
    f32x4 acc[2][2][4][2];
#pragma unroll
    for (int a = 0; a < 2; ++a)
#pragma unroll
        for (int b = 0; b < 2; ++b)
#pragma unroll
            for (int m = 0; m < 4; ++m)
#pragma unroll
                for (int n = 0; n < 2; ++n) acc[a][b][m][n] = (f32x4){0.f, 0.f, 0.f, 0.f};
    bf16x8 At[4][2], B0[2][2], B1[2][2];
    const char* cA = (const char*)g.A + (size_t)cur.pm * tstep; const char* cB = (const char*)g.Bt + (size_t)cur.pn * tstep;
    S.a_ready(cur);
    if constexpr (SP2) {
        PG8_STAGE(PG8_SB(0, 0), cB, voffB); PG8_STAGE(PG8_SB(0, 1), cB + hstep, voffB); PG8_STAGE(PG8_SA(0, 0), cA, voffA); PG8_STAGE(PG8_SA(0, 1), cA + hstep, voffA);
        if (wr == 1) PG8_BAR;
        PG8_WAIT_V(2); PG8_BAR;
        PG8_STAGE(PG8_SB(1, 0), cB + kstep, voffB); PG8_STAGE(PG8_SA(1, 0), cA + kstep, voffA); PG8_STAGE(PG8_SB(1, 1), cB + hstep + kstep, voffB);
        PG8_WAIT_V(6); PG8_BAR;
    } else {
        PG8_STAGE(PG8_SB(0, 0), cB, voffB); PG8_STAGE(PG8_SA(0, 0), cA, voffA); PG8_STAGE(PG8_SB(0, 1), cB + hstep, voffB); PG8_STAGE(PG8_SA(0, 1), cA + hstep, voffA);
        if (wr == 1) PG8_BAR;
        PG8_WAIT_V(4); PG8_BAR;
        PG8_STAGE(PG8_SB(1, 0), cB + kstep, voffB); PG8_STAGE(PG8_SA(1, 0), cA + kstep, voffA); PG8_STAGE(PG8_SB(1, 1), cB + hstep + kstep, voffB);
        PG8_WAIT_V(6); PG8_BAR;
    }
    for (;;) {
        const bool has_next = S.next(ui + 1, nxt);
        const char* nA = has_next ? (const char*)g.A + (size_t)nxt.pm * tstep : cA; const char* nB = has_next ? (const char*)g.Bt + (size_t)nxt.pn * tstep : cB;
        for (int t = 0; t < nt; t += 2) {
            const bool last = (t == nt - 2);
            const char* a1 = cA + (size_t)(t + 1) * kstep;
            const char* a2 = last ? nA : cA + (size_t)(t + 2) * kstep; const char* b2 = last ? nB : cB + (size_t)(t + 2) * kstep;
            const char* a3 = a2 + kstep; const char* b3 = b2 + kstep;
            if (last && has_next) S.a_ready(nxt);
            if constexpr (SP2) {
            PG8_LDB(B0, 0, 0); PG8_LDB(B1, 0, 1); PG8_SCHED; PG8_LDA(At, 0, 0); PG8_STAGE(PG8_SA(1, 1), a1 + hstep, voffA);
            PG8_WAIT_V(8); PG8_WAIT_L(0); PG8_BAR; PG8_MMA(0, 0, At, B0); PG8_MMA(0, 1, At, B1); PG8_BAR; PG8_SCHED;
            PG8_LDA(At, 0, 1); PG8_STAGE(PG8_SB(0, 0), b2, voffB); PG8_STAGE(PG8_SB(0, 1), b2 + hstep, voffB); PG8_STAGE(PG8_SA(0, 0), a2, voffA);
            PG8_WAIT_V(8); PG8_WAIT_L(0); PG8_BAR; PG8_MMA(1, 0, At, B0); PG8_MMA(1, 1, At, B1); PG8_BAR; PG8_SCHED;
            PG8_LDB(B0, 1, 0); PG8_LDB(B1, 1, 1); PG8_SCHED; PG8_LDA(At, 1, 0); PG8_STAGE(PG8_SA(0, 1), a2 + hstep, voffA);
            PG8_WAIT_V(8); PG8_WAIT_L(0); PG8_BAR; PG8_MMA(0, 0, At, B0); PG8_MMA(0, 1, At, B1); PG8_BAR; PG8_SCHED;
            PG8_LDA(At, 1, 1); PG8_STAGE(PG8_SB(1, 0), b3, voffB); PG8_STAGE(PG8_SB(1, 1), b3 + hstep, voffB); PG8_STAGE(PG8_SA(1, 0), a3, voffA);
            PG8_WAIT_V(8); PG8_WAIT_L(0); PG8_BAR; PG8_MMA(1, 0, At, B0); PG8_MMA(1, 1, At, B1); PG8_BAR; PG8_SCHED;
            } else {
            PG8_LDB(B0, 0, 0); PG8_SCHED; PG8_LDA(At, 0, 0); PG8_STAGE(PG8_SA(1, 1), a1 + hstep, voffA);
            PG8_WAIT_L(8); PG8_BAR; PG8_WAIT_L(0); PG8_MMA(0, 0, At, B0); PG8_BAR; PG8_SCHED;
            PG8_LDB(B1, 0, 1); PG8_STAGE(PG8_SB(0, 0), b2, voffB);
            PG8_BAR; PG8_WAIT_L(0); PG8_MMA(0, 1, At, B1); PG8_BAR;
            PG8_LDA(At, 0, 1); PG8_STAGE(PG8_SA(0, 0), a2, voffA);
            PG8_BAR; PG8_WAIT_L(0); PG8_MMA(1, 0, At, B0); PG8_BAR; PG8_SCHED;
            PG8_STAGE(PG8_SB(0, 1), b2 + hstep, voffB);
            PG8_WAIT_V(6); PG8_BAR; PG8_MMA(1, 1, At, B1); PG8_BAR;
            PG8_LDB(B0, 1, 0); PG8_SCHED; PG8_LDA(At, 1, 0); PG8_STAGE(PG8_SA(0, 1), a2 + hstep, voffA);
            PG8_WAIT_L(8); PG8_BAR; PG8_WAIT_L(0); PG8_MMA(0, 0, At, B0); PG8_BAR; PG8_SCHED;
            PG8_LDB(B1, 1, 1); PG8_STAGE(PG8_SB(1, 0), b3, voffB);
            PG8_BAR; PG8_WAIT_L(0); PG8_MMA(0, 1, At, B1); PG8_BAR;
            PG8_LDA(At, 1, 1); PG8_STAGE(PG8_SA(1, 0), a3, voffA);
            PG8_BAR; PG8_WAIT_L(0); PG8_MMA(1, 0, At, B0); PG8_BAR; PG8_SCHED;
            PG8_STAGE(PG8_SB(1, 1), b3 + hstep, voffB);
            PG8_WAIT_V(6); PG8_BAR; PG8_MMA(1, 1, At, B1); PG8_BAR;
            }
        }
        if constexpr (ALIGN_EPI) { if (wr == 0) PG8_BAR; }
        if constexpr (!Epi::AFTER_DRAIN) { E(acc, cur, wr, wc, fr, fq); S.done(cur); }
        if (!has_next) break;
#pragma unroll
        for (int a = 0; a < 2; ++a)
#pragma unroll
            for (int b = 0; b < 2; ++b)
#pragma unroll
                for (int m = 0; m < 4; ++m)
#pragma unroll
                    for (int n = 0; n < 2; ++n) acc[a][b][m][n] = (f32x4){0.f, 0.f, 0.f, 0.f};
        cur = nxt; cA = nA; cB = nB; ++ui;
        if constexpr (ALIGN_EPI) { if (wr == 1) PG8_BAR; }
    }
    PG8_WAIT_V(0);
    if constexpr (!ALIGN_EPI) { if (wr == 0) PG8_BAR; }
    PG8_BAR;
    if constexpr (Epi::AFTER_DRAIN) { E.fused(acc, cur, wr, wc, fr, fq, lds, wid, lane); S.done(cur); }
#undef PG8_SA
#undef PG8_SB
#undef PG8_STAGE
#undef PG8_LDA
#undef PG8_LDB
#undef PG8_MMA
#undef PG8_WAIT_V
#undef PG8_WAIT_L
#undef PG8_BAR
#undef PG8_SCHED
}
}

constexpr int NWAVES = 8;
constexpr int BATCH = 8, SEQ = 8192, DM = 1024, T = BATCH * SEQ;
constexpr int INW = 7680, QW = 3072, GATEW = 2048, POOLW = 512;
constexpr int NEXP = 16384;
constexpr float EPS = 1e-6f;
constexpr float LOG2E = 1.4426950408889634f;

constexpr size_t MiB = 1u << 20;
constexpr size_t WS_CTL = 0, CTL_ZERO_BYTES = 1 * MiB;
constexpr size_t WS_W1T = 2 * MiB;
constexpr size_t WS_WOT = 17 * MiB;
constexpr size_t WS_WQT = 19 * MiB;
constexpr size_t WS_WPT = 23 * MiB;
constexpr size_t WS_SKB = 23 * MiB + 512 * 1024;
constexpr size_t WS_S1 = 24 * MiB;
constexpr size_t WS_SU = 24 * MiB + 256 * 1024, WS_SV = 24 * MiB + 512 * 1024;
constexpr size_t WS_UB = 25 * MiB;
constexpr size_t WS_VB = 57 * MiB;
constexpr size_t WS_MD = 89 * MiB;
constexpr size_t WS_XB = 113 * MiB;
constexpr size_t WS_AIN = 241 * MiB;
constexpr size_t WS_Q = 305 * MiB;
constexpr size_t WS_G = 689 * MiB;
constexpr size_t WS_END = 945 * MiB;
constexpr size_t WS_HB = WS_AIN;
constexpr size_t WS_CMAX = 64 * 1024;
constexpr size_t WS_CS = 128 * 1024;
constexpr size_t WS_CMAX2 = 96 * 1024;
constexpr size_t WS_CS2 = 192 * 1024;
constexpr size_t WS_CMAX3 = 104 * 1024;
constexpr size_t WS_CS3 = 200 * 1024;
constexpr size_t WS_MS = 512 * 1024;
constexpr size_t WS_XM = 256 * 1024;

constexpr int CW_BAR = 4096;
constexpr int RING_OFF = 0, RING_BYTES = 131072;
constexpr int LDSCTL_OFF = 162816, MISC_OFF = LDSCTL_OFF + 320;
constexpr int LDS_BYTES = 163840;

#define GAS __attribute__((address_space(1)))
#define LAS __attribute__((address_space(3)))
typedef unsigned short bf16;
typedef unsigned v4u __attribute__((ext_vector_type(4)));
typedef unsigned v2u __attribute__((ext_vector_type(2)));
typedef float f32x4 __attribute__((ext_vector_type(4)));
typedef float f32x16 __attribute__((ext_vector_type(16)));
typedef short bf16x8 __attribute__((ext_vector_type(8)));
typedef short s16x4 __attribute__((ext_vector_type(4)));
typedef __bf16 bf16x2_t __attribute__((ext_vector_type(2)));
typedef GAS unsigned gu32;
#define RLX_AGENT __ATOMIC_RELAXED, __HIP_MEMORY_SCOPE_AGENT
#define LDS_WAIT() asm volatile("s_waitcnt lgkmcnt(0)" ::: "memory")
#define VM_WAIT() asm volatile("s_waitcnt vmcnt(0)" ::: "memory")
__device__ __forceinline__ unsigned f2bf(float f) { unsigned u = __builtin_bit_cast(unsigned, f); return (u + 0x7fffu + ((u >> 16) & 1u)) >> 16; }
__device__ __forceinline__ unsigned pk2(float lo, float hi) { return f2bf(lo) | (f2bf(hi) << 16); }
__device__ __forceinline__ float bflo(unsigned w) { return __uint_as_float(w << 16); }
__device__ __forceinline__ float bfhi(unsigned w) { return __uint_as_float(w & 0xffff0000u); }
__device__ __forceinline__ int crow(int r, int hi) { return (r & 3) + 8 * (r >> 2) + 4 * hi; }
__device__ __forceinline__ float xhalf_max(float x) { auto t = __builtin_amdgcn_permlane32_swap(__float_as_uint(x), __float_as_uint(x), false, false); return fmaxf(__uint_as_float(t[0]), __uint_as_float(t[1])); }
__device__ __forceinline__ float xhalf_sum(float x) { auto t = __builtin_amdgcn_permlane32_swap(__float_as_uint(x), __float_as_uint(x), false, false); return __uint_as_float(t[0]) + __uint_as_float(t[1]); }
__device__ __forceinline__ float wave_sum(float v) {
#pragma unroll
    for (int o = 1; o < 64; o <<= 1) v += __shfl_xor(v, o);
    return v;
}
__device__ __forceinline__ float dot2bf(unsigned a, unsigned b, float acc) { return __builtin_amdgcn_fdot2_f32_bf16(__builtin_bit_cast(bf16x2_t, a), __builtin_bit_cast(bf16x2_t, b), acc, false); }

#define XB_TMO      128
#define XB_XCNT(j)  (256  + 64 * (j))
#define XB_XSUB(j)  (1280 + 64 * (j))
#define XB_XGEN(j)  (2304 + 64 * (j))
#define XB_TOP      3328
#define XB_TOPGEN   3392
#define XCD_BAR_WORDS 3456
#define XB_SPIN_CAP (1u << 18)

__device__ __forceinline__ unsigned xb_ld(unsigned* p)              { return __hip_atomic_load(p, __ATOMIC_RELAXED, __HIP_MEMORY_SCOPE_AGENT); }
__device__ __forceinline__ unsigned xb_add(unsigned* p, unsigned v) { return __hip_atomic_fetch_add(p, v, __ATOMIC_RELAXED, __HIP_MEMORY_SCOPE_AGENT); }
__device__ __forceinline__ unsigned xb_xcc_id() { return (unsigned)__builtin_amdgcn_s_getreg((3 << 11) | 20) & 0xFu; }
#define XB_SPIN(cond, bar) do { unsigned _sp = 0; while (cond) { __builtin_amdgcn_s_sleep(1); \
    if ((++_sp & 255u) == 0u) { if (xb_ld(&(bar)[XB_TMO])) break; if (_sp > XB_SPIN_CAP) { atomicAdd(&(bar)[XB_TMO], 1u); break; } } } } while (0)

struct XcdBarrier {
    unsigned* bar; unsigned x;
    volatile LAS unsigned* st;
};

__device__ __forceinline__ XcdBarrier xcd_barrier_post(unsigned* bar, volatile LAS unsigned* st) {
    XcdBarrier b; b.bar = bar; b.x = xb_xcc_id(); b.st = st;
    if (threadIdx.x == 0) (void)xb_add(&bar[XB_XCNT(b.x)], 1u);
    return b;
}
__device__ __forceinline__ void xcd_barrier_complete(unsigned* bar, unsigned x, unsigned& nloc, unsigned& nx) {
    const unsigned G = gridDim.x * gridDim.y * gridDim.z;
    unsigned sum, cnt, mine, sp = 0u;
    for (;;) {
        sum = 0u; cnt = 0u; mine = 0u;
#pragma unroll
        for (unsigned j = 0; j < 16; ++j) { const unsigned c = xb_ld(&bar[XB_XCNT(j)]); sum += c; cnt += (c > 0u) ? 1u : 0u; mine = (j == x) ? c : mine; }
        if (sum == G) break;
        __builtin_amdgcn_s_sleep(1);
        if ((++sp & 255u) == 0u) { if (xb_ld(&bar[XB_TMO])) break; if (sp > XB_SPIN_CAP) { atomicAdd(&bar[XB_TMO], 1u); break; } }
    }
    nloc = mine > 0u ? mine : 1u; nx = cnt > 0u ? cnt : 1u;
}

__device__ __forceinline__ void xcd_barrier(const XcdBarrier& b) {
    asm volatile("s_waitcnt vmcnt(0)" ::: "memory");
    __syncthreads();
    if (threadIdx.x == 0) {
        unsigned* bar = b.bar;
        __builtin_amdgcn_s_waitcnt(0);
        unsigned nloc = b.st[0], nx = b.st[1];
        if (nloc == 0u) { xcd_barrier_complete(bar, b.x, nloc, nx); b.st[0] = nloc; b.st[1] = nx; }
        const unsigned old = xb_add(&bar[XB_XSUB(b.x)], 1u);
        const unsigned gen = old / nloc;
        if (old + 1u == (gen + 1u) * nloc) {
            __builtin_amdgcn_fence(__ATOMIC_RELEASE, "agent");
            asm volatile("s_waitcnt vmcnt(0)" ::: "memory");
            const unsigned og = xb_add(&bar[XB_TOP], 1u);
            const unsigned tg = og / nx;
            if (og + 1u == (tg + 1u) * nx) xb_add(&bar[XB_TOPGEN], 1u);
            else XB_SPIN(xb_ld(&bar[XB_TOPGEN]) == tg, bar);
            __builtin_amdgcn_fence(__ATOMIC_ACQUIRE, "agent");
            xb_add(&bar[XB_XGEN(b.x)], 1u);
            asm volatile("s_waitcnt vmcnt(0)" ::: "memory");
        } else {
            XB_SPIN(xb_ld(&bar[XB_XGEN(b.x)]) == gen, bar);
            __builtin_amdgcn_fence(__ATOMIC_ACQUIRE, "agent");
            asm volatile("s_waitcnt vmcnt(0)" ::: "memory");
        }
    }
    __syncthreads();
}

struct Frame {
    LAS unsigned char* lds;
    volatile LAS unsigned* MISC;
    gu32* ctl;
    int tid, lane, wave, G;
    const float *x, *norm1_g, *w_in, *q_norm_g, *k_norm_g, *w_pool, *pool_scale, *w_out, *norm2_g, *w_query, *sub_keys, *expert_u, *expert_v;
    float* out; unsigned char* ws;
};
template <int CTRL> __device__ __forceinline__ float dppf(float x) { return __builtin_bit_cast(float, __builtin_amdgcn_mov_dpp(__builtin_bit_cast(int, x), CTRL, 0xf, 0xf, true)); }
__device__ __forceinline__ float wave_sum_dpp(float x) {
    x += dppf<0xB1>(x);
    x += dppf<0x4E>(x);
    x += dppf<0x141>(x);
    x += dppf<0x128>(x);
    return pg8::xrow16_sum(x);
}

__device__ __forceinline__ float wave_max_dpp(float x) {
    x = fmaxf(x, dppf<0xB1>(x)); x = fmaxf(x, dppf<0x4E>(x)); x = fmaxf(x, dppf<0x141>(x)); x = fmaxf(x, dppf<0x128>(x));
    auto s = __builtin_amdgcn_permlane16_swap(__float_as_uint(x), __float_as_uint(x), false, false);
    x = fmaxf(__uint_as_float(s[0]), __uint_as_float(s[1]));
    auto t = __builtin_amdgcn_permlane32_swap(__float_as_uint(x), __float_as_uint(x), false, false);
    return fmaxf(__uint_as_float(t[0]), __uint_as_float(t[1]));
}
template <int CTRL> __device__ __forceinline__ int dppi(int x) { return __builtin_amdgcn_mov_dpp(x, CTRL, 0xf, 0xf, true); }
__device__ __forceinline__ int wave_sum_dpp_i(int x) {
    x += dppi<0xB1>(x); x += dppi<0x4E>(x); x += dppi<0x141>(x); x += dppi<0x128>(x);
    auto s = __builtin_amdgcn_permlane16_swap((unsigned)x, (unsigned)x, false, false); x = (int)(s[0] + s[1]);
    auto t = __builtin_amdgcn_permlane32_swap((unsigned)x, (unsigned)x, false, false); return (int)(t[0] + t[1]);
}
__device__ __forceinline__ v4u quant16(const f32x4 (&v)[4], float inv, int off) {
    v4u o;
#pragma unroll
    for (int j = 0; j < 4; ++j) {
        const int a = (int)__builtin_rintf(v[j].x * inv) + off, b = (int)__builtin_rintf(v[j].y * inv) + off, c = (int)__builtin_rintf(v[j].z * inv) + off, d = (int)__builtin_rintf(v[j].w * inv) + off;
        o[j] = (unsigned)(a & 255) | ((unsigned)(b & 255) << 8) | ((unsigned)(c & 255) << 16) | ((unsigned)(d & 255) << 24);
    }
    return o;
}
__device__ __forceinline__ void p0_quant_row(const float* xrow, const float* gain, unsigned char* orow, float* scale_out, int off, int lane) {
    const GAS f32x4* xr = (const GAS f32x4*)xrow + lane;
    f32x4 v[4]; float mx = 0.f;
#pragma unroll
    for (int j = 0; j < 4; ++j) { v[j] = xr[64 * j]; if (gain) v[j] = v[j] * ((const f32x4*)gain)[64 * j + lane];
        mx = fmaxf(mx, fmaxf(fmaxf(fabsf(v[j].x), fabsf(v[j].y)), fmaxf(fabsf(v[j].z), fabsf(v[j].w)))); }
    mx = wave_max_dpp(mx);
    const float sc = mx > 0.f ? mx * (1.0f / 127.0f) : 1.0f, inv = 1.0f / sc;
    *(GAS v4u*)(orow + 16 * lane) = quant16(v, inv, off);
    if (lane == 0) __hip_atomic_store(scale_out, sc, __ATOMIC_RELAXED, __HIP_MEMORY_SCOPE_AGENT);
}
__device__ __forceinline__ void p0_fp8_row(const float* xrow, unsigned char* orow, float* scale_out, int lane) {
    const GAS f32x4* xr = (const GAS f32x4*)xrow + lane;
    f32x4 v[4]; float mx = 0.f;
#pragma unroll
    for (int j = 0; j < 4; ++j) { v[j] = xr[64 * j]; mx = fmaxf(mx, fmaxf(fmaxf(fabsf(v[j].x), fabsf(v[j].y)), fmaxf(fabsf(v[j].z), fabsf(v[j].w)))); }
    mx = wave_max_dpp(mx);
    const float sc = mx > 0.f ? mx * (1.0f / 400.0f) : 1.0f, inv = 1.0f / sc;
    v4u o;
#pragma unroll
    for (int j = 0; j < 4; ++j) { int pk = __builtin_amdgcn_cvt_pk_fp8_f32(v[j].x * inv, v[j].y * inv, 0, false); pk = __builtin_amdgcn_cvt_pk_fp8_f32(v[j].z * inv, v[j].w * inv, pk, true); o[j] = (unsigned)pk; }
    *(GAS v4u*)(orow + 16 * lane) = o;
    if (lane == 0) __hip_atomic_store(scale_out, sc, __ATOMIC_RELAXED, __HIP_MEMORY_SCOPE_AGENT);
}
__device__ __forceinline__ void p0_transpose_item(const float* W, int K, int N, const float* rs, const float* cs, bf16* WT, int permute, LAS float* scr, int item, int lane) {
    const int nblk = N / 32, kb = item / nblk, nb = item % nblk, k0 = 64 * kb, n0 = 32 * nb;
    const float csv = cs ? cs[n0 + (lane & 31)] : 1.f;
#pragma unroll 8
    for (int i = 0; i < 32; ++i) { const int kk = 2 * i + (lane >> 5); const float r = rs ? rs[k0 + kk] : 1.f; scr[kk * 33 + (lane & 31)] = W[(size_t)(k0 + kk) * N + n0 + (lane & 31)] * r * csv; }
    LDS_WAIT(); asm volatile("" ::: "memory");
    int nout0 = n0;
    if (permute) { const int gl = (n0 & 255) >> 5; const int gp = 4 * (gl & 1) + (gl >> 1); nout0 = (n0 & ~255) + 32 * gp; }
    const int c = lane & 7;
#pragma unroll
    for (int j = 0; j < 4; ++j) { const int n = (lane >> 3) + 8 * j; const LAS float* s = scr + (8 * c) * 33 + n;
        v4u o; o.x = pk2(s[0 * 33], s[1 * 33]); o.y = pk2(s[2 * 33], s[3 * 33]); o.z = pk2(s[4 * 33], s[5 * 33]); o.w = pk2(s[6 * 33], s[7 * 33]);
        *(GAS v4u*)(WT + (size_t)(nout0 + n) * K + k0 + 8 * c) = o; }
    LDS_WAIT(); asm volatile("" ::: "memory");
}
__device__ __forceinline__ void p0_row(const float* xrow, const float* gain, bf16* orow, bool rms, int lane) {
    const GAS f32x4* xr = (const GAS f32x4*)xrow + lane;
    f32x4 v[4]; float s = 0.f;
#pragma unroll
    for (int j = 0; j < 4; ++j) { v[j] = xr[64 * j]; s += (v[j].x * v[j].x + v[j].y * v[j].y) + (v[j].z * v[j].z + v[j].w * v[j].w); }
    if (rms) { s = wave_sum(s); const float r = 1.0f / sqrtf(s * (1.0f / 1024.0f) + EPS);
#pragma unroll
        for (int j = 0; j < 4; ++j) v[j] = v[j] * r; }
    if (gain) {
#pragma unroll
        for (int j = 0; j < 4; ++j) v[j] = v[j] * ((const f32x4*)gain)[64 * j + lane];
    }
    GAS unsigned long long* o8 = (GAS unsigned long long*)orow + lane;
#pragma unroll
    for (int j = 0; j < 4; ++j) o8[64 * j] = (unsigned long long)pk2(v[j].x, v[j].y) | ((unsigned long long)pk2(v[j].z, v[j].w) << 32);
}
__device__ __forceinline__ void p0_colmax_item(const float* W, int N, const float* rs, unsigned* cmax, int item, int lane) {
    const int nblk = N / 32, kb = item / nblk, nb = item % nblk, k0 = 64 * kb, n0 = 32 * nb;
    float mx = 0.f;
#pragma unroll 8
    for (int i = 0; i < 32; ++i) { const int kk = 2 * i + (lane >> 5); const float r = rs ? rs[k0 + kk] : 1.f; mx = fmaxf(mx, fabsf(W[(size_t)(k0 + kk) * N + n0 + (lane & 31)] * r)); }
    mx = xhalf_max(mx);
    if (lane < 32) (void)__hip_atomic_fetch_max(cmax + n0 + lane, __float_as_uint(mx), __ATOMIC_RELAXED, __HIP_MEMORY_SCOPE_AGENT);
}
__device__ __forceinline__ void p0_transpose_q8_item(const float* W, int N, const float* rs, unsigned* cmax, float* cscale, unsigned char* WT, int permute, LAS float* scr, int item, int lane) {
    constexpr int K = 1024;
    const int nblk = N / 32, kb = item / nblk, nb = item % nblk, k0 = 128 * kb, n0 = 32 * nb;
    const float cm = __uint_as_float(__hip_atomic_load(cmax + n0 + (lane & 31), __ATOMIC_RELAXED, __HIP_MEMORY_SCOPE_AGENT));
    const float inv = cm > 0.f ? 127.0f / cm : 0.f;
    if (kb == 0 && lane < 32) cscale[n0 + lane] = cm * (1.0f / 127.0f);
#pragma unroll 8
    for (int i = 0; i < 64; ++i) { const int kk = 2 * i + (lane >> 5); const float r = rs ? rs[k0 + kk] : 1.f; scr[kk * 33 + (lane & 31)] = __builtin_rintf(W[(size_t)(k0 + kk) * N + n0 + (lane & 31)] * r * inv); }
    LDS_WAIT(); asm volatile("" ::: "memory");
    int nout0 = n0;
    if (permute) { const int gl = (n0 & 255) >> 5; const int gp = 4 * (gl & 1) + (gl >> 1); nout0 = (n0 & ~255) + 32 * gp; }
    const int c = lane & 7;
#pragma unroll
    for (int j = 0; j < 4; ++j) { const int n = (lane >> 3) + 8 * j; const LAS float* sp = scr + (16 * c) * 33 + n;
        v4u o;
#pragma unroll
        for (int d = 0; d < 4; ++d) o[d] = ((unsigned)(int)sp[(4 * d) * 33] & 255u) | (((unsigned)(int)sp[(4 * d + 1) * 33] & 255u) << 8) | (((unsigned)(int)sp[(4 * d + 2) * 33] & 255u) << 16) | ((unsigned)(int)sp[(4 * d + 3) * 33] << 24);
        *(GAS v4u*)(WT + (size_t)(nout0 + n) * K + k0 + 16 * c) = o; }
    LDS_WAIT(); asm volatile("" ::: "memory");
}
__device__ __forceinline__ void p0_xrow_q8(const float* xrow, unsigned char* orow, float* rs_out, float* xm_out, int lane) {
    const GAS f32x4* xr = (const GAS f32x4*)xrow + lane;
    f32x4 v[4]; float s = 0.f, mx = 0.f;
#pragma unroll
    for (int j = 0; j < 4; ++j) { v[j] = xr[64 * j]; s += (v[j].x * v[j].x + v[j].y * v[j].y) + (v[j].z * v[j].z + v[j].w * v[j].w);
        mx = fmaxf(mx, fmaxf(fmaxf(fabsf(v[j].x), fabsf(v[j].y)), fmaxf(fabsf(v[j].z), fabsf(v[j].w)))); }
    s = wave_sum_dpp(s); mx = wave_max_dpp(mx);
    const float r = 1.0f / sqrtf(s * (1.0f / 1024.0f) + EPS);
    const float q = mx > 0.f ? mx * (1.0f / 127.0f) : 1.0f, inv = 1.0f / q;
    const v4u o = quant16(v, inv, 0);
#pragma unroll
    for (int j = 0; j < 4; ++j) ((GAS unsigned*)orow)[64 * j + lane] = o[j];
    if (lane == 0) { *xm_out = mx; *rs_out = r * q; }
}
__device__ __forceinline__ void p0_part_a(Frame& F) {
    const int gw = blockIdx.x * NWAVES + F.wave, NGW = F.G * NWAVES;
    unsigned char* ws = F.ws;
    constexpr int I_IN = (DM / 64) * (INW / 32);
    constexpr int I_Q = (DM / 64) * (2048 / 32);
    for (int it = gw; it < I_IN + I_Q; it += NGW) {
        if (it < I_IN) p0_colmax_item(F.w_in, INW, F.norm1_g, (unsigned*)(ws + WS_CMAX), it, F.lane);
        else p0_colmax_item(F.w_query, 2048, F.norm2_g, (unsigned*)(ws + WS_CMAX2), it - I_IN, F.lane);
    }
    constexpr int I_O = (DM / 64) * (DM / 32);
    for (int it = gw; it < I_O; it += NGW) p0_colmax_item(F.w_out, DM, nullptr, (unsigned*)(ws + WS_CMAX3), it, F.lane);
    for (int q = blockIdx.x; q < T / 32; q += F.G)
        for (int i = F.wave; i < 32; i += NWAVES) { const int m = 32 * q + i; p0_xrow_q8(F.x + (size_t)m * DM, ws + WS_XB + (size_t)m * DM, (float*)(ws + WS_S1) + m, (float*)(ws + WS_XM) + m, F.lane); }
    constexpr int NROWS = 2 * NEXP + 512;
    for (int m = gw; m < NROWS; m += NGW) {
        int r = m;
        if (r < NEXP) { p0_quant_row(F.expert_u + (size_t)r * DM, F.norm2_g, ws + WS_UB + (size_t)r * 2048, (float*)(ws + WS_SU) + r, 0, F.lane); continue; } r -= NEXP;
        if (r < NEXP) { p0_fp8_row(F.expert_v + (size_t)r * DM, ws + WS_UB + (size_t)r * 2048 + 1024, (float*)(ws + WS_SV) + r, F.lane); continue; } r -= NEXP;
        {
            const int hp = r >> 5, ks = (r >> 2) & 7, mt = r & 3, key = 32 * mt + (F.lane & 31), d0 = 16 * ks + 8 * (F.lane >> 5);
            const GAS f32x4* sp = (const GAS f32x4*)(F.sub_keys + ((size_t)(hp * 128 + key) * 128 + d0)); const f32x4 a = sp[0], b = sp[1];
            v4u o; o.x = pk2(a.x, a.y); o.y = pk2(a.z, a.w); o.z = pk2(b.x, b.y); o.w = pk2(b.z, b.w);
            *(GAS v4u*)((bf16*)(ws + WS_SKB) + ((size_t)r * 64 + F.lane) * 8) = o; }
    }
}
__device__ __forceinline__ void p0_part_b(Frame& F) {
    LAS float* scr = (LAS float*)(F.lds + RING_OFF + F.wave * 16896);
    const int gw = blockIdx.x * NWAVES + F.wave, NGW = F.G * NWAVES;
    unsigned char* ws = F.ws;
    constexpr int I_IN = (DM / 128) * (INW / 32), I_O = (DM / 128) * (DM / 32), I_Q = (DM / 128) * (2048 / 32), I_P = 4 * (128 / 64) * (256 / 32);
    constexpr int NITEMS = I_IN + I_O + I_Q + I_P;
    for (int it = gw; it < NITEMS; it += NGW) {
        int r = it;
        if (r < I_IN) { p0_transpose_q8_item(F.w_in, INW, F.norm1_g, (unsigned*)(ws + WS_CMAX), (float*)(ws + WS_CS), ws + WS_W1T, 1, scr, r, F.lane); continue; } r -= I_IN;
        if (r < I_O) { p0_transpose_q8_item(F.w_out, DM, nullptr, (unsigned*)(ws + WS_CMAX3), (float*)(ws + WS_CS3), ws + WS_WOT, 0, scr, r, F.lane); continue; } r -= I_O;
        if (r < I_Q) { p0_transpose_q8_item(F.w_query, 2048, F.norm2_g, (unsigned*)(ws + WS_CMAX2), (float*)(ws + WS_CS2), ws + WS_WQT, 0, scr, r, F.lane); continue; } r -= I_Q;
        { const int g = r / 16, ri = r % 16;
          p0_transpose_item(F.w_pool + (size_t)g * 128 * 256, 128, 256, nullptr, F.pool_scale + g * 256, (bf16*)(ws + WS_WPT) + (size_t)g * 256 * 128, 0, scr, ri, F.lane); }
    }
}

constexpr int ATT_NK = 384, ATT_K_OFF = 0, ATT_V_OFF = ATT_NK * 128;
typedef short v4i16_t __attribute__((ext_vector_type(4)));
__device__ __forceinline__ s16x4 vtr(unsigned ldsaddr) { return __builtin_bit_cast(s16x4, __builtin_amdgcn_ds_read_tr16_b64_v4i16((LAS v4i16_t*)(uintptr_t)ldsaddr)); }
struct AttnU { int p, b, h, dil, r, bp; };
__device__ __forceinline__ AttnU attn_decode(int unit) {
    AttnU u; const int idx = unit & 31; int t1 = unit >> 5; u.h = t1 & 15; t1 >>= 4; u.b = t1 & 7; u.p = t1 >> 3;
    const int dl = (u.p == 0) ? 0 : (u.p == 1 ? 2 : 4); u.dil = 1 << dl; const int nbp = 32 >> dl; u.r = idx >> (5 - dl); u.bp = idx & (nbp - 1); return u;
}
__device__ __forceinline__ void attn_load_kv(const AttnU& u, int tid, const unsigned char* __restrict__ K8, const unsigned char* __restrict__ V8, v2u (&kr)[6], v2u (&vr)[6]) {
    const int rsub = tid >> 3, ch = tid & 7;
#pragma unroll
    for (int i = 0; i < 6; ++i) { const int ki = i * 64 + rsub; const int sidx = u.bp * 256 - 128 + ki; const bool ok = sidx >= 0;
        const long pos = ok ? ((long)sidx * u.dil + u.r) : 0; const size_t off = ((size_t)(u.b * 16 + u.h) * 8192 + pos) * 64 + ch * 8;
        kr[i] = *(const GAS v2u*)(K8 + off); vr[i] = *(const GAS v2u*)(V8 + off);
        if (!ok) { kr[i] = (v2u){0u, 0u}; vr[i] = (v2u){0u, 0u}; } }
}
__device__ __forceinline__ void attn_load_q(const AttnU& u, int w, int c32, int hi, const bf16* Qg, bf16x8 (&qf)[4]) {
    const long qt = (long)(u.bp * 256 + 32 * w + c32) * u.dil + u.r;
    const bf16* qp = Qg + ((size_t)((u.p * 8 + u.b) * 16 + u.h) * 8192 + qt) * 64;
#pragma unroll
    for (int d0 = 0; d0 < 4; ++d0) qf[d0] = *(const GAS bf16x8*)(qp + d0 * 16 + hi * 8);
}
__device__ __forceinline__ v4u fp8x8_to_bf16(v2u x) {
    const auto f0 = __builtin_amdgcn_cvt_pk_f32_fp8((int)x.x, false), f1 = __builtin_amdgcn_cvt_pk_f32_fp8((int)x.x, true), f2 = __builtin_amdgcn_cvt_pk_f32_fp8((int)x.y, false), f3 = __builtin_amdgcn_cvt_pk_f32_fp8((int)x.y, true);
    v4u r; r.x = pg8::cvt_pk_bf16(f0[0], f0[1]); r.y = pg8::cvt_pk_bf16(f1[0], f1[1]); r.z = pg8::cvt_pk_bf16(f2[0], f2[1]); r.w = pg8::cvt_pk_bf16(f3[0], f3[1]); return r;
}
__device__ __forceinline__ void attn_body(Frame& F, const AttnU& u, bool has_nn, const AttnU& nn, bool has_nq, const AttnU& nq, v2u (&kr)[6], v2u (&vr)[6], bf16x8 (&qf)[4],
                                          const unsigned char* __restrict__ K8, const unsigned char* __restrict__ V8, bf16* Qg, float* MDd) {
    const int tid = F.tid, lane = F.lane, w = F.wave, c32 = lane & 31, hi = lane >> 5;
    LAS unsigned char* lds = F.lds;
    const int rsub = tid >> 3, ch = tid & 7;
    const int lam = lane & 15;
    const unsigned vbase = (unsigned)(uintptr_t)(lds + ATT_V_OFF) + (unsigned)((4 * hi + (lam >> 2)) * 64 + (16 * ((lane >> 4) & 1) + 4 * (lam & 3)) * 2);
    const int cz = c32 - 4 * hi;
#pragma unroll
    for (int i = 0; i < 6; ++i) { const int ki = i * 64 + rsub;
        *(LAS v4u*)(lds + ATT_K_OFF + ki * 128 + ((ch ^ ((ki >> 1) & 7)) * 16)) = fp8x8_to_bf16(kr[i]);
        *(LAS v4u*)(lds + ATT_V_OFF + (ch >> 2) * (ATT_NK * 64) + ki * 64 + (ch & 3) * 16) = fp8x8_to_bf16(vr[i]); }
    __syncthreads();
    if (has_nn) attn_load_kv(nn, tid, K8, V8, kr, vr);
    const int sidx = u.p * 16 + u.h; const float sexp = sidx < 32 ? 0.125f * (float)(sidx + 1) : 4.0f + 0.25f * (float)(sidx - 31);
    const float slope2 = exp2f(-sexp) * LOG2E * (float)u.dil;
    const float a0 = -slope2 * (float)(128 + cz) - 16.0f;
    f32x16 st[5]; f32x16 a0v;
#pragma unroll
    for (int rr = 0; rr < 16; ++rr) a0v[rr] = a0;
#pragma unroll
    for (int kt = 0; kt < 5; ++kt) {
        const int key = 32 * (w + kt) + c32; const LAS unsigned char* kb = lds + ATT_K_OFF + key * 128; const int sw = (key >> 1) & 7;
        f32x16 a;
#pragma unroll
        for (int d0 = 0; d0 < 4; ++d0) { const bf16x8 kf = *(const LAS bf16x8*)(kb + (((2 * d0 + hi) ^ sw) * 16)); a = __builtin_amdgcn_mfma_f32_32x32x16_bf16(kf, qf[d0], d0 == 0 ? a0v : a, 0, 0, 0); }
        st[kt] = a;
    }
    if (has_nq) attn_load_q(nq, w, c32, hi, Qg, qf);
    float l = 0.f;
#pragma unroll
    for (int kt = 0; kt < 5; ++kt) {
        float lt = 0.f;
#pragma unroll
        for (int rr = 0; rr < 16; ++rr) { const int rc = (rr & 3) + 8 * (rr >> 2);
            float e = __builtin_amdgcn_exp2f(fmaf(slope2, (float)(32 * kt + rc), st[kt][rr]));
            if (kt == 0) e = (rc >= cz) ? e : 0.f;
            if (kt == 4) e = (rc <= cz) ? e : 0.f;
            st[kt][rr] = e; lt += e; }
        l += ((u.bp == 0) && (w + kt < 4)) ? 0.f : lt;
    }
    l = xhalf_sum(l);
    f32x16 o[2]; o[0] = f32x16{}; o[1] = f32x16{};
#pragma unroll
    for (int kt = 0; kt < 5; ++kt)
#pragma unroll
        for (int s2 = 0; s2 < 2; ++s2) {
            v4u pw; pw.x = pg8::cvt_pk_bf16(st[kt][8 * s2 + 0], st[kt][8 * s2 + 1]); pw.y = pg8::cvt_pk_bf16(st[kt][8 * s2 + 2], st[kt][8 * s2 + 3]);
            pw.z = pg8::cvt_pk_bf16(st[kt][8 * s2 + 4], st[kt][8 * s2 + 5]); pw.w = pg8::cvt_pk_bf16(st[kt][8 * s2 + 6], st[kt][8 * s2 + 7]);
            const bf16x8 pf = __builtin_bit_cast(bf16x8, pw);
#pragma unroll
            for (int dt = 0; dt < 2; ++dt) {
                const unsigned a = vbase + (unsigned)(dt * (ATT_NK * 64) + (32 * (w + kt) + 16 * s2) * 64);
                const s16x4 lo = vtr(a), hi4 = vtr(a + 8 * 64);
                const bf16x8 vf = (bf16x8){lo[0], lo[1], lo[2], lo[3], hi4[0], hi4[1], hi4[2], hi4[3]};
                o[dt] = __builtin_amdgcn_mfma_f32_32x32x16_bf16(vf, pf, o[dt], 0, 0, 0);
            }
        }
    const float inv = 1.0f / l;
    const long qt = (long)(u.bp * 256 + 32 * w + c32) * u.dil + u.r; const long qrow = (long)u.b * SEQ + qt;
    bf16* qp = Qg + ((size_t)((u.p * 8 + u.b) * 16 + u.h) * 8192 + qt) * 64;
#pragma unroll
    for (int dt = 0; dt < 2; ++dt)
#pragma unroll
        for (int g = 0; g < 4; ++g) { v2u ow; ow.x = pg8::cvt_pk_bf16(o[dt][4 * g] * inv, o[dt][4 * g + 1] * inv); ow.y = pg8::cvt_pk_bf16(o[dt][4 * g + 2] * inv, o[dt][4 * g + 3] * inv);
            *(GAS v2u*)(qp + 32 * dt + 8 * g + 4 * hi) = ow; }
    if (hi == 0) { const size_t mi = ((size_t)u.p * T + (size_t)qrow) * 16 + u.h; __hip_atomic_store(MDd + mi, l, __ATOMIC_RELAXED, __HIP_MEMORY_SCOPE_AGENT); }
    __syncthreads();
}
__device__ __forceinline__ void attn_phase(Frame& F, int u0, int u1, bool xl, const bf16* Kg, const bf16* Vg, bf16* Qg, float* MDm, float* MDd) {
    if (u0 >= u1) return;
    const int xrank = (int)blockIdx.x >> 3, xbh0 = ((int)blockIdx.x & 7) * 16;
#define ATT_UMAP(i_) (xl ? ((((i_) % 3) * 128 + xbh0 + (i_) / 3) * 32 + xrank) : (i_))
    const int tid = F.tid, lane = F.lane, w = F.wave, c32 = lane & 31, hi = lane >> 5;
    const unsigned char* K8 = (const unsigned char*)Kg; const unsigned char* V8 = (const unsigned char*)Vg;
    v2u krA[6], vrA[6], krB[6], vrB[6]; bf16x8 qf[4];
    AttnU uA = attn_decode(ATT_UMAP(u0)), uB = uA;
    attn_load_kv(uA, tid, K8, V8, krA, vrA); attn_load_q(uA, w, c32, hi, Qg, qf);
    if (u0 + 1 < u1) { uB = attn_decode(ATT_UMAP(u0 + 1)); attn_load_kv(uB, tid, K8, V8, krB, vrB); }
#pragma unroll 1
    for (int uu = u0; uu < u1; uu += 2) {
        { const AttnU cur = uA; const bool nx = uu + 2 < u1; if (nx) uA = attn_decode(ATT_UMAP(uu + 2));
          attn_body(F, cur, nx, uA, uu + 1 < u1, uB, krA, vrA, qf, K8, V8, Qg, MDd); }
        if (uu + 1 < u1) { const AttnU cur = uB; const bool nx = uu + 3 < u1; if (nx) uB = attn_decode(ATT_UMAP(uu + 3));
          attn_body(F, cur, nx, uB, uu + 2 < u1, uA, krB, vrB, qf, K8, V8, Qg, MDd); }
    }
#undef ATT_UMAP
}

constexpr int PB_AIN_PITCH = 272, PB_POOL_OFF = 40960, PB_POOL_PITCH = 528;
__device__ __forceinline__ void pool_merge_unit(Frame& F, int unit, const bf16* AIN, const bf16* Wpt, const bf16* OP, const bf16* Gt, const float* MDm, const float* MDd, bf16* MERGED) {
    const int tid = F.tid, lane = F.lane, w = F.wave, c32 = lane & 31, hi = lane >> 5;
    const int g = unit & 3, tile = unit >> 2, t0 = tile * 128, tin = t0 & (SEQ - 1), win = 2 << g;
    LAS unsigned char* lds = F.lds;
    for (int id = tid; id < 143 * 16; id += NWAVES * 64) { const int rr = id >> 4, ch = id & 15; v4u v = (v4u){0u, 0u, 0u, 0u};
        if (tin - 15 + rr >= 0) v = *(const GAS v4u*)(AIN + (size_t)(t0 - 15 + rr) * POOLW + g * 128 + ch * 8);
        *(LAS v4u*)(lds + rr * PB_AIN_PITCH + ch * 16) = v; }
    __syncthreads();
    {
        const int tq = w & 3, oh = w >> 2, tokl = 32 * tq + c32;
        const int cnt = (tin + tokl + 1) < win ? (tin + tokl + 1) : win; const float rc = 1.0f / (float)cnt;
        f32x16 acc[4]; acc[0] = f32x16{}; acc[1] = f32x16{}; acc[2] = f32x16{}; acc[3] = f32x16{};
        const bf16* wp = Wpt + (size_t)(g * 256 + oh * 128 + c32) * 128 + 8 * hi;
#pragma unroll 1
        for (int ks = 0; ks < 8; ++ks) {
            const LAS unsigned char* ap = lds + (15 + tokl) * PB_AIN_PITCH + (16 * ks + 8 * hi) * 2;
            const v4u own = *(const LAS v4u*)ap;
            float s[8] = {0.f, 0.f, 0.f, 0.f, 0.f, 0.f, 0.f, 0.f};
            for (int i = 0; i < win; ++i) { const v4u a = *(const LAS v4u*)(ap - i * PB_AIN_PITCH);
                s[0] += bflo(a.x); s[1] += bfhi(a.x); s[2] += bflo(a.y); s[3] += bfhi(a.y); s[4] += bflo(a.z); s[5] += bfhi(a.z); s[6] += bflo(a.w); s[7] += bfhi(a.w); }
            v4u dw; dw.x = pg8::cvt_pk_bf16(s[0] * rc - bflo(own.x), s[1] * rc - bfhi(own.x)); dw.y = pg8::cvt_pk_bf16(s[2] * rc - bflo(own.y), s[3] * rc - bfhi(own.y));
            dw.z = pg8::cvt_pk_bf16(s[4] * rc - bflo(own.z), s[5] * rc - bfhi(own.z)); dw.w = pg8::cvt_pk_bf16(s[6] * rc - bflo(own.w), s[7] * rc - bfhi(own.w));
            const bf16x8 df = __builtin_bit_cast(bf16x8, dw);
#pragma unroll
            for (int mt = 0; mt < 4; ++mt) { const bf16x8 wf = *(const GAS bf16x8*)(wp + (size_t)(32 * mt) * 128 + 16 * ks); acc[mt] = __builtin_amdgcn_mfma_f32_32x32x16_bf16(wf, df, acc[mt], 0, 0, 0); }
        }
#pragma unroll
        for (int mt = 0; mt < 4; ++mt)
#pragma unroll
            for (int gq = 0; gq < 4; ++gq) { v2u ow; ow.x = pg8::cvt_pk_bf16(acc[mt][4 * gq], acc[mt][4 * gq + 1]); ow.y = pg8::cvt_pk_bf16(acc[mt][4 * gq + 2], acc[mt][4 * gq + 3]);
                *(LAS v2u*)(lds + PB_POOL_OFF + tokl * PB_POOL_PITCH + (oh * 128 + 32 * mt + 8 * gq + 4 * hi) * 2) = ow; }
    }
    __syncthreads();
#pragma unroll 1
    for (int pass = 0; pass < 8; ++pass) {
        const int id = pass * 512 + tid, tok = id >> 5, cc = id & 31, col = g * 256 + 8 * cc, head = col >> 6; const size_t row = (size_t)t0 + tok;
        float wgt[3]; float ws_ = 0.f;
#pragma unroll
        for (int p = 0; p < 3; ++p) { wgt[p] = __hip_atomic_load(MDd + ((size_t)p * T + row) * 16 + head, __ATOMIC_RELAXED, __HIP_MEMORY_SCOPE_AGENT); ws_ += wgt[p]; }
        const float iw = 1.0f / ws_;
        const size_t ob = ((size_t)((row >> 13) * 16 + head) * 8192 + (row & 8191)) * 64 + (col & 63); constexpr size_t PST = (size_t)8 * 16 * 8192 * 64;
        const v4u o0 = *(const GAS v4u*)(OP + ob), o1 = *(const GAS v4u*)(OP + PST + ob), o2 = *(const GAS v4u*)(OP + 2 * PST + ob);
        const v2u g0 = *(const GAS v2u*)((const unsigned char*)Gt + row * GATEW + col), g1 = *(const GAS v2u*)((const unsigned char*)Gt + row * GATEW + 1024 + col);
        const v4u pl = *(const LAS v4u*)(lds + PB_POOL_OFF + tok * PB_POOL_PITCH + cc * 16);
        const float w0 = wgt[0] * iw, w1 = wgt[1] * iw, w2 = wgt[2] * iw;
        v4u res;
#define SIG(x_) __builtin_amdgcn_rcpf(1.0f + __builtin_amdgcn_exp2f(-LOG2E * (x_)))
#define MRG(f, gw, HI) { const float alo = w0 * bflo(o0.f) + w1 * bflo(o1.f) + w2 * bflo(o2.f), ahi = w0 * bfhi(o0.f) + w1 * bfhi(o1.f) + w2 * bfhi(o2.f); \
                 const auto ga = __builtin_amdgcn_cvt_pk_f32_fp8((int)g0.gw, HI), gb = __builtin_amdgcn_cvt_pk_f32_fp8((int)g1.gw, HI); \
                 res.f = pg8::cvt_pk_bf16(SIG(ga[0]) * bflo(pl.f) + SIG(gb[0]) * alo, SIG(ga[1]) * bfhi(pl.f) + SIG(gb[1]) * ahi); }
        MRG(x, x, false) MRG(y, x, true) MRG(z, y, false) MRG(w, y, true)
#undef MRG
#undef SIG
        *(GAS v4u*)(MERGED + row * DM + col) = res;
    }
    __syncthreads();
}


constexpr int PC_AIN_PITCH = 1040, PC_POOL_OFF = 49152, PC_POOL_PITCH = 2064, PC_RMAX_OFF = PC_POOL_OFF + 32 * PC_POOL_PITCH;
__device__ __forceinline__ void pool_merge_unit32(Frame& F, int unit, const bf16* AIN, const bf16* Wpt, const bf16* OP, const bf16* Gt, const float* MDd, unsigned char* M8, float* MS) {
    const int tid = F.tid, lane = F.lane, w = F.wave, c32 = lane & 31, hi = lane >> 5;
    const int t0 = unit * 32, tin = t0 & (SEQ - 1);
    LAS unsigned char* lds = F.lds;
    LAS unsigned* rmax = (LAS unsigned*)(lds + PC_RMAX_OFF);
    for (int id = tid; id < 47 * 64; id += NWAVES * 64) { const int rr = id >> 6, ch = id & 63; v4u v = (v4u){0u, 0u, 0u, 0u};
        if (tin - 15 + rr >= 0) v = *(const GAS v4u*)(AIN + (size_t)(t0 - 15 + rr) * POOLW + ch * 8);
        *(LAS v4u*)(lds + rr * PC_AIN_PITCH + ch * 16) = v; }
    if (tid < 32) rmax[tid] = 0u;
    __syncthreads();
    {
        const int g = w >> 1, oh = w & 1, win = 2 << g, tokl = c32;
        const int cnt = (tin + tokl + 1) < win ? (tin + tokl + 1) : win; const float rc = 1.0f / (float)cnt;
        f32x16 acc[4]; acc[0] = f32x16{}; acc[1] = f32x16{}; acc[2] = f32x16{}; acc[3] = f32x16{};
        const bf16* wp = Wpt + (size_t)(g * 256 + oh * 128 + c32) * 128 + 8 * hi;
#pragma unroll 1
        for (int ks = 0; ks < 8; ++ks) {
            const LAS unsigned char* ap = lds + (15 + tokl) * PC_AIN_PITCH + (g * 128 + 16 * ks + 8 * hi) * 2;
            const v4u own = *(const LAS v4u*)ap;
            float s[8] = {0.f, 0.f, 0.f, 0.f, 0.f, 0.f, 0.f, 0.f};
            for (int i = 0; i < win; ++i) { const v4u a = *(const LAS v4u*)(ap - i * PC_AIN_PITCH);
                s[0] += bflo(a.x); s[1] += bfhi(a.x); s[2] += bflo(a.y); s[3] += bfhi(a.y); s[4] += bflo(a.z); s[5] += bfhi(a.z); s[6] += bflo(a.w); s[7] += bfhi(a.w); }
            v4u dw; dw.x = pg8::cvt_pk_bf16(s[0] * rc - bflo(own.x), s[1] * rc - bfhi(own.x)); dw.y = pg8::cvt_pk_bf16(s[2] * rc - bflo(own.y), s[3] * rc - bfhi(own.y));
            dw.z = pg8::cvt_pk_bf16(s[4] * rc - bflo(own.z), s[5] * rc - bfhi(own.z)); dw.w = pg8::cvt_pk_bf16(s[6] * rc - bflo(own.w), s[7] * rc - bfhi(own.w));
            const bf16x8 df = __builtin_bit_cast(bf16x8, dw);
#pragma unroll
            for (int mt = 0; mt < 4; ++mt) { const bf16x8 wf = *(const GAS bf16x8*)(wp + (size_t)(32 * mt) * 128 + 16 * ks); acc[mt] = __builtin_amdgcn_mfma_f32_32x32x16_bf16(wf, df, acc[mt], 0, 0, 0); }
        }
#pragma unroll
        for (int mt = 0; mt < 4; ++mt)
#pragma unroll
            for (int gq = 0; gq < 4; ++gq) { v2u ow; ow.x = pg8::cvt_pk_bf16(acc[mt][4 * gq], acc[mt][4 * gq + 1]); ow.y = pg8::cvt_pk_bf16(acc[mt][4 * gq + 2], acc[mt][4 * gq + 3]);
                *(LAS v2u*)(lds + PC_POOL_OFF + tokl * PC_POOL_PITCH + (g * 256 + oh * 128 + 32 * mt + 8 * gq + 4 * hi) * 2) = ow; }
    }
    __syncthreads();
    v4u res[8];
#define SIG(x_) __builtin_amdgcn_rcpf(1.0f + __builtin_amdgcn_exp2f(-LOG2E * (x_)))
#define MRG(f, gw, HI) { const float alo = w0 * bflo(o0.f) + w1 * bflo(o1.f) + w2 * bflo(o2.f), ahi = w0 * bfhi(o0.f) + w1 * bfhi(o1.f) + w2 * bfhi(o2.f); \
                 const auto ga = __builtin_amdgcn_cvt_pk_f32_fp8((int)g0.gw, HI), gb = __builtin_amdgcn_cvt_pk_f32_fp8((int)g1.gw, HI); \
                 r.f = pg8::cvt_pk_bf16(SIG(ga[0]) * bflo(pl.f) + SIG(gb[0]) * alo, SIG(ga[1]) * bfhi(pl.f) + SIG(gb[1]) * ahi); \
                 mx = fmaxf(mx, fmaxf(fabsf(bflo(r.f)), fabsf(bfhi(r.f)))); }
#pragma unroll
    for (int pass = 0; pass < 8; ++pass) {
        const int tok = pass * 4 + (tid >> 7), cc = tid & 127, col = 8 * cc, head = col >> 6; const size_t row = (size_t)t0 + tok;
        float wgt[3]; float ws_ = 0.f;
#pragma unroll
        for (int p = 0; p < 3; ++p) { wgt[p] = __hip_atomic_load(MDd + ((size_t)p * T + row) * 16 + head, __ATOMIC_RELAXED, __HIP_MEMORY_SCOPE_AGENT); ws_ += wgt[p]; }
        const float iw = 1.0f / ws_;
        const size_t ob = ((size_t)((row >> 13) * 16 + head) * 8192 + (row & 8191)) * 64 + (col & 63); constexpr size_t PST = (size_t)8 * 16 * 8192 * 64;
        const v4u o0 = *(const GAS v4u*)(OP + ob), o1 = *(const GAS v4u*)(OP + PST + ob), o2 = *(const GAS v4u*)(OP + 2 * PST + ob);
        const v2u g0 = *(const GAS v2u*)((const unsigned char*)Gt + row * GATEW + col), g1 = *(const GAS v2u*)((const unsigned char*)Gt + row * GATEW + 1024 + col);
        const v4u pl = *(const LAS v4u*)(lds + PC_POOL_OFF + tok * PC_POOL_PITCH + cc * 16);
        const float w0 = wgt[0] * iw, w1 = wgt[1] * iw, w2 = wgt[2] * iw;
        v4u r; float mx = 0.f;
        MRG(x, x, false) MRG(y, x, true) MRG(z, y, false) MRG(w, y, true)
        res[pass] = r;
        mx = wave_max_dpp(mx);
        if (lane == 0) (void)__hip_atomic_fetch_max(rmax + tok, __float_as_uint(mx), __ATOMIC_RELAXED, __HIP_MEMORY_SCOPE_WORKGROUP);
    }
#undef MRG
#undef SIG
    __syncthreads();
#pragma unroll
    for (int pass = 0; pass < 8; ++pass) {
        const int tok = pass * 4 + (tid >> 7), cc = tid & 127; const size_t row = (size_t)t0 + tok;
        const float rm = __uint_as_float(rmax[tok]); const float inv = rm > 0.f ? 127.0f / rm : 0.f;
        const v4u r = res[pass];
        const int a0 = (int)__builtin_rintf(bflo(r.x) * inv), a1 = (int)__builtin_rintf(bfhi(r.x) * inv), a2 = (int)__builtin_rintf(bflo(r.y) * inv), a3 = (int)__builtin_rintf(bfhi(r.y) * inv);
        const int a4 = (int)__builtin_rintf(bflo(r.z) * inv), a5 = (int)__builtin_rintf(bfhi(r.z) * inv), a6 = (int)__builtin_rintf(bflo(r.w) * inv), a7 = (int)__builtin_rintf(bfhi(r.w) * inv);
        v2u q; q.x = ((unsigned)a0 & 255u) | (((unsigned)a1 & 255u) << 8) | (((unsigned)a2 & 255u) << 16) | ((unsigned)a3 << 24);
        q.y = ((unsigned)a4 & 255u) | (((unsigned)a5 & 255u) << 8) | (((unsigned)a6 & 255u) << 16) | ((unsigned)a7 << 24);
        *(GAS v2u*)(M8 + row * DM + 8 * cc) = q;
    }
    if (tid < 32) MS[t0 + tid] = __uint_as_float(rmax[tid]) * (1.0f / 127.0f);
    __syncthreads();
}

#ifndef P5_LOGNB
#define P5_LOGNB 4
#endif
#define P5_NBUCKET (1 << P5_LOGNB)
#ifndef P5_NSLOT_M
#define P5_NSLOT_M 5
#endif
#define P5_STR2(x) #x
#define P5_STR(x) P5_STR2(x)
#if P5_NSLOT_M == 3
#define P5_VM1 4
#define P5_VM2 2
#define P5_O1 24
#define P5_O2A 3
#define P5_O2B 4
#elif P5_NSLOT_M == 4
#define P5_VM1 6
#define P5_VM2 4
#define P5_O1 32
#define P5_O2A 4
#define P5_O2B 5
#elif P5_NSLOT_M == 5
#define P5_VM1 8
#define P5_VM2 6
#define P5_VM4 2
#define P5_O1 40
#define P5_O2A 5
#define P5_O2B 6
#define P5_O2C 7
#define P5_O2D 8
#endif
constexpr int P5_LIST_WAVE = 1032  , P5_LIST_OFF = 0, P5_RING_OFF = 66048, P5_RING_WAVE = 10240, P5_NSLOT = P5_NSLOT_M, P5_TL_OFF = 147968, P5_S2_OFF = 156160, P5_SH_OFF = 156416, P5_CNT_OFF = 147968  ;
constexpr int P5_DUMMY_OFF = 158720;
constexpr float P5_GSCALE = 256.0f;
__device__ __forceinline__ float gelu_tanh(float x) {
    const float z = 0.7978845608028654f * (x + 0.044715f * x * x * x);
    const float e = __builtin_amdgcn_exp2f(2.0f * LOG2E * z);
    const float th = 1.0f - 2.0f * __builtin_amdgcn_rcpf(1.0f + e);
    return 0.5f * x * (1.0f + th);
}
#define P5_CE(a, b) { const float hi__ = fmaxf(a, b), lo__ = fminf(a, b); a = hi__; b = lo__; }
__device__ __forceinline__ void sort16_desc(float (&v)[16]) {
#pragma unroll
    for (int k = 2; k <= 16; k <<= 1)
#pragma unroll
        for (int j = k >> 1; j > 0; j >>= 1)
#pragma unroll
            for (int i = 0; i < 16; ++i) { const int l = i ^ j; if (l > i) { if ((i & k) == 0) P5_CE(v[i], v[l]) else P5_CE(v[l], v[i]) } }
}
__device__ __forceinline__ void merge_top16(float (&a)[16], const float (&b)[16]) {
#pragma unroll
    for (int i = 0; i < 16; ++i) a[i] = fmaxf(a[i], b[15 - i]);
#pragma unroll
    for (int j = 8; j > 0; j >>= 1)
#pragma unroll
        for (int i = 0; i < 16; ++i) { const int l = i ^ j; if (l > i) P5_CE(a[i], a[l]) }
}
__device__ __forceinline__ void pair_merge_top16(float (&a)[16]) {
    float lo[16], hi[16];
#pragma unroll
    for (int i = 0; i < 16; ++i) { auto t = __builtin_amdgcn_permlane32_swap(__float_as_uint(a[i]), __float_as_uint(a[i]), false, false); lo[i] = __uint_as_float(t[0]); hi[i] = __uint_as_float(t[1]); }
    merge_top16(lo, hi);
#pragma unroll
    for (int i = 0; i < 16; ++i) a[i] = lo[i];
}
__device__ __forceinline__ void peer_stage_a(Frame& F, int t0, int hh, const bf16* QP, const bf16* SKB, const float* SU, const float* SV) {
    int lane = F.lane; asm volatile("" : "+v"(lane));
    const int w = F.wave, c32 = lane & 31, hi = lane >> 5;
    LAS unsigned char* lds = F.lds;
    const LAS float* s2l = (const LAS float*)(lds + P5_S2_OFF);
    float tops[2][16];
#pragma unroll
    for (int p = 0; p < 2; ++p) {
        f32x16 acc[4]; acc[0] = f32x16{}; acc[1] = f32x16{}; acc[2] = f32x16{}; acc[3] = f32x16{};
        const bf16* qrow = QP + ((size_t)(((t0 + 32 * hh) >> 5) * 16 + (w * 2 + p)) * 8 * 64 + lane) * 8;
        const bf16* skp = SKB + ((size_t)(w * 2 + p) * 32 * 64 + lane) * 8;
#pragma unroll 1
        for (int kg = 0; kg < 2; ++kg) {
            bf16x8 bq[4], af[4][4];
#pragma unroll
            for (int k = 0; k < 4; ++k) { bq[k] = *(const GAS bf16x8*)(qrow + (size_t)(4 * kg + k) * 512);
#pragma unroll
                for (int mt = 0; mt < 4; ++mt) af[k][mt] = *(const GAS bf16x8*)(skp + (size_t)((4 * kg + k) * 4 + mt) * 512); }
            __builtin_amdgcn_sched_barrier(0);
#pragma unroll
            for (int k = 0; k < 4; ++k)
#pragma unroll
                for (int mt = 0; mt < 4; ++mt) acc[mt] = __builtin_amdgcn_mfma_f32_32x32x16_bf16(af[k][mt], bq[k], acc[mt], 0, 0, 0);
            __builtin_amdgcn_sched_barrier(0);
        }
#pragma unroll
        for (int mt = 0; mt < 4; ++mt)
#pragma unroll
            for (int rr = 0; rr < 16; ++rr) acc[mt][rr] = __uint_as_float((__float_as_uint(acc[mt][rr]) & ~127u) | (unsigned)(32 * mt + crow(rr, hi)));
        {   float g0[16], g1[16], g2[16], g3[16];
#pragma unroll
            for (int rr = 0; rr < 16; ++rr) { g0[rr] = acc[0][rr]; g1[rr] = acc[1][rr]; g2[rr] = acc[2][rr]; g3[rr] = acc[3][rr]; }
            sort16_desc(g0); sort16_desc(g1); sort16_desc(g2); sort16_desc(g3);
            merge_top16(g0, g1); merge_top16(g2, g3); merge_top16(g0, g2);
            pair_merge_top16(g0);
#pragma unroll
            for (int k = 0; k < 16; ++k) tops[p][k] = g0[k];
        }
    }
    {
        v4u tb; unsigned b_[16];
#pragma unroll
        for (int k = 0; k < 16; ++k) b_[k] = __float_as_uint(hi ? tops[1][k] : tops[0][k]) & 127u;
        tb.x = b_[0] | (b_[1] << 8) | (b_[2] << 16) | (b_[3] << 24); tb.y = b_[4] | (b_[5] << 8) | (b_[6] << 16) | (b_[7] << 24);
        tb.z = b_[8] | (b_[9] << 8) | (b_[10] << 16) | (b_[11] << 24); tb.w = b_[12] | (b_[13] << 8) | (b_[14] << 16) | (b_[15] << 24);
        *(LAS v4u*)(lds + P5_TL_OFF + ((c32 * 8 + w) * 2 + hi) * 16) = tb;
    }
    float best[16];
    {   float ca[16], cb[16];
#pragma unroll
        for (int i = 0; i < 16; ++i) { ca[i] = -3.0e38f; cb[i] = -3.0e38f; }
        int c = 0;
#pragma unroll
        for (int i = 0; i < 16; ++i)
#pragma unroll
            for (int j = 0; j < 16; ++j)
                if ((i + 1) * (j + 1) <= 16) {
                    const float val = tops[0][i] + tops[1][j];
                    const float pk = __uint_as_float((__float_as_uint(val) & ~255u) | (unsigned)(i * 16 + j));
                    const int sl = c >> 1;
                    if (sl < 16) { if ((c & 1) == 0) ca[sl] = pk; else ca[sl] = hi ? pk : ca[sl]; }
                    else         { if ((c & 1) == 0) cb[sl - 16] = pk; else cb[sl - 16] = hi ? pk : cb[sl - 16]; }
                    ++c;
                }
        sort16_desc(ca); sort16_desc(cb); merge_top16(ca, cb); pair_merge_top16(ca);
#pragma unroll
        for (int k = 0; k < 16; ++k) best[k] = ca[k];
    }
    const int tokc = 32 * hh + c32;
    const float s2v = s2l[tokc] * LOG2E;
    float ge[16]; float gs = 0.f;
#pragma unroll
    for (int k = 0; k < 16; ++k) { ge[k] = __builtin_amdgcn_exp2f((best[k] - best[0]) * s2v); gs += ge[k]; }
    const float gi = 1.0f / gs;
    asm volatile("s_waitcnt lgkmcnt(0)" ::: "memory");
    const LAS unsigned char* tl0 = lds + P5_TL_OFF + ((c32 * 8 + w) * 2) * 16;
    LAS v2u* lst = (LAS v2u*)(lds + P5_LIST_OFF) + (tokc >> 3) * P5_LIST_WAVE + (tokc & 7) * 128 + w * 16 + 8 * hi;
#pragma unroll
    for (int k = 0; k < 8; ++k) {
        const float bsel = hi ? best[k + 8] : best[k]; const float gsel = (hi ? ge[k + 8] : ge[k]) * gi;
        const unsigned code = __float_as_uint(bsel) & 255u; const unsigned e0 = tl0[code >> 4], e1 = tl0[16 + (code & 15u)];
        const unsigned e = e0 * 128u + e1;
        const unsigned g16 = (unsigned)__builtin_bit_cast(unsigned short, (_Float16)(gsel * SV[e] * P5_GSCALE)) & 0x7fffu;
        v2u ent; ent.x = (e << 18) | ((unsigned)(tokc & 7) << 15) | g16; ent.y = __float_as_uint(SU[e]);
        lst[k] = ent;
    }
}
#define P5_BODY(S) { int d_ = 0; \
        d_ = __builtin_amdgcn_sdot4((int)uq.x, (int)hq[S].x, d_, false); d_ = __builtin_amdgcn_sdot4((int)uq.y, (int)hq[S].y, d_, false); \
        d_ = __builtin_amdgcn_sdot4((int)uq.z, (int)hq[S].z, d_, false); d_ = __builtin_amdgcn_sdot4((int)uq.w, (int)hq[S].w, d_, false); \
        d_ += dppi<0xB1>(d_); d_ += dppi<0x4E>(d_); d_ += dppi<0x141>(d_); d_ += dppi<0x140>(d_);              \
        d_ += __builtin_amdgcn_update_dpp(0, d_, 0x142, 0xA, 0xF, false); d_ += __builtin_amdgcn_update_dpp(0, d_, 0x143, 0xC, 0xF, false);     \
        const float x_ = (float)__builtin_amdgcn_readlane(d_, 63) * (su * kx[S]); \
        const float t_ = x_ * fmaf(x_ * x_, -0.10294324f, -2.30220819f);                                        \
        const float cf = gate * x_ * __builtin_amdgcn_rcpf(1.0f + __builtin_amdgcn_exp2f(t_)); \
        const _Float16 ch_ = (_Float16)cf; const h2v cp_ = (h2v){ch_, ch_}; \
        _Pragma("unroll") for (int j_ = 0; j_ < 4; ++j_) { \
        acc[S][2 * j_ + 0] = __builtin_elementwise_fma(cp_, f8h<false>(vq[j_]), acc[S][2 * j_ + 0]); \
        acc[S][2 * j_ + 1] = __builtin_elementwise_fma(cp_, f8h<true>(vq[j_]), acc[S][2 * j_ + 1]); } }
typedef _Float16 h2v __attribute__((ext_vector_type(2)));
template <bool HI> __device__ __forceinline__ h2v f8h(unsigned w) { return __builtin_bit_cast(h2v, __builtin_amdgcn_cvt_scalef32_pk_f16_fp8((int)w, 1.0f, HI)); }
typedef float f32x2v __attribute__((ext_vector_type(2)));
__device__ __forceinline__ void peer_unit(Frame& F, int unit, const bf16* QP, const bf16* SKB, const unsigned char* UQ, const unsigned char* VQ, const float* SU, const float* SV, const bf16* HB, float* out) {
    int lane = F.lane; asm volatile("" : "+v"(lane));
    const int w = F.wave;
    const int t0 = unit * 64;
    LAS unsigned char* lds = F.lds;
    LAS float* s2l = (LAS float*)(lds + P5_S2_OFF);
    LAS unsigned char* ringw = lds + P5_RING_OFF + w * P5_RING_WAVE; LAS float* kxl = (LAS float*)(lds + P5_SH_OFF);
#pragma unroll
    for (int hf = 0; hf < 2; ++hf) {
        f32x4 v[4][4];
#pragma unroll
        for (int q = 0; q < 4; ++q) { const GAS v2u* xr = (const GAS v2u*)(HB + (size_t)(t0 + 8 * w + 4 * hf + q) * DM) + lane;
#pragma unroll
            for (int j = 0; j < 4; ++j) { const v2u hw = xr[64 * j]; v[q][j] = (f32x4){bflo(hw.x), bfhi(hw.x), bflo(hw.y), bfhi(hw.y)}; } }
#pragma unroll
        for (int q = 0; q < 4; ++q) { float s = 0.f, mx = 0.f;
#pragma unroll
            for (int j = 0; j < 4; ++j) { const f32x4 x = v[q][j]; s += (x.x * x.x + x.y * x.y) + (x.z * x.z + x.w * x.w); mx = fmaxf(mx, fmaxf(fmaxf(fabsf(x.x), fabsf(x.y)), fmaxf(fabsf(x.z), fabsf(x.w)))); }
            s = wave_sum_dpp(s); mx = wave_max_dpp(mx);
            const float s2 = 1.0f / sqrtf(s * (1.0f / 1024.0f) + EPS), sh = mx > 0.f ? mx * (1.0f / 127.0f) : 1.0f;
            *(LAS v4u*)(ringw + (4 * hf + q) * 1024 + 16 * lane) = quant16(v[q], 1.0f / sh, 0);
            if (lane == 0) { s2l[8 * w + 4 * hf + q] = s2; kxl[8 * w + 4 * hf + q] = sh * s2; } }
    }
    __syncthreads();
#pragma unroll 1
    for (int hh = 0; hh < 2; ++hh) { peer_stage_a(F, t0, hh, QP, SKB, SU, SV); __syncthreads(); }
    lane = F.lane; asm volatile("" : "+v"(lane));
    LAS v2u* lw = (LAS v2u*)(lds + P5_LIST_OFF) + w * P5_LIST_WAVE;
    constexpr int NBK = P5_NBUCKET, WPL = NBK / 16;
    LAS unsigned* cnt = (LAS unsigned*)(lds + P5_CNT_OFF) + w * (NBK * 4);
#define P5_BIN(x) ((((x) >> (32 - P5_LOGNB)) << 3) | (((x) >> 15) & 7u))
    {
        v2u e16[16];
#pragma unroll
        for (int i = 0; i < 16; ++i) e16[i] = lw[64 * i + lane];
#pragma unroll
        for (int k = 0; k < WPL; ++k) cnt[WPL * lane + k] = 0u;
        asm volatile("s_waitcnt lgkmcnt(0)" ::: "memory");
        unsigned rk[16];
#pragma unroll
        for (int i = 0; i < 16; ++i) { const unsigned bin = P5_BIN(e16[i].x); const unsigned sh = (bin & 1u) * 16u;
            const unsigned old = __hip_atomic_fetch_add(cnt + (bin >> 1), 1u << sh, __ATOMIC_RELAXED, __HIP_MEMORY_SCOPE_WORKGROUP); rk[i] = (old >> sh) & 0xffffu; }
        asm volatile("s_waitcnt lgkmcnt(0)" ::: "memory");
        unsigned cb[2 * WPL]; unsigned tot = 0;
#pragma unroll
        for (int k = 0; k < WPL; ++k) { const unsigned cwd = cnt[WPL * lane + k]; cb[2 * k] = cwd & 0xffffu; cb[2 * k + 1] = cwd >> 16; tot += cb[2 * k] + cb[2 * k + 1]; }
        unsigned incl = tot;
#pragma unroll
        for (int o = 1; o < 64; o <<= 1) { const unsigned t = (unsigned)__shfl_up((int)incl, o); if (lane >= o) incl += t; }
        unsigned run = incl - tot; unsigned stt[2 * WPL];
#pragma unroll
        for (int k = 0; k < 2 * WPL; ++k) { stt[k] = run; run += cb[k]; }
        asm volatile("s_waitcnt lgkmcnt(0)" ::: "memory");
#pragma unroll
        for (int k = 0; k < WPL; ++k) cnt[WPL * lane + k] = stt[2 * k] | (stt[2 * k + 1] << 16);
        asm volatile("s_waitcnt lgkmcnt(0)" ::: "memory");
#pragma unroll
        for (int i = 0; i < 16; ++i) { const unsigned bin = P5_BIN(e16[i].x);
            const unsigned base = (cnt[bin >> 1] >> ((bin & 1u) * 16u)) & 0xffffu; lw[base + rk[i]] = e16[i]; }
        asm volatile("s_waitcnt lgkmcnt(0)" ::: "memory");
        if (lane < 8) lw[1024 + lane] = lw[lane];
        asm volatile("s_waitcnt lgkmcnt(0)" ::: "memory");
    }
#undef P5_BIN
    lane = F.lane; asm volatile("" : "+v"(lane));
    v4u hq[8]; float kx[8];
#pragma unroll
    for (int s = 0; s < 8; ++s) { hq[s] = *(const LAS v4u*)(lds + P5_RING_OFF + w * P5_RING_WAVE + s * 1024 + 16 * lane); kx[s] = ((const LAS float*)(lds + P5_SH_OFF))[8 * w + s]; }
    asm volatile("s_waitcnt lgkmcnt(0)" : "+v"(hq[0]), "+v"(hq[1]), "+v"(hq[2]), "+v"(hq[3]), "+v"(hq[4]), "+v"(hq[5]), "+v"(hq[6]), "+v"(hq[7]) :: "memory");
    h2v acc[8][8];
#pragma unroll
    for (int s = 0; s < 8; ++s)
#pragma unroll
        for (int j = 0; j < 8; ++j) acc[s][j] = (h2v){(_Float16)0.f, (_Float16)0.f};
    asm volatile("s_waitcnt vmcnt(0)" ::: "memory");
    LAS unsigned char* ring = lds + P5_RING_OFF + w * P5_RING_WAVE;
    const unsigned char* uvgl = UQ + 16 * lane;
#define P5_ISSUE(idx, slot_) { const v2u en_ = lw[(idx) & 1023]; const unsigned e_ = (unsigned)__builtin_amdgcn_readfirstlane((int)en_.x) >> 18; \
        const unsigned* gp_ = (const unsigned*)(uvgl + (size_t)e_ * 2048); \
        __builtin_amdgcn_global_load_lds(gp_, (LAS unsigned*)(ring + (slot_) * 2048), 16, 0, 0); \
        __builtin_amdgcn_global_load_lds(gp_, (LAS unsigned*)(ring + (slot_) * 2048), 16, 1024, 0); }
#pragma unroll
    for (int i = 0; i < P5_NSLOT; ++i) P5_ISSUE(i, i)
    int slot = 0, i = 0;
    const unsigned xw = (unsigned)(((blockIdx.x >> 3) & 31) * 8 + w);
    const bool hih = lane >= 32; const unsigned lane16 = 16u * (unsigned)lane; const unsigned ringa = (unsigned)(uintptr_t)ring;
    const unsigned lwa = (unsigned)(uintptr_t)lw;
    const unsigned lwah = lwa + (hih ? 8u : 0u);
    const unsigned lwaq = lwa + 8u * ((unsigned)lane >> 4);
#define P5_DMA(e_, slot_) { const unsigned char* rb_ = UQ + (size_t)(e_) * 2048; const unsigned la_ = ringa + (unsigned)(slot_) * 2048u; unsigned keep_; \
        asm volatile("s_mov_b32 %0, m0\n\ts_mov_b32 m0, %3\n\ts_nop 0\n\tglobal_load_lds_dwordx4 %1, %2\n\tglobal_load_lds_dwordx4 %1, %2 offset:1024\n\ts_mov_b32 m0, %0" \
                     : "=&s"(keep_) : "v"(lane16), "s"(rb_), "s"(la_) : "memory"); }
#define P5_PAIR(S) { v2u ent; unsigned nx_;     \
        asm volatile("ds_read_b64 %0, %2\n\tds_read_b32 %1, %2 offset:" P5_STR(P5_O1) : "=&v"(ent), "=&v"(nx_) : "v"(lwa + 8u * (unsigned)i) : "memory"); \
        asm volatile("s_waitcnt vmcnt(" P5_STR(P5_VM1) ")" ::: "memory"); \
        const v4u uq = *(const LAS v4u*)(ring + slot * 2048 + 16 * lane), vq = *(const LAS v4u*)(ring + slot * 2048 + 1024 + 16 * lane); \
        asm volatile("s_waitcnt lgkmcnt(0)" : "+v"(ent), "+v"(nx_) :: "memory");         \
        const unsigned key = (unsigned)__builtin_amdgcn_readfirstlane((int)ent.x); const float su = __uint_as_float((unsigned)__builtin_amdgcn_readfirstlane((int)ent.y)); \
        P5_DMA((unsigned)__builtin_amdgcn_readfirstlane((int)nx_) >> 18, slot) \
        slot = (slot == P5_NSLOT - 1) ? 0 : slot + 1; \
        const float gate = (float)__builtin_bit_cast(_Float16, (unsigned short)(key & 0x7fffu)); \
        P5_BODY(S) }
#define P5_PAIR2(S) { v2u entl_; v4u nab_;                  \
        asm volatile("ds_read_b64 %0, %2\n\tds_read2_b64 %1, %3 offset0:" P5_STR(P5_O2A) " offset1:" P5_STR(P5_O2B) : "=&v"(entl_), "=&v"(nab_) : "v"(lwah + 8u * (unsigned)i), "v"(lwa + 8u * (unsigned)i) : "memory"); \
        asm volatile("s_waitcnt vmcnt(" P5_STR(P5_VM2) ")" ::: "memory"); \
        const int slotB = (slot == P5_NSLOT - 1) ? 0 : slot + 1; \
        const v4u uqA = *(const LAS v4u*)(ring + slot * 2048 + 16 * lane), vqA = *(const LAS v4u*)(ring + slot * 2048 + 1024 + 16 * lane); \
        const v4u uqB = *(const LAS v4u*)(ring + slotB * 2048 + 16 * lane), vqB = *(const LAS v4u*)(ring + slotB * 2048 + 1024 + 16 * lane); \
        asm volatile("s_waitcnt lgkmcnt(0)" : "+v"(entl_), "+v"(nab_) :: "memory"); \
        P5_DMA((unsigned)__builtin_amdgcn_readfirstlane((int)nab_.x) >> 18, slot) P5_DMA((unsigned)__builtin_amdgcn_readfirstlane((int)nab_.z) >> 18, slotB) \
        slot = (slotB == P5_NSLOT - 1) ? 0 : slotB + 1; \
        int dA_ = 0, dB_ = 0; \
        dA_ = __builtin_amdgcn_sdot4((int)uqA.x, (int)hq[S].x, dA_, false); dB_ = __builtin_amdgcn_sdot4((int)uqB.x, (int)hq[S].x, dB_, false); \
        dA_ = __builtin_amdgcn_sdot4((int)uqA.y, (int)hq[S].y, dA_, false); dB_ = __builtin_amdgcn_sdot4((int)uqB.y, (int)hq[S].y, dB_, false); \
        dA_ = __builtin_amdgcn_sdot4((int)uqA.z, (int)hq[S].z, dA_, false); dB_ = __builtin_amdgcn_sdot4((int)uqB.z, (int)hq[S].z, dB_, false); \
        dA_ = __builtin_amdgcn_sdot4((int)uqA.w, (int)hq[S].w, dA_, false); dB_ = __builtin_amdgcn_sdot4((int)uqB.w, (int)hq[S].w, dB_, false); \
        auto sw_ = __builtin_amdgcn_permlane32_swap((unsigned)dA_, (unsigned)dB_, false, false); int e_ = (int)(sw_[0] + sw_[1]);        \
        e_ += dppi<0xB1>(e_); e_ += dppi<0x4E>(e_); e_ += dppi<0x141>(e_); e_ += dppi<0x140>(e_); \
        e_ += __builtin_amdgcn_update_dpp(0, e_, 0x142, 0xA, 0xF, false);                   \
        const float x_ = (float)e_ * (__uint_as_float(entl_.y) * kx[S]); \
        const float t_ = x_ * fmaf(x_ * x_, -0.10294324f, -2.30220819f); \
        const float cfv_ = (float)__builtin_bit_cast(_Float16, (unsigned short)(entl_.x & 0x7fffu)) * x_ * __builtin_amdgcn_rcpf(1.0f + __builtin_amdgcn_exp2f(t_)); \
        const _Float16 ch_ = (_Float16)cfv_; const unsigned cpk_ = __builtin_bit_cast(unsigned, (h2v){ch_, ch_}); \
        const h2v cpA = __builtin_bit_cast(h2v, (unsigned)__builtin_amdgcn_readlane((int)cpk_, 31)), cpB = __builtin_bit_cast(h2v, (unsigned)__builtin_amdgcn_readlane((int)cpk_, 63)); \
        _Pragma("unroll") for (int j_ = 0; j_ < 4; ++j_) { \
        acc[S][2 * j_ + 0] = __builtin_elementwise_fma(cpB, f8h<false>(vqB[j_]), __builtin_elementwise_fma(cpA, f8h<false>(vqA[j_]), acc[S][2 * j_ + 0])); \
        acc[S][2 * j_ + 1] = __builtin_elementwise_fma(cpB, f8h<true>(vqB[j_]), __builtin_elementwise_fma(cpA, f8h<true>(vqA[j_]), acc[S][2 * j_ + 1])); } }
#define P5_QUAD(S) { v2u entl_; v4u n01_, n23_; \
        asm volatile("ds_read_b64 %0, %3\n\tds_read2_b64 %1, %4 offset0:" P5_STR(P5_O2A) " offset1:" P5_STR(P5_O2B) "\n\tds_read2_b64 %2, %4 offset0:" P5_STR(P5_O2C) " offset1:" P5_STR(P5_O2D) \
                     : "=&v"(entl_), "=&v"(n01_), "=&v"(n23_) : "v"(lwaq + 8u * (unsigned)i), "v"(lwa + 8u * (unsigned)i) : "memory"); \
        asm volatile("s_waitcnt vmcnt(" P5_STR(P5_VM4) ")" ::: "memory"); \
        const int s1_ = (slot == P5_NSLOT - 1) ? 0 : slot + 1, s2_ = (s1_ == P5_NSLOT - 1) ? 0 : s1_ + 1, s3_ = (s2_ == P5_NSLOT - 1) ? 0 : s2_ + 1; \
        const v4u uqA = *(const LAS v4u*)(ring + slot * 2048 + 16 * lane), vqA = *(const LAS v4u*)(ring + slot * 2048 + 1024 + 16 * lane); \
        const v4u uqB = *(const LAS v4u*)(ring + s1_ * 2048 + 16 * lane), vqB = *(const LAS v4u*)(ring + s1_ * 2048 + 1024 + 16 * lane); \
        const v4u uqC = *(const LAS v4u*)(ring + s2_ * 2048 + 16 * lane), vqC = *(const LAS v4u*)(ring + s2_ * 2048 + 1024 + 16 * lane); \
        const v4u uqD = *(const LAS v4u*)(ring + s3_ * 2048 + 16 * lane), vqD = *(const LAS v4u*)(ring + s3_ * 2048 + 1024 + 16 * lane); \
        asm volatile("s_waitcnt lgkmcnt(0)" : "+v"(entl_), "+v"(n01_), "+v"(n23_) :: "memory"); \
        P5_DMA((unsigned)__builtin_amdgcn_readfirstlane((int)n01_.x) >> 18, slot) P5_DMA((unsigned)__builtin_amdgcn_readfirstlane((int)n01_.z) >> 18, s1_) \
        P5_DMA((unsigned)__builtin_amdgcn_readfirstlane((int)n23_.x) >> 18, s2_) P5_DMA((unsigned)__builtin_amdgcn_readfirstlane((int)n23_.z) >> 18, s3_) \
        slot = (s3_ == P5_NSLOT - 1) ? 0 : s3_ + 1; \
        int dA_ = 0, dB_ = 0, dC_ = 0, dD_ = 0; \
        dA_ = __builtin_amdgcn_sdot4((int)uqA.x, (int)hq[S].x, dA_, false); dB_ = __builtin_amdgcn_sdot4((int)uqB.x, (int)hq[S].x, dB_, false); dC_ = __builtin_amdgcn_sdot4((int)uqC.x, (int)hq[S].x, dC_, false); dD_ = __builtin_amdgcn_sdot4((int)uqD.x, (int)hq[S].x, dD_, false); \
        dA_ = __builtin_amdgcn_sdot4((int)uqA.y, (int)hq[S].y, dA_, false); dB_ = __builtin_amdgcn_sdot4((int)uqB.y, (int)hq[S].y, dB_, false); dC_ = __builtin_amdgcn_sdot4((int)uqC.y, (int)hq[S].y, dC_, false); dD_ = __builtin_amdgcn_sdot4((int)uqD.y, (int)hq[S].y, dD_, false); \
        dA_ = __builtin_amdgcn_sdot4((int)uqA.z, (int)hq[S].z, dA_, false); dB_ = __builtin_amdgcn_sdot4((int)uqB.z, (int)hq[S].z, dB_, false); dC_ = __builtin_amdgcn_sdot4((int)uqC.z, (int)hq[S].z, dC_, false); dD_ = __builtin_amdgcn_sdot4((int)uqD.z, (int)hq[S].z, dD_, false); \
        dA_ = __builtin_amdgcn_sdot4((int)uqA.w, (int)hq[S].w, dA_, false); dB_ = __builtin_amdgcn_sdot4((int)uqB.w, (int)hq[S].w, dB_, false); dC_ = __builtin_amdgcn_sdot4((int)uqC.w, (int)hq[S].w, dC_, false); dD_ = __builtin_amdgcn_sdot4((int)uqD.w, (int)hq[S].w, dD_, false); \
        auto w1_ = __builtin_amdgcn_permlane32_swap((unsigned)dA_, (unsigned)dC_, false, false); const unsigned e1_ = w1_[0] + w1_[1];          \
        auto w2_ = __builtin_amdgcn_permlane32_swap((unsigned)dB_, (unsigned)dD_, false, false); const unsigned e2_ = w2_[0] + w2_[1];          \
        auto w3_ = __builtin_amdgcn_permlane16_swap(e1_, e2_, false, false); int e_ = (int)(w3_[0] + w3_[1]);                                    \
        e_ += dppi<0xB1>(e_); e_ += dppi<0x4E>(e_); e_ += dppi<0x141>(e_); e_ += dppi<0x140>(e_); \
        const float x_ = (float)e_ * (__uint_as_float(entl_.y) * kx[S]); \
        const float t_ = x_ * fmaf(x_ * x_, -0.10294324f, -2.30220819f); \
        const float cfv_ = (float)__builtin_bit_cast(_Float16, (unsigned short)(entl_.x & 0x7fffu)) * x_ * __builtin_amdgcn_rcpf(1.0f + __builtin_amdgcn_exp2f(t_)); \
        const _Float16 ch_ = (_Float16)cfv_; const unsigned cpk_ = __builtin_bit_cast(unsigned, (h2v){ch_, ch_}); \
        const h2v cpA = __builtin_bit_cast(h2v, (unsigned)__builtin_amdgcn_readlane((int)cpk_, 0)), cpB = __builtin_bit_cast(h2v, (unsigned)__builtin_amdgcn_readlane((int)cpk_, 16)); \
        const h2v cpC = __builtin_bit_cast(h2v, (unsigned)__builtin_amdgcn_readlane((int)cpk_, 32)), cpD = __builtin_bit_cast(h2v, (unsigned)__builtin_amdgcn_readlane((int)cpk_, 48)); \
        _Pragma("unroll") for (int j_ = 0; j_ < 4; ++j_) { \
        acc[S][2 * j_ + 0] = __builtin_elementwise_fma(cpD, f8h<false>(vqD[j_]), __builtin_elementwise_fma(cpC, f8h<false>(vqC[j_]), __builtin_elementwise_fma(cpB, f8h<false>(vqB[j_]), __builtin_elementwise_fma(cpA, f8h<false>(vqA[j_]), acc[S][2 * j_ + 0])))); \
        acc[S][2 * j_ + 1] = __builtin_elementwise_fma(cpD, f8h<true>(vqD[j_]), __builtin_elementwise_fma(cpC, f8h<true>(vqC[j_]), __builtin_elementwise_fma(cpB, f8h<true>(vqB[j_]), __builtin_elementwise_fma(cpA, f8h<true>(vqA[j_]), acc[S][2 * j_ + 1])))); } }
#define P5_RUN(S, END) { _Pragma("unroll 1") for (; i + 3 < (END); i += 4) P5_QUAD(S) if (i + 1 < (END)) { P5_PAIR2(S) i += 2; } if (i < (END)) { P5_PAIR(S) ++i; } }
#pragma unroll 1
    for (int b = 0; b < NBK; ++b) {
        {
            constexpr int RPB = NEXP / NBK;
#pragma unroll
            for (int k = 0; k < (RPB + 255) / 256; ++k) { const unsigned pe = (unsigned)(((b + 2) & (NBK - 1)) * RPB) + ((xw + 256u * k) & (unsigned)(RPB - 1));
                const unsigned* gp = (const unsigned*)(uvgl + (size_t)pe * 2048);
                __builtin_amdgcn_global_load_lds(gp, (LAS unsigned*)(lds + P5_DUMMY_OFF), 16, 0, 0);
                __builtin_amdgcn_global_load_lds(gp, (LAS unsigned*)(lds + P5_DUMMY_OFF), 16, 1024, 0); } }
        const v4u sw = *(const LAS v4u*)(cnt + 4 * b);
        const unsigned w0 = (unsigned)__builtin_amdgcn_readfirstlane((int)sw.x), w1 = (unsigned)__builtin_amdgcn_readfirstlane((int)sw.y), w2 = (unsigned)__builtin_amdgcn_readfirstlane((int)sw.z), w3 = (unsigned)__builtin_amdgcn_readfirstlane((int)sw.w);
        const unsigned nb = (b == NBK - 1) ? 1024u : ((unsigned)__builtin_amdgcn_readfirstlane((int)cnt[4 * b + 4]) & 0xffffu);
        const int e0 = (int)(w0 >> 16), e1 = (int)(w1 & 0xffffu), e2 = (int)(w1 >> 16), e3 = (int)(w2 & 0xffffu), e4 = (int)(w2 >> 16), e5 = (int)(w3 & 0xffffu), e6 = (int)(w3 >> 16), e7 = (int)nb;
        P5_RUN(0, e0) P5_RUN(1, e1) P5_RUN(2, e2) P5_RUN(3, e3) P5_RUN(4, e4) P5_RUN(5, e5) P5_RUN(6, e6) P5_RUN(7, e7)
    }
#undef P5_RUN
#undef P5_QUAD
#undef P5_PAIR2
#undef P5_PAIR
#undef P5_DMA
    asm volatile("s_waitcnt vmcnt(0)" ::: "memory");
    lane = F.lane; asm volatile("" : "+v"(lane));
    v2u hw[8][4];
#pragma unroll
    for (int s = 0; s < 8; ++s) { const GAS v2u* hrow = (const GAS v2u*)(HB + (size_t)(t0 + 8 * w + s) * DM) + lane;
#pragma unroll
        for (int j = 0; j < 4; ++j) hw[s][j] = hrow[64 * j]; }
#pragma unroll
    for (int s = 0; s < 8; ++s) { GAS f32x4* orow = (GAS f32x4*)(out + (size_t)(t0 + 8 * w + s) * DM) + lane;
#pragma unroll
        for (int j = 0; j < 4; ++j) { f32x4 a = (f32x4){bflo(hw[s][j].x), bfhi(hw[s][j].x), bflo(hw[s][j].y), bfhi(hw[s][j].y)}; const float c = 1.0f / P5_GSCALE;
            a.x += (float)acc[s][2 * j][0] * c; a.y += (float)acc[s][2 * j][1] * c; a.z += (float)acc[s][2 * j + 1][0] * c; a.w += (float)acc[s][2 * j + 1][1] * c; orow[64 * j] = a; } }
    __syncthreads();
}
#undef P5_ISSUE
#undef P5_BODY

#ifndef GEMM_WGM1
#define GEMM_WGM1 2
#endif
#ifndef GEMM_WGM3
#define GEMM_WGM3 2
#endif
#ifndef GEMM_WGM4
#define GEMM_WGM4 2
#endif
#ifndef MK_N_LAUNCHES
#define MK_N_LAUNCHES 1
#endif
constexpr int N_LAUNCHES = MK_N_LAUNCHES;
constexpr int PER_PHASE = 7;
struct Args { const float* in[13]; float* out; unsigned char* ws; int ph_lo, ph_hi; };
__global__ void __launch_bounds__(NWAVES * 64, 2) fwd_megakernel(Args args) {
    extern __shared__ __attribute__((aligned(16))) unsigned char lds[];
    Frame F;
    F.lds = (LAS unsigned char*)lds;
    F.MISC = (volatile LAS unsigned*)(F.lds + MISC_OFF);
    F.tid = threadIdx.x; F.lane = F.tid & 63; F.wave = __builtin_amdgcn_readfirstlane(F.tid >> 6);
    F.G = gridDim.x;
    unsigned char* ws = args.ws; F.ws = ws;
    F.ctl = (gu32*)(ws + WS_CTL);
    F.x = args.in[0]; F.norm1_g = args.in[1]; F.w_in = args.in[2]; F.q_norm_g = args.in[3]; F.k_norm_g = args.in[4]; F.w_pool = args.in[5]; F.pool_scale = args.in[6];
    F.w_out = args.in[7]; F.norm2_g = args.in[8]; F.w_query = args.in[9]; F.sub_keys = args.in[10]; F.expert_u = args.in[11]; F.expert_v = args.in[12]; F.out = args.out;
    for (int u = F.tid; u < (LDS_BYTES - LDSCTL_OFF) / 4; u += NWAVES * 64) ((LAS unsigned*)(F.lds + LDSCTL_OFF))[u] = 0u;
    __syncthreads();
    XcdBarrier bar; bar.bar = (unsigned*)(F.ctl + CW_BAR); bar.x = 0; bar.st = nullptr;
    if (N_LAUNCHES == 1) bar = xcd_barrier_post((unsigned*)(F.ctl + CW_BAR), F.MISC + 8);
#define GRID_BAR() do { if (N_LAUNCHES == 1) xcd_barrier(bar); } while (0)
    const int lo = args.ph_lo, hi = args.ph_hi;
#define IN(k) (lo <= (k) && (k) < hi)
    bf16* const XB = (bf16*)(ws + WS_XB); bf16* const W1T = (bf16*)(ws + WS_W1T); bf16* const WOT = (bf16*)(ws + WS_WOT); bf16* const WQT = (bf16*)(ws + WS_WQT);
    bf16* const AIN = (bf16*)(ws + WS_AIN); bf16* const Qb = (bf16*)(ws + WS_Q); bf16* const Gb = (bf16*)(ws + WS_G);
    bf16* const Kb = (bf16*)args.out; bf16* const Vb = (bf16*)args.out + (size_t)T * DM;
    float* const MDm = (float*)(ws + WS_MD); float* const MDd = MDm + (size_t)3 * T * 16;
    bf16* const MERGED = XB; bf16* const HB = (bf16*)(ws + WS_HB); bf16* const QP = Gb;

    if (IN(0)) { p0_part_a(F); GRID_BAR(); p0_part_b(F); GRID_BAR(); }
    if (IN(1)) {
        pg8::Gemm g{XB, W1T, T, INW, DM / 2}; pg8::StaticOrder S; S.init(T, INW, F.G, (int)blockIdx.x, GEMM_WGM1);
        pg8::EpiProj E{AIN, Qb, Kb, Vb, Gb, F.q_norm_g, F.k_norm_g, (const float*)(ws + WS_S1), (const float*)(ws + WS_CS)};
        pg8::gemm_phase<pg8::EpiProj, pg8::StaticOrder, true, true, true>(F.lds + RING_OFF, g, S, E);
        GRID_BAR();
    }
    if (IN(2)) {
        constexpr int NU = 3 * BATCH * 16 * 32; const int per = (NU + F.G - 1) / F.G; const int u0 = blockIdx.x * per, u1 = (u0 + per) < NU ? (u0 + per) : NU;
        const bool xl = (F.G == 256);
        attn_phase(F, xl ? 0 : u0, xl ? 48 : u1, xl, Kb, Vb, Qb, MDm, MDd);
        GRID_BAR();
    }
    if (IN(3)) {
        constexpr int NU = T / 32; const int per = (NU + F.G - 1) / F.G; const int u0 = blockIdx.x * per, u1 = (u0 + per) < NU ? (u0 + per) : NU;
        for (int u = u0; u < u1; ++u) pool_merge_unit32(F, u, AIN, (const bf16*)(ws + WS_WPT), Qb, Gb, MDd, (unsigned char*)MERGED, (float*)(ws + WS_MS));
        GRID_BAR();
    }
    if (IN(4)) {
        pg8::Gemm g{MERGED, WOT, T, DM, DM / 2}; pg8::StaticOrder S; S.init(T, DM, F.G, (int)blockIdx.x, GEMM_WGM3);
        pg8::EpiOut E{F.x, F.out, HB, (const float*)(ws + WS_XM), (unsigned char*)args.out, (const float*)(ws + WS_MS), (const float*)(ws + WS_CS3)};
        pg8::gemm_phase<pg8::EpiOut, pg8::StaticOrder, true, true, true>(F.lds + RING_OFF, g, S, E);
        GRID_BAR();
    }
    if (IN(5)) {
        pg8::Gemm g{(const bf16*)args.out, WQT, T, 2048, DM / 2}; pg8::StaticOrder S; S.init(T, 2048, F.G, (int)blockIdx.x, GEMM_WGM4);
        pg8::EpiPlainI8 E{QP, 2048, (const float*)(ws + WS_XM), (const float*)(ws + WS_CS2)};
        pg8::gemm_phase<pg8::EpiPlainI8, pg8::StaticOrder, true, true, true>(F.lds + RING_OFF, g, S, E);
        GRID_BAR();
    }
    if (IN(6)) {
        constexpr int NU = T / 64; const int per = (NU + F.G - 1) / F.G; const int u0 = blockIdx.x * per, u1 = (u0 + per) < NU ? (u0 + per) : NU;
        for (int u = u0; u < u1; ++u) peer_unit(F, u, QP, (const bf16*)(ws + WS_SKB), ws + WS_UB, ws + WS_VB, (const float*)(ws + WS_SU), (const float*)(ws + WS_SV), HB, F.out);
    }
#undef IN
#undef GRID_BAR
}

extern "C" void kernel_launch(void* const* d_in, const int* in_sizes, int n_in, void* d_out, int out_size, void* d_ws, size_t ws_size, hipStream_t stream) {
    static int grid = 0;
    if (grid == 0) {
        if (n_in != 13 || in_sizes[0] != T * DM || out_size != T * DM || ws_size < WS_END) {
            fprintf(stderr, "kernel_launch: unexpected shapes (n_in %d, in0 %d, out %d, ws %zu, need %zu); nothing launched\n", n_in, n_in > 0 ? in_sizes[0] : -1, out_size, ws_size, (size_t)WS_END); grid = -1; return; }
        int dev = 0, cus = 0, per_cu = 0;
        if (hipGetDevice(&dev) != hipSuccess || hipDeviceGetAttribute(&cus, hipDeviceAttributeMultiprocessorCount, dev) != hipSuccess) { grid = -1; return; }
        if (hipFuncSetAttribute((const void*)fwd_megakernel, hipFuncAttributeMaxDynamicSharedMemorySize, LDS_BYTES) != hipSuccess) { fprintf(stderr, "kernel_launch: hipFuncSetAttribute failed\n"); grid = -1; return; }
        if (hipOccupancyMaxActiveBlocksPerMultiprocessor(&per_cu, (const void*)fwd_megakernel, NWAVES * 64, LDS_BYTES) != hipSuccess || per_cu < 1) { fprintf(stderr, "kernel_launch: occupancy query reports %d workgroups per CU\n", per_cu); grid = -1; (void)hipGetLastError(); return; }
        (void)hipGetLastError();
        grid = cus;
    }
    if (grid < 0) return;
    if (hipMemsetAsync((char*)d_ws + WS_CTL, 0, CTL_ZERO_BYTES, stream) != hipSuccess) return;
    Args a{};
    for (int i = 0; i < 13; ++i) a.in[i] = (const float*)d_in[i];
    a.out = (float*)d_out; a.ws = (unsigned char*)d_ws;
    for (int li = 0; li < N_LAUNCHES; ++li) {
        a.ph_lo = (N_LAUNCHES == 1) ? 0 : li; a.ph_hi = (N_LAUNCHES == 1) ? PER_PHASE : li + 1;
        hipLaunchKernelGGL(fwd_megakernel, dim3(grid), dim3(NWAVES * 64), LDS_BYTES, stream, a);
    }
}
```

```cpp
#include <hip/hip_runtime.h>
#include <cstdio>
#include <cstdint>
namespace pg8 {
#define PG8_LAS __attribute__((address_space(3)))
typedef unsigned short bf16_t;
typedef short bf16x8 __attribute__((ext_vector_type(8)));
typedef float f32x4 __attribute__((ext_vector_type(4)));
typedef unsigned u32x4 __attribute__((ext_vector_type(4)));
typedef int i32x4 __attribute__((ext_vector_type(4)));
constexpr int BM = 256, BK = 64, HALF = 128, HTB = HALF * BK * 2  , STAGE_BYTES = 8 * HTB, NXCD = 8;

__host__ __device__ __forceinline__ int lds_byte(int r, int c) { const int st = (r >> 4) * 2 + (c >> 5), rr = r & 15, cc = c & 31, ob = rr * 64 + cc * 2; return st * 1024 + (ob ^ (((ob >> 9) & 1) << 5)); }
__host__ __device__ __forceinline__ void stage_rc(int b, int& R, int& C) { const int st = b / 1024, sb = b % 1024, swz = sb ^ (((sb >> 9) & 1) << 5); R = (st >> 1) * 16 + swz / 64; C = (st & 1) * 32 + (swz % 64) / 2; }
__host__ __device__ __forceinline__ int perm32(int rho) { const int n = rho >> 4, i = rho & 15; return 8 * (i >> 2) + 4 * n + (i & 3); }

struct Unit { int pm, pn; };
struct Gemm { const bf16_t* A; const bf16_t* Bt; int M, N, K; };

struct StaticOrder {
    int nM, nN, nwg, G, c, WGM;
    __host__ __device__ void init(int M, int N, int G_, int c_, int wgm_ = 8) { nM = M / BM; nN = N / BM; nwg = nM * nN; G = G_; c = c_; WGM = wgm_; }
    __host__ __device__ bool next(int i, Unit& u) const {
        const long L = (long)i * G + c; if (L >= nwg) return false;
        int wgid = (int)L; { const int q = nwg / NXCD, r = nwg % NXCD, xcd = wgid % NXCD, off = wgid / NXCD; wgid = (xcd < r ? xcd * (q + 1) : r * (q + 1) + (xcd - r) * q) + off; }
        const int nig = WGM * nN, gid = wgid / nig, fm = gid * WGM, gsz = (nM - fm) < WGM ? (nM - fm) : WGM;
        u.pm = fm + ((wgid % nig) % gsz); u.pn = (wgid % nig) / gsz; return true;
    }
    __device__ __forceinline__ void a_ready(const Unit&) const {}
    __device__ __forceinline__ void done(const Unit&) const {}
};
__device__ __forceinline__ unsigned cvt_pk_bf16(float lo, float hi) { unsigned r; asm volatile("v_cvt_pk_bf16_f32 %0, %1, %2" : "=v"(r) : "v"(lo), "v"(hi)); return r; }

typedef float f32x2 __attribute__((ext_vector_type(2)));
__device__ __forceinline__ float xrow16_sum(float x) {
    auto s = __builtin_amdgcn_permlane16_swap(__float_as_uint(x), __float_as_uint(x), false, false);
    x = __uint_as_float(s[0]) + __uint_as_float(s[1]);
    auto t = __builtin_amdgcn_permlane32_swap(__float_as_uint(x), __float_as_uint(x), false, false);
    return __uint_as_float(t[0]) + __uint_as_float(t[1]);
}
struct EpiPlain {
    static constexpr bool PERM = true, AFTER_DRAIN = false;
    bf16_t* O; int ldc;
    __device__ __forceinline__ void operator()(const f32x4 (&acc)[2][2][4][2], const Unit& u, int wr, int wc, int fr, int fq) const {
        const int row0 = u.pm * BM + wr * 64 + fr; const int col0 = u.pn * BM + wc * 32 + 8 * fq;
#pragma unroll
        for (int ai = 0; ai < 2; ++ai)
#pragma unroll
            for (int m = 0; m < 4; ++m) { bf16_t* rowp = O + (size_t)(row0 + ai * HALF + m * 16) * ldc + col0;
#pragma unroll
                for (int bj = 0; bj < 2; ++bj) { const f32x4 v0 = acc[ai][bj][m][0], v1 = acc[ai][bj][m][1];
                    u32x4 w; w.x = cvt_pk_bf16(v0[0], v0[1]); w.y = cvt_pk_bf16(v0[2], v0[3]); w.z = cvt_pk_bf16(v1[0], v1[1]); w.w = cvt_pk_bf16(v1[2], v1[3]);
                    *(u32x4*)(rowp + bj * HALF) = w; } }
    }
};
struct EpiPlainI8 {
    static constexpr bool PERM = true, AFTER_DRAIN = false;
    bf16_t* O; int ldc; const float* xm; const float* cs;
    __device__ __forceinline__ void operator()(const f32x4 (&acc)[2][2][4][2], const Unit& u, int wr, int wc, int fr, int fq) const;
};
struct EpiProj {
    static constexpr bool PERM = true, AFTER_DRAIN = false;
    bf16_t *AIN, *Q, *K, *V, *G; const float* qg; const float* kg; const float* rs; const float* cs;
    __device__ __forceinline__ void operator()(const f32x4 (&acc)[2][2][4][2], const Unit& u, int wr, int wc, int fr, int fq) const {
        const int pn = u.pn; int type, ldc, colt; bf16_t* base;
        if (pn < 2)       { type = 0; base = AIN; ldc = 512;  colt = pn * 256; }
        else if (pn < 14) { type = 1; base = Q;   ldc = 3072; colt = (pn - 2) * 256; }
        else if (pn < 18) { type = 2; base = K;   ldc = 1024; colt = (pn - 14) * 256; }
        else if (pn < 22) { type = 3; base = V;   ldc = 1024; colt = (pn - 18) * 256; }
        else              { type = 4; base = G;   ldc = 2048; colt = (pn - 22) * 256; }
        const int col0 = colt + 64 * wc + 8 * fq;
        const int row0 = u.pm * BM + wr * 64 + fr;
        f32x4 gn[2][2], csv[2][2];
        const float* csp = cs + pn * 256 + 64 * wc + 8 * fq;
#pragma unroll
        for (int bj = 0; bj < 2; ++bj)
#pragma unroll
            for (int n = 0; n < 2; ++n) csv[bj][n] = *(const f32x4*)(csp + 32 * bj + 4 * n);
        float rs8[2][4];
#pragma unroll
        for (int ai = 0; ai < 2; ++ai)
#pragma unroll
            for (int m = 0; m < 4; ++m) rs8[ai][m] = rs[row0 + ai * HALF + m * 16];
        const float* gp = (type == 2) ? kg : qg;
        const float gmul = (type == 1) ? 0.125f * 1.4426950408889634f : 1.0f;
#pragma unroll
        for (int bj = 0; bj < 2; ++bj)
#pragma unroll
            for (int n = 0; n < 2; ++n) gn[bj][n] = *(const f32x4*)(gp + 32 * bj + 8 * fq + 4 * n) * gmul;
#pragma unroll
        for (int ai = 0; ai < 2; ++ai)
#pragma unroll
            for (int m = 0; m < 4; ++m) {
                const int row = row0 + ai * HALF + m * 16;
                f32x4 v[2][2];
#pragma unroll
                for (int bj = 0; bj < 2; ++bj)
#pragma unroll
                    for (int n = 0; n < 2; ++n) { const i32x4 iv = __builtin_bit_cast(i32x4, acc[ai][bj][m][n]); v[bj][n] = (f32x4){(float)iv[0], (float)iv[1], (float)iv[2], (float)iv[3]} * csv[bj][n]; }
                const float rsv = rs8[ai][m];
                if (type == 1 || type == 2) {
                    float ss = 0.f;
#pragma unroll
                    for (int bj = 0; bj < 2; ++bj)
#pragma unroll
                        for (int n = 0; n < 2; ++n) { const f32x4 x = v[bj][n]; ss += (x[0] * x[0] + x[1] * x[1]) + (x[2] * x[2] + x[3] * x[3]); }
                    ss = xrow16_sum(ss);
                    const float rn = __builtin_amdgcn_rsqf(ss * (rsv * rsv * (1.0f / 64.0f)) + 1e-6f) * rsv;
#pragma unroll
                    for (int bj = 0; bj < 2; ++bj)
#pragma unroll
                        for (int n = 0; n < 2; ++n) v[bj][n] = v[bj][n] * rn * gn[bj][n];
                } else {
#pragma unroll
                    for (int bj = 0; bj < 2; ++bj)
#pragma unroll
                        for (int n = 0; n < 2; ++n) v[bj][n] = v[bj][n] * rsv;
                }
                bf16_t* rowp = base + (size_t)row * ldc + col0;
                if (type >= 1 && type <= 3) {
                    const int hh = (colt >> 6) + wc;
                    const int bb = row >> 13, tt = row & 8191;
                    const size_t slab = (type == 1) ? (size_t)((hh >> 4) * 8 + bb) * 16 + (hh & 15) : (size_t)bb * 16 + hh;
                    rowp = base + (slab * 8192 + tt) * 64 + 8 * fq; }
                if (type >= 2) {
                    unsigned char* gp8 = (type == 4) ? (unsigned char*)G + (size_t)row * 2048 + col0 : (unsigned char*)(type == 2 ? K : V) + (((size_t)(row >> 13) * 16 + ((colt >> 6) + wc)) * 8192 + (row & 8191)) * 64 + 8 * fq;
                    typedef unsigned u32x2 __attribute__((ext_vector_type(2)));
#pragma unroll
                    for (int bj = 0; bj < 2; ++bj) { const f32x4 v0 = v[bj][0], v1 = v[bj][1];
                        int p0 = __builtin_amdgcn_cvt_pk_fp8_f32(v0[0], v0[1], 0, false); p0 = __builtin_amdgcn_cvt_pk_fp8_f32(v0[2], v0[3], p0, true);
                        int p1 = __builtin_amdgcn_cvt_pk_fp8_f32(v1[0], v1[1], 0, false); p1 = __builtin_amdgcn_cvt_pk_fp8_f32(v1[2], v1[3], p1, true);
                        *(u32x2*)(gp8 + 32 * bj) = (u32x2){(unsigned)p0, (unsigned)p1}; }
                } else {
#pragma unroll
                for (int bj = 0; bj < 2; ++bj) { const f32x4 v0 = v[bj][0], v1 = v[bj][1];
                    u32x4 w; w.x = cvt_pk_bf16(v0[0], v0[1]); w.y = cvt_pk_bf16(v0[2], v0[3]); w.z = cvt_pk_bf16(v1[0], v1[1]); w.w = cvt_pk_bf16(v1[2], v1[3]);
                    *(u32x4*)(rowp + 32 * bj) = w; }
                }
            }
    }
};
__device__ __forceinline__ float hscale(float xmax) { return (1.25f * xmax + 1.0f) * (1.0f / 127.0f); }
struct EpiOut {
    static constexpr bool PERM = true, AFTER_DRAIN = false;
    const float* x; float* out; bf16_t* hb; const float* xm; unsigned char* hq; const float* ms; const float* cs;
    __device__ __forceinline__ void operator()(const f32x4 (&acc)[2][2][4][2], const Unit& u, int wr, int wc, int fr, int fq) const {
        const int row0 = u.pm * BM + wr * 64 + fr; const int col0 = u.pn * BM + wc * 32 + 8 * fq;
        typedef unsigned u32x2 __attribute__((ext_vector_type(2)));
        float xm8[8], ms8[8];
#pragma unroll
        for (int it = 0; it < 8; ++it) { xm8[it] = xm[row0 + (it >> 2) * HALF + (it & 3) * 16]; ms8[it] = ms[row0 + (it >> 2) * HALF + (it & 3) * 16]; }
        f32x4 csv[2][2];
#pragma unroll
        for (int bj = 0; bj < 2; ++bj)
#pragma unroll
            for (int n = 0; n < 2; ++n) csv[bj][n] = *(const f32x4*)(cs + col0 + bj * HALF + 4 * n);
        f32x4 xc[2][2], xn[2][2];
#pragma unroll
        for (int bj = 0; bj < 2; ++bj) { xc[bj][0] = *(const f32x4*)(x + (size_t)row0 * 1024 + col0 + bj * HALF); xc[bj][1] = *(const f32x4*)(x + (size_t)row0 * 1024 + col0 + bj * HALF + 4); }
#pragma unroll
        for (int it = 0; it < 8; ++it) { const int ai = it >> 2, m = it & 3; const int row = row0 + ai * HALF + m * 16; const size_t off = (size_t)row * 1024 + col0;
            if (it < 7) { const size_t offn = (size_t)(row0 + ((it + 1) >> 2) * HALF + ((it + 1) & 3) * 16) * 1024 + col0;
#pragma unroll
                for (int bj = 0; bj < 2; ++bj) { xn[bj][0] = *(const f32x4*)(x + offn + bj * HALF); xn[bj][1] = *(const f32x4*)(x + offn + bj * HALF + 4); } }
            const float inv = 1.0f / hscale(xm8[it]);
#pragma unroll
            for (int bj = 0; bj < 2; ++bj) {
                const i32x4 i0 = __builtin_bit_cast(i32x4, acc[ai][bj][m][0]), i1 = __builtin_bit_cast(i32x4, acc[ai][bj][m][1]);
                const f32x4 v0 = (f32x4){(float)i0[0], (float)i0[1], (float)i0[2], (float)i0[3]} * (csv[bj][0] * ms8[it]) + xc[bj][0], v1 = (f32x4){(float)i1[0], (float)i1[1], (float)i1[2], (float)i1[3]} * (csv[bj][1] * ms8[it]) + xc[bj][1];
                u32x4 w; w.x = cvt_pk_bf16(v0[0], v0[1]); w.y = cvt_pk_bf16(v0[2], v0[3]); w.z = cvt_pk_bf16(v1[0], v1[1]); w.w = cvt_pk_bf16(v1[2], v1[3]);
                *(u32x4*)(hb + off + bj * HALF) = w;
                unsigned q0 = 0u, q1 = 0u;
#pragma unroll
                for (int e = 0; e < 4; ++e) { q0 = __builtin_amdgcn_cvt_pk_u8_f32(__builtin_amdgcn_fmed3f(__builtin_rintf(fmaf(v0[e], inv, 128.0f)), 1.0f, 255.0f), e, q0);
                                              q1 = __builtin_amdgcn_cvt_pk_u8_f32(__builtin_amdgcn_fmed3f(__builtin_rintf(fmaf(v1[e], inv, 128.0f)), 1.0f, 255.0f), e, q1); }
                *(u32x2*)(hq + off + bj * HALF) = (u32x2){q0 ^ 0x80808080u, q1 ^ 0x80808080u}; }
#pragma unroll
            for (int bj = 0; bj < 2; ++bj) { xc[bj][0] = xn[bj][0]; xc[bj][1] = xn[bj][1]; } }
    }
};
__device__ __forceinline__ void EpiPlainI8::operator()(const f32x4 (&acc)[2][2][4][2], const Unit& u, int wr, int wc, int fr, int fq) const {
    const int row0 = u.pm * BM + wr * 64 + fr; const int col0 = u.pn * BM + wc * 32 + 8 * fq;
    f32x4 csv[2][2];
#pragma unroll
    for (int bj = 0; bj < 2; ++bj)
#pragma unroll
        for (int n = 0; n < 2; ++n) csv[bj][n] = *(const f32x4*)(cs + col0 + bj * HALF + 4 * n);
    float xm8[2][4];
#pragma unroll
    for (int ai = 0; ai < 2; ++ai)
#pragma unroll
        for (int m = 0; m < 4; ++m) xm8[ai][m] = xm[row0 + ai * HALF + m * 16];
#pragma unroll
    for (int ai = 0; ai < 2; ++ai)
#pragma unroll
        for (int m = 0; m < 4; ++m) { const int row = row0 + ai * HALF + m * 16; bf16_t* rowp = O + (size_t)row * ldc + col0; const float rsv = hscale(xm8[ai][m]);
#pragma unroll
            for (int bj = 0; bj < 2; ++bj) { const i32x4 i0 = __builtin_bit_cast(i32x4, acc[ai][bj][m][0]), i1 = __builtin_bit_cast(i32x4, acc[ai][bj][m][1]);
                const f32x4 v0 = (f32x4){(float)i0[0], (float)i0[1], (float)i0[2], (float)i0[3]} * csv[bj][0] * rsv, v1 = (f32x4){(float)i1[0], (float)i1[1], (float)i1[2], (float)i1[3]} * csv[bj][1] * rsv;
                u32x4 w; w.x = cvt_pk_bf16(v0[0], v0[1]); w.y = cvt_pk_bf16(v0[2], v0[3]); w.z = cvt_pk_bf16(v1[0], v1[1]); w.w = cvt_pk_bf16(v1[2], v1[3]);
                *(u32x4*)(rowp + bj * HALF) = w; } }
}
template <class Epi, class Sched, bool ALIGN_EPI = false, bool SP2 = false, bool I8 = false>
__device__ __forceinline__ void gemm_phase(PG8_LAS unsigned char* lds, const Gemm g, const Sched& S, const Epi& E) {
    const int tid = threadIdx.x, wid = __builtin_amdgcn_readfirstlane(tid >> 6), lane = tid & 63, wr = wid >> 2, wc = wid & 3, fr = lane & 15, fq = lane >> 4;
    const int K = g.K, nt = K / BK;
    unsigned voffA[2], voffB[2];
#pragma unroll
    for (int i = 0; i < 2; ++i) { int R, C; stage_rc(tid * 16 + i * 8192, R, C); const int Rb = Epi::PERM ? ((R & ~31) + perm32(R & 31)) : R;
        voffA[i] = (unsigned)(R * K + C) * 2u; voffB[i] = (unsigned)(Rb * K + C) * 2u; }
    const size_t kstep = (size_t)(BK * 2);
    const size_t hstep = (size_t)HALF * K * 2;
    const size_t tstep = 2 * hstep;
    const unsigned ldsw = (unsigned)wid * 1024u;
    const int aoff = lds_byte(wr * 64 + fr, fq * 8), boff = lds_byte(wc * 32 + fr, fq * 8);
#define PG8_SA(b, h) (((b) * 2 + (h)) * HTB)
#define PG8_SB(b, h) ((4 + (b) * 2 + (h)) * HTB)
#define PG8_STAGE(bufoff, gbase, voff) do { _Pragma("unroll") for (int _i = 0; _i < 2; ++_i) \
        __builtin_amdgcn_global_load_lds((const unsigned*)((const char*)(gbase) + (voff)[_i]), (PG8_LAS unsigned*)(lds + (bufoff) + ldsw + _i * 8192), 16, 0, 0); } while (0)
#define PG8_LDA(dst, b, h) do { _Pragma("unroll") for (int m = 0; m < 4; ++m) _Pragma("unroll") for (int k = 0; k < 2; ++k) dst[m][k] = *(const PG8_LAS bf16x8*)(lds + PG8_SA(b, h) + aoff + m * 2048 + k * 1024); } while (0)
#define PG8_LDB(dst, b, h) do { _Pragma("unroll") for (int n = 0; n < 2; ++n) _Pragma("unroll") for (int k = 0; k < 2; ++k) dst[n][k] = *(const PG8_LAS bf16x8*)(lds + PG8_SB(b, h) + boff + n * 2048 + k * 1024); } while (0)
#define PG8_MMA(ai, bj, At, Bt) do { __builtin_amdgcn_s_setprio(1); _Pragma("unroll") for (int m = 0; m < 4; ++m) _Pragma("unroll") for (int n = 0; n < 2; ++n) _Pragma("unroll") for (int k = 0; k < 2; ++k) \
        { if constexpr (I8) acc[ai][bj][m][n] = __builtin_bit_cast(f32x4, __builtin_amdgcn_mfma_i32_16x16x64_i8(__builtin_bit_cast(i32x4, Bt[n][k]), __builtin_bit_cast(i32x4, At[m][k]), __builtin_bit_cast(i32x4, acc[ai][bj][m][n]), 0, 0, 0)); \
          else acc[ai][bj][m][n] = __builtin_amdgcn_mfma_f32_16x16x32_bf16(Bt[n][k], At[m][k], acc[ai][bj][m][n], 0, 0, 0); } __builtin_amdgcn_s_setprio(0); } while (0)
#define PG8_WAIT_V(n) asm volatile("s_waitcnt vmcnt(" #n ")" ::: "memory")
#define PG8_WAIT_L(n) asm volatile("s_waitcnt lgkmcnt(" #n ")" ::: "memory")
#define PG8_BAR __builtin_amdgcn_s_barrier()
#define PG8_SCHED __builtin_amdgcn_sched_barrier(0)
    Unit cur, nxt; int ui = 0;
    if (!S.next(0, cur)) return;
    f32x4 acc[2][2][4][2];
#pragma unroll
    for (int a = 0; a < 2; ++a)
#pragma unroll
        for (int b = 0; b < 2; ++b)
#pragma unroll
            for (int m = 0; m < 4; ++m)
#pragma unroll
                for (int n = 0; n < 2; ++n) acc[a][b][m][n] = (f32x4){0.f, 0.f, 0.f, 0.f};
    bf16x8 At[4][2], B0[2][2], B1[2][2];
    const char* cA = (const char*)g.A + (size_t)cur.pm * tstep; const char* cB = (const char*)g.Bt + (size_t)cur.pn * tstep;
    S.a_ready(cur);
    if constexpr (SP2) {
        PG8_STAGE(PG8_SB(0, 0), cB, voffB); PG8_STAGE(PG8_SB(0, 1), cB + hstep, voffB); PG8_STAGE(PG8_SA(0, 0), cA, voffA); PG8_STAGE(PG8_SA(0, 1), cA + hstep, voffA);
        if (wr == 1) PG8_BAR;
        PG8_WAIT_V(2); PG8_BAR;
        PG8_STAGE(PG8_SB(1, 0), cB + kstep, voffB); PG8_STAGE(PG8_SA(1, 0), cA + kstep, voffA); PG8_STAGE(PG8_SB(1, 1), cB + hstep + kstep, voffB);
        PG8_WAIT_V(6); PG8_BAR;
    } else {
        PG8_STAGE(PG8_SB(0, 0), cB, voffB); PG8_STAGE(PG8_SA(0, 0), cA, voffA); PG8_STAGE(PG8_SB(0, 1), cB + hstep, voffB); PG8_STAGE(PG8_SA(0, 1), cA + hstep, voffA);
        if (wr == 1) PG8_BAR;
        PG8_WAIT_V(4); PG8_BAR;
        PG8_STAGE(PG8_SB(1, 0), cB + kstep, voffB); PG8_STAGE(PG8_SA(1, 0), cA + kstep, voffA); PG8_STAGE(PG8_SB(1, 1), cB + hstep + kstep, voffB);
        PG8_WAIT_V(6); PG8_BAR;
    }
    for (;;) {
        const bool has_next = S.next(ui + 1, nxt);
        const char* nA = has_next ? (const char*)g.A + (size_t)nxt.pm * tstep : cA; const char* nB = has_next ? (const char*)g.Bt + (size_t)nxt.pn * tstep : cB;
        for (int t = 0; t < nt; t += 2) {
            const bool last = (t == nt - 2);
            const char* a1 = cA + (size_t)(t + 1) * kstep;
            const char* a2 = last ? nA : cA + (size_t)(t + 2) * kstep; const char* b2 = last ? nB : cB + (size_t)(t + 2) * kstep;
            const char* a3 = a2 + kstep; const char* b3 = b2 + kstep;
            if (last && has_next) S.a_ready(nxt);
            if constexpr (SP2) {
            PG8_LDB(B0, 0, 0); PG8_LDB(B1, 0, 1); PG8_SCHED; PG8_LDA(At, 0, 0); PG8_STAGE(PG8_SA(1, 1), a1 + hstep, voffA);
            PG8_WAIT_V(8); PG8_WAIT_L(0); PG8_BAR; PG8_MMA(0, 0, At, B0); PG8_MMA(0, 1, At, B1); PG8_BAR; PG8_SCHED;
            PG8_LDA(At, 0, 1); PG8_STAGE(PG8_SB(0, 0), b2, voffB); PG8_STAGE(PG8_SB(0, 1), b2 + hstep, voffB); PG8_STAGE(PG8_SA(0, 0), a2, voffA);
            PG8_WAIT_V(8); PG8_WAIT_L(0); PG8_BAR; PG8_MMA(1, 0, At, B0); PG8_MMA(1, 1, At, B1); PG8_BAR; PG8_SCHED;
            PG8_LDB(B0, 1, 0); PG8_LDB(B1, 1, 1); PG8_SCHED; PG8_LDA(At, 1, 0); PG8_STAGE(PG8_SA(0, 1), a2 + hstep, voffA);
            PG8_WAIT_V(8); PG8_WAIT_L(0); PG8_BAR; PG8_MMA(0, 0, At, B0); PG8_MMA(0, 1, At, B1); PG8_BAR; PG8_SCHED;
            PG8_LDA(At, 1, 1); PG8_STAGE(PG8_SB(1, 0), b3, voffB); PG8_STAGE(PG8_SB(1, 1), b3 + hstep, voffB); PG8_STAGE(PG8_SA(1, 0), a3, voffA);
            PG8_WAIT_V(8); PG8_WAIT_L(0); PG8_BAR; PG8_MMA(1, 0, At, B0); PG8_MMA(1, 1, At, B1); PG8_BAR; PG8_SCHED;
            } else {
            PG8_LDB(B0, 0, 0); PG8_SCHED; PG8_LDA(At, 0, 0); PG8_STAGE(PG8_SA(1, 1), a1 + hstep, voffA);
            PG8_WAIT_L(8); PG8_BAR; PG8_WAIT_L(0); PG8_MMA(0, 0, At, B0); PG8_BAR; PG8_SCHED;
            PG8_LDB(B1, 0, 1); PG8_STAGE(PG8_SB(0, 0), b2, voffB);
            PG8_BAR; PG8_WAIT_L(0); PG8_MMA(0, 1, At, B1); PG8_BAR;
            PG8_LDA(At, 0, 1); PG8_STAGE(PG8_SA(0, 0), a2, voffA);
            PG8_BAR; PG8_WAIT_L(0); PG8_MMA(1, 0, At, B0); PG8_BAR; PG8_SCHED;
            PG8_STAGE(PG8_SB(0, 1), b2 + hstep, voffB);
            PG8_WAIT_V(6); PG8_BAR; PG8_MMA(1, 1, At, B1); PG8_BAR;
            PG8_LDB(B0, 1, 0); PG8_SCHED; PG8_LDA(At, 1, 0); PG8_STAGE(PG8_SA(0, 1), a2 + hstep, voffA);
            PG8_WAIT_L(8); PG8_BAR; PG8_WAIT_L(0); PG8_MMA(0, 0, At, B0); PG8_BAR; PG8_SCHED;
            PG8_LDB(B1, 1, 1); PG8_STAGE(PG8_SB(1, 0), b3, voffB);
            PG8_BAR; PG8_WAIT_L(0); PG8_MMA(0, 1, At, B1); PG8_BAR;
            PG8_LDA(At, 1, 1); PG8_STAGE(PG8_SA(1, 0), a3, voffA);
            PG8_BAR; PG8_WAIT_L(0); PG8_MMA(1, 0, At, B0); PG8_BAR; PG8_SCHED;
            PG8_STAGE(PG8_SB(1, 1), b3 + hstep, voffB);
            PG8_WAIT_V(6); PG8_BAR; PG8_MMA(1, 1, At, B1); PG8_BAR;
            }
        }
        if constexpr (ALIGN_EPI) { if (wr == 0) PG8_BAR; }
        if constexpr (!Epi::AFTER_DRAIN) { E(acc, cur, wr, wc, fr, fq); S.done(cur); }
        if (!has_next) break;
#pragma unroll
        for (int a = 0; a < 2; ++a)
#pragma unroll
            for (int b = 0; b < 2; ++b)
#pragma unroll
                for (int m = 0; m < 4; ++m)
#pragma unroll
                    for (int n = 0; n < 2; ++n) acc[a][b][m][n] = (f32x4){0.f, 0.f, 0.f, 0.f};
        cur = nxt; cA = nA; cB = nB; ++ui;
        if constexpr (ALIGN_EPI) { if (wr == 1) PG8_BAR; }
    }
    PG8_WAIT_V(0);
    if constexpr (!ALIGN_EPI) { if (wr == 0) PG8_BAR; }
    PG8_BAR;
    if constexpr (Epi::AFTER_DRAIN) { E.fused(acc, cur, wr, wc, fr, fq, lds, wid, lane); S.done(cur); }
#undef PG8_SA
#undef PG8_SB
#undef PG8_STAGE
#undef PG8_LDA
#undef PG8_LDB
#undef PG8_MMA
#undef PG8_WAIT_V
#undef PG8_WAIT_L
#undef PG8_BAR
#undef PG8_SCHED
}
}

constexpr int NWAVES = 8;
constexpr int BATCH = 8, SEQ = 8192, DM = 1024, T = BATCH * SEQ;
constexpr int INW = 7680, QW = 3072, GATEW = 2048, POOLW = 512;
constexpr int NEXP = 16384;
constexpr float EPS = 1e-6f;
constexpr float LOG2E = 1.4426950408889634f;

constexpr size_t MiB = 1u << 20;
constexpr size_t WS_CTL = 0, CTL_ZERO_BYTES = 1 * MiB;
constexpr size_t WS_W1T = 2 * MiB;
constexpr size_t WS_WOT = 17 * MiB;
constexpr size_t WS_WQT = 19 * MiB;
constexpr size_t WS_WPT = 23 * MiB;
constexpr size_t WS_SKB = 23 * MiB + 512 * 1024;
constexpr size_t WS_S1 = 24 * MiB;
constexpr size_t WS_SU = 24 * MiB + 256 * 1024, WS_SV = 24 * MiB + 512 * 1024;
constexpr size_t WS_UB = 25 * MiB;
constexpr size_t WS_VB = 57 * MiB;
constexpr size_t WS_MD = 89 * MiB;
constexpr size_t WS_XB = 113 * MiB;
constexpr size_t WS_AIN = 241 * MiB;
constexpr size_t WS_Q = 305 * MiB;
constexpr size_t WS_G = 689 * MiB;
constexpr size_t WS_END = 945 * MiB;
constexpr size_t WS_HB = WS_AIN;
constexpr size_t WS_CMAX = 64 * 1024;
constexpr size_t WS_CS = 128 * 1024;
constexpr size_t WS_CMAX2 = 96 * 1024;
constexpr size_t WS_CS2 = 192 * 1024;
constexpr size_t WS_CMAX3 = 104 * 1024;
constexpr size_t WS_CS3 = 200 * 1024;
constexpr size_t WS_MS = 512 * 1024;
constexpr size_t WS_XM = 256 * 1024;

constexpr int CW_BAR = 4096;
constexpr int RING_OFF = 0, RING_BYTES = 131072;
constexpr int LDSCTL_OFF = 162816, MISC_OFF = LDSCTL_OFF + 320;
constexpr int LDS_BYTES = 163840;

#define GAS __attribute__((address_space(1)))
#define LAS __attribute__((address_space(3)))
typedef unsigned short bf16;
typedef unsigned v4u __attribute__((ext_vector_type(4)));
typedef unsigned v2u __attribute__((ext_vector_type(2)));
typedef float f32x4 __attribute__((ext_vector_type(4)));
typedef float f32x16 __attribute__((ext_vector_type(16)));
typedef short bf16x8 __attribute__((ext_vector_type(8)));
typedef short s16x4 __attribute__((ext_vector_type(4)));
typedef __bf16 bf16x2_t __attribute__((ext_vector_type(2)));
typedef GAS unsigned gu32;
#define RLX_AGENT __ATOMIC_RELAXED, __HIP_MEMORY_SCOPE_AGENT
#define LDS_WAIT() asm volatile("s_waitcnt lgkmcnt(0)" ::: "memory")
#define VM_WAIT() asm volatile("s_waitcnt vmcnt(0)" ::: "memory")
__device__ __forceinline__ unsigned f2bf(float f) { unsigned u = __builtin_bit_cast(unsigned, f); return (u + 0x7fffu + ((u >> 16) & 1u)) >> 16; }
__device__ __forceinline__ unsigned pk2(float lo, float hi) { return f2bf(lo) | (f2bf(hi) << 16); }
__device__ __forceinline__ float bflo(unsigned w) { return __uint_as_float(w << 16); }
__device__ __forceinline__ float bfhi(unsigned w) { return __uint_as_float(w & 0xffff0000u); }
__device__ __forceinline__ int crow(int r, int hi) { return (r & 3) + 8 * (r >> 2) + 4 * hi; }
__device__ __forceinline__ float xhalf_max(float x) { auto t = __builtin_amdgcn_permlane32_swap(__float_as_uint(x), __float_as_uint(x), false, false); return fmaxf(__uint_as_float(t[0]), __uint_as_float(t[1])); }
__device__ __forceinline__ float xhalf_sum(float x) { auto t = __builtin_amdgcn_permlane32_swap(__float_as_uint(x), __float_as_uint(x), false, false); return __uint_as_float(t[0]) + __uint_as_float(t[1]); }
__device__ __forceinline__ float wave_sum(float v) {
#pragma unroll
    for (int o = 1; o < 64; o <<= 1) v += __shfl_xor(v, o);
    return v;
}
__device__ __forceinline__ float dot2bf(unsigned a, unsigned b, float acc) { return __builtin_amdgcn_fdot2_f32_bf16(__builtin_bit_cast(bf16x2_t, a), __builtin_bit_cast(bf16x2_t, b), acc, false); }

#define XB_TMO      128
#define XB_XCNT(j)  (256  + 64 * (j))
#define XB_XSUB(j)  (1280 + 64 * (j))
#define XB_XGEN(j)  (2304 + 64 * (j))
#define XB_TOP      3328
#define XB_TOPGEN   3392
#define XCD_BAR_WORDS 3456
#define XB_SPIN_CAP (1u << 18)

__device__ __forceinline__ unsigned xb_ld(unsigned* p)              { return __hip_atomic_load(p, __ATOMIC_RELAXED, __HIP_MEMORY_SCOPE_AGENT); }
__device__ __forceinline__ unsigned xb_add(unsigned* p, unsigned v) { return __hip_atomic_fetch_add(p, v, __ATOMIC_RELAXED, __HIP_MEMORY_SCOPE_AGENT); }
__device__ __forceinline__ unsigned xb_xcc_id() { return (unsigned)__builtin_amdgcn_s_getreg((3 << 11) | 20) & 0xFu; }
#define XB_SPIN(cond, bar) do { unsigned _sp = 0; while (cond) { __builtin_amdgcn_s_sleep(1); \
    if ((++_sp & 255u) == 0u) { if (xb_ld(&(bar)[XB_TMO])) break; if (_sp > XB_SPIN_CAP) { atomicAdd(&(bar)[XB_TMO], 1u); break; } } } } while (0)

struct XcdBarrier {
    unsigned* bar; unsigned x;
    volatile LAS unsigned* st;
};

__device__ __forceinline__ XcdBarrier xcd_barrier_post(unsigned* bar, volatile LAS unsigned* st) {
    XcdBarrier b; b.bar = bar; b.x = xb_xcc_id(); b.st = st;
    if (threadIdx.x == 0) (void)xb_add(&bar[XB_XCNT(b.x)], 1u);
    return b;
}
__device__ __forceinline__ void xcd_barrier_complete(unsigned* bar, unsigned x, unsigned& nloc, unsigned& nx) {
    const unsigned G = gridDim.x * gridDim.y * gridDim.z;
    unsigned sum, cnt, mine, sp = 0u;
    for (;;) {
        sum = 0u; cnt = 0u; mine = 0u;
#pragma unroll
        for (unsigned j = 0; j < 16; ++j) { const unsigned c = xb_ld(&bar[XB_XCNT(j)]); sum += c; cnt += (c > 0u) ? 1u : 0u; mine = (j == x) ? c : mine; }
        if (sum == G) break;
        __builtin_amdgcn_s_sleep(1);
        if ((++sp & 255u) == 0u) { if (xb_ld(&bar[XB_TMO])) break; if (sp > XB_SPIN_CAP) { atomicAdd(&bar[XB_TMO], 1u); break; } }
    }
    nloc = mine > 0u ? mine : 1u; nx = cnt > 0u ? cnt : 1u;
}

__device__ __forceinline__ void xcd_barrier(const XcdBarrier& b) {
    asm volatile("s_waitcnt vmcnt(0)" ::: "memory");
    __syncthreads();
    if (threadIdx.x == 0) {
        unsigned* bar = b.bar;
        __builtin_amdgcn_s_waitcnt(0);
        unsigned nloc = b.st[0], nx = b.st[1];
        if (nloc == 0u) { xcd_barrier_complete(bar, b.x, nloc, nx); b.st[0] = nloc; b.st[1] = nx; }
        const unsigned old = xb_add(&bar[XB_XSUB(b.x)], 1u);
        const unsigned gen = old / nloc;
        if (old + 1u == (gen + 1u) * nloc) {
            __builtin_amdgcn_fence(__ATOMIC_RELEASE, "agent");
            asm volatile("s_waitcnt vmcnt(0)" ::: "memory");
            const unsigned og = xb_add(&bar[XB_TOP], 1u);
            const unsigned tg = og / nx;
            if (og + 1u == (tg + 1u) * nx) xb_add(&bar[XB_TOPGEN], 1u);
            else XB_SPIN(xb_ld(&bar[XB_TOPGEN]) == tg, bar);
            __builtin_amdgcn_fence(__ATOMIC_ACQUIRE, "agent");
            xb_add(&bar[XB_XGEN(b.x)], 1u);
            asm volatile("s_waitcnt vmcnt(0)" ::: "memory");
        } else {
            XB_SPIN(xb_ld(&bar[XB_XGEN(b.x)]) == gen, bar);
            __builtin_amdgcn_fence(__ATOMIC_ACQUIRE, "agent");
            asm volatile("s_waitcnt vmcnt(0)" ::: "memory");
        }
    }
    __syncthreads();
}

struct Frame {
    LAS unsigned char* lds;
    volatile LAS unsigned* MISC;
    gu32* ctl;
    int tid, lane, wave, G;
    const float *x, *norm1_g, *w_in, *q_norm_g, *k_norm_g, *w_pool, *pool_scale, *w_out, *norm2_g, *w_query, *sub_keys, *expert_u, *expert_v;
    float* out; unsigned char* ws;
};
template <int CTRL> __device__ __forceinline__ float dppf(float x) { return __builtin_bit_cast(float, __builtin_amdgcn_mov_dpp(__builtin_bit_cast(int, x), CTRL, 0xf, 0xf, true)); }
__device__ __forceinline__ float wave_sum_dpp(float x) {
    x += dppf<0xB1>(x);
    x += dppf<0x4E>(x);
    x += dppf<0x141>(x);
    x += dppf<0x128>(x);
    return pg8::xrow16_sum(x);
}

__device__ __forceinline__ float wave_max_dpp(float x) {
    x = fmaxf(x, dppf<0xB1>(x)); x = fmaxf(x, dppf<0x4E>(x)); x = fmaxf(x, dppf<0x141>(x)); x = fmaxf(x, dppf<0x128>(x));
    auto s = __builtin_amdgcn_permlane16_swap(__float_as_uint(x), __float_as_uint(x), false, false);
    x = fmaxf(__uint_as_float(s[0]), __uint_as_float(s[1]));
    auto t = __builtin_amdgcn_permlane32_swap(__float_as_uint(x), __float_as_uint(x), false, false);
    return fmaxf(__uint_as_float(t[0]), __uint_as_float(t[1]));
}
template <int CTRL> __device__ __forceinline__ int dppi(int x) { return __builtin_amdgcn_mov_dpp(x, CTRL, 0xf, 0xf, true); }
__device__ __forceinline__ int wave_sum_dpp_i(int x) {
    x += dppi<0xB1>(x); x += dppi<0x4E>(x); x += dppi<0x141>(x); x += dppi<0x128>(x);
    auto s = __builtin_amdgcn_permlane16_swap((unsigned)x, (unsigned)x, false, false); x = (int)(s[0] + s[1]);
    auto t = __builtin_amdgcn_permlane32_swap((unsigned)x, (unsigned)x, false, false); return (int)(t[0] + t[1]);
}
__device__ __forceinline__ v4u quant16(const f32x4 (&v)[4], float inv, int off) {
    v4u o;
#pragma unroll
    for (int j = 0; j < 4; ++j) {
        const int a = (int)__builtin_rintf(v[j].x * inv) + off, b = (int)__builtin_rintf(v[j].y * inv) + off, c = (int)__builtin_rintf(v[j].z * inv) + off, d = (int)__builtin_rintf(v[j].w * inv) + off;
        o[j] = (unsigned)(a & 255) | ((unsigned)(b & 255) << 8) | ((unsigned)(c & 255) << 16) | ((unsigned)(d & 255) << 24);
    }
    return o;
}
__device__ __forceinline__ void p0_quant_row(const float* xrow, const float* gain, unsigned char* orow, float* scale_out, int off, int lane) {
    const GAS f32x4* xr = (const GAS f32x4*)xrow + lane;
    f32x4 v[4]; float mx = 0.f;
#pragma unroll
    for (int j = 0; j < 4; ++j) { v[j] = xr[64 * j]; if (gain) v[j] = v[j] * ((const f32x4*)gain)[64 * j + lane];
        mx = fmaxf(mx, fmaxf(fmaxf(fabsf(v[j].x), fabsf(v[j].y)), fmaxf(fabsf(v[j].z), fabsf(v[j].w)))); }
    mx = wave_max_dpp(mx);
    const float sc = mx > 0.f ? mx * (1.0f / 127.0f) : 1.0f, inv = 1.0f / sc;
    *(GAS v4u*)(orow + 16 * lane) = quant16(v, inv, off);
    if (lane == 0) __hip_atomic_store(scale_out, sc, __ATOMIC_RELAXED, __HIP_MEMORY_SCOPE_AGENT);
}
__device__ __forceinline__ void p0_fp8_row(const float* xrow, unsigned char* orow, float* scale_out, int lane) {
    const GAS f32x4* xr = (const GAS f32x4*)xrow + lane;
    f32x4 v[4]; float mx = 0.f;
#pragma unroll
    for (int j = 0; j < 4; ++j) { v[j] = xr[64 * j]; mx = fmaxf(mx, fmaxf(fmaxf(fabsf(v[j].x), fabsf(v[j].y)), fmaxf(fabsf(v[j].z), fabsf(v[j].w)))); }
    mx = wave_max_dpp(mx);
    const float sc = mx > 0.f ? mx * (1.0f / 400.0f) : 1.0f, inv = 1.0f / sc;
    v4u o;
#pragma unroll
    for (int j = 0; j < 4; ++j) { int pk = __builtin_amdgcn_cvt_pk_fp8_f32(v[j].x * inv, v[j].y * inv, 0, false); pk = __builtin_amdgcn_cvt_pk_fp8_f32(v[j].z * inv, v[j].w * inv, pk, true); o[j] = (unsigned)pk; }
    *(GAS v4u*)(orow + 16 * lane) = o;
    if (lane == 0) __hip_atomic_store(scale_out, sc, __ATOMIC_RELAXED, __HIP_MEMORY_SCOPE_AGENT);
}
__device__ __forceinline__ void p0_transpose_item(const float* W, int K, int N, const float* rs, const float* cs, bf16* WT, int permute, LAS float* scr, int item, int lane) {
    const int nblk = N / 32, kb = item / nblk, nb = item % nblk, k0 = 64 * kb, n0 = 32 * nb;
    const float csv = cs ? cs[n0 + (lane & 31)] : 1.f;
#pragma unroll 8
    for (int i = 0; i < 32; ++i) { const int kk = 2 * i + (lane >> 5); const float r = rs ? rs[k0 + kk] : 1.f; scr[kk * 33 + (lane & 31)] = W[(size_t)(k0 + kk) * N + n0 + (lane & 31)] * r * csv; }
    LDS_WAIT(); asm volatile("" ::: "memory");
    int nout0 = n0;
    if (permute) { const int gl = (n0 & 255) >> 5; const int gp = 4 * (gl & 1) + (gl >> 1); nout0 = (n0 & ~255) + 32 * gp; }
    const int c = lane & 7;
#pragma unroll
    for (int j = 0; j < 4; ++j) { const int n = (lane >> 3) + 8 * j; const LAS float* s = scr + (8 * c) * 33 + n;
        v4u o; o.x = pk2(s[0 * 33], s[1 * 33]); o.y = pk2(s[2 * 33], s[3 * 33]); o.z = pk2(s[4 * 33], s[5 * 33]); o.w = pk2(s[6 * 33], s[7 * 33]);
        *(GAS v4u*)(WT + (size_t)(nout0 + n) * K + k0 + 8 * c) = o; }
    LDS_WAIT(); asm volatile("" ::: "memory");
}
__device__ __forceinline__ void p0_row(const float* xrow, const float* gain, bf16* orow, bool rms, int lane) {
    const GAS f32x4* xr = (const GAS f32x4*)xrow + lane;
    f32x4 v[4]; float s = 0.f;
#pragma unroll
    for (int j = 0; j < 4; ++j) { v[j] = xr[64 * j]; s += (v[j].x * v[j].x + v[j].y * v[j].y) + (v[j].z * v[j].z + v[j].w * v[j].w); }
    if (rms) { s = wave_sum(s); const float r = 1.0f / sqrtf(s * (1.0f / 1024.0f) + EPS);
#pragma unroll
        for (int j = 0; j < 4; ++j) v[j] = v[j] * r; }
    if (gain) {
#pragma unroll
        for (int j = 0; j < 4; ++j) v[j] = v[j] * ((const f32x4*)gain)[64 * j + lane];
    }
    GAS unsigned long long* o8 = (GAS unsigned long long*)orow + lane;
#pragma unroll
    for (int j = 0; j < 4; ++j) o8[64 * j] = (unsigned long long)pk2(v[j].x, v[j].y) | ((unsigned long long)pk2(v[j].z, v[j].w) << 32);
}
__device__ __forceinline__ void p0_colmax_item(const float* W, int N, const float* rs, unsigned* cmax, int item, int lane) {
    const int nblk = N / 32, kb = item / nblk, nb = item % nblk, k0 = 64 * kb, n0 = 32 * nb;
    float mx = 0.f;
#pragma unroll 8
    for (int i = 0; i < 32; ++i) { const int kk = 2 * i + (lane >> 5); const float r = rs ? rs[k0 + kk] : 1.f; mx = fmaxf(mx, fabsf(W[(size_t)(k0 + kk) * N + n0 + (lane & 31)] * r)); }
    mx = xhalf_max(mx);
    if (lane < 32) (void)__hip_atomic_fetch_max(cmax + n0 + lane, __float_as_uint(mx), __ATOMIC_RELAXED, __HIP_MEMORY_SCOPE_AGENT);
}
__device__ __forceinline__ void p0_transpose_q8_item(const float* W, int N, const float* rs, unsigned* cmax, float* cscale, unsigned char* WT, int permute, LAS float* scr, int item, int lane) {
    constexpr int K = 1024;
    const int nblk = N / 32, kb = item / nblk, nb = item % nblk, k0 = 128 * kb, n0 = 32 * nb;
    const float cm = __uint_as_float(__hip_atomic_load(cmax + n0 + (lane & 31), __ATOMIC_RELAXED, __HIP_MEMORY_SCOPE_AGENT));
    const float inv = cm > 0.f ? 127.0f / cm : 0.f;
    if (kb == 0 && lane < 32) cscale[n0 + lane] = cm * (1.0f / 127.0f);
#pragma unroll 8
    for (int i = 0; i < 64; ++i) { const int kk = 2 * i + (lane >> 5); const float r = rs ? rs[k0 + kk] : 1.f; scr[kk * 33 + (lane & 31)] = __builtin_rintf(W[(size_t)(k0 + kk) * N + n0 + (lane & 31)] * r * inv); }
    LDS_WAIT(); asm volatile("" ::: "memory");
    int nout0 = n0;
    if (permute) { const int gl = (n0 & 255) >> 5; const int gp = 4 * (gl & 1) + (gl >> 1); nout0 = (n0 & ~255) + 32 * gp; }
    const int c = lane & 7;
#pragma unroll
    for (int j = 0; j < 4; ++j) { const int n = (lane >> 3) + 8 * j; const LAS float* sp = scr + (16 * c) * 33 + n;
        v4u o;
#pragma unroll
        for (int d = 0; d < 4; ++d) o[d] = ((unsigned)(int)sp[(4 * d) * 33] & 255u) | (((unsigned)(int)sp[(4 * d + 1) * 33] & 255u) << 8) | (((unsigned)(int)sp[(4 * d + 2) * 33] & 255u) << 16) | ((unsigned)(int)sp[(4 * d + 3) * 33] << 24);
        *(GAS v4u*)(WT + (size_t)(nout0 + n) * K + k0 + 16 * c) = o; }
    LDS_WAIT(); asm volatile("" ::: "memory");
}
__device__ __forceinline__ void p0_xrow_q8(const float* xrow, unsigned char* orow, float* rs_out, float* xm_out, int lane) {
    const GAS f32x4* xr = (const GAS f32x4*)xrow + lane;
    f32x4 v[4]; float s = 0.f, mx = 0.f;
#pragma unroll
    for (int j = 0; j < 4; ++j) { v[j] = xr[64 * j]; s += (v[j].x * v[j].x + v[j].y * v[j].y) + (v[j].z * v[j].z + v[j].w * v[j].w);
        mx = fmaxf(mx, fmaxf(fmaxf(fabsf(v[j].x), fabsf(v[j].y)), fmaxf(fabsf(v[j].z), fabsf(v[j].w)))); }
    s = wave_sum_dpp(s); mx = wave_max_dpp(mx);
    const float r = 1.0f / sqrtf(s * (1.0f / 1024.0f) + EPS);
    const float q = mx > 0.f ? mx * (1.0f / 127.0f) : 1.0f, inv = 1.0f / q;
    const v4u o = quant16(v, inv, 0);
#pragma unroll
    for (int j = 0; j < 4; ++j) ((GAS unsigned*)orow)[64 * j + lane] = o[j];
    if (lane == 0) { *xm_out = mx; *rs_out = r * q; }
}
__device__ __forceinline__ void p0_part_a(Frame& F) {
    const int gw = blockIdx.x * NWAVES + F.wave, NGW = F.G * NWAVES;
    unsigned char* ws = F.ws;
    constexpr int I_IN = (DM / 64) * (INW / 32);
    constexpr int I_Q = (DM / 64) * (2048 / 32);
    for (int it = gw; it < I_IN + I_Q; it += NGW) {
        if (it < I_IN) p0_colmax_item(F.w_in, INW, F.norm1_g, (unsigned*)(ws + WS_CMAX), it, F.lane);
        else p0_colmax_item(F.w_query, 2048, F.norm2_g, (unsigned*)(ws + WS_CMAX2), it - I_IN, F.lane);
    }
    constexpr int I_O = (DM / 64) * (DM / 32);
    for (int it = gw; it < I_O; it += NGW) p0_colmax_item(F.w_out, DM, nullptr, (unsigned*)(ws + WS_CMAX3), it, F.lane);
    for (int q = blockIdx.x; q < T / 32; q += F.G)
        for (int i = F.wave; i < 32; i += NWAVES) { const int m = 32 * q + i; p0_xrow_q8(F.x + (size_t)m * DM, ws + WS_XB + (size_t)m * DM, (float*)(ws + WS_S1) + m, (float*)(ws + WS_XM) + m, F.lane); }
    constexpr int NROWS = 2 * NEXP + 512;
    for (int m = gw; m < NROWS; m += NGW) {
        int r = m;
        if (r < NEXP) { p0_quant_row(F.expert_u + (size_t)r * DM, F.norm2_g, ws + WS_UB + (size_t)r * 2048, (float*)(ws + WS_SU) + r, 0, F.lane); continue; } r -= NEXP;
        if (r < NEXP) { p0_fp8_row(F.expert_v + (size_t)r * DM, ws + WS_UB + (size_t)r * 2048 + 1024, (float*)(ws + WS_SV) + r, F.lane); continue; } r -= NEXP;
        {
            const int hp = r >> 5, ks = (r >> 2) & 7, mt = r & 3, key = 32 * mt + (F.lane & 31), d0 = 16 * ks + 8 * (F.lane >> 5);
            const GAS f32x4* sp = (const GAS f32x4*)(F.sub_keys + ((size_t)(hp * 128 + key) * 128 + d0)); const f32x4 a = sp[0], b = sp[1];
            v4u o; o.x = pk2(a.x, a.y); o.y = pk2(a.z, a.w); o.z = pk2(b.x, b.y); o.w = pk2(b.z, b.w);
            *(GAS v4u*)((bf16*)(ws + WS_SKB) + ((size_t)r * 64 + F.lane) * 8) = o; }
    }
}
__device__ __forceinline__ void p0_part_b(Frame& F) {
    LAS float* scr = (LAS float*)(F.lds + RING_OFF + F.wave * 16896);
    const int gw = blockIdx.x * NWAVES + F.wave, NGW = F.G * NWAVES;
    unsigned char* ws = F.ws;
    constexpr int I_IN = (DM / 128) * (INW / 32), I_O = (DM / 128) * (DM / 32), I_Q = (DM / 128) * (2048 / 32), I_P = 4 * (128 / 64) * (256 / 32);
    constexpr int NITEMS = I_IN + I_O + I_Q + I_P;
    for (int it = gw; it < NITEMS; it += NGW) {
        int r = it;
        if (r < I_IN) { p0_transpose_q8_item(F.w_in, INW, F.norm1_g, (unsigned*)(ws + WS_CMAX), (float*)(ws + WS_CS), ws + WS_W1T, 1, scr, r, F.lane); continue; } r -= I_IN;
        if (r < I_O) { p0_transpose_q8_item(F.w_out, DM, nullptr, (unsigned*)(ws + WS_CMAX3), (float*)(ws + WS_CS3), ws + WS_WOT, 0, scr, r, F.lane); continue; } r -= I_O;
        if (r < I_Q) { p0_transpose_q8_item(F.w_query, 2048, F.norm2_g, (unsigned*)(ws + WS_CMAX2), (float*)(ws + WS_CS2), ws + WS_WQT, 0, scr, r, F.lane); continue; } r -= I_Q;
        { const int g = r / 16, ri = r % 16;
          p0_transpose_item(F.w_pool + (size_t)g * 128 * 256, 128, 256, nullptr, F.pool_scale + g * 256, (bf16*)(ws + WS_WPT) + (size_t)g * 256 * 128, 0, scr, ri, F.lane); }
    }
}

constexpr int ATT_NK = 384, ATT_K_OFF = 0, ATT_V_OFF = ATT_NK * 128;
typedef short v4i16_t __attribute__((ext_vector_type(4)));
__device__ __forceinline__ s16x4 vtr(unsigned ldsaddr) { return __builtin_bit_cast(s16x4, __builtin_amdgcn_ds_read_tr16_b64_v4i16((LAS v4i16_t*)(uintptr_t)ldsaddr)); }
struct AttnU { int p, b, h, dil, r, bp; };
__device__ __forceinline__ AttnU attn_decode(int unit) {
    AttnU u; const int idx = unit & 31; int t1 = unit >> 5; u.h = t1 & 15; t1 >>= 4; u.b = t1 & 7; u.p = t1 >> 3;
    const int dl = (u.p == 0) ? 0 : (u.p == 1 ? 2 : 4); u.dil = 1 << dl; const int nbp = 32 >> dl; u.r = idx >> (5 - dl); u.bp = idx & (nbp - 1); return u;
}
__device__ __forceinline__ void attn_load_kv(const AttnU& u, int tid, const unsigned char* __restrict__ K8, const unsigned char* __restrict__ V8, v2u (&kr)[6], v2u (&vr)[6]) {
    const int rsub = tid >> 3, ch = tid & 7;
#pragma unroll
    for (int i = 0; i < 6; ++i) { const int ki = i * 64 + rsub; const int sidx = u.bp * 256 - 128 + ki; const bool ok = sidx >= 0;
        const long pos = ok ? ((long)sidx * u.dil + u.r) : 0; const size_t off = ((size_t)(u.b * 16 + u.h) * 8192 + pos) * 64 + ch * 8;
        kr[i] = *(const GAS v2u*)(K8 + off); vr[i] = *(const GAS v2u*)(V8 + off);
        if (!ok) { kr[i] = (v2u){0u, 0u}; vr[i] = (v2u){0u, 0u}; } }
}
__device__ __forceinline__ void attn_load_q(const AttnU& u, int w, int c32, int hi, const bf16* Qg, bf16x8 (&qf)[4]) {
    const long qt = (long)(u.bp * 256 + 32 * w + c32) * u.dil + u.r;
    const bf16* qp = Qg + ((size_t)((u.p * 8 + u.b) * 16 + u.h) * 8192 + qt) * 64;
#pragma unroll
    for (int d0 = 0; d0 < 4; ++d0) qf[d0] = *(const GAS bf16x8*)(qp + d0 * 16 + hi * 8);
}
__device__ __forceinline__ v4u fp8x8_to_bf16(v2u x) {
    const auto f0 = __builtin_amdgcn_cvt_pk_f32_fp8((int)x.x, false), f1 = __builtin_amdgcn_cvt_pk_f32_fp8((int)x.x, true), f2 = __builtin_amdgcn_cvt_pk_f32_fp8((int)x.y, false), f3 = __builtin_amdgcn_cvt_pk_f32_fp8((int)x.y, true);
    v4u r; r.x = pg8::cvt_pk_bf16(f0[0], f0[1]); r.y = pg8::cvt_pk_bf16(f1[0], f1[1]); r.z = pg8::cvt_pk_bf16(f2[0], f2[1]); r.w = pg8::cvt_pk_bf16(f3[0], f3[1]); return r;
}
__device__ __forceinline__ void attn_body(Frame& F, const AttnU& u, bool has_nn, const AttnU& nn, bool has_nq, const AttnU& nq, v2u (&kr)[6], v2u (&vr)[6], bf16x8 (&qf)[4],
                                          const unsigned char* __restrict__ K8, const unsigned char* __restrict__ V8, bf16* Qg, float* MDd) {
    const int tid = F.tid, lane = F.lane, w = F.wave, c32 = lane & 31, hi = lane >> 5;
    LAS unsigned char* lds = F.lds;
    const int rsub = tid >> 3, ch = tid & 7;
    const int lam = lane & 15;
    const unsigned vbase = (unsigned)(uintptr_t)(lds + ATT_V_OFF) + (unsigned)((4 * hi + (lam >> 2)) * 64 + (16 * ((lane >> 4) & 1) + 4 * (lam & 3)) * 2);
    const int cz = c32 - 4 * hi;
#pragma unroll
    for (int i = 0; i < 6; ++i) { const int ki = i * 64 + rsub;
        *(LAS v4u*)(lds + ATT_K_OFF + ki * 128 + ((ch ^ ((ki >> 1) & 7)) * 16)) = fp8x8_to_bf16(kr[i]);
        *(LAS v4u*)(lds + ATT_V_OFF + (ch >> 2) * (ATT_NK * 64) + ki * 64 + (ch & 3) * 16) = fp8x8_to_bf16(vr[i]); }
    __syncthreads();
    if (has_nn) attn_load_kv(nn, tid, K8, V8, kr, vr);
    const int sidx = u.p * 16 + u.h; const float sexp = sidx < 32 ? 0.125f * (float)(sidx + 1) : 4.0f + 0.25f * (float)(sidx - 31);
    const float slope2 = exp2f(-sexp) * LOG2E * (float)u.dil;
    const float a0 = -slope2 * (float)(128 + cz) - 16.0f;
    f32x16 st[5]; f32x16 a0v;
#pragma unroll
    for (int rr = 0; rr < 16; ++rr) a0v[rr] = a0;
#pragma unroll
    for (int kt = 0; kt < 5; ++kt) {
        const int key = 32 * (w + kt) + c32; const LAS unsigned char* kb = lds + ATT_K_OFF + key * 128; const int sw = (key >> 1) & 7;
        f32x16 a;
#pragma unroll
        for (int d0 = 0; d0 < 4; ++d0) { const bf16x8 kf = *(const LAS bf16x8*)(kb + (((2 * d0 + hi) ^ sw) * 16)); a = __builtin_amdgcn_mfma_f32_32x32x16_bf16(kf, qf[d0], d0 == 0 ? a0v : a, 0, 0, 0); }
        st[kt] = a;
    }
    if (has_nq) attn_load_q(nq, w, c32, hi, Qg, qf);
    float l = 0.f;
#pragma unroll
    for (int kt = 0; kt < 5; ++kt) {
        float lt = 0.f;
#pragma unroll
        for (int rr = 0; rr < 16; ++rr) { const int rc = (rr & 3) + 8 * (rr >> 2);
            float e = __builtin_amdgcn_exp2f(fmaf(slope2, (float)(32 * kt + rc), st[kt][rr]));
            if (kt == 0) e = (rc >= cz) ? e : 0.f;
            if (kt == 4) e = (rc <= cz) ? e : 0.f;
            st[kt][rr] = e; lt += e; }
        l += ((u.bp == 0) && (w + kt < 4)) ? 0.f : lt;
    }
    l = xhalf_sum(l);
    f32x16 o[2]; o[0] = f32x16{}; o[1] = f32x16{};
#pragma unroll
    for (int kt = 0; kt < 5; ++kt)
#pragma unroll
        for (int s2 = 0; s2 < 2; ++s2) {
            v4u pw; pw.x = pg8::cvt_pk_bf16(st[kt][8 * s2 + 0], st[kt][8 * s2 + 1]); pw.y = pg8::cvt_pk_bf16(st[kt][8 * s2 + 2], st[kt][8 * s2 + 3]);
            pw.z = pg8::cvt_pk_bf16(st[kt][8 * s2 + 4], st[kt][8 * s2 + 5]); pw.w = pg8::cvt_pk_bf16(st[kt][8 * s2 + 6], st[kt][8 * s2 + 7]);
            const bf16x8 pf = __builtin_bit_cast(bf16x8, pw);
#pragma unroll
            for (int dt = 0; dt < 2; ++dt) {
                const unsigned a = vbase + (unsigned)(dt * (ATT_NK * 64) + (32 * (w + kt) + 16 * s2) * 64);
                const s16x4 lo = vtr(a), hi4 = vtr(a + 8 * 64);
                const bf16x8 vf = (bf16x8){lo[0], lo[1], lo[2], lo[3], hi4[0], hi4[1], hi4[2], hi4[3]};
                o[dt] = __builtin_amdgcn_mfma_f32_32x32x16_bf16(vf, pf, o[dt], 0, 0, 0);
            }
        }
    const float inv = 1.0f / l;
    const long qt = (long)(u.bp * 256 + 32 * w + c32) * u.dil + u.r; const long qrow = (long)u.b * SEQ + qt;
    bf16* qp = Qg + ((size_t)((u.p * 8 + u.b) * 16 + u.h) * 8192 + qt) * 64;
#pragma unroll
    for (int dt = 0; dt < 2; ++dt)
#pragma unroll
        for (int g = 0; g < 4; ++g) { v2u ow; ow.x = pg8::cvt_pk_bf16(o[dt][4 * g] * inv, o[dt][4 * g + 1] * inv); ow.y = pg8::cvt_pk_bf16(o[dt][4 * g + 2] * inv, o[dt][4 * g + 3] * inv);
            *(GAS v2u*)(qp + 32 * dt + 8 * g + 4 * hi) = ow; }
    if (hi == 0) { const size_t mi = ((size_t)u.p * T + (size_t)qrow) * 16 + u.h; __hip_atomic_store(MDd + mi, l, __ATOMIC_RELAXED, __HIP_MEMORY_SCOPE_AGENT); }
    __syncthreads();
}
__device__ __forceinline__ void attn_phase(Frame& F, int u0, int u1, bool xl, const bf16* Kg, const bf16* Vg, bf16* Qg, float* MDm, float* MDd) {
    if (u0 >= u1) return;
    const int xrank = (int)blockIdx.x >> 3, xbh0 = ((int)blockIdx.x & 7) * 16;
#define ATT_UMAP(i_) (xl ? ((((i_) % 3) * 128 + xbh0 + (i_) / 3) * 32 + xrank) : (i_))
    const int tid = F.tid, lane = F.lane, w = F.wave, c32 = lane & 31, hi = lane >> 5;
    const unsigned char* K8 = (const unsigned char*)Kg; const unsigned char* V8 = (const unsigned char*)Vg;
    v2u krA[6], vrA[6], krB[6], vrB[6]; bf16x8 qf[4];
    AttnU uA = attn_decode(ATT_UMAP(u0)), uB = uA;
    attn_load_kv(uA, tid, K8, V8, krA, vrA); attn_load_q(uA, w, c32, hi, Qg, qf);
    if (u0 + 1 < u1) { uB = attn_decode(ATT_UMAP(u0 + 1)); attn_load_kv(uB, tid, K8, V8, krB, vrB); }
#pragma unroll 1
    for (int uu = u0; uu < u1; uu += 2) {
        { const AttnU cur = uA; const bool nx = uu + 2 < u1; if (nx) uA = attn_decode(ATT_UMAP(uu + 2));
          attn_body(F, cur, nx, uA, uu + 1 < u1, uB, krA, vrA, qf, K8, V8, Qg, MDd); }
        if (uu + 1 < u1) { const AttnU cur = uB; const bool nx = uu + 3 < u1; if (nx) uB = attn_decode(ATT_UMAP(uu + 3));
          attn_body(F, cur, nx, uB, uu + 2 < u1, uA, krB, vrB, qf, K8, V8, Qg, MDd); }
    }
#undef ATT_UMAP
}

constexpr int PB_AIN_PITCH = 272, PB_POOL_OFF = 40960, PB_POOL_PITCH = 528;
__device__ __forceinline__ void pool_merge_unit(Frame& F, int unit, const bf16* AIN, const bf16* Wpt, const bf16* OP, const bf16* Gt, const float* MDm, const float* MDd, bf16* MERGED) {
    const int tid = F.tid, lane = F.lane, w = F.wave, c32 = lane & 31, hi = lane >> 5;
    const int g = unit & 3, tile = unit >> 2, t0 = tile * 128, tin = t0 & (SEQ - 1), win = 2 << g;
    LAS unsigned char* lds = F.lds;
    for (int id = tid; id < 143 * 16; id += NWAVES * 64) { const int rr = id >> 4, ch = id & 15; v4u v = (v4u){0u, 0u, 0u, 0u};
        if (tin - 15 + rr >= 0) v = *(const GAS v4u*)(AIN + (size_t)(t0 - 15 + rr) * POOLW + g * 128 + ch * 8);
        *(LAS v4u*)(lds + rr * PB_AIN_PITCH + ch * 16) = v; }
    __syncthreads();
    {
        const int tq = w & 3, oh = w >> 2, tokl = 32 * tq + c32;
        const int cnt = (tin + tokl + 1) < win ? (tin + tokl + 1) : win; const float rc = 1.0f / (float)cnt;
        f32x16 acc[4]; acc[0] = f32x16{}; acc[1] = f32x16{}; acc[2] = f32x16{}; acc[3] = f32x16{};
        const bf16* wp = Wpt + (size_t)(g * 256 + oh * 128 + c32) * 128 + 8 * hi;
#pragma unroll 1
        for (int ks = 0; ks < 8; ++ks) {
            const LAS unsigned char* ap = lds + (15 + tokl) * PB_AIN_PITCH + (16 * ks + 8 * hi) * 2;
            const v4u own = *(const LAS v4u*)ap;
            float s[8] = {0.f, 0.f, 0.f, 0.f, 0.f, 0.f, 0.f, 0.f};
            for (int i = 0; i < win; ++i) { const v4u a = *(const LAS v4u*)(ap - i * PB_AIN_PITCH);
                s[0] += bflo(a.x); s[1] += bfhi(a.x); s[2] += bflo(a.y); s[3] += bfhi(a.y); s[4] += bflo(a.z); s[5] += bfhi(a.z); s[6] += bflo(a.w); s[7] += bfhi(a.w); }
            v4u dw; dw.x = pg8::cvt_pk_bf16(s[0] * rc - bflo(own.x), s[1] * rc - bfhi(own.x)); dw.y = pg8::cvt_pk_bf16(s[2] * rc - bflo(own.y), s[3] * rc - bfhi(own.y));
            dw.z = pg8::cvt_pk_bf16(s[4] * rc - bflo(own.z), s[5] * rc - bfhi(own.z)); dw.w = pg8::cvt_pk_bf16(s[6] * rc - bflo(own.w), s[7] * rc - bfhi(own.w));
            const bf16x8 df = __builtin_bit_cast(bf16x8, dw);
#pragma unroll
            for (int mt = 0; mt < 4; ++mt) { const bf16x8 wf = *(const GAS bf16x8*)(wp + (size_t)(32 * mt) * 128 + 16 * ks); acc[mt] = __builtin_amdgcn_mfma_f32_32x32x16_bf16(wf, df, acc[mt], 0, 0, 0); }
        }
#pragma unroll
        for (int mt = 0; mt < 4; ++mt)
#pragma unroll
            for (int gq = 0; gq < 4; ++gq) { v2u ow; ow.x = pg8::cvt_pk_bf16(acc[mt][4 * gq], acc[mt][4 * gq + 1]); ow.y = pg8::cvt_pk_bf16(acc[mt][4 * gq + 2], acc[mt][4 * gq + 3]);
                *(LAS v2u*)(lds + PB_POOL_OFF + tokl * PB_POOL_PITCH + (oh * 128 + 32 * mt + 8 * gq + 4 * hi) * 2) = ow; }
    }
    __syncthreads();
#pragma unroll 1
    for (int pass = 0; pass < 8; ++pass) {
        const int id = pass * 512 + tid, tok = id >> 5, cc = id & 31, col = g * 256 + 8 * cc, head = col >> 6; const size_t row = (size_t)t0 + tok;
        float wgt[3]; float ws_ = 0.f;
#pragma unroll
        for (int p = 0; p < 3; ++p) { wgt[p] = __hip_atomic_load(MDd + ((size_t)p * T + row) * 16 + head, __ATOMIC_RELAXED, __HIP_MEMORY_SCOPE_AGENT); ws_ += wgt[p]; }
        const float iw = 1.0f / ws_;
        const size_t ob = ((size_t)((row >> 13) * 16 + head) * 8192 + (row & 8191)) * 64 + (col & 63); constexpr size_t PST = (size_t)8 * 16 * 8192 * 64;
        const v4u o0 = *(const GAS v4u*)(OP + ob), o1 = *(const GAS v4u*)(OP + PST + ob), o2 = *(const GAS v4u*)(OP + 2 * PST + ob);
        const v2u g0 = *(const GAS v2u*)((const unsigned char*)Gt + row * GATEW + col), g1 = *(const GAS v2u*)((const unsigned char*)Gt + row * GATEW + 1024 + col);
        const v4u pl = *(const LAS v4u*)(lds + PB_POOL_OFF + tok * PB_POOL_PITCH + cc * 16);
        const float w0 = wgt[0] * iw, w1 = wgt[1] * iw, w2 = wgt[2] * iw;
        v4u res;
#define SIG(x_) __builtin_amdgcn_rcpf(1.0f + __builtin_amdgcn_exp2f(-LOG2E * (x_)))
#define MRG(f, gw, HI) { const float alo = w0 * bflo(o0.f) + w1 * bflo(o1.f) + w2 * bflo(o2.f), ahi = w0 * bfhi(o0.f) + w1 * bfhi(o1.f) + w2 * bfhi(o2.f); \
                 const auto ga = __builtin_amdgcn_cvt_pk_f32_fp8((int)g0.gw, HI), gb = __builtin_amdgcn_cvt_pk_f32_fp8((int)g1.gw, HI); \
                 res.f = pg8::cvt_pk_bf16(SIG(ga[0]) * bflo(pl.f) + SIG(gb[0]) * alo, SIG(ga[1]) * bfhi(pl.f) + SIG(gb[1]) * ahi); }
        MRG(x, x, false) MRG(y, x, true) MRG(z, y, false) MRG(w, y, true)
#undef MRG
#undef SIG
        *(GAS v4u*)(MERGED + row * DM + col) = res;
    }
    __syncthreads();
}


constexpr int PC_AIN_PITCH = 1040, PC_POOL_OFF = 49152, PC_POOL_PITCH = 2064, PC_RMAX_OFF = PC_POOL_OFF + 32 * PC_POOL_PITCH;
__device__ __forceinline__ void pool_merge_unit32(Frame& F, int unit, const bf16* AIN, const bf16* Wpt, const bf16* OP, const bf16* Gt, const float* MDd, unsigned char* M8, float* MS) {
    const int tid = F.tid, lane = F.lane, w = F.wave, c32 = lane & 31, hi = lane >> 5;
    const int t0 = unit * 32, tin = t0 & (SEQ - 1);
    LAS unsigned char* lds = F.lds;
    LAS unsigned* rmax = (LAS unsigned*)(lds + PC_RMAX_OFF);
    for (int id = tid; id < 47 * 64; id += NWAVES * 64) { const int rr = id >> 6, ch = id & 63; v4u v = (v4u){0u, 0u, 0u, 0u};
        if (tin - 15 + rr >= 0) v = *(const GAS v4u*)(AIN + (size_t)(t0 - 15 + rr) * POOLW + ch * 8);
        *(LAS v4u*)(lds + rr * PC_AIN_PITCH + ch * 16) = v; }
    if (tid < 32) rmax[tid] = 0u;
    __syncthreads();
    {
        const int g = w >> 1, oh = w & 1, win = 2 << g, tokl = c32;
        const int cnt = (tin + tokl + 1) < win ? (tin + tokl + 1) : win; const float rc = 1.0f / (float)cnt;
        f32x16 acc[4]; acc[0] = f32x16{}; acc[1] = f32x16{}; acc[2] = f32x16{}; acc[3] = f32x16{};
        const bf16* wp = Wpt + (size_t)(g * 256 + oh * 128 + c32) * 128 + 8 * hi;
#pragma unroll 1
        for (int ks = 0; ks < 8; ++ks) {
            const LAS unsigned char* ap = lds + (15 + tokl) * PC_AIN_PITCH + (g * 128 + 16 * ks + 8 * hi) * 2;
            const v4u own = *(const LAS v4u*)ap;
            float s[8] = {0.f, 0.f, 0.f, 0.f, 0.f, 0.f, 0.f, 0.f};
            for (int i = 0; i < win; ++i) { const v4u a = *(const LAS v4u*)(ap - i * PC_AIN_PITCH);
                s[0] += bflo(a.x); s[1] += bfhi(a.x); s[2] += bflo(a.y); s[3] += bfhi(a.y); s[4] += bflo(a.z); s[5] += bfhi(a.z); s[6] += bflo(a.w); s[7] += bfhi(a.w); }
            v4u dw; dw.x = pg8::cvt_pk_bf16(s[0] * rc - bflo(own.x), s[1] * rc - bfhi(own.x)); dw.y = pg8::cvt_pk_bf16(s[2] * rc - bflo(own.y), s[3] * rc - bfhi(own.y));
            dw.z = pg8::cvt_pk_bf16(s[4] * rc - bflo(own.z), s[5] * rc - bfhi(own.z)); dw.w = pg8::cvt_pk_bf16(s[6] * rc - bflo(own.w), s[7] * rc - bfhi(own.w));
            const bf16x8 df = __builtin_bit_cast(bf16x8, dw);
#pragma unroll
            for (int mt = 0; mt < 4; ++mt) { const bf16x8 wf = *(const GAS bf16x8*)(wp + (size_t)(32 * mt) * 128 + 16 * ks); acc[mt] = __builtin_amdgcn_mfma_f32_32x32x16_bf16(wf, df, acc[mt], 0, 0, 0); }
        }
#pragma unroll
        for (int mt = 0; mt < 4; ++mt)
#pragma unroll
            for (int gq = 0; gq < 4; ++gq) { v2u ow; ow.x = pg8::cvt_pk_bf16(acc[mt][4 * gq], acc[mt][4 * gq + 1]); ow.y = pg8::cvt_pk_bf16(acc[mt][4 * gq + 2], acc[mt][4 * gq + 3]);
                *(LAS v2u*)(lds + PC_POOL_OFF + tokl * PC_POOL_PITCH + (g * 256 + oh * 128 + 32 * mt + 8 * gq + 4 * hi) * 2) = ow; }
    }
    __syncthreads();
    v4u res[8];
#define SIG(x_) __builtin_amdgcn_rcpf(1.0f + __builtin_amdgcn_exp2f(-LOG2E * (x_)))
#define MRG(f, gw, HI) { const float alo = w0 * bflo(L.o0.f) + w1 * bflo(L.o1.f) + w2 * bflo(L.o2.f), ahi = w0 * bfhi(L.o0.f) + w1 * bfhi(L.o1.f) + w2 * bfhi(L.o2.f); \
                 const auto ga = __builtin_amdgcn_cvt_pk_f32_fp8((int)L.g0.gw, HI), gb = __builtin_amdgcn_cvt_pk_f32_fp8((int)L.g1.gw, HI); \
                 r.f = pg8::cvt_pk_bf16(SIG(ga[0]) * bflo(pl.f) + SIG(gb[0]) * alo, SIG(ga[1]) * bfhi(pl.f) + SIG(gb[1]) * ahi); \
                 mx = fmaxf(mx, fmaxf(fabsf(bflo(r.f)), fabsf(bfhi(r.f)))); }
    struct PcIn { float wg[3]; v4u o0, o1, o2; v2u g0, g1; };
#pragma unroll
    for (int pg = 0; pg < 2; ++pg) {
        PcIn Ls[4];
#pragma unroll
        for (int q = 0; q < 4; ++q) { const int pass = 4 * pg + q; PcIn& L = Ls[q];
            const int tok = pass * 4 + (tid >> 7), cc = tid & 127, col = 8 * cc, head = col >> 6; const size_t row = (size_t)t0 + tok;
#pragma unroll
            for (int p = 0; p < 3; ++p) L.wg[p] = __hip_atomic_load(MDd + ((size_t)p * T + row) * 16 + head, __ATOMIC_RELAXED, __HIP_MEMORY_SCOPE_AGENT);
            const size_t ob = ((size_t)((row >> 13) * 16 + head) * 8192 + (row & 8191)) * 64 + (col & 63); constexpr size_t PST = (size_t)8 * 16 * 8192 * 64;
            L.o0 = *(const GAS v4u*)(OP + ob); L.o1 = *(const GAS v4u*)(OP + PST + ob); L.o2 = *(const GAS v4u*)(OP + 2 * PST + ob);
            L.g0 = *(const GAS v2u*)((const unsigned char*)Gt + row * GATEW + col); L.g1 = *(const GAS v2u*)((const unsigned char*)Gt + row * GATEW + 1024 + col); }
        __builtin_amdgcn_sched_barrier(0);
#pragma unroll
        for (int q = 0; q < 4; ++q) { const int pass = 4 * pg + q; const PcIn& L = Ls[q];
            const int tok = pass * 4 + (tid >> 7), cc = tid & 127;
            const float iw = 1.0f / (L.wg[0] + L.wg[1] + L.wg[2]); const float w0 = L.wg[0] * iw, w1 = L.wg[1] * iw, w2 = L.wg[2] * iw;
            const v4u pl = *(const LAS v4u*)(lds + PC_POOL_OFF + tok * PC_POOL_PITCH + cc * 16);
            v4u r; float mx = 0.f;
            MRG(x, x, false) MRG(y, x, true) MRG(z, y, false) MRG(w, y, true)
            res[pass] = r;
            mx = wave_max_dpp(mx);
            if (lane == 0) (void)__hip_atomic_fetch_max(rmax + tok, __float_as_uint(mx), __ATOMIC_RELAXED, __HIP_MEMORY_SCOPE_WORKGROUP); }
        __builtin_amdgcn_sched_barrier(0);
    }
#undef MRG
#undef SIG
    __syncthreads();
#pragma unroll
    for (int pass = 0; pass < 8; ++pass) {
        const int tok = pass * 4 + (tid >> 7), cc = tid & 127; const size_t row = (size_t)t0 + tok;
        const float rm = __uint_as_float(rmax[tok]); const float inv = rm > 0.f ? 127.0f / rm : 0.f;
        const v4u r = res[pass];
        const int a0 = (int)__builtin_rintf(bflo(r.x) * inv), a1 = (int)__builtin_rintf(bfhi(r.x) * inv), a2 = (int)__builtin_rintf(bflo(r.y) * inv), a3 = (int)__builtin_rintf(bfhi(r.y) * inv);
        const int a4 = (int)__builtin_rintf(bflo(r.z) * inv), a5 = (int)__builtin_rintf(bfhi(r.z) * inv), a6 = (int)__builtin_rintf(bflo(r.w) * inv), a7 = (int)__builtin_rintf(bfhi(r.w) * inv);
        v2u q; q.x = ((unsigned)a0 & 255u) | (((unsigned)a1 & 255u) << 8) | (((unsigned)a2 & 255u) << 16) | ((unsigned)a3 << 24);
        q.y = ((unsigned)a4 & 255u) | (((unsigned)a5 & 255u) << 8) | (((unsigned)a6 & 255u) << 16) | ((unsigned)a7 << 24);
        *(GAS v2u*)(M8 + row * DM + 8 * cc) = q;
    }
    if (tid < 32) MS[t0 + tid] = __uint_as_float(rmax[tid]) * (1.0f / 127.0f);
    __syncthreads();
}

#ifndef P5_LOGNB
#define P5_LOGNB 4
#endif
#define P5_NBUCKET (1 << P5_LOGNB)
#ifndef P5_NSLOT_M
#define P5_NSLOT_M 5
#endif
#define P5_STR2(x) #x
#define P5_STR(x) P5_STR2(x)
#if P5_NSLOT_M == 3
#define P5_VM1 4
#define P5_VM2 2
#define P5_O1 24
#define P5_O2A 3
#define P5_O2B 4
#elif P5_NSLOT_M == 4
#define P5_VM1 6
#define P5_VM2 4
#define P5_O1 32
#define P5_O2A 4
#define P5_O2B 5
#elif P5_NSLOT_M == 5
#define P5_VM1 8
#define P5_VM2 6
#define P5_VM4 2
#define P5_O1 40
#define P5_O2A 5
#define P5_O2B 6
#define P5_O2C 7
#define P5_O2D 8
#endif
constexpr int P5_LIST_WAVE = 1032  , P5_LIST_OFF = 0, P5_RING_OFF = 66048, P5_RING_WAVE = 10240, P5_NSLOT = P5_NSLOT_M, P5_TL_OFF = 147968, P5_S2_OFF = 156160, P5_SH_OFF = 156416, P5_CNT_OFF = 147968  ;
constexpr int P5_DUMMY_OFF = 158720;
constexpr float P5_GSCALE = 256.0f;
__device__ __forceinline__ float gelu_tanh(float x) {
    const float z = 0.7978845608028654f * (x + 0.044715f * x * x * x);
    const float e = __builtin_amdgcn_exp2f(2.0f * LOG2E * z);
    const float th = 1.0f - 2.0f * __builtin_amdgcn_rcpf(1.0f + e);
    return 0.5f * x * (1.0f + th);
}
#define P5_CE(a, b) { const float hi__ = fmaxf(a, b), lo__ = fminf(a, b); a = hi__; b = lo__; }
__device__ __forceinline__ void sort16_desc(float (&v)[16]) {
#pragma unroll
    for (int k = 2; k <= 16; k <<= 1)
#pragma unroll
        for (int j = k >> 1; j > 0; j >>= 1)
#pragma unroll
            for (int i = 0; i < 16; ++i) { const int l = i ^ j; if (l > i) { if ((i & k) == 0) P5_CE(v[i], v[l]) else P5_CE(v[l], v[i]) } }
}
__device__ __forceinline__ void merge_top16(float (&a)[16], const float (&b)[16]) {
#pragma unroll
    for (int i = 0; i < 16; ++i) a[i] = fmaxf(a[i], b[15 - i]);
#pragma unroll
    for (int j = 8; j > 0; j >>= 1)
#pragma unroll
        for (int i = 0; i < 16; ++i) { const int l = i ^ j; if (l > i) P5_CE(a[i], a[l]) }
}
__device__ __forceinline__ void pair_merge_top16(float (&a)[16]) {
    float lo[16], hi[16];
#pragma unroll
    for (int i = 0; i < 16; ++i) { auto t = __builtin_amdgcn_permlane32_swap(__float_as_uint(a[i]), __float_as_uint(a[i]), false, false); lo[i] = __uint_as_float(t[0]); hi[i] = __uint_as_float(t[1]); }
    merge_top16(lo, hi);
#pragma unroll
    for (int i = 0; i < 16; ++i) a[i] = lo[i];
}
__device__ __forceinline__ void peer_stage_a(Frame& F, int t0, int hh, const bf16* QP, const bf16* SKB, const float* SU, const float* SV) {
    int lane = F.lane; asm volatile("" : "+v"(lane));
    const int w = F.wave, c32 = lane & 31, hi = lane >> 5;
    LAS unsigned char* lds = F.lds;
    const LAS float* s2l = (const LAS float*)(lds + P5_S2_OFF);
    float tops[2][16];
#pragma unroll
    for (int p = 0; p < 2; ++p) {
        f32x16 acc[4]; acc[0] = f32x16{}; acc[1] = f32x16{}; acc[2] = f32x16{}; acc[3] = f32x16{};
        const bf16* qrow = QP + (size_t)(t0 + 32 * hh + c32) * 2048 + (w * 2 + p) * 128 + 8 * hi;
        const bf16* skp = SKB + ((size_t)(w * 2 + p) * 32 * 64 + lane) * 8;
#pragma unroll 1
        for (int kg = 0; kg < 2; ++kg) {
            bf16x8 bq[4], af[4][4];
#pragma unroll
            for (int k = 0; k < 4; ++k) { bq[k] = *(const GAS bf16x8*)(qrow + 16 * (4 * kg + k));
#pragma unroll
                for (int mt = 0; mt < 4; ++mt) af[k][mt] = *(const GAS bf16x8*)(skp + (size_t)((4 * kg + k) * 4 + mt) * 512); }
            __builtin_amdgcn_sched_barrier(0);
#pragma unroll
            for (int k = 0; k < 4; ++k)
#pragma unroll
                for (int mt = 0; mt < 4; ++mt) acc[mt] = __builtin_amdgcn_mfma_f32_32x32x16_bf16(af[k][mt], bq[k], acc[mt], 0, 0, 0);
            __builtin_amdgcn_sched_barrier(0);
        }
#pragma unroll
        for (int mt = 0; mt < 4; ++mt)
#pragma unroll
            for (int rr = 0; rr < 16; ++rr) acc[mt][rr] = __uint_as_float((__float_as_uint(acc[mt][rr]) & ~127u) | (unsigned)(32 * mt + crow(rr, hi)));
        {   float g0[16], g1[16], g2[16], g3[16];
#pragma unroll
            for (int rr = 0; rr < 16; ++rr) { g0[rr] = acc[0][rr]; g1[rr] = acc[1][rr]; g2[rr] = acc[2][rr]; g3[rr] = acc[3][rr]; }
            sort16_desc(g0); sort16_desc(g1); sort16_desc(g2); sort16_desc(g3);
            merge_top16(g0, g1); merge_top16(g2, g3); merge_top16(g0, g2);
            pair_merge_top16(g0);
#pragma unroll
            for (int k = 0; k < 16; ++k) tops[p][k] = g0[k];
        }
    }
    {
        v4u tb; unsigned b_[16];
#pragma unroll
        for (int k = 0; k < 16; ++k) b_[k] = __float_as_uint(hi ? tops[1][k] : tops[0][k]) & 127u;
        tb.x = b_[0] | (b_[1] << 8) | (b_[2] << 16) | (b_[3] << 24); tb.y = b_[4] | (b_[5] << 8) | (b_[6] << 16) | (b_[7] << 24);
        tb.z = b_[8] | (b_[9] << 8) | (b_[10] << 16) | (b_[11] << 24); tb.w = b_[12] | (b_[13] << 8) | (b_[14] << 16) | (b_[15] << 24);
        *(LAS v4u*)(lds + P5_TL_OFF + ((c32 * 8 + w) * 2 + hi) * 16) = tb;
    }
    float best[16];
    {   float ca[16], cb[16];
#pragma unroll
        for (int i = 0; i < 16; ++i) { ca[i] = -3.0e38f; cb[i] = -3.0e38f; }
        int c = 0;
#pragma unroll
        for (int i = 0; i < 16; ++i)
#pragma unroll
            for (int j = 0; j < 16; ++j)
                if ((i + 1) * (j + 1) <= 16) {
                    const float val = tops[0][i] + tops[1][j];
                    const float pk = __uint_as_float((__float_as_uint(val) & ~255u) | (unsigned)(i * 16 + j));
                    const int sl = c >> 1;
                    if (sl < 16) { if ((c & 1) == 0) ca[sl] = pk; else ca[sl] = hi ? pk : ca[sl]; }
                    else         { if ((c & 1) == 0) cb[sl - 16] = pk; else cb[sl - 16] = hi ? pk : cb[sl - 16]; }
                    ++c;
                }
        sort16_desc(ca); sort16_desc(cb); merge_top16(ca, cb); pair_merge_top16(ca);
#pragma unroll
        for (int k = 0; k < 16; ++k) best[k] = ca[k];
    }
    const int tokc = 32 * hh + c32;
    const float s2v = s2l[tokc] * LOG2E;
    float ge[16]; float gs = 0.f;
#pragma unroll
    for (int k = 0; k < 16; ++k) { ge[k] = __builtin_amdgcn_exp2f((best[k] - best[0]) * s2v); gs += ge[k]; }
    const float gi = 1.0f / gs;
    asm volatile("s_waitcnt lgkmcnt(0)" ::: "memory");
    const LAS unsigned char* tl0 = lds + P5_TL_OFF + ((c32 * 8 + w) * 2) * 16;
    LAS v2u* lst = (LAS v2u*)(lds + P5_LIST_OFF) + (tokc >> 3) * P5_LIST_WAVE + (tokc & 7) * 128 + w * 16 + 8 * hi;
    unsigned ex[8]; float svx[8], sux[8];
#pragma unroll
    for (int k = 0; k < 8; ++k) { const float bsel = hi ? best[k + 8] : best[k]; const unsigned code = __float_as_uint(bsel) & 255u; ex[k] = (unsigned)tl0[code >> 4] * 128u + (unsigned)tl0[16 + (code & 15u)]; }
    __builtin_amdgcn_sched_barrier(0);
#pragma unroll
    for (int k = 0; k < 8; ++k) { svx[k] = SV[ex[k]]; sux[k] = SU[ex[k]]; }
    __builtin_amdgcn_sched_barrier(0);
#pragma unroll
    for (int k = 0; k < 8; ++k) {
        const float gsel = (hi ? ge[k + 8] : ge[k]) * gi;
        const unsigned g16 = (unsigned)__builtin_bit_cast(unsigned short, (_Float16)(gsel * svx[k] * P5_GSCALE)) & 0x7fffu;
        v2u ent; ent.x = (ex[k] << 18) | ((unsigned)(tokc & 7) << 15) | g16; ent.y = __float_as_uint(sux[k]);
        lst[k] = ent;
    }
}
#define P5_BODY(S) { int d_ = 0; \
        d_ = __builtin_amdgcn_sdot4((int)uq.x, (int)hq[S].x, d_, false); d_ = __builtin_amdgcn_sdot4((int)uq.y, (int)hq[S].y, d_, false); \
        d_ = __builtin_amdgcn_sdot4((int)uq.z, (int)hq[S].z, d_, false); d_ = __builtin_amdgcn_sdot4((int)uq.w, (int)hq[S].w, d_, false); \
        d_ += dppi<0xB1>(d_); d_ += dppi<0x4E>(d_); d_ += dppi<0x141>(d_); d_ += dppi<0x140>(d_);              \
        d_ += __builtin_amdgcn_update_dpp(0, d_, 0x142, 0xA, 0xF, false); d_ += __builtin_amdgcn_update_dpp(0, d_, 0x143, 0xC, 0xF, false);     \
        const float x_ = (float)__builtin_amdgcn_readlane(d_, 63) * (su * kx[S]); \
        const float t_ = x_ * fmaf(x_ * x_, -0.10294324f, -2.30220819f);                                        \
        const float cf = gate * x_ * __builtin_amdgcn_rcpf(1.0f + __builtin_amdgcn_exp2f(t_)); \
        const _Float16 ch_ = (_Float16)cf; const h2v cp_ = (h2v){ch_, ch_}; \
        _Pragma("unroll") for (int j_ = 0; j_ < 4; ++j_) { \
        acc[S][2 * j_ + 0] = __builtin_elementwise_fma(cp_, f8h<false>(vq[j_]), acc[S][2 * j_ + 0]); \
        acc[S][2 * j_ + 1] = __builtin_elementwise_fma(cp_, f8h<true>(vq[j_]), acc[S][2 * j_ + 1]); } }
typedef _Float16 h2v __attribute__((ext_vector_type(2)));
template <bool HI> __device__ __forceinline__ h2v f8h(unsigned w) { return __builtin_bit_cast(h2v, __builtin_amdgcn_cvt_scalef32_pk_f16_fp8((int)w, 1.0f, HI)); }
typedef float f32x2v __attribute__((ext_vector_type(2)));
__device__ __forceinline__ void peer_unit(Frame& F, int unit, const bf16* QP, const bf16* SKB, const unsigned char* UQ, const unsigned char* VQ, const float* SU, const float* SV, const bf16* HB, float* out) {
    int lane = F.lane; asm volatile("" : "+v"(lane));
    const int w = F.wave;
    const int t0 = unit * 64;
    LAS unsigned char* lds = F.lds;
    LAS float* s2l = (LAS float*)(lds + P5_S2_OFF);
    LAS unsigned char* ringw = lds + P5_RING_OFF + w * P5_RING_WAVE; LAS float* kxl = (LAS float*)(lds + P5_SH_OFF);
#pragma unroll
    for (int hf = 0; hf < 2; ++hf) {
        f32x4 v[4][4];
#pragma unroll
        for (int q = 0; q < 4; ++q) { const GAS v2u* xr = (const GAS v2u*)(HB + (size_t)(t0 + 8 * w + 4 * hf + q) * DM) + lane;
#pragma unroll
            for (int j = 0; j < 4; ++j) { const v2u hw = xr[64 * j]; v[q][j] = (f32x4){bflo(hw.x), bfhi(hw.x), bflo(hw.y), bfhi(hw.y)}; } }
#pragma unroll
        for (int q = 0; q < 4; ++q) { float s = 0.f, mx = 0.f;
#pragma unroll
            for (int j = 0; j < 4; ++j) { const f32x4 x = v[q][j]; s += (x.x * x.x + x.y * x.y) + (x.z * x.z + x.w * x.w); mx = fmaxf(mx, fmaxf(fmaxf(fabsf(x.x), fabsf(x.y)), fmaxf(fabsf(x.z), fabsf(x.w)))); }
            s = wave_sum_dpp(s); mx = wave_max_dpp(mx);
            const float s2 = 1.0f / sqrtf(s * (1.0f / 1024.0f) + EPS), sh = mx > 0.f ? mx * (1.0f / 127.0f) : 1.0f;
            *(LAS v4u*)(ringw + (4 * hf + q) * 1024 + 16 * lane) = quant16(v[q], 1.0f / sh, 0);
            if (lane == 0) { s2l[8 * w + 4 * hf + q] = s2; kxl[8 * w + 4 * hf + q] = sh * s2; } }
    }
    __syncthreads();
#pragma unroll 1
    for (int hh = 0; hh < 2; ++hh) { peer_stage_a(F, t0, hh, QP, SKB, SU, SV); __syncthreads(); }
    lane = F.lane; asm volatile("" : "+v"(lane));
    LAS v2u* lw = (LAS v2u*)(lds + P5_LIST_OFF) + w * P5_LIST_WAVE;
    constexpr int NBK = P5_NBUCKET, WPL = NBK / 16;
    LAS unsigned* cnt = (LAS unsigned*)(lds + P5_CNT_OFF) + w * (NBK * 4);
#define P5_BIN(x) ((((x) >> (32 - P5_LOGNB)) << 3) | (((x) >> 15) & 7u))
    {
        v2u e16[16];
#pragma unroll
        for (int i = 0; i < 16; ++i) e16[i] = lw[64 * i + lane];
#pragma unroll
        for (int k = 0; k < WPL; ++k) cnt[WPL * lane + k] = 0u;
        asm volatile("s_waitcnt lgkmcnt(0)" ::: "memory");
        unsigned rk[16];
#pragma unroll
        for (int i = 0; i < 16; ++i) { const unsigned bin = P5_BIN(e16[i].x); const unsigned sh = (bin & 1u) * 16u;
            const unsigned old = __hip_atomic_fetch_add(cnt + (bin >> 1), 1u << sh, __ATOMIC_RELAXED, __HIP_MEMORY_SCOPE_WORKGROUP); rk[i] = (old >> sh) & 0xffffu; }
        asm volatile("s_waitcnt lgkmcnt(0)" ::: "memory");
        unsigned cb[2 * WPL]; unsigned tot = 0;
#pragma unroll
        for (int k = 0; k < WPL; ++k) { const unsigned cwd = cnt[WPL * lane + k]; cb[2 * k] = cwd & 0xffffu; cb[2 * k + 1] = cwd >> 16; tot += cb[2 * k] + cb[2 * k + 1]; }
        unsigned incl = tot;
#pragma unroll
        for (int o = 1; o < 64; o <<= 1) { const unsigned t = (unsigned)__shfl_up((int)incl, o); if (lane >= o) incl += t; }
        unsigned run = incl - tot; unsigned stt[2 * WPL];
#pragma unroll
        for (int k = 0; k < 2 * WPL; ++k) { stt[k] = run; run += cb[k]; }
        asm volatile("s_waitcnt lgkmcnt(0)" ::: "memory");
#pragma unroll
        for (int k = 0; k < WPL; ++k) cnt[WPL * lane + k] = stt[2 * k] | (stt[2 * k + 1] << 16);
        asm volatile("s_waitcnt lgkmcnt(0)" ::: "memory");
#pragma unroll
        for (int i = 0; i < 16; ++i) { const unsigned bin = P5_BIN(e16[i].x);
            const unsigned base = (cnt[bin >> 1] >> ((bin & 1u) * 16u)) & 0xffffu; lw[base + rk[i]] = e16[i]; }
        asm volatile("s_waitcnt lgkmcnt(0)" ::: "memory");
        if (lane < 8) lw[1024 + lane] = lw[lane];
        asm volatile("s_waitcnt lgkmcnt(0)" ::: "memory");
    }
#undef P5_BIN
    lane = F.lane; asm volatile("" : "+v"(lane));
    v4u hq[8]; float kx[8];
#pragma unroll
    for (int s = 0; s < 8; ++s) { hq[s] = *(const LAS v4u*)(lds + P5_RING_OFF + w * P5_RING_WAVE + s * 1024 + 16 * lane); kx[s] = ((const LAS float*)(lds + P5_SH_OFF))[8 * w + s]; }
    asm volatile("s_waitcnt lgkmcnt(0)" : "+v"(hq[0]), "+v"(hq[1]), "+v"(hq[2]), "+v"(hq[3]), "+v"(hq[4]), "+v"(hq[5]), "+v"(hq[6]), "+v"(hq[7]) :: "memory");
    h2v acc[8][8];
#pragma unroll
    for (int s = 0; s < 8; ++s)
#pragma unroll
        for (int j = 0; j < 8; ++j) acc[s][j] = (h2v){(_Float16)0.f, (_Float16)0.f};
    asm volatile("s_waitcnt vmcnt(0)" ::: "memory");
    LAS unsigned char* ring = lds + P5_RING_OFF + w * P5_RING_WAVE;
    const unsigned char* uvgl = UQ + 16 * lane;
#define P5_ISSUE(idx, slot_) { const v2u en_ = lw[(idx) & 1023]; const unsigned e_ = (unsigned)__builtin_amdgcn_readfirstlane((int)en_.x) >> 18; \
        const unsigned* gp_ = (const unsigned*)(uvgl + (size_t)e_ * 2048); \
        __builtin_amdgcn_global_load_lds(gp_, (LAS unsigned*)(ring + (slot_) * 2048), 16, 0, 0); \
        __builtin_amdgcn_global_load_lds(gp_, (LAS unsigned*)(ring + (slot_) * 2048), 16, 1024, 0); }
#pragma unroll
    for (int i = 0; i < P5_NSLOT; ++i) P5_ISSUE(i, i)
    int slot = 0, i = 0;
    const unsigned xw = (unsigned)(((blockIdx.x >> 3) & 31) * 8 + w);
    const bool hih = lane >= 32; const unsigned lane16 = 16u * (unsigned)lane; const unsigned ringa = (unsigned)(uintptr_t)ring;
    const unsigned lwa = (unsigned)(uintptr_t)lw;
    const unsigned lwah = lwa + (hih ? 8u : 0u);
    const unsigned lwaq = lwa + 8u * ((unsigned)lane >> 4);
#define P5_DMA(e_, slot_) { const unsigned char* rb_ = UQ + (size_t)(e_) * 2048; const unsigned la_ = ringa + (unsigned)(slot_) * 2048u; unsigned keep_; \
        asm volatile("s_mov_b32 %0, m0\n\ts_mov_b32 m0, %3\n\ts_nop 0\n\tglobal_load_lds_dwordx4 %1, %2\n\tglobal_load_lds_dwordx4 %1, %2 offset:1024\n\ts_mov_b32 m0, %0" \
                     : "=&s"(keep_) : "v"(lane16), "s"(rb_), "s"(la_) : "memory"); }
#define P5_PAIR(S) { v2u ent; unsigned nx_;     \
        asm volatile("ds_read_b64 %0, %2\n\tds_read_b32 %1, %2 offset:" P5_STR(P5_O1) : "=&v"(ent), "=&v"(nx_) : "v"(lwa + 8u * (unsigned)i) : "memory"); \
        asm volatile("s_waitcnt vmcnt(" P5_STR(P5_VM1) ")" ::: "memory"); \
        const v4u uq = *(const LAS v4u*)(ring + slot * 2048 + 16 * lane), vq = *(const LAS v4u*)(ring + slot * 2048 + 1024 + 16 * lane); \
        asm volatile("s_waitcnt lgkmcnt(0)" : "+v"(ent), "+v"(nx_) :: "memory");         \
        const unsigned key = (unsigned)__builtin_amdgcn_readfirstlane((int)ent.x); const float su = __uint_as_float((unsigned)__builtin_amdgcn_readfirstlane((int)ent.y)); \
        P5_DMA((unsigned)__builtin_amdgcn_readfirstlane((int)nx_) >> 18, slot) \
        slot = (slot == P5_NSLOT - 1) ? 0 : slot + 1; \
        const float gate = (float)__builtin_bit_cast(_Float16, (unsigned short)(key & 0x7fffu)); \
        P5_BODY(S) }
#define P5_PAIR2(S) { v2u entl_; v4u nab_;                  \
        asm volatile("ds_read_b64 %0, %2\n\tds_read2_b64 %1, %3 offset0:" P5_STR(P5_O2A) " offset1:" P5_STR(P5_O2B) : "=&v"(entl_), "=&v"(nab_) : "v"(lwah + 8u * (unsigned)i), "v"(lwa + 8u * (unsigned)i) : "memory"); \
        asm volatile("s_waitcnt vmcnt(" P5_STR(P5_VM2) ")" ::: "memory"); \
        const int slotB = (slot == P5_NSLOT - 1) ? 0 : slot + 1; \
        const v4u uqA = *(const LAS v4u*)(ring + slot * 2048 + 16 * lane), vqA = *(const LAS v4u*)(ring + slot * 2048 + 1024 + 16 * lane); \
        const v4u uqB = *(const LAS v4u*)(ring + slotB * 2048 + 16 * lane), vqB = *(const LAS v4u*)(ring + slotB * 2048 + 1024 + 16 * lane); \
        asm volatile("s_waitcnt lgkmcnt(0)" : "+v"(entl_), "+v"(nab_) :: "memory"); \
        P5_DMA((unsigned)__builtin_amdgcn_readfirstlane((int)nab_.x) >> 18, slot) P5_DMA((unsigned)__builtin_amdgcn_readfirstlane((int)nab_.z) >> 18, slotB) \
        slot = (slotB == P5_NSLOT - 1) ? 0 : slotB + 1; \
        int dA_ = 0, dB_ = 0; \
        dA_ = __builtin_amdgcn_sdot4((int)uqA.x, (int)hq[S].x, dA_, false); dB_ = __builtin_amdgcn_sdot4((int)uqB.x, (int)hq[S].x, dB_, false); \
        dA_ = __builtin_amdgcn_sdot4((int)uqA.y, (int)hq[S].y, dA_, false); dB_ = __builtin_amdgcn_sdot4((int)uqB.y, (int)hq[S].y, dB_, false); \
        dA_ = __builtin_amdgcn_sdot4((int)uqA.z, (int)hq[S].z, dA_, false); dB_ = __builtin_amdgcn_sdot4((int)uqB.z, (int)hq[S].z, dB_, false); \
        dA_ = __builtin_amdgcn_sdot4((int)uqA.w, (int)hq[S].w, dA_, false); dB_ = __builtin_amdgcn_sdot4((int)uqB.w, (int)hq[S].w, dB_, false); \
        auto sw_ = __builtin_amdgcn_permlane32_swap((unsigned)dA_, (unsigned)dB_, false, false); int e_ = (int)(sw_[0] + sw_[1]);        \
        e_ += dppi<0xB1>(e_); e_ += dppi<0x4E>(e_); e_ += dppi<0x141>(e_); e_ += dppi<0x140>(e_); \
        e_ += __builtin_amdgcn_update_dpp(0, e_, 0x142, 0xA, 0xF, false);                   \
        const float x_ = (float)e_ * (__uint_as_float(entl_.y) * kx[S]); \
        const float t_ = x_ * fmaf(x_ * x_, -0.10294324f, -2.30220819f); \
        const float cfv_ = (float)__builtin_bit_cast(_Float16, (unsigned short)(entl_.x & 0x7fffu)) * x_ * __builtin_amdgcn_rcpf(1.0f + __builtin_amdgcn_exp2f(t_)); \
        const _Float16 ch_ = (_Float16)cfv_; const unsigned cpk_ = __builtin_bit_cast(unsigned, (h2v){ch_, ch_}); \
        const h2v cpA = __builtin_bit_cast(h2v, (unsigned)__builtin_amdgcn_readlane((int)cpk_, 31)), cpB = __builtin_bit_cast(h2v, (unsigned)__builtin_amdgcn_readlane((int)cpk_, 63)); \
        _Pragma("unroll") for (int j_ = 0; j_ < 4; ++j_) { \
        acc[S][2 * j_ + 0] = __builtin_elementwise_fma(cpB, f8h<false>(vqB[j_]), __builtin_elementwise_fma(cpA, f8h<false>(vqA[j_]), acc[S][2 * j_ + 0])); \
        acc[S][2 * j_ + 1] = __builtin_elementwise_fma(cpB, f8h<true>(vqB[j_]), __builtin_elementwise_fma(cpA, f8h<true>(vqA[j_]), acc[S][2 * j_ + 1])); } }
#define P5_QUAD(S) { v2u entl_; v4u n01_, n23_; \
        asm volatile("ds_read_b64 %0, %3\n\tds_read2_b64 %1, %4 offset0:" P5_STR(P5_O2A) " offset1:" P5_STR(P5_O2B) "\n\tds_read2_b64 %2, %4 offset0:" P5_STR(P5_O2C) " offset1:" P5_STR(P5_O2D) \
                     : "=&v"(entl_), "=&v"(n01_), "=&v"(n23_) : "v"(lwaq + 8u * (unsigned)i), "v"(lwa + 8u * (unsigned)i) : "memory"); \
        asm volatile("s_waitcnt vmcnt(" P5_STR(P5_VM4) ")" ::: "memory"); \
        const int s1_ = (slot == P5_NSLOT - 1) ? 0 : slot + 1, s2_ = (s1_ == P5_NSLOT - 1) ? 0 : s1_ + 1, s3_ = (s2_ == P5_NSLOT - 1) ? 0 : s2_ + 1; \
        const v4u uqA = *(const LAS v4u*)(ring + slot * 2048 + 16 * lane), vqA = *(const LAS v4u*)(ring + slot * 2048 + 1024 + 16 * lane); \
        const v4u uqB = *(const LAS v4u*)(ring + s1_ * 2048 + 16 * lane), vqB = *(const LAS v4u*)(ring + s1_ * 2048 + 1024 + 16 * lane); \
        const v4u uqC = *(const LAS v4u*)(ring + s2_ * 2048 + 16 * lane), vqC = *(const LAS v4u*)(ring + s2_ * 2048 + 1024 + 16 * lane); \
        const v4u uqD = *(const LAS v4u*)(ring + s3_ * 2048 + 16 * lane), vqD = *(const LAS v4u*)(ring + s3_ * 2048 + 1024 + 16 * lane); \
        asm volatile("s_waitcnt lgkmcnt(0)" : "+v"(entl_), "+v"(n01_), "+v"(n23_) :: "memory"); \
        P5_DMA((unsigned)__builtin_amdgcn_readfirstlane((int)n01_.x) >> 18, slot) P5_DMA((unsigned)__builtin_amdgcn_readfirstlane((int)n01_.z) >> 18, s1_) \
        P5_DMA((unsigned)__builtin_amdgcn_readfirstlane((int)n23_.x) >> 18, s2_) P5_DMA((unsigned)__builtin_amdgcn_readfirstlane((int)n23_.z) >> 18, s3_) \
        slot = (s3_ == P5_NSLOT - 1) ? 0 : s3_ + 1; \
        int dA_ = 0, dB_ = 0, dC_ = 0, dD_ = 0; \
        dA_ = __builtin_amdgcn_sdot4((int)uqA.x, (int)hq[S].x, dA_, false); dB_ = __builtin_amdgcn_sdot4((int)uqB.x, (int)hq[S].x, dB_, false); dC_ = __builtin_amdgcn_sdot4((int)uqC.x, (int)hq[S].x, dC_, false); dD_ = __builtin_amdgcn_sdot4((int)uqD.x, (int)hq[S].x, dD_, false); \
        dA_ = __builtin_amdgcn_sdot4((int)uqA.y, (int)hq[S].y, dA_, false); dB_ = __builtin_amdgcn_sdot4((int)uqB.y, (int)hq[S].y, dB_, false); dC_ = __builtin_amdgcn_sdot4((int)uqC.y, (int)hq[S].y, dC_, false); dD_ = __builtin_amdgcn_sdot4((int)uqD.y, (int)hq[S].y, dD_, false); \
        dA_ = __builtin_amdgcn_sdot4((int)uqA.z, (int)hq[S].z, dA_, false); dB_ = __builtin_amdgcn_sdot4((int)uqB.z, (int)hq[S].z, dB_, false); dC_ = __builtin_amdgcn_sdot4((int)uqC.z, (int)hq[S].z, dC_, false); dD_ = __builtin_amdgcn_sdot4((int)uqD.z, (int)hq[S].z, dD_, false); \
        dA_ = __builtin_amdgcn_sdot4((int)uqA.w, (int)hq[S].w, dA_, false); dB_ = __builtin_amdgcn_sdot4((int)uqB.w, (int)hq[S].w, dB_, false); dC_ = __builtin_amdgcn_sdot4((int)uqC.w, (int)hq[S].w, dC_, false); dD_ = __builtin_amdgcn_sdot4((int)uqD.w, (int)hq[S].w, dD_, false); \
        auto w1_ = __builtin_amdgcn_permlane32_swap((unsigned)dA_, (unsigned)dC_, false, false); const unsigned e1_ = w1_[0] + w1_[1];          \
        auto w2_ = __builtin_amdgcn_permlane32_swap((unsigned)dB_, (unsigned)dD_, false, false); const unsigned e2_ = w2_[0] + w2_[1];          \
        auto w3_ = __builtin_amdgcn_permlane16_swap(e1_, e2_, false, false); int e_ = (int)(w3_[0] + w3_[1]);                                    \
        e_ += dppi<0xB1>(e_); e_ += dppi<0x4E>(e_); e_ += dppi<0x141>(e_); e_ += dppi<0x140>(e_); \
        const float x_ = (float)e_ * (__uint_as_float(entl_.y) * kx[S]); \
        const float t_ = x_ * fmaf(x_ * x_, -0.10294324f, -2.30220819f); \
        const float cfv_ = (float)__builtin_bit_cast(_Float16, (unsigned short)(entl_.x & 0x7fffu)) * x_ * __builtin_amdgcn_rcpf(1.0f + __builtin_amdgcn_exp2f(t_)); \
        const _Float16 ch_ = (_Float16)cfv_; const unsigned cpk_ = __builtin_bit_cast(unsigned, (h2v){ch_, ch_}); \
        const h2v cpA = __builtin_bit_cast(h2v, (unsigned)__builtin_amdgcn_readlane((int)cpk_, 0)), cpB = __builtin_bit_cast(h2v, (unsigned)__builtin_amdgcn_readlane((int)cpk_, 16)); \
        const h2v cpC = __builtin_bit_cast(h2v, (unsigned)__builtin_amdgcn_readlane((int)cpk_, 32)), cpD = __builtin_bit_cast(h2v, (unsigned)__builtin_amdgcn_readlane((int)cpk_, 48)); \
        _Pragma("unroll") for (int j_ = 0; j_ < 4; ++j_) { \
        acc[S][2 * j_ + 0] = __builtin_elementwise_fma(cpD, f8h<false>(vqD[j_]), __builtin_elementwise_fma(cpC, f8h<false>(vqC[j_]), __builtin_elementwise_fma(cpB, f8h<false>(vqB[j_]), __builtin_elementwise_fma(cpA, f8h<false>(vqA[j_]), acc[S][2 * j_ + 0])))); \
        acc[S][2 * j_ + 1] = __builtin_elementwise_fma(cpD, f8h<true>(vqD[j_]), __builtin_elementwise_fma(cpC, f8h<true>(vqC[j_]), __builtin_elementwise_fma(cpB, f8h<true>(vqB[j_]), __builtin_elementwise_fma(cpA, f8h<true>(vqA[j_]), acc[S][2 * j_ + 1])))); } }
#define P5_RUN(S, END) { _Pragma("unroll 1") for (; i + 3 < (END); i += 4) P5_QUAD(S) if (i + 1 < (END)) { P5_PAIR2(S) i += 2; } if (i < (END)) { P5_PAIR(S) ++i; } }
#pragma unroll 1
    for (int b = 0; b < NBK; ++b) {
        {
            constexpr int RPB = NEXP / NBK;
#pragma unroll
            for (int k = 0; k < (RPB + 255) / 256; ++k) { const unsigned pe = (unsigned)(((b + 2) & (NBK - 1)) * RPB) + ((xw + 256u * k) & (unsigned)(RPB - 1));
                const unsigned* gp = (const unsigned*)(uvgl + (size_t)pe * 2048);
                __builtin_amdgcn_global_load_lds(gp, (LAS unsigned*)(lds + P5_DUMMY_OFF), 16, 0, 0);
                __builtin_amdgcn_global_load_lds(gp, (LAS unsigned*)(lds + P5_DUMMY_OFF), 16, 1024, 0); } }
        const v4u sw = *(const LAS v4u*)(cnt + 4 * b);
        const unsigned w0 = (unsigned)__builtin_amdgcn_readfirstlane((int)sw.x), w1 = (unsigned)__builtin_amdgcn_readfirstlane((int)sw.y), w2 = (unsigned)__builtin_amdgcn_readfirstlane((int)sw.z), w3 = (unsigned)__builtin_amdgcn_readfirstlane((int)sw.w);
        const unsigned nb = (b == NBK - 1) ? 1024u : ((unsigned)__builtin_amdgcn_readfirstlane((int)cnt[4 * b + 4]) & 0xffffu);
        const int e0 = (int)(w0 >> 16), e1 = (int)(w1 & 0xffffu), e2 = (int)(w1 >> 16), e3 = (int)(w2 & 0xffffu), e4 = (int)(w2 >> 16), e5 = (int)(w3 & 0xffffu), e6 = (int)(w3 >> 16), e7 = (int)nb;
        P5_RUN(0, e0) P5_RUN(1, e1) P5_RUN(2, e2) P5_RUN(3, e3) P5_RUN(4, e4) P5_RUN(5, e5) P5_RUN(6, e6) P5_RUN(7, e7)
    }
#undef P5_RUN
#undef P5_QUAD
#undef P5_PAIR2
#undef P5_PAIR
#undef P5_DMA
    asm volatile("s_waitcnt vmcnt(0)" ::: "memory");
    lane = F.lane; asm volatile("" : "+v"(lane));
    v2u hw[8][4];
#pragma unroll
    for (int s = 0; s < 8; ++s) { const GAS v2u* hrow = (const GAS v2u*)(HB + (size_t)(t0 + 8 * w + s) * DM) + lane;
#pragma unroll
        for (int j = 0; j < 4; ++j) hw[s][j] = hrow[64 * j]; }
#pragma unroll
    for (int s = 0; s < 8; ++s) { GAS f32x4* orow = (GAS f32x4*)(out + (size_t)(t0 + 8 * w + s) * DM) + lane;
#pragma unroll
        for (int j = 0; j < 4; ++j) { f32x4 a = (f32x4){bflo(hw[s][j].x), bfhi(hw[s][j].x), bflo(hw[s][j].y), bfhi(hw[s][j].y)}; const float c = 1.0f / P5_GSCALE;
            a.x += (float)acc[s][2 * j][0] * c; a.y += (float)acc[s][2 * j][1] * c; a.z += (float)acc[s][2 * j + 1][0] * c; a.w += (float)acc[s][2 * j + 1][1] * c; orow[64 * j] = a; } }
    __syncthreads();
}
#undef P5_ISSUE
#undef P5_BODY

#ifndef GEMM_WGM1
#define GEMM_WGM1 2
#endif
#ifndef GEMM_WGM3
#define GEMM_WGM3 2
#endif
#ifndef GEMM_WGM4
#define GEMM_WGM4 2
#endif
#ifndef MK_N_LAUNCHES
#define MK_N_LAUNCHES 1
#endif
constexpr int N_LAUNCHES = MK_N_LAUNCHES;
constexpr int PER_PHASE = 7;
struct Args { const float* in[13]; float* out; unsigned char* ws; int ph_lo, ph_hi; };
__global__ void __launch_bounds__(NWAVES * 64, 2) fwd_megakernel(Args args) {
    extern __shared__ __attribute__((aligned(16))) unsigned char lds[];
    Frame F;
    F.lds = (LAS unsigned char*)lds;
    F.MISC = (volatile LAS unsigned*)(F.lds + MISC_OFF);
    F.tid = threadIdx.x; F.lane = F.tid & 63; F.wave = __builtin_amdgcn_readfirstlane(F.tid >> 6);
    F.G = gridDim.x;
    unsigned char* ws = args.ws; F.ws = ws;
    F.ctl = (gu32*)(ws + WS_CTL);
    F.x = args.in[0]; F.norm1_g = args.in[1]; F.w_in = args.in[2]; F.q_norm_g = args.in[3]; F.k_norm_g = args.in[4]; F.w_pool = args.in[5]; F.pool_scale = args.in[6];
    F.w_out = args.in[7]; F.norm2_g = args.in[8]; F.w_query = args.in[9]; F.sub_keys = args.in[10]; F.expert_u = args.in[11]; F.expert_v = args.in[12]; F.out = args.out;
    for (int u = F.tid; u < (LDS_BYTES - LDSCTL_OFF) / 4; u += NWAVES * 64) ((LAS unsigned*)(F.lds + LDSCTL_OFF))[u] = 0u;
    __syncthreads();
    XcdBarrier bar; bar.bar = (unsigned*)(F.ctl + CW_BAR); bar.x = 0; bar.st = nullptr;
    if (N_LAUNCHES == 1) bar = xcd_barrier_post((unsigned*)(F.ctl + CW_BAR), F.MISC + 8);
#define GRID_BAR() do { if (N_LAUNCHES == 1) xcd_barrier(bar); } while (0)
    const int lo = args.ph_lo, hi = args.ph_hi;
#define IN(k) (lo <= (k) && (k) < hi)
    bf16* const XB = (bf16*)(ws + WS_XB); bf16* const W1T = (bf16*)(ws + WS_W1T); bf16* const WOT = (bf16*)(ws + WS_WOT); bf16* const WQT = (bf16*)(ws + WS_WQT);
    bf16* const AIN = (bf16*)(ws + WS_AIN); bf16* const Qb = (bf16*)(ws + WS_Q); bf16* const Gb = (bf16*)(ws + WS_G);
    bf16* const Kb = (bf16*)args.out; bf16* const Vb = (bf16*)args.out + (size_t)T * DM;
    float* const MDm = (float*)(ws + WS_MD); float* const MDd = MDm + (size_t)3 * T * 16;
    bf16* const MERGED = XB; bf16* const HB = (bf16*)(ws + WS_HB); bf16* const QP = Gb;

    if (IN(0)) { p0_part_a(F); GRID_BAR(); p0_part_b(F); GRID_BAR(); }
    if (IN(1)) {
        pg8::Gemm g{XB, W1T, T, INW, DM / 2}; pg8::StaticOrder S; S.init(T, INW, F.G, (int)blockIdx.x, GEMM_WGM1);
        pg8::EpiProj E{AIN, Qb, Kb, Vb, Gb, F.q_norm_g, F.k_norm_g, (const float*)(ws + WS_S1), (const float*)(ws + WS_CS)};
        pg8::gemm_phase<pg8::EpiProj, pg8::StaticOrder, true, true, true>(F.lds + RING_OFF, g, S, E);
        GRID_BAR();
    }
    if (IN(2)) {
        constexpr int NU = 3 * BATCH * 16 * 32; const int per = (NU + F.G - 1) / F.G; const int u0 = blockIdx.x * per, u1 = (u0 + per) < NU ? (u0 + per) : NU;
        const bool xl = (F.G == 256);
        attn_phase(F, xl ? 0 : u0, xl ? 48 : u1, xl, Kb, Vb, Qb, MDm, MDd);
        GRID_BAR();
    }
    if (IN(3)) {
        constexpr int NU = T / 32; const int per = (NU + F.G - 1) / F.G; const int u0 = blockIdx.x * per, u1 = (u0 + per) < NU ? (u0 + per) : NU;
        for (int u = u0; u < u1; ++u) pool_merge_unit32(F, u, AIN, (const bf16*)(ws + WS_WPT), Qb, Gb, MDd, (unsigned char*)MERGED, (float*)(ws + WS_MS));
        GRID_BAR();
    }
    if (IN(4)) {
        pg8::Gemm g{MERGED, WOT, T, DM, DM / 2}; pg8::StaticOrder S; S.init(T, DM, F.G, (int)blockIdx.x, GEMM_WGM3);
        pg8::EpiOut E{F.x, F.out, HB, (const float*)(ws + WS_XM), (unsigned char*)args.out, (const float*)(ws + WS_MS), (const float*)(ws + WS_CS3)};
        pg8::gemm_phase<pg8::EpiOut, pg8::StaticOrder, true, true, true>(F.lds + RING_OFF, g, S, E);
        GRID_BAR();
    }
    if (IN(5)) {
        pg8::Gemm g{(const bf16*)args.out, WQT, T, 2048, DM / 2}; pg8::StaticOrder S; S.init(T, 2048, F.G, (int)blockIdx.x, GEMM_WGM4);
        pg8::EpiPlainI8 E{QP, 2048, (const float*)(ws + WS_XM), (const float*)(ws + WS_CS2)};
        pg8::gemm_phase<pg8::EpiPlainI8, pg8::StaticOrder, true, true, true>(F.lds + RING_OFF, g, S, E);
        GRID_BAR();
    }
    if (IN(6)) {
        constexpr int NU = T / 64; const int per = (NU + F.G - 1) / F.G; const int u0 = blockIdx.x * per, u1 = (u0 + per) < NU ? (u0 + per) : NU;
        for (int u = u0; u < u1; ++u) peer_unit(F, u, QP, (const bf16*)(ws + WS_SKB), ws + WS_UB, ws + WS_VB, (const float*)(ws + WS_SU), (const float*)(ws + WS_SV), HB, F.out);
    }
#undef IN
#undef GRID_BAR
}

extern "C" void kernel_launch(void* const* d_in, const int* in_sizes, int n_in, void* d_out, int out_size, void* d_ws, size_t ws_size, hipStream_t stream) {
    static int grid = 0;
    if (grid == 0) {
        if (n_in != 13 || in_sizes[0] != T * DM || out_size != T * DM || ws_size < WS_END) {
            fprintf(stderr, "kernel_launch: unexpected shapes (n_in %d, in0 %d, out %d, ws %zu, need %zu); nothing launched\n", n_in, n_in > 0 ? in_sizes[0] : -1, out_size, ws_size, (size_t)WS_END); grid = -1; return; }
        int dev = 0, cus = 0, per_cu = 0;
        if (hipGetDevice(&dev) != hipSuccess || hipDeviceGetAttribute(&cus, hipDeviceAttributeMultiprocessorCount, dev) != hipSuccess) { grid = -1; return; }
        if (hipFuncSetAttribute((const void*)fwd_megakernel, hipFuncAttributeMaxDynamicSharedMemorySize, LDS_BYTES) != hipSuccess) { fprintf(stderr, "kernel_launch: hipFuncSetAttribute failed\n"); grid = -1; return; }
        if (hipOccupancyMaxActiveBlocksPerMultiprocessor(&per_cu, (const void*)fwd_megakernel, NWAVES * 64, LDS_BYTES) != hipSuccess || per_cu < 1) { fprintf(stderr, "kernel_launch: occupancy query reports %d workgroups per CU\n", per_cu); grid = -1; (void)hipGetLastError(); return; }
        (void)hipGetLastError();
        grid = cus;
    }
    if (grid < 0) return;
    if (hipMemsetAsync((char*)d_ws + WS_CTL, 0, CTL_ZERO_BYTES, stream) != hipSuccess) return;
    Args a{};
    for (int i = 0; i < 13; ++i) a.in[i] = (const float*)d_in[i];
    a.out = (float*)d_out; a.ws = (unsigned char*)d_ws;
    for (int li = 0; li < N_LAUNCHES; ++li) {
        a.ph_lo = (N_LAUNCHES == 1) ? 0 : li; a.ph_hi = (N_LAUNCHES == 1) ? PER_PHASE : li + 1;
        hipLaunchKernelGGL(fwd_megakernel, dim3(grid), dim3(NWAVES * 64), LDS_BYTES, stream, a);
    }
}
```

```cpp
#include <hip/hip_runtime.h>
#include <cstdio>
#include <cstdint>
namespace pg8 {
#define PG8_LAS __attribute__((address_space(3)))
typedef unsigned short bf16_t;
typedef short bf16x8 __attribute__((ext_vector_type(8)));
typedef float f32x4 __attribute__((ext_vector_type(4)));
typedef unsigned u32x4 __attribute__((ext_vector_type(4)));
typedef int i32x4 __attribute__((ext_vector_type(4)));
constexpr int BM = 256, BK = 64, HALF = 128, HTB = HALF * BK * 2  , STAGE_BYTES = 8 * HTB, NXCD = 8;

__host__ __device__ __forceinline__ int lds_byte(int r, int c) { const int st = (r >> 4) * 2 + (c >> 5), rr = r & 15, cc = c & 31, ob = rr * 64 + cc * 2; return st * 1024 + (ob ^ (((ob >> 9) & 1) << 5)); }
__host__ __device__ __forceinline__ void stage_rc(int b, int& R, int& C) { const int st = b / 1024, sb = b % 1024, swz = sb ^ (((sb >> 9) & 1) << 5); R = (st >> 1) * 16 + swz / 64; C = (st & 1) * 32 + (swz % 64) / 2; }
__host__ __device__ __forceinline__ int perm32(int rho) { const int n = rho >> 4, i = rho & 15; return 8 * (i >> 2) + 4 * n + (i & 3); }

struct Unit { int pm, pn; };
struct Gemm { const bf16_t* A; const bf16_t* Bt; int M, N, K; };

struct StaticOrder {
    int nM, nN, nwg, G, c, WGM;
    __host__ __device__ void init(int M, int N, int G_, int c_, int wgm_ = 8) { nM = M / BM; nN = N / BM; nwg = nM * nN; G = G_; c = c_; WGM = wgm_; }
    __host__ __device__ bool next(int i, Unit& u) const {
        const long L = (long)i * G + c; if (L >= nwg) return false;
        int wgid = (int)L; { const int q = nwg / NXCD, r = nwg % NXCD, xcd = wgid % NXCD, off = wgid / NXCD; wgid = (xcd < r ? xcd * (q + 1) : r * (q + 1) + (xcd - r) * q) + off; }
        const int nig = WGM * nN, gid = wgid / nig, fm = gid * WGM, gsz = (nM - fm) < WGM ? (nM - fm) : WGM;
        u.pm = fm + ((wgid % nig) % gsz); u.pn = (wgid % nig) / gsz; return true;
    }
    __device__ __forceinline__ void a_ready(const Unit&) const {}
    __device__ __forceinline__ void done(const Unit&) const {}
};
__device__ __forceinline__ unsigned cvt_pk_bf16(float lo, float hi) { unsigned r; asm volatile("v_cvt_pk_bf16_f32 %0, %1, %2" : "=v"(r) : "v"(lo), "v"(hi)); return r; }

typedef float f32x2 __attribute__((ext_vector_type(2)));
__device__ __forceinline__ float xrow16_sum(float x) {
    auto s = __builtin_amdgcn_permlane16_swap(__float_as_uint(x), __float_as_uint(x), false, false);
    x = __uint_as_float(s[0]) + __uint_as_float(s[1]);
    auto t = __builtin_amdgcn_permlane32_swap(__float_as_uint(x), __float_as_uint(x), false, false);
    return __uint_as_float(t[0]) + __uint_as_float(t[1]);
}
struct EpiPlain {
    static constexpr bool PERM = true, AFTER_DRAIN = false;
    bf16_t* O; int ldc;
    __device__ __forceinline__ void operator()(const f32x4 (&acc)[2][2][4][2], const Unit& u, int wr, int wc, int fr, int fq) const {
        const int row0 = u.pm * BM + wr * 64 + fr; const int col0 = u.pn * BM + wc * 32 + 8 * fq;
#pragma unroll
        for (int ai = 0; ai < 2; ++ai)
#pragma unroll
            for (int m = 0; m < 4; ++m) { bf16_t* rowp = O + (size_t)(row0 + ai * HALF + m * 16) * ldc + col0;
#pragma unroll
                for (int bj = 0; bj < 2; ++bj) { const f32x4 v0 = acc[ai][bj][m][0], v1 = acc[ai][bj][m][1];
                    u32x4 w; w.x = cvt_pk_bf16(v0[0], v0[1]); w.y = cvt_pk_bf16(v0[2], v0[3]); w.z = cvt_pk_bf16(v1[0], v1[1]); w.w = cvt_pk_bf16(v1[2], v1[3]);
                    *(u32x4*)(rowp + bj * HALF) = w; } }
    }
};
struct EpiPlainI8 {
    static constexpr bool PERM = true, AFTER_DRAIN = false;
    bf16_t* O; int ldc; const float* xm; const float* cs;
    __device__ __forceinline__ void operator()(const f32x4 (&acc)[2][2][4][2], const Unit& u, int wr, int wc, int fr, int fq) const;
};
struct EpiProj {
    static constexpr bool PERM = true, AFTER_DRAIN = false;
    bf16_t *AIN, *Q, *K, *V, *G; const float* qg; const float* kg; const float* rs; const float* cs;
    __device__ __forceinline__ void operator()(const f32x4 (&acc)[2][2][4][2], const Unit& u, int wr, int wc, int fr, int fq) const {
        const int pn = u.pn; int type, ldc, colt; bf16_t* base;
        if (pn < 2)       { type = 0; base = AIN; ldc = 512;  colt = pn * 256; }
        else if (pn < 14) { type = 1; base = Q;   ldc = 3072; colt = (pn - 2) * 256; }
        else if (pn < 18) { type = 2; base = K;   ldc = 1024; colt = (pn - 14) * 256; }
        else if (pn < 22) { type = 3; base = V;   ldc = 1024; colt = (pn - 18) * 256; }
        else              { type = 4; base = G;   ldc = 2048; colt = (pn - 22) * 256; }
        const int col0 = colt + 64 * wc + 8 * fq;
        const int row0 = u.pm * BM + wr * 64 + fr;
        f32x4 gn[2][2], csv[2][2];
        const float* csp = cs + pn * 256 + 64 * wc + 8 * fq;
#pragma unroll
        for (int bj = 0; bj < 2; ++bj)
#pragma unroll
            for (int n = 0; n < 2; ++n) csv[bj][n] = *(const f32x4*)(csp + 32 * bj + 4 * n);
        float rs8[2][4];
#pragma unroll
        for (int ai = 0; ai < 2; ++ai)
#pragma unroll
            for (int m = 0; m < 4; ++m) rs8[ai][m] = rs[row0 + ai * HALF + m * 16];
        const float* gp = (type == 2) ? kg : qg;
        const float gmul = (type == 1) ? 0.125f * 1.4426950408889634f : 1.0f;
#pragma unroll
        for (int bj = 0; bj < 2; ++bj)
#pragma unroll
            for (int n = 0; n < 2; ++n) gn[bj][n] = *(const f32x4*)(gp + 32 * bj + 8 * fq + 4 * n) * gmul;
#pragma unroll
        for (int ai = 0; ai < 2; ++ai)
#pragma unroll
            for (int m = 0; m < 4; ++m) {
                const int row = row0 + ai * HALF + m * 16;
                f32x4 v[2][2];
#pragma unroll
                for (int bj = 0; bj < 2; ++bj)
#pragma unroll
                    for (int n = 0; n < 2; ++n) { const i32x4 iv = __builtin_bit_cast(i32x4, acc[ai][bj][m][n]); v[bj][n] = (f32x4){(float)iv[0], (float)iv[1], (float)iv[2], (float)iv[3]} * csv[bj][n]; }
                const float rsv = rs8[ai][m];
                if (type == 1 || type == 2) {
                    float ss = 0.f;
#pragma unroll
                    for (int bj = 0; bj < 2; ++bj)
#pragma unroll
                        for (int n = 0; n < 2; ++n) { const f32x4 x = v[bj][n]; ss += (x[0] * x[0] + x[1] * x[1]) + (x[2] * x[2] + x[3] * x[3]); }
                    ss = xrow16_sum(ss);
                    const float rn = __builtin_amdgcn_rsqf(ss * (rsv * rsv * (1.0f / 64.0f)) + 1e-6f) * rsv;
#pragma unroll
                    for (int bj = 0; bj < 2; ++bj)
#pragma unroll
                        for (int n = 0; n < 2; ++n) v[bj][n] = v[bj][n] * rn * gn[bj][n];
                } else {
#pragma unroll
                    for (int bj = 0; bj < 2; ++bj)
#pragma unroll
                        for (int n = 0; n < 2; ++n) v[bj][n] = v[bj][n] * rsv;
                }
                bf16_t* rowp = base + (size_t)row * ldc + col0;
                if (type >= 1 && type <= 3) {
                    const int hh = (colt >> 6) + wc;
                    const int bb = row >> 13, tt = row & 8191;
                    const size_t slab = (type == 1) ? (size_t)((hh >> 4) * 8 + bb) * 16 + (hh & 15) : (size_t)bb * 16 + hh;
                    rowp = base + (slab * 8192 + tt) * 64 + 8 * fq; }
                if (type >= 2) {
                    unsigned char* gp8 = (type == 4) ? (unsigned char*)G + (size_t)row * 2048 + col0 : (unsigned char*)(type == 2 ? K : V) + (((size_t)(row >> 13) * 16 + ((colt >> 6) + wc)) * 8192 + (row & 8191)) * 64 + 8 * fq;
                    typedef unsigned u32x2 __attribute__((ext_vector_type(2)));
#pragma unroll
                    for (int bj = 0; bj < 2; ++bj) { const f32x4 v0 = v[bj][0], v1 = v[bj][1];
                        int p0 = __builtin_amdgcn_cvt_pk_fp8_f32(v0[0], v0[1], 0, false); p0 = __builtin_amdgcn_cvt_pk_fp8_f32(v0[2], v0[3], p0, true);
                        int p1 = __builtin_amdgcn_cvt_pk_fp8_f32(v1[0], v1[1], 0, false); p1 = __builtin_amdgcn_cvt_pk_fp8_f32(v1[2], v1[3], p1, true);
                        *(u32x2*)(gp8 + 32 * bj) = (u32x2){(unsigned)p0, (unsigned)p1}; }
                } else {
#pragma unroll
                for (int bj = 0; bj < 2; ++bj) { const f32x4 v0 = v[bj][0], v1 = v[bj][1];
                    u32x4 w; w.x = cvt_pk_bf16(v0[0], v0[1]); w.y = cvt_pk_bf16(v0[2], v0[3]); w.z = cvt_pk_bf16(v1[0], v1[1]); w.w = cvt_pk_bf16(v1[2], v1[3]);
                    *(u32x4*)(rowp + 32 * bj) = w; }
                }
            }
    }
};
__device__ __forceinline__ float hscale(float xmax) { return (1.25f * xmax + 1.0f) * (1.0f / 127.0f); }
struct EpiOut {
    static constexpr bool PERM = true, AFTER_DRAIN = false;
    const float* x; float* out; bf16_t* hb; const float* xm; unsigned char* hq; const float* ms; const float* cs;
    __device__ __forceinline__ void operator()(const f32x4 (&acc)[2][2][4][2], const Unit& u, int wr, int wc, int fr, int fq) const {
        const int row0 = u.pm * BM + wr * 64 + fr; const int col0 = u.pn * BM + wc * 32 + 8 * fq;
        typedef unsigned u32x2 __attribute__((ext_vector_type(2)));
        float xm8[8], ms8[8];
#pragma unroll
        for (int it = 0; it < 8; ++it) { xm8[it] = xm[row0 + (it >> 2) * HALF + (it & 3) * 16]; ms8[it] = ms[row0 + (it >> 2) * HALF + (it & 3) * 16]; }
        f32x4 csv[2][2];
#pragma unroll
        for (int bj = 0; bj < 2; ++bj)
#pragma unroll
            for (int n = 0; n < 2; ++n) csv[bj][n] = *(const f32x4*)(cs + col0 + bj * HALF + 4 * n);
        f32x4 xc[2][2], xn[2][2];
#pragma unroll
        for (int bj = 0; bj < 2; ++bj) { xc[bj][0] = *(const f32x4*)(x + (size_t)row0 * 1024 + col0 + bj * HALF); xc[bj][1] = *(const f32x4*)(x + (size_t)row0 * 1024 + col0 + bj * HALF + 4); }
#pragma unroll
        for (int it = 0; it < 8; ++it) { const int ai = it >> 2, m = it & 3; const int row = row0 + ai * HALF + m * 16; const size_t off = (size_t)row * 1024 + col0;
            if (it < 7) { const size_t offn = (size_t)(row0 + ((it + 1) >> 2) * HALF + ((it + 1) & 3) * 16) * 1024 + col0;
#pragma unroll
                for (int bj = 0; bj < 2; ++bj) { xn[bj][0] = *(const f32x4*)(x + offn + bj * HALF); xn[bj][1] = *(const f32x4*)(x + offn + bj * HALF + 4); } }
            const float inv = 1.0f / hscale(xm8[it]);
#pragma unroll
            for (int bj = 0; bj < 2; ++bj) {
                const i32x4 i0 = __builtin_bit_cast(i32x4, acc[ai][bj][m][0]), i1 = __builtin_bit_cast(i32x4, acc[ai][bj][m][1]);
                const f32x4 v0 = (f32x4){(float)i0[0], (float)i0[1], (float)i0[2], (float)i0[3]} * (csv[bj][0] * ms8[it]) + xc[bj][0], v1 = (f32x4){(float)i1[0], (float)i1[1], (float)i1[2], (float)i1[3]} * (csv[bj][1] * ms8[it]) + xc[bj][1];
                u32x4 w; w.x = cvt_pk_bf16(v0[0], v0[1]); w.y = cvt_pk_bf16(v0[2], v0[3]); w.z = cvt_pk_bf16(v1[0], v1[1]); w.w = cvt_pk_bf16(v1[2], v1[3]);
                *(u32x4*)(hb + off + bj * HALF) = w;
                unsigned q0 = 0u, q1 = 0u;
#pragma unroll
                for (int e = 0; e < 4; ++e) { q0 = __builtin_amdgcn_cvt_pk_u8_f32(__builtin_amdgcn_fmed3f(__builtin_rintf(fmaf(v0[e], inv, 128.0f)), 1.0f, 255.0f), e, q0);
                                              q1 = __builtin_amdgcn_cvt_pk_u8_f32(__builtin_amdgcn_fmed3f(__builtin_rintf(fmaf(v1[e], inv, 128.0f)), 1.0f, 255.0f), e, q1); }
                *(u32x2*)(hq + off + bj * HALF) = (u32x2){q0 ^ 0x80808080u, q1 ^ 0x80808080u}; }
#pragma unroll
            for (int bj = 0; bj < 2; ++bj) { xc[bj][0] = xn[bj][0]; xc[bj][1] = xn[bj][1]; } }
    }
};
__device__ __forceinline__ void EpiPlainI8::operator()(const f32x4 (&acc)[2][2][4][2], const Unit& u, int wr, int wc, int fr, int fq) const {
    const int row0 = u.pm * BM + wr * 64 + fr; const int col0 = u.pn * BM + wc * 32 + 8 * fq;
    f32x4 csv[2][2];
#pragma unroll
    for (int bj = 0; bj < 2; ++bj)
#pragma unroll
        for (int n = 0; n < 2; ++n) csv[bj][n] = *(const f32x4*)(cs + col0 + bj * HALF + 4 * n);
    float xm8[2][4];
#pragma unroll
    for (int ai = 0; ai < 2; ++ai)
#pragma unroll
        for (int m = 0; m < 4; ++m) xm8[ai][m] = xm[row0 + ai * HALF + m * 16];
#pragma unroll
    for (int ai = 0; ai < 2; ++ai)
#pragma unroll
        for (int m = 0; m < 4; ++m) { const int row = row0 + ai * HALF + m * 16; bf16_t* rowp = O + (size_t)row * ldc + col0; const float rsv = hscale(xm8[ai][m]);
#pragma unroll
            for (int bj = 0; bj < 2; ++bj) { const i32x4 i0 = __builtin_bit_cast(i32x4, acc[ai][bj][m][0]), i1 = __builtin_bit_cast(i32x4, acc[ai][bj][m][1]);
                const f32x4 v0 = (f32x4){(float)i0[0], (float)i0[1], (float)i0[2], (float)i0[3]} * csv[bj][0] * rsv, v1 = (f32x4){(float)i1[0], (float)i1[1], (float)i1[2], (float)i1[3]} * csv[bj][1] * rsv;
                u32x4 w; w.x = cvt_pk_bf16(v0[0], v0[1]); w.y = cvt_pk_bf16(v0[2], v0[3]); w.z = cvt_pk_bf16(v1[0], v1[1]); w.w = cvt_pk_bf16(v1[2], v1[3]);
                *(u32x4*)(rowp + bj * HALF) = w; } }
}
template <class Epi, class Sched, bool ALIGN_EPI = false, bool SP2 = false, bool I8 = false>
__device__ __forceinline__ void gemm_phase(PG8_LAS unsigned char* lds, const Gemm g, const Sched& S, const Epi& E) {
    const int tid = threadIdx.x, wid = __builtin_amdgcn_readfirstlane(tid >> 6), lane = tid & 63, wr = wid >> 2, wc = wid & 3, fr = lane & 15, fq = lane >> 4;
    const int K = g.K, nt = K / BK;
    unsigned voffA[2], voffB[2];
#pragma unroll
    for (int i = 0; i < 2; ++i) { int R, C; stage_rc(tid * 16 + i * 8192, R, C); const int Rb = Epi::PERM ? ((R & ~31) + perm32(R & 31)) : R;
        voffA[i] = (unsigned)(R * K + C) * 2u; voffB[i] = (unsigned)(Rb * K + C) * 2u; }
    const size_t kstep = (size_t)(BK * 2);
    const size_t hstep = (size_t)HALF * K * 2;
    const size_t tstep = 2 * hstep;
    const unsigned ldsw = (unsigned)wid * 1024u;
    const int aoff = lds_byte(wr * 64 + fr, fq * 8), boff = lds_byte(wc * 32 + fr, fq * 8);
#define PG8_SA(b, h) (((b) * 2 + (h)) * HTB)
#define PG8_SB(b, h) ((4 + (b) * 2 + (h)) * HTB)
#define PG8_STAGE(bufoff, gbase, voff) do { _Pragma("unroll") for (int _i = 0; _i < 2; ++_i) \
        __builtin_amdgcn_global_load_lds((const unsigned*)((const char*)(gbase) + (voff)[_i]), (PG8_LAS unsigned*)(lds + (bufoff) + ldsw + _i * 8192), 16, 0, 0); } while (0)
#define PG8_LDA(dst, b, h) do { _Pragma("unroll") for (int m = 0; m < 4; ++m) _Pragma("unroll") for (int k = 0; k < 2; ++k) dst[m][k] = *(const PG8_LAS bf16x8*)(lds + PG8_SA(b, h) + aoff + m * 2048 + k * 1024); } while (0)
#define PG8_LDB(dst, b, h) do { _Pragma("unroll") for (int n = 0; n < 2; ++n) _Pragma("unroll") for (int k = 0; k < 2; ++k) dst[n][k] = *(const PG8_LAS bf16x8*)(lds + PG8_SB(b, h) + boff + n * 2048 + k * 1024); } while (0)
#define PG8_MMA(ai, bj, At, Bt) do { __builtin_amdgcn_s_setprio(1); _Pragma("unroll") for (int m = 0; m < 4; ++m) _Pragma("unroll") for (int n = 0; n < 2; ++n) _Pragma("unroll") for (int k = 0; k < 2; ++k) \
        { if constexpr (I8) acc[ai][bj][m][n] = __builtin_bit_cast(f32x4, __builtin_amdgcn_mfma_i32_16x16x64_i8(__builtin_bit_cast(i32x4, Bt[n][k]), __builtin_bit_cast(i32x4, At[m][k]), __builtin_bit_cast(i32x4, acc[ai][bj][m][n]), 0, 0, 0)); \
          else acc[ai][bj][m][n] = __builtin_amdgcn_mfma_f32_16x16x32_bf16(Bt[n][k], At[m][k], acc[ai][bj][m][n], 0, 0, 0); } __builtin_amdgcn_s_setprio(0); } while (0)
#define PG8_WAIT_V(n) asm volatile("s_waitcnt vmcnt(" #n ")" ::: "memory")
#define PG8_WAIT_L(n) asm volatile("s_waitcnt lgkmcnt(" #n ")" ::: "memory")
#define PG8_BAR __builtin_amdgcn_s_barrier()
#define PG8_SCHED __builtin_amdgcn_sched_barrier(0)
    Unit cur, nxt; int ui = 0;
    if (!S.next(0, cur)) return;
    f32x4 acc[2][2][4][2];
#pragma unroll
    for (int a = 0; a < 2; ++a)
#pragma unroll
        for (int b = 0; b < 2; ++b)
#pragma unroll
            for (int m = 0; m < 4; ++m)
#pragma unroll
                for (int n = 0; n < 2; ++n) acc[a][b][m][n] = (f32x4){0.f, 0.f, 0.f, 0.f};
    bf16x8 At[4][2], B0[2][2], B1[2][2];
    const char* cA = (const char*)g.A + (size_t)cur.pm * tstep; const char* cB = (const char*)g.Bt + (size_t)cur.pn * tstep;
    S.a_ready(cur);
    if constexpr (SP2) {
        PG8_STAGE(PG8_SB(0, 0), cB, voffB); PG8_STAGE(PG8_SB(0, 1), cB + hstep, voffB); PG8_STAGE(PG8_SA(0, 0), cA, voffA); PG8_STAGE(PG8_SA(0, 1), cA + hstep, voffA);
        if (wr == 1) PG8_BAR;
        PG8_WAIT_V(2); PG8_BAR;
        PG8_STAGE(PG8_SB(1, 0), cB + kstep, voffB); PG8_STAGE(PG8_SA(1, 0), cA + kstep, voffA); PG8_STAGE(PG8_SB(1, 1), cB + hstep + kstep, voffB);
        PG8_WAIT_V(6); PG8_BAR;
    } else {
        PG8_STAGE(PG8_SB(0, 0), cB, voffB); PG8_STAGE(PG8_SA(0, 0), cA, voffA); PG8_STAGE(PG8_SB(0, 1), cB + hstep, voffB); PG8_STAGE(PG8_SA(0, 1), cA + hstep, voffA);
        if (wr == 1) PG8_BAR;
        PG8_WAIT_V(4); PG8_BAR;
        PG8_STAGE(PG8_SB(1, 0), cB + kstep, voffB); PG8_STAGE(PG8_SA(1, 0), cA + kstep, voffA); PG8_STAGE(PG8_SB(1, 1), cB + hstep + kstep, voffB);
        PG8_WAIT_V(6); PG8_BAR;
    }
    for (;;) {
        const bool has_next = S.next(ui + 1, nxt);
        const char* nA = has_next ? (const char*)g.A + (size_t)nxt.pm * tstep : cA; const char* nB = has_next ? (const char*)g.Bt + (size_t)nxt.pn * tstep : cB;
        for (int t = 0; t < nt; t += 2) {
            const bool last = (t == nt - 2);
            const char* a1 = cA + (size_t)(t + 1) * kstep;
            const char* a2 = last ? nA : cA + (size_t)(t + 2) * kstep; const char* b2 = last ? nB : cB + (size_t)(t + 2) * kstep;
            const char* a3 = a2 + kstep; const char* b3 = b2 + kstep;
            if (last && has_next) S.a_ready(nxt);
            if constexpr (SP2) {
            PG8_LDB(B0, 0, 0); PG8_LDB(B1, 0, 1); PG8_SCHED; PG8_LDA(At, 0, 0); PG8_STAGE(PG8_SA(1, 1), a1 + hstep, voffA);
            PG8_WAIT_V(8); PG8_WAIT_L(0); PG8_BAR; PG8_MMA(0, 0, At, B0); PG8_MMA(0, 1, At, B1); PG8_BAR; PG8_SCHED;
            PG8_LDA(At, 0, 1); PG8_STAGE(PG8_SB(0, 0), b2, voffB); PG8_STAGE(PG8_SB(0, 1), b2 + hstep, voffB); PG8_STAGE(PG8_SA(0, 0), a2, voffA);
            PG8_WAIT_V(8); PG8_WAIT_L(0); PG8_BAR; PG8_MMA(1, 0, At, B0); PG8_MMA(1, 1, At, B1); PG8_BAR; PG8_SCHED;
            PG8_LDB(B0, 1, 0); PG8_LDB(B1, 1, 1); PG8_SCHED; PG8_LDA(At, 1, 0); PG8_STAGE(PG8_SA(0, 1), a2 + hstep, voffA);
            PG8_WAIT_V(8); PG8_WAIT_L(0); PG8_BAR; PG8_MMA(0, 0, At, B0); PG8_MMA(0, 1, At, B1); PG8_BAR; PG8_SCHED;
            PG8_LDA(At, 1, 1); PG8_STAGE(PG8_SB(1, 0), b3, voffB); PG8_STAGE(PG8_SB(1, 1), b3 + hstep, voffB); PG8_STAGE(PG8_SA(1, 0), a3, voffA);
            PG8_WAIT_V(8); PG8_WAIT_L(0); PG8_BAR; PG8_MMA(1, 0, At, B0); PG8_MMA(1, 1, At, B1); PG8_BAR; PG8_SCHED;
            } else {
            PG8_LDB(B0, 0, 0); PG8_SCHED; PG8_LDA(At, 0, 0); PG8_STAGE(PG8_SA(1, 1), a1 + hstep, voffA);
            PG8_WAIT_L(8); PG8_BAR; PG8_WAIT_L(0); PG8_MMA(0, 0, At, B0); PG8_BAR; PG8_SCHED;
            PG8_LDB(B1, 0, 1); PG8_STAGE(PG8_SB(0, 0), b2, voffB);
            PG8_BAR; PG8_WAIT_L(0); PG8_MMA(0, 1, At, B1); PG8_BAR;
            PG8_LDA(At, 0, 1); PG8_STAGE(PG8_SA(0, 0), a2, voffA);
            PG8_BAR; PG8_WAIT_L(0); PG8_MMA(1, 0, At, B0); PG8_BAR; PG8_SCHED;
            PG8_STAGE(PG8_SB(0, 1), b2 + hstep, voffB);
            PG8_WAIT_V(6); PG8_BAR; PG8_MMA(1, 1, At, B1); PG8_BAR;
            PG8_LDB(B0, 1, 0); PG8_SCHED; PG8_LDA(At, 1, 0); PG8_STAGE(PG8_SA(0, 1), a2 + hstep, voffA);
            PG8_WAIT_L(8); PG8_BAR; PG8_WAIT_L(0); PG8_MMA(0, 0, At, B0); PG8_BAR; PG8_SCHED;
            PG8_LDB(B1, 1, 1); PG8_STAGE(PG8_SB(1, 0), b3, voffB);
            PG8_BAR; PG8_WAIT_L(0); PG8_MMA(0, 1, At, B1); PG8_BAR;
            PG8_LDA(At, 1, 1); PG8_STAGE(PG8_SA(1, 0), a3, voffA);
            PG8_BAR; PG8_WAIT_L(0); PG8_MMA(1, 0, At, B0); PG8_BAR; PG8_SCHED;
            PG8_STAGE(PG8_SB(1, 1), b3 + hstep, voffB);
            PG8_WAIT_V(6); PG8_BAR; PG8_MMA(1, 1, At, B1); PG8_BAR;
            }
        }
        if constexpr (ALIGN_EPI) { if (wr == 0) PG8_BAR; }
        if constexpr (!Epi::AFTER_DRAIN) { E(acc, cur, wr, wc, fr, fq); S.done(cur); }
        if (!has_next) break;
#pragma unroll
        for (int a = 0; a < 2; ++a)
#pragma unroll
            for (int b = 0; b < 2; ++b)
#pragma unroll
                for (int m = 0; m < 4; ++m)
#pragma unroll
                    for (int n = 0; n < 2; ++n) acc[a][b][m][n] = (f32x4){0.f, 0.f, 0.f, 0.f};
        cur = nxt; cA = nA; cB = nB; ++ui;
        if constexpr (ALIGN_EPI) { if (wr == 1) PG8_BAR; }
    }
    PG8_WAIT_V(0);
    if constexpr (!ALIGN_EPI) { if (wr == 0) PG8_BAR; }
    PG8_BAR;
    if constexpr (Epi::AFTER_DRAIN) { E.fused(acc, cur, wr, wc, fr, fq, lds, wid, lane); S.done(cur); }
#undef PG8_SA
#undef PG8_SB
#undef PG8_STAGE
#undef PG8_LDA
#undef PG8_LDB
#undef PG8_MMA
#undef PG8_WAIT_V
#undef PG8_WAIT_L
#undef PG8_BAR
#undef PG8_SCHED
}
}

constexpr int NWAVES = 8;
constexpr int BATCH = 8, SEQ = 8192, DM = 1024, T = BATCH * SEQ;
constexpr int INW = 7680, QW = 3072, GATEW = 2048, POOLW = 512;
constexpr int NEXP = 16384;
constexpr float EPS = 1e-6f;
constexpr float LOG2E = 1.4426950408889634f;

constexpr size_t MiB = 1u << 20;
constexpr size_t WS_CTL = 0, CTL_ZERO_BYTES = 1 * MiB;
constexpr size_t WS_W1T = 2 * MiB;
constexpr size_t WS_WOT = 17 * MiB;
constexpr size_t WS_WQT = 19 * MiB;
constexpr size_t WS_WPT = 23 * MiB;
constexpr size_t WS_SKB = 23 * MiB + 512 * 1024;
constexpr size_t WS_S1 = 24 * MiB;
constexpr size_t WS_SU = 24 * MiB + 256 * 1024, WS_SV = 24 * MiB + 512 * 1024;
constexpr size_t WS_UB = 25 * MiB;
constexpr size_t WS_VB = 57 * MiB;
constexpr size_t WS_MD = 89 * MiB;
constexpr size_t WS_XB = 113 * MiB;
constexpr size_t WS_AIN = 241 * MiB;
constexpr size_t WS_Q = 305 * MiB;
constexpr size_t WS_G = 689 * MiB;
constexpr size_t WS_END = 945 * MiB;
constexpr size_t WS_HB = WS_AIN;
constexpr size_t WS_CMAX = 64 * 1024;
constexpr size_t WS_CS = 128 * 1024;
constexpr size_t WS_CMAX2 = 96 * 1024;
constexpr size_t WS_CS2 = 192 * 1024;
constexpr size_t WS_CMAX3 = 104 * 1024;
constexpr size_t WS_CS3 = 200 * 1024;
constexpr size_t WS_MS = 512 * 1024;
constexpr size_t WS_XM = 256 * 1024;

constexpr int CW_BAR = 4096;
constexpr int RING_OFF = 0, RING_BYTES = 131072;
constexpr int LDSCTL_OFF = 162816, MISC_OFF = LDSCTL_OFF + 320;
constexpr int LDS_BYTES = 163840;

#define GAS __attribute__((address_space(1)))
#define LAS __attribute__((address_space(3)))
typedef unsigned short bf16;
typedef unsigned v4u __attribute__((ext_vector_type(4)));
typedef unsigned v2u __attribute__((ext_vector_type(2)));
typedef float f32x4 __attribute__((ext_vector_type(4)));
typedef float f32x16 __attribute__((ext_vector_type(16)));
typedef short bf16x8 __attribute__((ext_vector_type(8)));
typedef short s16x4 __attribute__((ext_vector_type(4)));
typedef __bf16 bf16x2_t __attribute__((ext_vector_type(2)));
typedef GAS unsigned gu32;
#define RLX_AGENT __ATOMIC_RELAXED, __HIP_MEMORY_SCOPE_AGENT
#define LDS_WAIT() asm volatile("s_waitcnt lgkmcnt(0)" ::: "memory")
#define VM_WAIT() asm volatile("s_waitcnt vmcnt(0)" ::: "memory")
__device__ __forceinline__ unsigned f2bf(float f) { unsigned u = __builtin_bit_cast(unsigned, f); return (u + 0x7fffu + ((u >> 16) & 1u)) >> 16; }
__device__ __forceinline__ unsigned pk2(float lo, float hi) { return f2bf(lo) | (f2bf(hi) << 16); }
__device__ __forceinline__ float bflo(unsigned w) { return __uint_as_float(w << 16); }
__device__ __forceinline__ float bfhi(unsigned w) { return __uint_as_float(w & 0xffff0000u); }
__device__ __forceinline__ int crow(int r, int hi) { return (r & 3) + 8 * (r >> 2) + 4 * hi; }
__device__ __forceinline__ float xhalf_max(float x) { auto t = __builtin_amdgcn_permlane32_swap(__float_as_uint(x), __float_as_uint(x), false, false); return fmaxf(__uint_as_float(t[0]), __uint_as_float(t[1])); }
__device__ __forceinline__ float xhalf_sum(float x) { auto t = __builtin_amdgcn_permlane32_swap(__float_as_uint(x), __float_as_uint(x), false, false); return __uint_as_float(t[0]) + __uint_as_float(t[1]); }
__device__ __forceinline__ float wave_sum(float v) {
#pragma unroll
    for (int o = 1; o < 64; o <<= 1) v += __shfl_xor(v, o);
    return v;
}
__device__ __forceinline__ float dot2bf(unsigned a, unsigned b, float acc) { return __builtin_amdgcn_fdot2_f32_bf16(__builtin_bit_cast(bf16x2_t, a), __builtin_bit_cast(bf16x2_t, b), acc, false); }

#define XB_TMO      128
#define XB_XCNT(j)  (256  + 64 * (j))
#define XB_XSUB(j)  (1280 + 64 * (j))
#define XB_XGEN(j)  (2304 + 64 * (j))
#define XB_TOP      3328
#define XB_TOPGEN   3392
#define XCD_BAR_WORDS 3456
#define XB_SPIN_CAP (1u << 18)

__device__ __forceinline__ unsigned xb_ld(unsigned* p)              { return __hip_atomic_load(p, __ATOMIC_RELAXED, __HIP_MEMORY_SCOPE_AGENT); }
__device__ __forceinline__ unsigned xb_add(unsigned* p, unsigned v) { return __hip_atomic_fetch_add(p, v, __ATOMIC_RELAXED, __HIP_MEMORY_SCOPE_AGENT); }
__device__ __forceinline__ unsigned xb_xcc_id() { return (unsigned)__builtin_amdgcn_s_getreg((3 << 11) | 20) & 0xFu; }
#define XB_SPIN(cond, bar) do { unsigned _sp = 0; while (cond) { __builtin_amdgcn_s_sleep(1); \
    if ((++_sp & 255u) == 0u) { if (xb_ld(&(bar)[XB_TMO])) break; if (_sp > XB_SPIN_CAP) { atomicAdd(&(bar)[XB_TMO], 1u); break; } } } } while (0)

struct XcdBarrier {
    unsigned* bar; unsigned x;
    volatile LAS unsigned* st;
};

__device__ __forceinline__ XcdBarrier xcd_barrier_post(unsigned* bar, volatile LAS unsigned* st) {
    XcdBarrier b; b.bar = bar; b.x = xb_xcc_id(); b.st = st;
    if (threadIdx.x == 0) (void)xb_add(&bar[XB_XCNT(b.x)], 1u);
    return b;
}
__device__ __forceinline__ void xcd_barrier_complete(unsigned* bar, unsigned x, unsigned& nloc, unsigned& nx) {
    const unsigned G = gridDim.x * gridDim.y * gridDim.z;
    unsigned sum, cnt, mine, sp = 0u;
    for (;;) {
        sum = 0u; cnt = 0u; mine = 0u;
#pragma unroll
        for (unsigned j = 0; j < 16; ++j) { const unsigned c = xb_ld(&bar[XB_XCNT(j)]); sum += c; cnt += (c > 0u) ? 1u : 0u; mine = (j == x) ? c : mine; }
        if (sum == G) break;
        __builtin_amdgcn_s_sleep(1);
        if ((++sp & 255u) == 0u) { if (xb_ld(&bar[XB_TMO])) break; if (sp > XB_SPIN_CAP) { atomicAdd(&bar[XB_TMO], 1u); break; } }
    }
    nloc = mine > 0u ? mine : 1u; nx = cnt > 0u ? cnt : 1u;
}

__device__ __forceinline__ void xcd_barrier(const XcdBarrier& b) {
    asm volatile("s_waitcnt vmcnt(0)" ::: "memory");
    __syncthreads();
    if (threadIdx.x == 0) {
        unsigned* bar = b.bar;
        __builtin_amdgcn_s_waitcnt(0);
        unsigned nloc = b.st[0], nx = b.st[1];
        if (nloc == 0u) { xcd_barrier_complete(bar, b.x, nloc, nx); b.st[0] = nloc; b.st[1] = nx; }
        const unsigned old = xb_add(&bar[XB_XSUB(b.x)], 1u);
        const unsigned gen = old / nloc;
        if (old + 1u == (gen + 1u) * nloc) {
            __builtin_amdgcn_fence(__ATOMIC_RELEASE, "agent");
            asm volatile("s_waitcnt vmcnt(0)" ::: "memory");
            const unsigned og = xb_add(&bar[XB_TOP], 1u);
            const unsigned tg = og / nx;
            if (og + 1u == (tg + 1u) * nx) xb_add(&bar[XB_TOPGEN], 1u);
            else XB_SPIN(xb_ld(&bar[XB_TOPGEN]) == tg, bar);
            __builtin_amdgcn_fence(__ATOMIC_ACQUIRE, "agent");
            xb_add(&bar[XB_XGEN(b.x)], 1u);
            asm volatile("s_waitcnt vmcnt(0)" ::: "memory");
        } else {
            XB_SPIN(xb_ld(&bar[XB_XGEN(b.x)]) == gen, bar);
            __builtin_amdgcn_fence(__ATOMIC_ACQUIRE, "agent");
            asm volatile("s_waitcnt vmcnt(0)" ::: "memory");
        }
    }
    __syncthreads();
}

struct Frame {
    LAS unsigned char* lds;
    volatile LAS unsigned* MISC;
    gu32* ctl;
    int tid, lane, wave, G;
    const float *x, *norm1_g, *w_in, *q_norm_g, *k_norm_g, *w_pool, *pool_scale, *w_out, *norm2_g, *w_query, *sub_keys, *expert_u, *expert_v;
    float* out; unsigned char* ws;
};
template <int CTRL> __device__ __forceinline__ float dppf(float x) { return __builtin_bit_cast(float, __builtin_amdgcn_mov_dpp(__builtin_bit_cast(int, x), CTRL, 0xf, 0xf, true)); }
__device__ __forceinline__ float wave_sum_dpp(float x) {
    x += dppf<0xB1>(x);
    x += dppf<0x4E>(x);
    x += dppf<0x141>(x);
    x += dppf<0x128>(x);
    return pg8::xrow16_sum(x);
}

__device__ __forceinline__ float wave_max_dpp(float x) {
    x = fmaxf(x, dppf<0xB1>(x)); x = fmaxf(x, dppf<0x4E>(x)); x = fmaxf(x, dppf<0x141>(x)); x = fmaxf(x, dppf<0x128>(x));
    auto s = __builtin_amdgcn_permlane16_swap(__float_as_uint(x), __float_as_uint(x), false, false);
    x = fmaxf(__uint_as_float(s[0]), __uint_as_float(s[1]));
    auto t = __builtin_amdgcn_permlane32_swap(__float_as_uint(x), __float_as_uint(x), false, false);
    return fmaxf(__uint_as_float(t[0]), __uint_as_float(t[1]));
}
template <int CTRL> __device__ __forceinline__ int dppi(int x) { return __builtin_amdgcn_mov_dpp(x, CTRL, 0xf, 0xf, true); }
__device__ __forceinline__ int wave_sum_dpp_i(int x) {
    x += dppi<0xB1>(x); x += dppi<0x4E>(x); x += dppi<0x141>(x); x += dppi<0x128>(x);
    auto s = __builtin_amdgcn_permlane16_swap((unsigned)x, (unsigned)x, false, false); x = (int)(s[0] + s[1]);
    auto t = __builtin_amdgcn_permlane32_swap((unsigned)x, (unsigned)x, false, false); return (int)(t[0] + t[1]);
}
__device__ __forceinline__ v4u quant16(const f32x4 (&v)[4], float inv, int off) {
    v4u o;
#pragma unroll
    for (int j = 0; j < 4; ++j) {
        const int a = (int)__builtin_rintf(v[j].x * inv) + off, b = (int)__builtin_rintf(v[j].y * inv) + off, c = (int)__builtin_rintf(v[j].z * inv) + off, d = (int)__builtin_rintf(v[j].w * inv) + off;
        o[j] = (unsigned)(a & 255) | ((unsigned)(b & 255) << 8) | ((unsigned)(c & 255) << 16) | ((unsigned)(d & 255) << 24);
    }
    return o;
}
__device__ __forceinline__ void p0_quant_row(const float* xrow, const float* gain, unsigned char* orow, float* scale_out, int off, int lane) {
    const GAS f32x4* xr = (const GAS f32x4*)xrow + lane;
    f32x4 v[4]; float mx = 0.f;
#pragma unroll
    for (int j = 0; j < 4; ++j) { v[j] = xr[64 * j]; if (gain) v[j] = v[j] * ((const f32x4*)gain)[64 * j + lane];
        mx = fmaxf(mx, fmaxf(fmaxf(fabsf(v[j].x), fabsf(v[j].y)), fmaxf(fabsf(v[j].z), fabsf(v[j].w)))); }
    mx = wave_max_dpp(mx);
    const float sc = mx > 0.f ? mx * (1.0f / 127.0f) : 1.0f, inv = 1.0f / sc;
    *(GAS v4u*)(orow + 16 * lane) = quant16(v, inv, off);
    if (lane == 0) __hip_atomic_store(scale_out, sc, __ATOMIC_RELAXED, __HIP_MEMORY_SCOPE_AGENT);
}
__device__ __forceinline__ void p0_fp8_row(const float* xrow, unsigned char* orow, float* scale_out, int lane) {
    const GAS f32x4* xr = (const GAS f32x4*)xrow + lane;
    f32x4 v[4]; float mx = 0.f;
#pragma unroll
    for (int j = 0; j < 4; ++j) { v[j] = xr[64 * j]; mx = fmaxf(mx, fmaxf(fmaxf(fabsf(v[j].x), fabsf(v[j].y)), fmaxf(fabsf(v[j].z), fabsf(v[j].w)))); }
    mx = wave_max_dpp(mx);
    const float sc = mx > 0.f ? mx * (1.0f / 400.0f) : 1.0f, inv = 1.0f / sc;
    v4u o;
#pragma unroll
    for (int j = 0; j < 4; ++j) { int pk = __builtin_amdgcn_cvt_pk_fp8_f32(v[j].x * inv, v[j].y * inv, 0, false); pk = __builtin_amdgcn_cvt_pk_fp8_f32(v[j].z * inv, v[j].w * inv, pk, true); o[j] = (unsigned)pk; }
    *(GAS v4u*)(orow + 16 * lane) = o;
    if (lane == 0) __hip_atomic_store(scale_out, sc, __ATOMIC_RELAXED, __HIP_MEMORY_SCOPE_AGENT);
}
__device__ __forceinline__ void p0_transpose_item(const float* W, int K, int N, const float* rs, const float* cs, bf16* WT, int permute, LAS float* scr, int item, int lane) {
    const int nblk = N / 32, kb = item / nblk, nb = item % nblk, k0 = 64 * kb, n0 = 32 * nb;
    const float csv = cs ? cs[n0 + (lane & 31)] : 1.f;
#pragma unroll 8
    for (int i = 0; i < 32; ++i) { const int kk = 2 * i + (lane >> 5); const float r = rs ? rs[k0 + kk] : 1.f; scr[kk * 33 + (lane & 31)] = W[(size_t)(k0 + kk) * N + n0 + (lane & 31)] * r * csv; }
    LDS_WAIT(); asm volatile("" ::: "memory");
    int nout0 = n0;
    if (permute) { const int gl = (n0 & 255) >> 5; const int gp = 4 * (gl & 1) + (gl >> 1); nout0 = (n0 & ~255) + 32 * gp; }
    const int c = lane & 7;
#pragma unroll
    for (int j = 0; j < 4; ++j) { const int n = (lane >> 3) + 8 * j; const LAS float* s = scr + (8 * c) * 33 + n;
        v4u o; o.x = pk2(s[0 * 33], s[1 * 33]); o.y = pk2(s[2 * 33], s[3 * 33]); o.z = pk2(s[4 * 33], s[5 * 33]); o.w = pk2(s[6 * 33], s[7 * 33]);
        *(GAS v4u*)(WT + (size_t)(nout0 + n) * K + k0 + 8 * c) = o; }
    LDS_WAIT(); asm volatile("" ::: "memory");
}
__device__ __forceinline__ void p0_row(const float* xrow, const float* gain, bf16* orow, bool rms, int lane) {
    const GAS f32x4* xr = (const GAS f32x4*)xrow + lane;
    f32x4 v[4]; float s = 0.f;
#pragma unroll
    for (int j = 0; j < 4; ++j) { v[j] = xr[64 * j]; s += (v[j].x * v[j].x + v[j].y * v[j].y) + (v[j].z * v[j].z + v[j].w * v[j].w); }
    if (rms) { s = wave_sum(s); const float r = 1.0f / sqrtf(s * (1.0f / 1024.0f) + EPS);
#pragma unroll
        for (int j = 0; j < 4; ++j) v[j] = v[j] * r; }
    if (gain) {
#pragma unroll
        for (int j = 0; j < 4; ++j) v[j] = v[j] * ((const f32x4*)gain)[64 * j + lane];
    }
    GAS unsigned long long* o8 = (GAS unsigned long long*)orow + lane;
#pragma unroll
    for (int j = 0; j < 4; ++j) o8[64 * j] = (unsigned long long)pk2(v[j].x, v[j].y) | ((unsigned long long)pk2(v[j].z, v[j].w) << 32);
}
__device__ __forceinline__ void p0_colmax_item(const float* W, int N, const float* rs, unsigned* cmax, int item, int lane) {
    const int nblk = N / 32, kb = item / nblk, nb = item % nblk, k0 = 64 * kb, n0 = 32 * nb;
    float mx = 0.f;
    const int half = lane >> 5, col = lane & 31;
    const int rsreg = rs ? __float_as_int(rs[k0 + lane]) : __float_as_int(1.f);
#pragma unroll
    for (int c = 0; c < 2; ++c) { float wv[16];
#pragma unroll
        for (int j = 0; j < 16; ++j) wv[j] = W[(size_t)(k0 + 2 * (16 * c + j) + half) * N + n0 + col];
        __builtin_amdgcn_sched_barrier(0);
#pragma unroll
        for (int j = 0; j < 16; ++j) { const int i = 16 * c + j; const float r0 = __int_as_float(__builtin_amdgcn_readlane(rsreg, 2 * i)), r1 = __int_as_float(__builtin_amdgcn_readlane(rsreg, 2 * i + 1));
            mx = fmaxf(mx, fabsf(wv[j] * (half ? r1 : r0))); }
        __builtin_amdgcn_sched_barrier(0); }
    mx = xhalf_max(mx);
    if (lane < 32) (void)__hip_atomic_fetch_max(cmax + n0 + lane, __float_as_uint(mx), __ATOMIC_RELAXED, __HIP_MEMORY_SCOPE_AGENT);
}
__device__ __forceinline__ void p0_transpose_q8_item(const float* W, int N, const float* rs, unsigned* cmax, float* cscale, unsigned char* WT, int permute, LAS float* scr, int item, int lane) {
    constexpr int K = 1024;
    const int nblk = N / 32, kb = item / nblk, nb = item % nblk, k0 = 128 * kb, n0 = 32 * nb;
    const float cm = __uint_as_float(__hip_atomic_load(cmax + n0 + (lane & 31), __ATOMIC_RELAXED, __HIP_MEMORY_SCOPE_AGENT));
    const float inv = cm > 0.f ? 127.0f / cm : 0.f;
    if (kb == 0 && lane < 32) cscale[n0 + lane] = cm * (1.0f / 127.0f);
    const int half = lane >> 5, col = lane & 31;
    const int rs0 = rs ? __float_as_int(rs[k0 + lane]) : __float_as_int(1.f), rs1 = rs ? __float_as_int(rs[k0 + 64 + lane]) : __float_as_int(1.f);
#pragma unroll
    for (int c = 0; c < 4; ++c) { float wv[16];
#pragma unroll
        for (int j = 0; j < 16; ++j) wv[j] = W[(size_t)(k0 + 2 * (16 * c + j) + half) * N + n0 + col];
        __builtin_amdgcn_sched_barrier(0);
#pragma unroll
        for (int j = 0; j < 16; ++j) { const int i = 16 * c + j; const int rr = (i < 32) ? rs0 : rs1; const float r0 = __int_as_float(__builtin_amdgcn_readlane(rr, (2 * i) & 63)), r1 = __int_as_float(__builtin_amdgcn_readlane(rr, (2 * i + 1) & 63));
            scr[(2 * i + half) * 33 + col] = __builtin_rintf(wv[j] * (half ? r1 : r0) * inv); }
        __builtin_amdgcn_sched_barrier(0); }
    LDS_WAIT(); asm volatile("" ::: "memory");
    int nout0 = n0;
    if (permute) { const int gl = (n0 & 255) >> 5; const int gp = 4 * (gl & 1) + (gl >> 1); nout0 = (n0 & ~255) + 32 * gp; }
    const int c = lane & 7;
#pragma unroll
    for (int j = 0; j < 4; ++j) { const int n = (lane >> 3) + 8 * j; const LAS float* sp = scr + (16 * c) * 33 + n;
        v4u o;
#pragma unroll
        for (int d = 0; d < 4; ++d) o[d] = ((unsigned)(int)sp[(4 * d) * 33] & 255u) | (((unsigned)(int)sp[(4 * d + 1) * 33] & 255u) << 8) | (((unsigned)(int)sp[(4 * d + 2) * 33] & 255u) << 16) | ((unsigned)(int)sp[(4 * d + 3) * 33] << 24);
        *(GAS v4u*)(WT + (size_t)(nout0 + n) * K + k0 + 16 * c) = o; }
    LDS_WAIT(); asm volatile("" ::: "memory");
}
__device__ __forceinline__ void p0_xrow_q8(const float* xrow, unsigned char* orow, float* rs_out, float* xm_out, int lane) {
    const GAS f32x4* xr = (const GAS f32x4*)xrow + lane;
    f32x4 v[4]; float s = 0.f, mx = 0.f;
#pragma unroll
    for (int j = 0; j < 4; ++j) { v[j] = xr[64 * j]; s += (v[j].x * v[j].x + v[j].y * v[j].y) + (v[j].z * v[j].z + v[j].w * v[j].w);
        mx = fmaxf(mx, fmaxf(fmaxf(fabsf(v[j].x), fabsf(v[j].y)), fmaxf(fabsf(v[j].z), fabsf(v[j].w)))); }
    s = wave_sum_dpp(s); mx = wave_max_dpp(mx);
    const float r = 1.0f / sqrtf(s * (1.0f / 1024.0f) + EPS);
    const float q = mx > 0.f ? mx * (1.0f / 127.0f) : 1.0f, inv = 1.0f / q;
    const v4u o = quant16(v, inv, 0);
#pragma unroll
    for (int j = 0; j < 4; ++j) ((GAS unsigned*)orow)[64 * j + lane] = o[j];
    if (lane == 0) { *xm_out = mx; *rs_out = r * q; }
}
__device__ __forceinline__ void p0_part_a(Frame& F) {
    const int gw = blockIdx.x * NWAVES + F.wave, NGW = F.G * NWAVES;
    unsigned char* ws = F.ws;
    constexpr int I_IN = (DM / 64) * (INW / 32);
    constexpr int I_Q = (DM / 64) * (2048 / 32);
    for (int it = gw; it < I_IN + I_Q; it += NGW) {
        if (it < I_IN) p0_colmax_item(F.w_in, INW, F.norm1_g, (unsigned*)(ws + WS_CMAX), it, F.lane);
        else p0_colmax_item(F.w_query, 2048, F.norm2_g, (unsigned*)(ws + WS_CMAX2), it - I_IN, F.lane);
    }
    constexpr int I_O = (DM / 64) * (DM / 32);
    for (int it = gw; it < I_O; it += NGW) p0_colmax_item(F.w_out, DM, nullptr, (unsigned*)(ws + WS_CMAX3), it, F.lane);
    for (int q = blockIdx.x; q < T / 32; q += F.G)
        for (int i = F.wave; i < 32; i += NWAVES) { const int m = 32 * q + i; p0_xrow_q8(F.x + (size_t)m * DM, ws + WS_XB + (size_t)m * DM, (float*)(ws + WS_S1) + m, (float*)(ws + WS_XM) + m, F.lane); }
    constexpr int NROWS = 2 * NEXP + 512;
    for (int m = gw; m < NROWS; m += NGW) {
        int r = m;
        if (r < NEXP) { p0_quant_row(F.expert_u + (size_t)r * DM, F.norm2_g, ws + WS_UB + (size_t)r * 2048, (float*)(ws + WS_SU) + r, 0, F.lane); continue; } r -= NEXP;
        if (r < NEXP) { p0_fp8_row(F.expert_v + (size_t)r * DM, ws + WS_UB + (size_t)r * 2048 + 1024, (float*)(ws + WS_SV) + r, F.lane); continue; } r -= NEXP;
        {
            const int hp = r >> 5, ks = (r >> 2) & 7, mt = r & 3, key = 32 * mt + (F.lane & 31), d0 = 16 * ks + 8 * (F.lane >> 5);
            const GAS f32x4* sp = (const GAS f32x4*)(F.sub_keys + ((size_t)(hp * 128 + key) * 128 + d0)); const f32x4 a = sp[0], b = sp[1];
            v4u o; o.x = pk2(a.x, a.y); o.y = pk2(a.z, a.w); o.z = pk2(b.x, b.y); o.w = pk2(b.z, b.w);
            *(GAS v4u*)((bf16*)(ws + WS_SKB) + ((size_t)r * 64 + F.lane) * 8) = o; }
    }
}
__device__ __forceinline__ void p0_part_b(Frame& F) {
    LAS float* scr = (LAS float*)(F.lds + RING_OFF + F.wave * 16896);
    const int gw = blockIdx.x * NWAVES + F.wave, NGW = F.G * NWAVES;
    unsigned char* ws = F.ws;
    constexpr int I_IN = (DM / 128) * (INW / 32), I_O = (DM / 128) * (DM / 32), I_Q = (DM / 128) * (2048 / 32), I_P = 4 * (128 / 64) * (256 / 32);
    constexpr int NITEMS = I_IN + I_O + I_Q + I_P;
    for (int it = gw; it < NITEMS; it += NGW) {
        int r = it;
        if (r < I_IN) { p0_transpose_q8_item(F.w_in, INW, F.norm1_g, (unsigned*)(ws + WS_CMAX), (float*)(ws + WS_CS), ws + WS_W1T, 1, scr, r, F.lane); continue; } r -= I_IN;
        if (r < I_O) { p0_transpose_q8_item(F.w_out, DM, nullptr, (unsigned*)(ws + WS_CMAX3), (float*)(ws + WS_CS3), ws + WS_WOT, 0, scr, r, F.lane); continue; } r -= I_O;
        if (r < I_Q) { p0_transpose_q8_item(F.w_query, 2048, F.norm2_g, (unsigned*)(ws + WS_CMAX2), (float*)(ws + WS_CS2), ws + WS_WQT, 0, scr, r, F.lane); continue; } r -= I_Q;
        { const int g = r / 16, ri = r % 16;
          p0_transpose_item(F.w_pool + (size_t)g * 128 * 256, 128, 256, nullptr, F.pool_scale + g * 256, (bf16*)(ws + WS_WPT) + (size_t)g * 256 * 128, 0, scr, ri, F.lane); }
    }
}

constexpr int ATT_NK = 384, ATT_K_OFF = 0, ATT_V_OFF = ATT_NK * 128;
typedef short v4i16_t __attribute__((ext_vector_type(4)));
__device__ __forceinline__ s16x4 vtr(unsigned ldsaddr) { return __builtin_bit_cast(s16x4, __builtin_amdgcn_ds_read_tr16_b64_v4i16((LAS v4i16_t*)(uintptr_t)ldsaddr)); }
struct AttnU { int p, b, h, dil, r, bp; };
__device__ __forceinline__ AttnU attn_decode(int unit) {
    AttnU u; const int idx = unit & 31; int t1 = unit >> 5; u.h = t1 & 15; t1 >>= 4; u.b = t1 & 7; u.p = t1 >> 3;
    const int dl = (u.p == 0) ? 0 : (u.p == 1 ? 2 : 4); u.dil = 1 << dl; const int nbp = 32 >> dl; u.r = idx >> (5 - dl); u.bp = idx & (nbp - 1); return u;
}
__device__ __forceinline__ void attn_load_kv(const AttnU& u, int tid, const unsigned char* __restrict__ K8, const unsigned char* __restrict__ V8, v2u (&kr)[6], v2u (&vr)[6]) {
    const int rsub = tid >> 3, ch = tid & 7;
#pragma unroll
    for (int i = 0; i < 6; ++i) { const int ki = i * 64 + rsub; const int sidx = u.bp * 256 - 128 + ki; const bool ok = sidx >= 0;
        const long pos = ok ? ((long)sidx * u.dil + u.r) : 0; const size_t off = ((size_t)(u.b * 16 + u.h) * 8192 + pos) * 64 + ch * 8;
        kr[i] = *(const GAS v2u*)(K8 + off); vr[i] = *(const GAS v2u*)(V8 + off);
        if (!ok) { kr[i] = (v2u){0u, 0u}; vr[i] = (v2u){0u, 0u}; } }
}
__device__ __forceinline__ void attn_load_q(const AttnU& u, int w, int c32, int hi, const bf16* Qg, bf16x8 (&qf)[4]) {
    const long qt = (long)(u.bp * 256 + 32 * w + c32) * u.dil + u.r;
    const bf16* qp = Qg + ((size_t)((u.p * 8 + u.b) * 16 + u.h) * 8192 + qt) * 64;
#pragma unroll
    for (int d0 = 0; d0 < 4; ++d0) qf[d0] = *(const GAS bf16x8*)(qp + d0 * 16 + hi * 8);
}
__device__ __forceinline__ v4u fp8x8_to_bf16(v2u x) {
    const auto f0 = __builtin_amdgcn_cvt_pk_f32_fp8((int)x.x, false), f1 = __builtin_amdgcn_cvt_pk_f32_fp8((int)x.x, true), f2 = __builtin_amdgcn_cvt_pk_f32_fp8((int)x.y, false), f3 = __builtin_amdgcn_cvt_pk_f32_fp8((int)x.y, true);
    v4u r; r.x = pg8::cvt_pk_bf16(f0[0], f0[1]); r.y = pg8::cvt_pk_bf16(f1[0], f1[1]); r.z = pg8::cvt_pk_bf16(f2[0], f2[1]); r.w = pg8::cvt_pk_bf16(f3[0], f3[1]); return r;
}
__device__ __forceinline__ void attn_body(Frame& F, const AttnU& u, bool has_nn, const AttnU& nn, bool has_nq, const AttnU& nq, v2u (&kr)[6], v2u (&vr)[6], bf16x8 (&qf)[4],
                                          const unsigned char* __restrict__ K8, const unsigned char* __restrict__ V8, bf16* Qg, float* MDd) {
    const int tid = F.tid, lane = F.lane, w = F.wave, c32 = lane & 31, hi = lane >> 5;
    LAS unsigned char* lds = F.lds;
    const int rsub = tid >> 3, ch = tid & 7;
    const int lam = lane & 15;
    const unsigned vbase = (unsigned)(uintptr_t)(lds + ATT_V_OFF) + (unsigned)((4 * hi + (lam >> 2)) * 64 + (16 * ((lane >> 4) & 1) + 4 * (lam & 3)) * 2);
    const int cz = c32 - 4 * hi;
#pragma unroll
    for (int i = 0; i < 6; ++i) { const int ki = i * 64 + rsub;
        *(LAS v4u*)(lds + ATT_K_OFF + ki * 128 + ((ch ^ ((ki >> 1) & 7)) * 16)) = fp8x8_to_bf16(kr[i]);
        *(LAS v4u*)(lds + ATT_V_OFF + (ch >> 2) * (ATT_NK * 64) + ki * 64 + (ch & 3) * 16) = fp8x8_to_bf16(vr[i]); }
    __syncthreads();
    if (has_nn) attn_load_kv(nn, tid, K8, V8, kr, vr);
    const int sidx = u.p * 16 + u.h; const float sexp = sidx < 32 ? 0.125f * (float)(sidx + 1) : 4.0f + 0.25f * (float)(sidx - 31);
    const float slope2 = exp2f(-sexp) * LOG2E * (float)u.dil;
    const float a0 = -slope2 * (float)(128 + cz) - 16.0f;
    f32x16 st[5]; f32x16 a0v;
#pragma unroll
    for (int rr = 0; rr < 16; ++rr) a0v[rr] = a0;
#pragma unroll
    for (int kt = 0; kt < 5; ++kt) {
        const int key = 32 * (w + kt) + c32; const LAS unsigned char* kb = lds + ATT_K_OFF + key * 128; const int sw = (key >> 1) & 7;
        f32x16 a;
#pragma unroll
        for (int d0 = 0; d0 < 4; ++d0) { const bf16x8 kf = *(const LAS bf16x8*)(kb + (((2 * d0 + hi) ^ sw) * 16)); a = __builtin_amdgcn_mfma_f32_32x32x16_bf16(kf, qf[d0], d0 == 0 ? a0v : a, 0, 0, 0); }
        st[kt] = a;
    }
    if (has_nq) attn_load_q(nq, w, c32, hi, Qg, qf);
    float l = 0.f;
#pragma unroll
    for (int kt = 0; kt < 5; ++kt) {
        float lt = 0.f;
#pragma unroll
        for (int rr = 0; rr < 16; ++rr) { const int rc = (rr & 3) + 8 * (rr >> 2);
            float e = __builtin_amdgcn_exp2f(fmaf(slope2, (float)(32 * kt + rc), st[kt][rr]));
            if (kt == 0) e = (rc >= cz) ? e : 0.f;
            if (kt == 4) e = (rc <= cz) ? e : 0.f;
            st[kt][rr] = e; lt += e; }
        l += ((u.bp == 0) && (w + kt < 4)) ? 0.f : lt;
    }
    l = xhalf_sum(l);
    f32x16 o[2]; o[0] = f32x16{}; o[1] = f32x16{};
#pragma unroll
    for (int kt = 0; kt < 5; ++kt)
#pragma unroll
        for (int s2 = 0; s2 < 2; ++s2) {
            v4u pw; pw.x = pg8::cvt_pk_bf16(st[kt][8 * s2 + 0], st[kt][8 * s2 + 1]); pw.y = pg8::cvt_pk_bf16(st[kt][8 * s2 + 2], st[kt][8 * s2 + 3]);
            pw.z = pg8::cvt_pk_bf16(st[kt][8 * s2 + 4], st[kt][8 * s2 + 5]); pw.w = pg8::cvt_pk_bf16(st[kt][8 * s2 + 6], st[kt][8 * s2 + 7]);
            const bf16x8 pf = __builtin_bit_cast(bf16x8, pw);
#pragma unroll
            for (int dt = 0; dt < 2; ++dt) {
                const unsigned a = vbase + (unsigned)(dt * (ATT_NK * 64) + (32 * (w + kt) + 16 * s2) * 64);
                const s16x4 lo = vtr(a), hi4 = vtr(a + 8 * 64);
                const bf16x8 vf = (bf16x8){lo[0], lo[1], lo[2], lo[3], hi4[0], hi4[1], hi4[2], hi4[3]};
                o[dt] = __builtin_amdgcn_mfma_f32_32x32x16_bf16(vf, pf, o[dt], 0, 0, 0);
            }
        }
    const float inv = 1.0f / l;
    const long qt = (long)(u.bp * 256 + 32 * w + c32) * u.dil + u.r; const long qrow = (long)u.b * SEQ + qt;
    bf16* qp = Qg + ((size_t)((u.p * 8 + u.b) * 16 + u.h) * 8192 + qt) * 64;
#pragma unroll
    for (int dt = 0; dt < 2; ++dt)
#pragma unroll
        for (int g = 0; g < 4; ++g) { v2u ow; ow.x = pg8::cvt_pk_bf16(o[dt][4 * g] * inv, o[dt][4 * g + 1] * inv); ow.y = pg8::cvt_pk_bf16(o[dt][4 * g + 2] * inv, o[dt][4 * g + 3] * inv);
            *(GAS v2u*)(qp + 32 * dt + 8 * g + 4 * hi) = ow; }
    if (hi == 0) { const size_t mi = ((size_t)u.p * T + (size_t)qrow) * 16 + u.h; __hip_atomic_store(MDd + mi, l, __ATOMIC_RELAXED, __HIP_MEMORY_SCOPE_AGENT); }
    __syncthreads();
}
__device__ __forceinline__ void attn_phase(Frame& F, int u0, int u1, bool xl, const bf16* Kg, const bf16* Vg, bf16* Qg, float* MDm, float* MDd) {
    if (u0 >= u1) return;
    const int xrank = (int)blockIdx.x >> 3, xbh0 = ((int)blockIdx.x & 7) * 16;
#define ATT_UMAP(i_) (xl ? ((((i_) % 3) * 128 + xbh0 + (i_) / 3) * 32 + xrank) : (i_))
    const int tid = F.tid, lane = F.lane, w = F.wave, c32 = lane & 31, hi = lane >> 5;
    const unsigned char* K8 = (const unsigned char*)Kg; const unsigned char* V8 = (const unsigned char*)Vg;
    v2u krA[6], vrA[6], krB[6], vrB[6]; bf16x8 qf[4];
    AttnU uA = attn_decode(ATT_UMAP(u0)), uB = uA;
    attn_load_kv(uA, tid, K8, V8, krA, vrA); attn_load_q(uA, w, c32, hi, Qg, qf);
    if (u0 + 1 < u1) { uB = attn_decode(ATT_UMAP(u0 + 1)); attn_load_kv(uB, tid, K8, V8, krB, vrB); }
#pragma unroll 1
    for (int uu = u0; uu < u1; uu += 2) {
        { const AttnU cur = uA; const bool nx = uu + 2 < u1; if (nx) uA = attn_decode(ATT_UMAP(uu + 2));
          attn_body(F, cur, nx, uA, uu + 1 < u1, uB, krA, vrA, qf, K8, V8, Qg, MDd); }
        if (uu + 1 < u1) { const AttnU cur = uB; const bool nx = uu + 3 < u1; if (nx) uB = attn_decode(ATT_UMAP(uu + 3));
          attn_body(F, cur, nx, uB, uu + 2 < u1, uA, krB, vrB, qf, K8, V8, Qg, MDd); }
    }
#undef ATT_UMAP
}

constexpr int PB_AIN_PITCH = 272, PB_POOL_OFF = 40960, PB_POOL_PITCH = 528;
__device__ __forceinline__ void pool_merge_unit(Frame& F, int unit, const bf16* AIN, const bf16* Wpt, const bf16* OP, const bf16* Gt, const float* MDm, const float* MDd, bf16* MERGED) {
    const int tid = F.tid, lane = F.lane, w = F.wave, c32 = lane & 31, hi = lane >> 5;
    const int g = unit & 3, tile = unit >> 2, t0 = tile * 128, tin = t0 & (SEQ - 1), win = 2 << g;
    LAS unsigned char* lds = F.lds;
    for (int id = tid; id < 143 * 16; id += NWAVES * 64) { const int rr = id >> 4, ch = id & 15; v4u v = (v4u){0u, 0u, 0u, 0u};
        if (tin - 15 + rr >= 0) v = *(const GAS v4u*)(AIN + (size_t)(t0 - 15 + rr) * POOLW + g * 128 + ch * 8);
        *(LAS v4u*)(lds + rr * PB_AIN_PITCH + ch * 16) = v; }
    __syncthreads();
    {
        const int tq = w & 3, oh = w >> 2, tokl = 32 * tq + c32;
        const int cnt = (tin + tokl + 1) < win ? (tin + tokl + 1) : win; const float rc = 1.0f / (float)cnt;
        f32x16 acc[4]; acc[0] = f32x16{}; acc[1] = f32x16{}; acc[2] = f32x16{}; acc[3] = f32x16{};
        const bf16* wp = Wpt + (size_t)(g * 256 + oh * 128 + c32) * 128 + 8 * hi;
#pragma unroll 1
        for (int ks = 0; ks < 8; ++ks) {
            const LAS unsigned char* ap = lds + (15 + tokl) * PB_AIN_PITCH + (16 * ks + 8 * hi) * 2;
            const v4u own = *(const LAS v4u*)ap;
            float s[8] = {0.f, 0.f, 0.f, 0.f, 0.f, 0.f, 0.f, 0.f};
            for (int i = 0; i < win; ++i) { const v4u a = *(const LAS v4u*)(ap - i * PB_AIN_PITCH);
                s[0] += bflo(a.x); s[1] += bfhi(a.x); s[2] += bflo(a.y); s[3] += bfhi(a.y); s[4] += bflo(a.z); s[5] += bfhi(a.z); s[6] += bflo(a.w); s[7] += bfhi(a.w); }
            v4u dw; dw.x = pg8::cvt_pk_bf16(s[0] * rc - bflo(own.x), s[1] * rc - bfhi(own.x)); dw.y = pg8::cvt_pk_bf16(s[2] * rc - bflo(own.y), s[3] * rc - bfhi(own.y));
            dw.z = pg8::cvt_pk_bf16(s[4] * rc - bflo(own.z), s[5] * rc - bfhi(own.z)); dw.w = pg8::cvt_pk_bf16(s[6] * rc - bflo(own.w), s[7] * rc - bfhi(own.w));
            const bf16x8 df = __builtin_bit_cast(bf16x8, dw);
#pragma unroll
            for (int mt = 0; mt < 4; ++mt) { const bf16x8 wf = *(const GAS bf16x8*)(wp + (size_t)(32 * mt) * 128 + 16 * ks); acc[mt] = __builtin_amdgcn_mfma_f32_32x32x16_bf16(wf, df, acc[mt], 0, 0, 0); }
        }
#pragma unroll
        for (int mt = 0; mt < 4; ++mt)
#pragma unroll
            for (int gq = 0; gq < 4; ++gq) { v2u ow; ow.x = pg8::cvt_pk_bf16(acc[mt][4 * gq], acc[mt][4 * gq + 1]); ow.y = pg8::cvt_pk_bf16(acc[mt][4 * gq + 2], acc[mt][4 * gq + 3]);
                *(LAS v2u*)(lds + PB_POOL_OFF + tokl * PB_POOL_PITCH + (oh * 128 + 32 * mt + 8 * gq + 4 * hi) * 2) = ow; }
    }
    __syncthreads();
#pragma unroll 1
    for (int pass = 0; pass < 8; ++pass) {
        const int id = pass * 512 + tid, tok = id >> 5, cc = id & 31, col = g * 256 + 8 * cc, head = col >> 6; const size_t row = (size_t)t0 + tok;
        float wgt[3]; float ws_ = 0.f;
#pragma unroll
        for (int p = 0; p < 3; ++p) { wgt[p] = __hip_atomic_load(MDd + ((size_t)p * T + row) * 16 + head, __ATOMIC_RELAXED, __HIP_MEMORY_SCOPE_AGENT); ws_ += wgt[p]; }
        const float iw = 1.0f / ws_;
        const size_t ob = ((size_t)((row >> 13) * 16 + head) * 8192 + (row & 8191)) * 64 + (col & 63); constexpr size_t PST = (size_t)8 * 16 * 8192 * 64;
        const v4u o0 = *(const GAS v4u*)(OP + ob), o1 = *(const GAS v4u*)(OP + PST + ob), o2 = *(const GAS v4u*)(OP + 2 * PST + ob);
        const v2u g0 = *(const GAS v2u*)((const unsigned char*)Gt + row * GATEW + col), g1 = *(const GAS v2u*)((const unsigned char*)Gt + row * GATEW + 1024 + col);
        const v4u pl = *(const LAS v4u*)(lds + PB_POOL_OFF + tok * PB_POOL_PITCH + cc * 16);
        const float w0 = wgt[0] * iw, w1 = wgt[1] * iw, w2 = wgt[2] * iw;
        v4u res;
#define SIG(x_) __builtin_amdgcn_rcpf(1.0f + __builtin_amdgcn_exp2f(-LOG2E * (x_)))
#define MRG(f, gw, HI) { const float alo = w0 * bflo(o0.f) + w1 * bflo(o1.f) + w2 * bflo(o2.f), ahi = w0 * bfhi(o0.f) + w1 * bfhi(o1.f) + w2 * bfhi(o2.f); \
                 const auto ga = __builtin_amdgcn_cvt_pk_f32_fp8((int)g0.gw, HI), gb = __builtin_amdgcn_cvt_pk_f32_fp8((int)g1.gw, HI); \
                 res.f = pg8::cvt_pk_bf16(SIG(ga[0]) * bflo(pl.f) + SIG(gb[0]) * alo, SIG(ga[1]) * bfhi(pl.f) + SIG(gb[1]) * ahi); }
        MRG(x, x, false) MRG(y, x, true) MRG(z, y, false) MRG(w, y, true)
#undef MRG
#undef SIG
        *(GAS v4u*)(MERGED + row * DM + col) = res;
    }
    __syncthreads();
}


constexpr int PC_AIN_PITCH = 1040, PC_POOL_OFF = 49152, PC_POOL_PITCH = 2064, PC_RMAX_OFF = PC_POOL_OFF + 32 * PC_POOL_PITCH;
__device__ __forceinline__ void pool_merge_unit32(Frame& F, int unit, const bf16* AIN, const bf16* Wpt, const bf16* OP, const bf16* Gt, const float* MDd, unsigned char* M8, float* MS) {
    const int tid = F.tid, lane = F.lane, w = F.wave, c32 = lane & 31, hi = lane >> 5;
    const int t0 = unit * 32, tin = t0 & (SEQ - 1);
    LAS unsigned char* lds = F.lds;
    LAS unsigned* rmax = (LAS unsigned*)(lds + PC_RMAX_OFF);
    {
        v4u tv[6];
#pragma unroll
        for (int i = 0; i < 6; ++i) { const int id = tid + i * NWAVES * 64, rr = id >> 6, ch = id & 63; const int rs_ = (rr < 47) ? rr : 46; const int tr = t0 - 15 + rs_;
            tv[i] = *(const GAS v4u*)(AIN + (size_t)(tr >= 0 ? tr : 0) * POOLW + ch * 8); }
        __builtin_amdgcn_sched_barrier(0);
#pragma unroll
        for (int i = 0; i < 6; ++i) { const int id = tid + i * NWAVES * 64, rr = id >> 6, ch = id & 63;
            if (rr < 47) *(LAS v4u*)(lds + rr * PC_AIN_PITCH + ch * 16) = (tin - 15 + rr >= 0) ? tv[i] : (v4u){0u, 0u, 0u, 0u}; }
        __builtin_amdgcn_sched_barrier(0);
    }
    if (tid < 32) rmax[tid] = 0u;
    __syncthreads();
    {
        const int g = w >> 1, oh = w & 1, win = 2 << g, tokl = c32;
        const int cnt = (tin + tokl + 1) < win ? (tin + tokl + 1) : win; const float rc = 1.0f / (float)cnt;
        f32x16 acc[4]; acc[0] = f32x16{}; acc[1] = f32x16{}; acc[2] = f32x16{}; acc[3] = f32x16{};
        const bf16* wp = Wpt + (size_t)(g * 256 + oh * 128 + c32) * 128 + 8 * hi;
#pragma unroll 1
        for (int ks = 0; ks < 8; ++ks) {
            const LAS unsigned char* ap = lds + (15 + tokl) * PC_AIN_PITCH + (g * 128 + 16 * ks + 8 * hi) * 2;
            const v4u own = *(const LAS v4u*)ap;
            float s[8] = {0.f, 0.f, 0.f, 0.f, 0.f, 0.f, 0.f, 0.f};
            for (int i = 0; i < win; ++i) { const v4u a = *(const LAS v4u*)(ap - i * PC_AIN_PITCH);
                s[0] += bflo(a.x); s[1] += bfhi(a.x); s[2] += bflo(a.y); s[3] += bfhi(a.y); s[4] += bflo(a.z); s[5] += bfhi(a.z); s[6] += bflo(a.w); s[7] += bfhi(a.w); }
            v4u dw; dw.x = pg8::cvt_pk_bf16(s[0] * rc - bflo(own.x), s[1] * rc - bfhi(own.x)); dw.y = pg8::cvt_pk_bf16(s[2] * rc - bflo(own.y), s[3] * rc - bfhi(own.y));
            dw.z = pg8::cvt_pk_bf16(s[4] * rc - bflo(own.z), s[5] * rc - bfhi(own.z)); dw.w = pg8::cvt_pk_bf16(s[6] * rc - bflo(own.w), s[7] * rc - bfhi(own.w));
            const bf16x8 df = __builtin_bit_cast(bf16x8, dw);
#pragma unroll
            for (int mt = 0; mt < 4; ++mt) { const bf16x8 wf = *(const GAS bf16x8*)(wp + (size_t)(32 * mt) * 128 + 16 * ks); acc[mt] = __builtin_amdgcn_mfma_f32_32x32x16_bf16(wf, df, acc[mt], 0, 0, 0); }
        }
#pragma unroll
        for (int mt = 0; mt < 4; ++mt)
#pragma unroll
            for (int gq = 0; gq < 4; ++gq) { v2u ow; ow.x = pg8::cvt_pk_bf16(acc[mt][4 * gq], acc[mt][4 * gq + 1]); ow.y = pg8::cvt_pk_bf16(acc[mt][4 * gq + 2], acc[mt][4 * gq + 3]);
                *(LAS v2u*)(lds + PC_POOL_OFF + tokl * PC_POOL_PITCH + (g * 256 + oh * 128 + 32 * mt + 8 * gq + 4 * hi) * 2) = ow; }
    }
    __syncthreads();
    v4u res[8];
#define SIG(x_) __builtin_amdgcn_rcpf(1.0f + __builtin_amdgcn_exp2f(-LOG2E * (x_)))
#define MRG(f, gw, HI) { const float alo = w0 * bflo(L.o0.f) + w1 * bflo(L.o1.f) + w2 * bflo(L.o2.f), ahi = w0 * bfhi(L.o0.f) + w1 * bfhi(L.o1.f) + w2 * bfhi(L.o2.f); \
                 const auto ga = __builtin_amdgcn_cvt_pk_f32_fp8((int)L.g0.gw, HI), gb = __builtin_amdgcn_cvt_pk_f32_fp8((int)L.g1.gw, HI); \
                 r.f = pg8::cvt_pk_bf16(SIG(ga[0]) * bflo(pl.f) + SIG(gb[0]) * alo, SIG(ga[1]) * bfhi(pl.f) + SIG(gb[1]) * ahi); \
                 mx = fmaxf(mx, fmaxf(fabsf(bflo(r.f)), fabsf(bfhi(r.f)))); }
    struct PcIn { float wg[3]; v4u o0, o1, o2; v2u g0, g1; };
#pragma unroll
    for (int pg = 0; pg < 2; ++pg) {
        PcIn Ls[4];
#pragma unroll
        for (int q = 0; q < 4; ++q) { const int pass = 4 * pg + q; PcIn& L = Ls[q];
            const int tok = pass * 4 + (tid >> 7), cc = tid & 127, col = 8 * cc, head = col >> 6; const size_t row = (size_t)t0 + tok;
#pragma unroll
            for (int p = 0; p < 3; ++p) L.wg[p] = __hip_atomic_load(MDd + ((size_t)p * T + row) * 16 + head, __ATOMIC_RELAXED, __HIP_MEMORY_SCOPE_AGENT);
            const size_t ob = ((size_t)((row >> 13) * 16 + head) * 8192 + (row & 8191)) * 64 + (col & 63); constexpr size_t PST = (size_t)8 * 16 * 8192 * 64;
            L.o0 = *(const GAS v4u*)(OP + ob); L.o1 = *(const GAS v4u*)(OP + PST + ob); L.o2 = *(const GAS v4u*)(OP + 2 * PST + ob);
            L.g0 = *(const GAS v2u*)((const unsigned char*)Gt + row * GATEW + col); L.g1 = *(const GAS v2u*)((const unsigned char*)Gt + row * GATEW + 1024 + col); }
        __builtin_amdgcn_sched_barrier(0);
#pragma unroll
        for (int q = 0; q < 4; ++q) { const int pass = 4 * pg + q; const PcIn& L = Ls[q];
            const int tok = pass * 4 + (tid >> 7), cc = tid & 127;
            const float iw = 1.0f / (L.wg[0] + L.wg[1] + L.wg[2]); const float w0 = L.wg[0] * iw, w1 = L.wg[1] * iw, w2 = L.wg[2] * iw;
            const v4u pl = *(const LAS v4u*)(lds + PC_POOL_OFF + tok * PC_POOL_PITCH + cc * 16);
            v4u r; float mx = 0.f;
            MRG(x, x, false) MRG(y, x, true) MRG(z, y, false) MRG(w, y, true)
            res[pass] = r;
            mx = wave_max_dpp(mx);
            if (lane == 0) (void)__hip_atomic_fetch_max(rmax + tok, __float_as_uint(mx), __ATOMIC_RELAXED, __HIP_MEMORY_SCOPE_WORKGROUP); }
        __builtin_amdgcn_sched_barrier(0);
    }
#undef MRG
#undef SIG
    __syncthreads();
#pragma unroll
    for (int pass = 0; pass < 8; ++pass) {
        const int tok = pass * 4 + (tid >> 7), cc = tid & 127; const size_t row = (size_t)t0 + tok;
        const float rm = __uint_as_float(rmax[tok]); const float inv = rm > 0.f ? 127.0f / rm : 0.f;
        const v4u r = res[pass];
        const int a0 = (int)__builtin_rintf(bflo(r.x) * inv), a1 = (int)__builtin_rintf(bfhi(r.x) * inv), a2 = (int)__builtin_rintf(bflo(r.y) * inv), a3 = (int)__builtin_rintf(bfhi(r.y) * inv);
        const int a4 = (int)__builtin_rintf(bflo(r.z) * inv), a5 = (int)__builtin_rintf(bfhi(r.z) * inv), a6 = (int)__builtin_rintf(bflo(r.w) * inv), a7 = (int)__builtin_rintf(bfhi(r.w) * inv);
        v2u q; q.x = ((unsigned)a0 & 255u) | (((unsigned)a1 & 255u) << 8) | (((unsigned)a2 & 255u) << 16) | ((unsigned)a3 << 24);
        q.y = ((unsigned)a4 & 255u) | (((unsigned)a5 & 255u) << 8) | (((unsigned)a6 & 255u) << 16) | ((unsigned)a7 << 24);
        *(GAS v2u*)(M8 + row * DM + 8 * cc) = q;
    }
    if (tid < 32) MS[t0 + tid] = __uint_as_float(rmax[tid]) * (1.0f / 127.0f);
    __syncthreads();
}

#ifndef P5_LOGNB
#define P5_LOGNB 4
#endif
#define P5_NBUCKET (1 << P5_LOGNB)
#ifndef P5_NSLOT_M
#define P5_NSLOT_M 5
#endif
#define P5_STR2(x) #x
#define P5_STR(x) P5_STR2(x)
#if P5_NSLOT_M == 3
#define P5_VM1 4
#define P5_VM2 2
#define P5_O1 24
#define P5_O2A 3
#define P5_O2B 4
#elif P5_NSLOT_M == 4
#define P5_VM1 6
#define P5_VM2 4
#define P5_O1 32
#define P5_O2A 4
#define P5_O2B 5
#elif P5_NSLOT_M == 5
#define P5_VM1 8
#define P5_VM2 6
#define P5_VM4 2
#define P5_O1 40
#define P5_O2A 5
#define P5_O2B 6
#define P5_O2C 7
#define P5_O2D 8
#endif
constexpr int P5_LIST_WAVE = 1032  , P5_LIST_OFF = 0, P5_RING_OFF = 66048, P5_RING_WAVE = 10240, P5_NSLOT = P5_NSLOT_M, P5_TL_OFF = 147968, P5_S2_OFF = 156160, P5_SH_OFF = 156416, P5_CNT_OFF = 147968  ;
constexpr int P5_DUMMY_OFF = 158720;
constexpr float P5_GSCALE = 256.0f;
__device__ __forceinline__ float gelu_tanh(float x) {
    const float z = 0.7978845608028654f * (x + 0.044715f * x * x * x);
    const float e = __builtin_amdgcn_exp2f(2.0f * LOG2E * z);
    const float th = 1.0f - 2.0f * __builtin_amdgcn_rcpf(1.0f + e);
    return 0.5f * x * (1.0f + th);
}
#define P5_CE(a, b) { const float hi__ = fmaxf(a, b), lo__ = fminf(a, b); a = hi__; b = lo__; }
__device__ __forceinline__ void sort16_desc(float (&v)[16]) {
#pragma unroll
    for (int k = 2; k <= 16; k <<= 1)
#pragma unroll
        for (int j = k >> 1; j > 0; j >>= 1)
#pragma unroll
            for (int i = 0; i < 16; ++i) { const int l = i ^ j; if (l > i) { if ((i & k) == 0) P5_CE(v[i], v[l]) else P5_CE(v[l], v[i]) } }
}
__device__ __forceinline__ void merge_top16(float (&a)[16], const float (&b)[16]) {
#pragma unroll
    for (int i = 0; i < 16; ++i) a[i] = fmaxf(a[i], b[15 - i]);
#pragma unroll
    for (int j = 8; j > 0; j >>= 1)
#pragma unroll
        for (int i = 0; i < 16; ++i) { const int l = i ^ j; if (l > i) P5_CE(a[i], a[l]) }
}
__device__ __forceinline__ void pair_merge_top16(float (&a)[16]) {
    float lo[16], hi[16];
#pragma unroll
    for (int i = 0; i < 16; ++i) { auto t = __builtin_amdgcn_permlane32_swap(__float_as_uint(a[i]), __float_as_uint(a[i]), false, false); lo[i] = __uint_as_float(t[0]); hi[i] = __uint_as_float(t[1]); }
    merge_top16(lo, hi);
#pragma unroll
    for (int i = 0; i < 16; ++i) a[i] = lo[i];
}
__device__ __forceinline__ void peer_stage_a(Frame& F, int t0, int hh, const bf16* QP, const bf16* SKB, const float* SU, const float* SV) {
    int lane = F.lane; asm volatile("" : "+v"(lane));
    const int w = F.wave, c32 = lane & 31, hi = lane >> 5;
    LAS unsigned char* lds = F.lds;
    const LAS float* s2l = (const LAS float*)(lds + P5_S2_OFF);
    float tops[2][16];
#pragma unroll
    for (int p = 0; p < 2; ++p) {
        f32x16 acc[4]; acc[0] = f32x16{}; acc[1] = f32x16{}; acc[2] = f32x16{}; acc[3] = f32x16{};
        const bf16* qrow = QP + (size_t)(t0 + 32 * hh + c32) * 2048 + (w * 2 + p) * 128 + 8 * hi;
        const bf16* skp = SKB + ((size_t)(w * 2 + p) * 32 * 64 + lane) * 8;
#pragma unroll 1
        for (int kg = 0; kg < 2; ++kg) {
            bf16x8 bq[4], af[4][4];
#pragma unroll
            for (int k = 0; k < 4; ++k) { bq[k] = *(const GAS bf16x8*)(qrow + 16 * (4 * kg + k));
#pragma unroll
                for (int mt = 0; mt < 4; ++mt) af[k][mt] = *(const GAS bf16x8*)(skp + (size_t)((4 * kg + k) * 4 + mt) * 512); }
            __builtin_amdgcn_sched_barrier(0);
#pragma unroll
            for (int k = 0; k < 4; ++k)
#pragma unroll
                for (int mt = 0; mt < 4; ++mt) acc[mt] = __builtin_amdgcn_mfma_f32_32x32x16_bf16(af[k][mt], bq[k], acc[mt], 0, 0, 0);
            __builtin_amdgcn_sched_barrier(0);
        }
#pragma unroll
        for (int mt = 0; mt < 4; ++mt)
#pragma unroll
            for (int rr = 0; rr < 16; ++rr) acc[mt][rr] = __uint_as_float((__float_as_uint(acc[mt][rr]) & ~127u) | (unsigned)(32 * mt + crow(rr, hi)));
        {   float g0[16], g1[16], g2[16], g3[16];
#pragma unroll
            for (int rr = 0; rr < 16; ++rr) { g0[rr] = acc[0][rr]; g1[rr] = acc[1][rr]; g2[rr] = acc[2][rr]; g3[rr] = acc[3][rr]; }
            sort16_desc(g0); sort16_desc(g1); sort16_desc(g2); sort16_desc(g3);
            merge_top16(g0, g1); merge_top16(g2, g3); merge_top16(g0, g2);
            pair_merge_top16(g0);
#pragma unroll
            for (int k = 0; k < 16; ++k) tops[p][k] = g0[k];
        }
    }
    {
        v4u tb; unsigned b_[16];
#pragma unroll
        for (int k = 0; k < 16; ++k) b_[k] = __float_as_uint(hi ? tops[1][k] : tops[0][k]) & 127u;
        tb.x = b_[0] | (b_[1] << 8) | (b_[2] << 16) | (b_[3] << 24); tb.y = b_[4] | (b_[5] << 8) | (b_[6] << 16) | (b_[7] << 24);
        tb.z = b_[8] | (b_[9] << 8) | (b_[10] << 16) | (b_[11] << 24); tb.w = b_[12] | (b_[13] << 8) | (b_[14] << 16) | (b_[15] << 24);
        *(LAS v4u*)(lds + P5_TL_OFF + ((c32 * 8 + w) * 2 + hi) * 16) = tb;
    }
    float best[16];
    {   float ca[16], cb[16];
#pragma unroll
        for (int i = 0; i < 16; ++i) { ca[i] = -3.0e38f; cb[i] = -3.0e38f; }
        int c = 0;
#pragma unroll
        for (int i = 0; i < 16; ++i)
#pragma unroll
            for (int j = 0; j < 16; ++j)
                if ((i + 1) * (j + 1) <= 16) {
                    const float val = tops[0][i] + tops[1][j];
                    const float pk = __uint_as_float((__float_as_uint(val) & ~255u) | (unsigned)(i * 16 + j));
                    const int sl = c >> 1;
                    if (sl < 16) { if ((c & 1) == 0) ca[sl] = pk; else ca[sl] = hi ? pk : ca[sl]; }
                    else         { if ((c & 1) == 0) cb[sl - 16] = pk; else cb[sl - 16] = hi ? pk : cb[sl - 16]; }
                    ++c;
                }
        sort16_desc(ca); sort16_desc(cb); merge_top16(ca, cb); pair_merge_top16(ca);
#pragma unroll
        for (int k = 0; k < 16; ++k) best[k] = ca[k];
    }
    const int tokc = 32 * hh + c32;
    const float s2v = s2l[tokc] * LOG2E;
    float ge[16]; float gs = 0.f;
#pragma unroll
    for (int k = 0; k < 16; ++k) { ge[k] = __builtin_amdgcn_exp2f((best[k] - best[0]) * s2v); gs += ge[k]; }
    const float gi = 1.0f / gs;
    asm volatile("s_waitcnt lgkmcnt(0)" ::: "memory");
    const LAS unsigned char* tl0 = lds + P5_TL_OFF + ((c32 * 8 + w) * 2) * 16;
    LAS v2u* lst = (LAS v2u*)(lds + P5_LIST_OFF) + (tokc >> 3) * P5_LIST_WAVE + (tokc & 7) * 128 + w * 16 + 8 * hi;
    unsigned ex[8]; float svx[8], sux[8];
#pragma unroll
    for (int k = 0; k < 8; ++k) { const float bsel = hi ? best[k + 8] : best[k]; const unsigned code = __float_as_uint(bsel) & 255u; ex[k] = (unsigned)tl0[code >> 4] * 128u + (unsigned)tl0[16 + (code & 15u)]; }
    __builtin_amdgcn_sched_barrier(0);
#pragma unroll
    for (int k = 0; k < 8; ++k) { svx[k] = SV[ex[k]]; sux[k] = SU[ex[k]]; }
    __builtin_amdgcn_sched_barrier(0);
#pragma unroll
    for (int k = 0; k < 8; ++k) {
        const float gsel = (hi ? ge[k + 8] : ge[k]) * gi;
        const unsigned g16 = (unsigned)__builtin_bit_cast(unsigned short, (_Float16)(gsel * svx[k] * P5_GSCALE)) & 0x7fffu;
        v2u ent; ent.x = (ex[k] << 18) | ((unsigned)(tokc & 7) << 15) | g16; ent.y = __float_as_uint(sux[k]);
        lst[k] = ent;
    }
}
#define P5_BODY(S) { int d_ = 0; \
        d_ = __builtin_amdgcn_sdot4((int)uq.x, (int)hq[S].x, d_, false); d_ = __builtin_amdgcn_sdot4((int)uq.y, (int)hq[S].y, d_, false); \
        d_ = __builtin_amdgcn_sdot4((int)uq.z, (int)hq[S].z, d_, false); d_ = __builtin_amdgcn_sdot4((int)uq.w, (int)hq[S].w, d_, false); \
        d_ += dppi<0xB1>(d_); d_ += dppi<0x4E>(d_); d_ += dppi<0x141>(d_); d_ += dppi<0x140>(d_);              \
        d_ += __builtin_amdgcn_update_dpp(0, d_, 0x142, 0xA, 0xF, false); d_ += __builtin_amdgcn_update_dpp(0, d_, 0x143, 0xC, 0xF, false);     \
        const float x_ = (float)__builtin_amdgcn_readlane(d_, 63) * (su * kx[S]); \
        const float t_ = x_ * fmaf(x_ * x_, -0.10294324f, -2.30220819f);                                        \
        const float cf = gate * x_ * __builtin_amdgcn_rcpf(1.0f + __builtin_amdgcn_exp2f(t_)); \
        const _Float16 ch_ = (_Float16)cf; const h2v cp_ = (h2v){ch_, ch_}; \
        _Pragma("unroll") for (int j_ = 0; j_ < 4; ++j_) { \
        acc[S][2 * j_ + 0] = __builtin_elementwise_fma(cp_, f8h<false>(vq[j_]), acc[S][2 * j_ + 0]); \
        acc[S][2 * j_ + 1] = __builtin_elementwise_fma(cp_, f8h<true>(vq[j_]), acc[S][2 * j_ + 1]); } }
typedef _Float16 h2v __attribute__((ext_vector_type(2)));
template <bool HI> __device__ __forceinline__ h2v f8h(unsigned w) { return __builtin_bit_cast(h2v, __builtin_amdgcn_cvt_scalef32_pk_f16_fp8((int)w, 1.0f, HI)); }
typedef float f32x2v __attribute__((ext_vector_type(2)));
__device__ __forceinline__ void peer_unit(Frame& F, int unit, const bf16* QP, const bf16* SKB, const unsigned char* UQ, const unsigned char* VQ, const float* SU, const float* SV, const bf16* HB, float* out) {
    int lane = F.lane; asm volatile("" : "+v"(lane));
    const int w = F.wave;
    const int t0 = unit * 64;
    LAS unsigned char* lds = F.lds;
    LAS float* s2l = (LAS float*)(lds + P5_S2_OFF);
    LAS unsigned char* ringw = lds + P5_RING_OFF + w * P5_RING_WAVE; LAS float* kxl = (LAS float*)(lds + P5_SH_OFF);
#pragma unroll
    for (int hf = 0; hf < 2; ++hf) {
        f32x4 v[4][4];
#pragma unroll
        for (int q = 0; q < 4; ++q) { const GAS v2u* xr = (const GAS v2u*)(HB + (size_t)(t0 + 8 * w + 4 * hf + q) * DM) + lane;
#pragma unroll
            for (int j = 0; j < 4; ++j) { const v2u hw = xr[64 * j]; v[q][j] = (f32x4){bflo(hw.x), bfhi(hw.x), bflo(hw.y), bfhi(hw.y)}; } }
#pragma unroll
        for (int q = 0; q < 4; ++q) { float s = 0.f, mx = 0.f;
#pragma unroll
            for (int j = 0; j < 4; ++j) { const f32x4 x = v[q][j]; s += (x.x * x.x + x.y * x.y) + (x.z * x.z + x.w * x.w); mx = fmaxf(mx, fmaxf(fmaxf(fabsf(x.x), fabsf(x.y)), fmaxf(fabsf(x.z), fabsf(x.w)))); }
            s = wave_sum_dpp(s); mx = wave_max_dpp(mx);
            const float s2 = 1.0f / sqrtf(s * (1.0f / 1024.0f) + EPS), sh = mx > 0.f ? mx * (1.0f / 127.0f) : 1.0f;
            *(LAS v4u*)(ringw + (4 * hf + q) * 1024 + 16 * lane) = quant16(v[q], 1.0f / sh, 0);
            if (lane == 0) { s2l[8 * w + 4 * hf + q] = s2; kxl[8 * w + 4 * hf + q] = sh * s2; } }
    }
    __syncthreads();
#pragma unroll 1
    for (int hh = 0; hh < 2; ++hh) { peer_stage_a(F, t0, hh, QP, SKB, SU, SV); __syncthreads(); }
    lane = F.lane; asm volatile("" : "+v"(lane));
    LAS v2u* lw = (LAS v2u*)(lds + P5_LIST_OFF) + w * P5_LIST_WAVE;
    constexpr int NBK = P5_NBUCKET, WPL = NBK / 16;
    LAS unsigned* cnt = (LAS unsigned*)(lds + P5_CNT_OFF) + w * (NBK * 4);
#define P5_BIN(x) ((((x) >> (32 - P5_LOGNB)) << 3) | (((x) >> 15) & 7u))
    {
        v2u e16[16];
#pragma unroll
        for (int i = 0; i < 16; ++i) e16[i] = lw[64 * i + lane];
#pragma unroll
        for (int k = 0; k < WPL; ++k) cnt[WPL * lane + k] = 0u;
        asm volatile("s_waitcnt lgkmcnt(0)" ::: "memory");
        unsigned rk[16];
#pragma unroll
        for (int i = 0; i < 16; ++i) { const unsigned bin = P5_BIN(e16[i].x); const unsigned sh = (bin & 1u) * 16u;
            const unsigned old = __hip_atomic_fetch_add(cnt + (bin >> 1), 1u << sh, __ATOMIC_RELAXED, __HIP_MEMORY_SCOPE_WORKGROUP); rk[i] = (old >> sh) & 0xffffu; }
        asm volatile("s_waitcnt lgkmcnt(0)" ::: "memory");
        unsigned cb[2 * WPL]; unsigned tot = 0;
#pragma unroll
        for (int k = 0; k < WPL; ++k) { const unsigned cwd = cnt[WPL * lane + k]; cb[2 * k] = cwd & 0xffffu; cb[2 * k + 1] = cwd >> 16; tot += cb[2 * k] + cb[2 * k + 1]; }
        unsigned incl = tot;
#pragma unroll
        for (int o = 1; o < 64; o <<= 1) { const unsigned t = (unsigned)__shfl_up((int)incl, o); if (lane >= o) incl += t; }
        unsigned run = incl - tot; unsigned stt[2 * WPL];
#pragma unroll
        for (int k = 0; k < 2 * WPL; ++k) { stt[k] = run; run += cb[k]; }
        asm volatile("s_waitcnt lgkmcnt(0)" ::: "memory");
#pragma unroll
        for (int k = 0; k < WPL; ++k) cnt[WPL * lane + k] = stt[2 * k] | (stt[2 * k + 1] << 16);
        asm volatile("s_waitcnt lgkmcnt(0)" ::: "memory");
#pragma unroll
        for (int i = 0; i < 16; ++i) { const unsigned bin = P5_BIN(e16[i].x);
            const unsigned base = (cnt[bin >> 1] >> ((bin & 1u) * 16u)) & 0xffffu; lw[base + rk[i]] = e16[i]; }
        asm volatile("s_waitcnt lgkmcnt(0)" ::: "memory");
        if (lane < 8) lw[1024 + lane] = lw[lane];
        asm volatile("s_waitcnt lgkmcnt(0)" ::: "memory");
    }
#undef P5_BIN
    lane = F.lane; asm volatile("" : "+v"(lane));
    v4u hq[8]; float kx[8];
#pragma unroll
    for (int s = 0; s < 8; ++s) { hq[s] = *(const LAS v4u*)(lds + P5_RING_OFF + w * P5_RING_WAVE + s * 1024 + 16 * lane); kx[s] = ((const LAS float*)(lds + P5_SH_OFF))[8 * w + s]; }
    asm volatile("s_waitcnt lgkmcnt(0)" : "+v"(hq[0]), "+v"(hq[1]), "+v"(hq[2]), "+v"(hq[3]), "+v"(hq[4]), "+v"(hq[5]), "+v"(hq[6]), "+v"(hq[7]) :: "memory");
    h2v acc[8][8];
#pragma unroll
    for (int s = 0; s < 8; ++s)
#pragma unroll
        for (int j = 0; j < 8; ++j) acc[s][j] = (h2v){(_Float16)0.f, (_Float16)0.f};
    asm volatile("s_waitcnt vmcnt(0)" ::: "memory");
    LAS unsigned char* ring = lds + P5_RING_OFF + w * P5_RING_WAVE;
    const unsigned char* uvgl = UQ + 16 * lane;
#define P5_ISSUE(idx, slot_) { const v2u en_ = lw[(idx) & 1023]; const unsigned e_ = (unsigned)__builtin_amdgcn_readfirstlane((int)en_.x) >> 18; \
        const unsigned* gp_ = (const unsigned*)(uvgl + (size_t)e_ * 2048); \
        __builtin_amdgcn_global_load_lds(gp_, (LAS unsigned*)(ring + (slot_) * 2048), 16, 0, 0); \
        __builtin_amdgcn_global_load_lds(gp_, (LAS unsigned*)(ring + (slot_) * 2048), 16, 1024, 0); }
#pragma unroll
    for (int i = 0; i < P5_NSLOT; ++i) P5_ISSUE(i, i)
    int slot = 0, i = 0;
    const unsigned xw = (unsigned)(((blockIdx.x >> 3) & 31) * 8 + w);
    const bool hih = lane >= 32; const unsigned lane16 = 16u * (unsigned)lane; const unsigned ringa = (unsigned)(uintptr_t)ring;
    const unsigned lwa = (unsigned)(uintptr_t)lw;
    const unsigned lwah = lwa + (hih ? 8u : 0u);
    const unsigned lwaq = lwa + 8u * ((unsigned)lane >> 4);
#define P5_DMA(e_, slot_) { const unsigned char* rb_ = UQ + (size_t)(e_) * 2048; const unsigned la_ = ringa + (unsigned)(slot_) * 2048u; unsigned keep_; \
        asm volatile("s_mov_b32 %0, m0\n\ts_mov_b32 m0, %3\n\ts_nop 0\n\tglobal_load_lds_dwordx4 %1, %2\n\tglobal_load_lds_dwordx4 %1, %2 offset:1024\n\ts_mov_b32 m0, %0" \
                     : "=&s"(keep_) : "v"(lane16), "s"(rb_), "s"(la_) : "memory"); }
#define P5_PAIR(S) { v2u ent; unsigned nx_;     \
        asm volatile("ds_read_b64 %0, %2\n\tds_read_b32 %1, %2 offset:" P5_STR(P5_O1) : "=&v"(ent), "=&v"(nx_) : "v"(lwa + 8u * (unsigned)i) : "memory"); \
        asm volatile("s_waitcnt vmcnt(" P5_STR(P5_VM1) ")" ::: "memory"); \
        const v4u uq = *(const LAS v4u*)(ring + slot * 2048 + 16 * lane), vq = *(const LAS v4u*)(ring + slot * 2048 + 1024 + 16 * lane); \
        asm volatile("s_waitcnt lgkmcnt(0)" : "+v"(ent), "+v"(nx_) :: "memory");         \
        const unsigned key = (unsigned)__builtin_amdgcn_readfirstlane((int)ent.x); const float su = __uint_as_float((unsigned)__builtin_amdgcn_readfirstlane((int)ent.y)); \
        P5_DMA((unsigned)__builtin_amdgcn_readfirstlane((int)nx_) >> 18, slot) \
        slot = (slot == P5_NSLOT - 1) ? 0 : slot + 1; \
        const float gate = (float)__builtin_bit_cast(_Float16, (unsigned short)(key & 0x7fffu)); \
        P5_BODY(S) }
#define P5_PAIR2(S) { v2u entl_; v4u nab_;                  \
        asm volatile("ds_read_b64 %0, %2\n\tds_read2_b64 %1, %3 offset0:" P5_STR(P5_O2A) " offset1:" P5_STR(P5_O2B) : "=&v"(entl_), "=&v"(nab_) : "v"(lwah + 8u * (unsigned)i), "v"(lwa + 8u * (unsigned)i) : "memory"); \
        asm volatile("s_waitcnt vmcnt(" P5_STR(P5_VM2) ")" ::: "memory"); \
        const int slotB = (slot == P5_NSLOT - 1) ? 0 : slot + 1; \
        const v4u uqA = *(const LAS v4u*)(ring + slot * 2048 + 16 * lane), vqA = *(const LAS v4u*)(ring + slot * 2048 + 1024 + 16 * lane); \
        const v4u uqB = *(const LAS v4u*)(ring + slotB * 2048 + 16 * lane), vqB = *(const LAS v4u*)(ring + slotB * 2048 + 1024 + 16 * lane); \
        asm volatile("s_waitcnt lgkmcnt(0)" : "+v"(entl_), "+v"(nab_) :: "memory"); \
        P5_DMA((unsigned)__builtin_amdgcn_readfirstlane((int)nab_.x) >> 18, slot) P5_DMA((unsigned)__builtin_amdgcn_readfirstlane((int)nab_.z) >> 18, slotB) \
        slot = (slotB == P5_NSLOT - 1) ? 0 : slotB + 1; \
        int dA_ = 0, dB_ = 0; \
        dA_ = __builtin_amdgcn_sdot4((int)uqA.x, (int)hq[S].x, dA_, false); dB_ = __builtin_amdgcn_sdot4((int)uqB.x, (int)hq[S].x, dB_, false); \
        dA_ = __builtin_amdgcn_sdot4((int)uqA.y, (int)hq[S].y, dA_, false); dB_ = __builtin_amdgcn_sdot4((int)uqB.y, (int)hq[S].y, dB_, false); \
        dA_ = __builtin_amdgcn_sdot4((int)uqA.z, (int)hq[S].z, dA_, false); dB_ = __builtin_amdgcn_sdot4((int)uqB.z, (int)hq[S].z, dB_, false); \
        dA_ = __builtin_amdgcn_sdot4((int)uqA.w, (int)hq[S].w, dA_, false); dB_ = __builtin_amdgcn_sdot4((int)uqB.w, (int)hq[S].w, dB_, false); \
        auto sw_ = __builtin_amdgcn_permlane32_swap((unsigned)dA_, (unsigned)dB_, false, false); int e_ = (int)(sw_[0] + sw_[1]);        \
        e_ += dppi<0xB1>(e_); e_ += dppi<0x4E>(e_); e_ += dppi<0x141>(e_); e_ += dppi<0x140>(e_); \
        e_ += __builtin_amdgcn_update_dpp(0, e_, 0x142, 0xA, 0xF, false);                   \
        const float x_ = (float)e_ * (__uint_as_float(entl_.y) * kx[S]); \
        const float t_ = x_ * fmaf(x_ * x_, -0.10294324f, -2.30220819f); \
        const float cfv_ = (float)__builtin_bit_cast(_Float16, (unsigned short)(entl_.x & 0x7fffu)) * x_ * __builtin_amdgcn_rcpf(1.0f + __builtin_amdgcn_exp2f(t_)); \
        const _Float16 ch_ = (_Float16)cfv_; const unsigned cpk_ = __builtin_bit_cast(unsigned, (h2v){ch_, ch_}); \
        const h2v cpA = __builtin_bit_cast(h2v, (unsigned)__builtin_amdgcn_readlane((int)cpk_, 31)), cpB = __builtin_bit_cast(h2v, (unsigned)__builtin_amdgcn_readlane((int)cpk_, 63)); \
        _Pragma("unroll") for (int j_ = 0; j_ < 4; ++j_) { \
        acc[S][2 * j_ + 0] = __builtin_elementwise_fma(cpB, f8h<false>(vqB[j_]), __builtin_elementwise_fma(cpA, f8h<false>(vqA[j_]), acc[S][2 * j_ + 0])); \
        acc[S][2 * j_ + 1] = __builtin_elementwise_fma(cpB, f8h<true>(vqB[j_]), __builtin_elementwise_fma(cpA, f8h<true>(vqA[j_]), acc[S][2 * j_ + 1])); } }
#define P5_QUAD(S) { v2u entl_; v4u n01_, n23_; \
        asm volatile("ds_read_b64 %0, %3\n\tds_read2_b64 %1, %4 offset0:" P5_STR(P5_O2A) " offset1:" P5_STR(P5_O2B) "\n\tds_read2_b64 %2, %4 offset0:" P5_STR(P5_O2C) " offset1:" P5_STR(P5_O2D) \
                     : "=&v"(entl_), "=&v"(n01_), "=&v"(n23_) : "v"(lwaq + 8u * (unsigned)i), "v"(lwa + 8u * (unsigned)i) : "memory"); \
        asm volatile("s_waitcnt vmcnt(" P5_STR(P5_VM4) ")" ::: "memory"); \
        const int s1_ = (slot == P5_NSLOT - 1) ? 0 : slot + 1, s2_ = (s1_ == P5_NSLOT - 1) ? 0 : s1_ + 1, s3_ = (s2_ == P5_NSLOT - 1) ? 0 : s2_ + 1; \
        const v4u uqA = *(const LAS v4u*)(ring + slot * 2048 + 16 * lane), vqA = *(const LAS v4u*)(ring + slot * 2048 + 1024 + 16 * lane); \
        const v4u uqB = *(const LAS v4u*)(ring + s1_ * 2048 + 16 * lane), vqB = *(const LAS v4u*)(ring + s1_ * 2048 + 1024 + 16 * lane); \
        const v4u uqC = *(const LAS v4u*)(ring + s2_ * 2048 + 16 * lane), vqC = *(const LAS v4u*)(ring + s2_ * 2048 + 1024 + 16 * lane); \
        const v4u uqD = *(const LAS v4u*)(ring + s3_ * 2048 + 16 * lane), vqD = *(const LAS v4u*)(ring + s3_ * 2048 + 1024 + 16 * lane); \
        asm volatile("s_waitcnt lgkmcnt(0)" : "+v"(entl_), "+v"(n01_), "+v"(n23_) :: "memory"); \
        P5_DMA((unsigned)__builtin_amdgcn_readfirstlane((int)n01_.x) >> 18, slot) P5_DMA((unsigned)__builtin_amdgcn_readfirstlane((int)n01_.z) >> 18, s1_) \
        P5_DMA((unsigned)__builtin_amdgcn_readfirstlane((int)n23_.x) >> 18, s2_) P5_DMA((unsigned)__builtin_amdgcn_readfirstlane((int)n23_.z) >> 18, s3_) \
        slot = (s3_ == P5_NSLOT - 1) ? 0 : s3_ + 1; \
        int dA_ = 0, dB_ = 0, dC_ = 0, dD_ = 0; \
        dA_ = __builtin_amdgcn_sdot4((int)uqA.x, (int)hq[S].x, dA_, false); dB_ = __builtin_amdgcn_sdot4((int)uqB.x, (int)hq[S].x, dB_, false); dC_ = __builtin_amdgcn_sdot4((int)uqC.x, (int)hq[S].x, dC_, false); dD_ = __builtin_amdgcn_sdot4((int)uqD.x, (int)hq[S].x, dD_, false); \
        dA_ = __builtin_amdgcn_sdot4((int)uqA.y, (int)hq[S].y, dA_, false); dB_ = __builtin_amdgcn_sdot4((int)uqB.y, (int)hq[S].y, dB_, false); dC_ = __builtin_amdgcn_sdot4((int)uqC.y, (int)hq[S].y, dC_, false); dD_ = __builtin_amdgcn_sdot4((int)uqD.y, (int)hq[S].y, dD_, false); \
        dA_ = __builtin_amdgcn_sdot4((int)uqA.z, (int)hq[S].z, dA_, false); dB_ = __builtin_amdgcn_sdot4((int)uqB.z, (int)hq[S].z, dB_, false); dC_ = __builtin_amdgcn_sdot4((int)uqC.z, (int)hq[S].z, dC_, false); dD_ = __builtin_amdgcn_sdot4((int)uqD.z, (int)hq[S].z, dD_, false); \
        dA_ = __builtin_amdgcn_sdot4((int)uqA.w, (int)hq[S].w, dA_, false); dB_ = __builtin_amdgcn_sdot4((int)uqB.w, (int)hq[S].w, dB_, false); dC_ = __builtin_amdgcn_sdot4((int)uqC.w, (int)hq[S].w, dC_, false); dD_ = __builtin_amdgcn_sdot4((int)uqD.w, (int)hq[S].w, dD_, false); \
        auto w1_ = __builtin_amdgcn_permlane32_swap((unsigned)dA_, (unsigned)dC_, false, false); const unsigned e1_ = w1_[0] + w1_[1];          \
        auto w2_ = __builtin_amdgcn_permlane32_swap((unsigned)dB_, (unsigned)dD_, false, false); const unsigned e2_ = w2_[0] + w2_[1];          \
        auto w3_ = __builtin_amdgcn_permlane16_swap(e1_, e2_, false, false); int e_ = (int)(w3_[0] + w3_[1]);                                    \
        e_ += dppi<0xB1>(e_); e_ += dppi<0x4E>(e_); e_ += dppi<0x141>(e_); e_ += dppi<0x140>(e_); \
        const float x_ = (float)e_ * (__uint_as_float(entl_.y) * kx[S]); \
        const float t_ = x_ * fmaf(x_ * x_, -0.10294324f, -2.30220819f); \
        const float cfv_ = (float)__builtin_bit_cast(_Float16, (unsigned short)(entl_.x & 0x7fffu)) * x_ * __builtin_amdgcn_rcpf(1.0f + __builtin_amdgcn_exp2f(t_)); \
        const _Float16 ch_ = (_Float16)cfv_; const unsigned cpk_ = __builtin_bit_cast(unsigned, (h2v){ch_, ch_}); \
        const h2v cpA = __builtin_bit_cast(h2v, (unsigned)__builtin_amdgcn_readlane((int)cpk_, 0)), cpB = __builtin_bit_cast(h2v, (unsigned)__builtin_amdgcn_readlane((int)cpk_, 16)); \
        const h2v cpC = __builtin_bit_cast(h2v, (unsigned)__builtin_amdgcn_readlane((int)cpk_, 32)), cpD = __builtin_bit_cast(h2v, (unsigned)__builtin_amdgcn_readlane((int)cpk_, 48)); \
        _Pragma("unroll") for (int j_ = 0; j_ < 4; ++j_) { \
        acc[S][2 * j_ + 0] = __builtin_elementwise_fma(cpD, f8h<false>(vqD[j_]), __builtin_elementwise_fma(cpC, f8h<false>(vqC[j_]), __builtin_elementwise_fma(cpB, f8h<false>(vqB[j_]), __builtin_elementwise_fma(cpA, f8h<false>(vqA[j_]), acc[S][2 * j_ + 0])))); \
        acc[S][2 * j_ + 1] = __builtin_elementwise_fma(cpD, f8h<true>(vqD[j_]), __builtin_elementwise_fma(cpC, f8h<true>(vqC[j_]), __builtin_elementwise_fma(cpB, f8h<true>(vqB[j_]), __builtin_elementwise_fma(cpA, f8h<true>(vqA[j_]), acc[S][2 * j_ + 1])))); } }
#define P5_RUN(S, END) { _Pragma("unroll 1") for (; i + 3 < (END); i += 4) P5_QUAD(S) if (i + 1 < (END)) { P5_PAIR2(S) i += 2; } if (i < (END)) { P5_PAIR(S) ++i; } }
#pragma unroll 1
    for (int b = 0; b < NBK; ++b) {
        {
            constexpr int RPB = NEXP / NBK;
#pragma unroll
            for (int k = 0; k < (RPB + 255) / 256; ++k) { const unsigned pe = (unsigned)(((b + 2) & (NBK - 1)) * RPB) + ((xw + 256u * k) & (unsigned)(RPB - 1));
                const unsigned* gp = (const unsigned*)(uvgl + (size_t)pe * 2048);
                __builtin_amdgcn_global_load_lds(gp, (LAS unsigned*)(lds + P5_DUMMY_OFF), 16, 0, 0);
                __builtin_amdgcn_global_load_lds(gp, (LAS unsigned*)(lds + P5_DUMMY_OFF), 16, 1024, 0); } }
        const v4u sw = *(const LAS v4u*)(cnt + 4 * b);
        const unsigned w0 = (unsigned)__builtin_amdgcn_readfirstlane((int)sw.x), w1 = (unsigned)__builtin_amdgcn_readfirstlane((int)sw.y), w2 = (unsigned)__builtin_amdgcn_readfirstlane((int)sw.z), w3 = (unsigned)__builtin_amdgcn_readfirstlane((int)sw.w);
        const unsigned nb = (b == NBK - 1) ? 1024u : ((unsigned)__builtin_amdgcn_readfirstlane((int)cnt[4 * b + 4]) & 0xffffu);
        const int e0 = (int)(w0 >> 16), e1 = (int)(w1 & 0xffffu), e2 = (int)(w1 >> 16), e3 = (int)(w2 & 0xffffu), e4 = (int)(w2 >> 16), e5 = (int)(w3 & 0xffffu), e6 = (int)(w3 >> 16), e7 = (int)nb;
        P5_RUN(0, e0) P5_RUN(1, e1) P5_RUN(2, e2) P5_RUN(3, e3) P5_RUN(4, e4) P5_RUN(5, e5) P5_RUN(6, e6) P5_RUN(7, e7)
    }
#undef P5_RUN
#undef P5_QUAD
#undef P5_PAIR2
#undef P5_PAIR
#undef P5_DMA
    asm volatile("s_waitcnt vmcnt(0)" ::: "memory");
    lane = F.lane; asm volatile("" : "+v"(lane));
    v2u hw[8][4];
#pragma unroll
    for (int s = 0; s < 8; ++s) { const GAS v2u* hrow = (const GAS v2u*)(HB + (size_t)(t0 + 8 * w + s) * DM) + lane;
#pragma unroll
        for (int j = 0; j < 4; ++j) hw[s][j] = hrow[64 * j]; }
#pragma unroll
    for (int s = 0; s < 8; ++s) { GAS f32x4* orow = (GAS f32x4*)(out + (size_t)(t0 + 8 * w + s) * DM) + lane;
#pragma unroll
        for (int j = 0; j < 4; ++j) { f32x4 a = (f32x4){bflo(hw[s][j].x), bfhi(hw[s][j].x), bflo(hw[s][j].y), bfhi(hw[s][j].y)}; const float c = 1.0f / P5_GSCALE;
            a.x += (float)acc[s][2 * j][0] * c; a.y += (float)acc[s][2 * j][1] * c; a.z += (float)acc[s][2 * j + 1][0] * c; a.w += (float)acc[s][2 * j + 1][1] * c; orow[64 * j] = a; } }
    __syncthreads();
}
#undef P5_ISSUE
#undef P5_BODY

#ifndef GEMM_WGM1
#define GEMM_WGM1 2
#endif
#ifndef GEMM_WGM3
#define GEMM_WGM3 2
#endif
#ifndef GEMM_WGM4
#define GEMM_WGM4 2
#endif
#ifndef MK_N_LAUNCHES
#define MK_N_LAUNCHES 1
#endif
constexpr int N_LAUNCHES = MK_N_LAUNCHES;
constexpr int PER_PHASE = 7;
struct Args { const float* in[13]; float* out; unsigned char* ws; int ph_lo, ph_hi; };
__global__ void __launch_bounds__(NWAVES * 64, 2) fwd_megakernel(Args args) {
    extern __shared__ __attribute__((aligned(16))) unsigned char lds[];
    Frame F;
    F.lds = (LAS unsigned char*)lds;
    F.MISC = (volatile LAS unsigned*)(F.lds + MISC_OFF);
    F.tid = threadIdx.x; F.lane = F.tid & 63; F.wave = __builtin_amdgcn_readfirstlane(F.tid >> 6);
    F.G = gridDim.x;
    unsigned char* ws = args.ws; F.ws = ws;
    F.ctl = (gu32*)(ws + WS_CTL);
    F.x = args.in[0]; F.norm1_g = args.in[1]; F.w_in = args.in[2]; F.q_norm_g = args.in[3]; F.k_norm_g = args.in[4]; F.w_pool = args.in[5]; F.pool_scale = args.in[6];
    F.w_out = args.in[7]; F.norm2_g = args.in[8]; F.w_query = args.in[9]; F.sub_keys = args.in[10]; F.expert_u = args.in[11]; F.expert_v = args.in[12]; F.out = args.out;
    for (int u = F.tid; u < (LDS_BYTES - LDSCTL_OFF) / 4; u += NWAVES * 64) ((LAS unsigned*)(F.lds + LDSCTL_OFF))[u] = 0u;
    __syncthreads();
    XcdBarrier bar; bar.bar = (unsigned*)(F.ctl + CW_BAR); bar.x = 0; bar.st = nullptr;
    if (N_LAUNCHES == 1) bar = xcd_barrier_post((unsigned*)(F.ctl + CW_BAR), F.MISC + 8);
#define GRID_BAR() do { if (N_LAUNCHES == 1) xcd_barrier(bar); } while (0)
    const int lo = args.ph_lo, hi = args.ph_hi;
#define IN(k) (lo <= (k) && (k) < hi)
    bf16* const XB = (bf16*)(ws + WS_XB); bf16* const W1T = (bf16*)(ws + WS_W1T); bf16* const WOT = (bf16*)(ws + WS_WOT); bf16* const WQT = (bf16*)(ws + WS_WQT);
    bf16* const AIN = (bf16*)(ws + WS_AIN); bf16* const Qb = (bf16*)(ws + WS_Q); bf16* const Gb = (bf16*)(ws + WS_G);
    bf16* const Kb = (bf16*)args.out; bf16* const Vb = (bf16*)args.out + (size_t)T * DM;
    float* const MDm = (float*)(ws + WS_MD); float* const MDd = MDm + (size_t)3 * T * 16;
    bf16* const MERGED = XB; bf16* const HB = (bf16*)(ws + WS_HB); bf16* const QP = Gb;

    if (IN(0)) { p0_part_a(F); GRID_BAR(); p0_part_b(F); GRID_BAR(); }
    if (IN(1)) {
        pg8::Gemm g{XB, W1T, T, INW, DM / 2}; pg8::StaticOrder S; S.init(T, INW, F.G, (int)blockIdx.x, GEMM_WGM1);
        pg8::EpiProj E{AIN, Qb, Kb, Vb, Gb, F.q_norm_g, F.k_norm_g, (const float*)(ws + WS_S1), (const float*)(ws + WS_CS)};
        pg8::gemm_phase<pg8::EpiProj, pg8::StaticOrder, true, true, true>(F.lds + RING_OFF, g, S, E);
        GRID_BAR();
    }
    if (IN(2)) {
        constexpr int NU = 3 * BATCH * 16 * 32; const int per = (NU + F.G - 1) / F.G; const int u0 = blockIdx.x * per, u1 = (u0 + per) < NU ? (u0 + per) : NU;
        const bool xl = (F.G == 256);
        attn_phase(F, xl ? 0 : u0, xl ? 48 : u1, xl, Kb, Vb, Qb, MDm, MDd);
        GRID_BAR();
    }
    if (IN(3)) {
        constexpr int NU = T / 32; const int per = (NU + F.G - 1) / F.G; const int u0 = blockIdx.x * per, u1 = (u0 + per) < NU ? (u0 + per) : NU;
        for (int u = u0; u < u1; ++u) pool_merge_unit32(F, u, AIN, (const bf16*)(ws + WS_WPT), Qb, Gb, MDd, (unsigned char*)MERGED, (float*)(ws + WS_MS));
        GRID_BAR();
    }
    if (IN(4)) {
        pg8::Gemm g{MERGED, WOT, T, DM, DM / 2}; pg8::StaticOrder S; S.init(T, DM, F.G, (int)blockIdx.x, GEMM_WGM3);
        pg8::EpiOut E{F.x, F.out, HB, (const float*)(ws + WS_XM), (unsigned char*)args.out, (const float*)(ws + WS_MS), (const float*)(ws + WS_CS3)};
        pg8::gemm_phase<pg8::EpiOut, pg8::StaticOrder, true, true, true>(F.lds + RING_OFF, g, S, E);
        GRID_BAR();
    }
    if (IN(5)) {
        pg8::Gemm g{(const bf16*)args.out, WQT, T, 2048, DM / 2}; pg8::StaticOrder S; S.init(T, 2048, F.G, (int)blockIdx.x, GEMM_WGM4);
        pg8::EpiPlainI8 E{QP, 2048, (const float*)(ws + WS_XM), (const float*)(ws + WS_CS2)};
        pg8::gemm_phase<pg8::EpiPlainI8, pg8::StaticOrder, true, true, true>(F.lds + RING_OFF, g, S, E);
        GRID_BAR();
    }
    if (IN(6)) {
        constexpr int NU = T / 64; const int per = (NU + F.G - 1) / F.G; const int u0 = blockIdx.x * per, u1 = (u0 + per) < NU ? (u0 + per) : NU;
        for (int u = u0; u < u1; ++u) peer_unit(F, u, QP, (const bf16*)(ws + WS_SKB), ws + WS_UB, ws + WS_VB, (const float*)(ws + WS_SU), (const float*)(ws + WS_SV), HB, F.out);
    }
#undef IN
#undef GRID_BAR
}

extern "C" void kernel_launch(void* const* d_in, const int* in_sizes, int n_in, void* d_out, int out_size, void* d_ws, size_t ws_size, hipStream_t stream) {
    static int grid = 0;
    if (grid == 0) {
        if (n_in != 13 || in_sizes[0] != T * DM || out_size != T * DM || ws_size < WS_END) {
            fprintf(stderr, "kernel_launch: unexpected shapes (n_in %d, in0 %d, out %d, ws %zu, need %zu); nothing launched\n", n_in, n_in > 0 ? in_sizes[0] : -1, out_size, ws_size, (size_t)WS_END); grid = -1; return; }
        int dev = 0, cus = 0, per_cu = 0;
        if (hipGetDevice(&dev) != hipSuccess || hipDeviceGetAttribute(&cus, hipDeviceAttributeMultiprocessorCount, dev) != hipSuccess) { grid = -1; return; }
        if (hipFuncSetAttribute((const void*)fwd_megakernel, hipFuncAttributeMaxDynamicSharedMemorySize, LDS_BYTES) != hipSuccess) { fprintf(stderr, "kernel_launch: hipFuncSetAttribute failed\n"); grid = -1; return; }
        if (hipOccupancyMaxActiveBlocksPerMultiprocessor(&per_cu, (const void*)fwd_megakernel, NWAVES * 64, LDS_BYTES) != hipSuccess || per_cu < 1) { fprintf(stderr, "kernel_launch: occupancy query reports %d workgroups per CU\n", per_cu); grid = -1; (void)hipGetLastError(); return; }
        (void)hipGetLastError();
        grid = cus;
    }
    if (grid < 0) return;
    if (hipMemsetAsync((char*)d_ws + WS_CTL, 0, CTL_ZERO_BYTES, stream) != hipSuccess) return;
    Args a{};
    for (int i = 0; i < 13; ++i) a.in[i] = (const float*)d_in[i];
    a.out = (float*)d_out; a.ws = (unsigned char*)d_ws;
    for (int li = 0; li < N_LAUNCHES; ++li) {
        a.ph_lo = (N_LAUNCHES == 1) ? 0 : li; a.ph_hi = (N_LAUNCHES == 1) ? PER_PHASE : li + 1;
        hipLaunchKernelGGL(fwd_megakernel, dim3(grid), dim3(NWAVES * 64), LDS_BYTES, stream, a);
    }
}
```

```cpp
#include <hip/hip_runtime.h>
#include <cstdio>
#include <cstdint>
namespace pg8 {
#define PG8_LAS __attribute__((address_space(3)))
typedef unsigned short bf16_t;
typedef short bf16x8 __attribute__((ext_vector_type(8)));
typedef float f32x4 __attribute__((ext_vector_type(4)));
typedef unsigned u32x4 __attribute__((ext_vector_type(4)));
typedef int i32x4 __attribute__((ext_vector_type(4)));
constexpr int BM = 256, BK = 64, HALF = 128, HTB = HALF * BK * 2  , STAGE_BYTES = 8 * HTB, NXCD = 8;

__host__ __device__ __forceinline__ int lds_byte(int r, int c) { const int st = (r >> 4) * 2 + (c >> 5), rr = r & 15, cc = c & 31, ob = rr * 64 + cc * 2; return st * 1024 + (ob ^ (((ob >> 9) & 1) << 5)); }
__host__ __device__ __forceinline__ void stage_rc(int b, int& R, int& C) { const int st = b / 1024, sb = b % 1024, swz = sb ^ (((sb >> 9) & 1) << 5); R = (st >> 1) * 16 + swz / 64; C = (st & 1) * 32 + (swz % 64) / 2; }
__host__ __device__ __forceinline__ int perm32(int rho) { const int n = rho >> 4, i = rho & 15; return 8 * (i >> 2) + 4 * n + (i & 3); }

struct Unit { int pm, pn; };
struct Gemm { const bf16_t* A; const bf16_t* Bt; int M, N, K; };

struct StaticOrder {
    int nM, nN, nwg, G, c, WGM;
    __host__ __device__ void init(int M, int N, int G_, int c_, int wgm_ = 8) { nM = M / BM; nN = N / BM; nwg = nM * nN; G = G_; c = c_; WGM = wgm_; }
    __host__ __device__ bool next(int i, Unit& u) const {
        const long L = (long)i * G + c; if (L >= nwg) return false;
        int wgid = (int)L; { const int q = nwg / NXCD, r = nwg % NXCD, xcd = wgid % NXCD, off = wgid / NXCD; wgid = (xcd < r ? xcd * (q + 1) : r * (q + 1) + (xcd - r) * q) + off; }
        const int nig = WGM * nN, gid = wgid / nig, fm = gid * WGM, gsz = (nM - fm) < WGM ? (nM - fm) : WGM;
        u.pm = fm + ((wgid % nig) % gsz); u.pn = (wgid % nig) / gsz; return true;
    }
    __device__ __forceinline__ void a_ready(const Unit&) const {}
    __device__ __forceinline__ void done(const Unit&) const {}
};
__device__ __forceinline__ unsigned cvt_pk_bf16(float lo, float hi) { unsigned r; asm volatile("v_cvt_pk_bf16_f32 %0, %1, %2" : "=v"(r) : "v"(lo), "v"(hi)); return r; }

typedef float f32x2 __attribute__((ext_vector_type(2)));
__device__ __forceinline__ float xrow16_sum(float x) {
    auto s = __builtin_amdgcn_permlane16_swap(__float_as_uint(x), __float_as_uint(x), false, false);
    x = __uint_as_float(s[0]) + __uint_as_float(s[1]);
    auto t = __builtin_amdgcn_permlane32_swap(__float_as_uint(x), __float_as_uint(x), false, false);
    return __uint_as_float(t[0]) + __uint_as_float(t[1]);
}
struct EpiPlain {
    static constexpr bool PERM = true, AFTER_DRAIN = false;
    bf16_t* O; int ldc;
    __device__ __forceinline__ void operator()(const f32x4 (&acc)[2][2][4][2], const Unit& u, int wr, int wc, int fr, int fq) const {
        const int row0 = u.pm * BM + wr * 64 + fr; const int col0 = u.pn * BM + wc * 32 + 8 * fq;
#pragma unroll
        for (int ai = 0; ai < 2; ++ai)
#pragma unroll
            for (int m = 0; m < 4; ++m) { bf16_t* rowp = O + (size_t)(row0 + ai * HALF + m * 16) * ldc + col0;
#pragma unroll
                for (int bj = 0; bj < 2; ++bj) { const f32x4 v0 = acc[ai][bj][m][0], v1 = acc[ai][bj][m][1];
                    u32x4 w; w.x = cvt_pk_bf16(v0[0], v0[1]); w.y = cvt_pk_bf16(v0[2], v0[3]); w.z = cvt_pk_bf16(v1[0], v1[1]); w.w = cvt_pk_bf16(v1[2], v1[3]);
                    *(u32x4*)(rowp + bj * HALF) = w; } }
    }
};
struct EpiPlainI8 {
    static constexpr bool PERM = true, AFTER_DRAIN = false;
    bf16_t* O; int ldc; const float* xm; const float* cs;
    __device__ __forceinline__ void operator()(const f32x4 (&acc)[2][2][4][2], const Unit& u, int wr, int wc, int fr, int fq) const;
};
struct EpiProj {
    static constexpr bool PERM = true, AFTER_DRAIN = false;
    bf16_t *AIN, *Q, *K, *V, *G; const float* qg; const float* kg; const float* rs; const float* cs;
    __device__ __forceinline__ void operator()(const f32x4 (&acc)[2][2][4][2], const Unit& u, int wr, int wc, int fr, int fq) const {
        const int pn = u.pn; int type, ldc, colt; bf16_t* base;
        if (pn < 2)       { type = 0; base = AIN; ldc = 512;  colt = pn * 256; }
        else if (pn < 14) { type = 1; base = Q;   ldc = 3072; colt = (pn - 2) * 256; }
        else if (pn < 18) { type = 2; base = K;   ldc = 1024; colt = (pn - 14) * 256; }
        else if (pn < 22) { type = 3; base = V;   ldc = 1024; colt = (pn - 18) * 256; }
        else              { type = 4; base = G;   ldc = 2048; colt = (pn - 22) * 256; }
        const int col0 = colt + 64 * wc + 8 * fq;
        const int row0 = u.pm * BM + wr * 64 + fr;
        f32x4 gn[2][2], csv[2][2];
        const float* csp = cs + pn * 256 + 64 * wc + 8 * fq;
#pragma unroll
        for (int bj = 0; bj < 2; ++bj)
#pragma unroll
            for (int n = 0; n < 2; ++n) csv[bj][n] = *(const f32x4*)(csp + 32 * bj + 4 * n);
        float rs8[2][4];
#pragma unroll
        for (int ai = 0; ai < 2; ++ai)
#pragma unroll
            for (int m = 0; m < 4; ++m) rs8[ai][m] = rs[row0 + ai * HALF + m * 16];
        const float* gp = (type == 2) ? kg : qg;
        const float gmul = (type == 1) ? 0.125f * 1.4426950408889634f : 1.0f;
#pragma unroll
        for (int bj = 0; bj < 2; ++bj)
#pragma unroll
            for (int n = 0; n < 2; ++n) gn[bj][n] = *(const f32x4*)(gp + 32 * bj + 8 * fq + 4 * n) * gmul;
#pragma unroll
        for (int ai = 0; ai < 2; ++ai)
#pragma unroll
            for (int m = 0; m < 4; ++m) {
                const int row = row0 + ai * HALF + m * 16;
                f32x4 v[2][2];
#pragma unroll
                for (int bj = 0; bj < 2; ++bj)
#pragma unroll
                    for (int n = 0; n < 2; ++n) { const i32x4 iv = __builtin_bit_cast(i32x4, acc[ai][bj][m][n]); v[bj][n] = (f32x4){(float)iv[0], (float)iv[1], (float)iv[2], (float)iv[3]} * csv[bj][n]; }
                const float rsv = rs8[ai][m];
                if (type == 1 || type == 2) {
                    float ss = 0.f;
#pragma unroll
                    for (int bj = 0; bj < 2; ++bj)
#pragma unroll
                        for (int n = 0; n < 2; ++n) { const f32x4 x = v[bj][n]; ss += (x[0] * x[0] + x[1] * x[1]) + (x[2] * x[2] + x[3] * x[3]); }
                    ss = xrow16_sum(ss);
                    const float rn = __builtin_amdgcn_rsqf(ss * (rsv * rsv * (1.0f / 64.0f)) + 1e-6f) * rsv;
#pragma unroll
                    for (int bj = 0; bj < 2; ++bj)
#pragma unroll
                        for (int n = 0; n < 2; ++n) v[bj][n] = v[bj][n] * rn * gn[bj][n];
                } else {
#pragma unroll
                    for (int bj = 0; bj < 2; ++bj)
#pragma unroll
                        for (int n = 0; n < 2; ++n) v[bj][n] = v[bj][n] * rsv;
                }
                bf16_t* rowp = base + (size_t)row * ldc + col0;
                if (type >= 1 && type <= 3) {
                    const int hh = (colt >> 6) + wc;
                    const int bb = row >> 13, tt = row & 8191;
                    const size_t slab = (type == 1) ? (size_t)((hh >> 4) * 8 + bb) * 16 + (hh & 15) : (size_t)bb * 16 + hh;
                    rowp = base + (slab * 8192 + tt) * 64 + 8 * fq; }
                if (type >= 2) {
                    unsigned char* gp8 = (type == 4) ? (unsigned char*)G + (size_t)row * 2048 + col0 : (unsigned char*)(type == 2 ? K : V) + (((size_t)(row >> 13) * 16 + ((colt >> 6) + wc)) * 8192 + (row & 8191)) * 64 + 8 * fq;
                    typedef unsigned u32x2 __attribute__((ext_vector_type(2)));
#pragma unroll
                    for (int bj = 0; bj < 2; ++bj) { const f32x4 v0 = v[bj][0], v1 = v[bj][1];
                        int p0 = __builtin_amdgcn_cvt_pk_fp8_f32(v0[0], v0[1], 0, false); p0 = __builtin_amdgcn_cvt_pk_fp8_f32(v0[2], v0[3], p0, true);
                        int p1 = __builtin_amdgcn_cvt_pk_fp8_f32(v1[0], v1[1], 0, false); p1 = __builtin_amdgcn_cvt_pk_fp8_f32(v1[2], v1[3], p1, true);
                        *(u32x2*)(gp8 + 32 * bj) = (u32x2){(unsigned)p0, (unsigned)p1}; }
                } else {
#pragma unroll
                for (int bj = 0; bj < 2; ++bj) { const f32x4 v0 = v[bj][0], v1 = v[bj][1];
                    u32x4 w; w.x = cvt_pk_bf16(v0[0], v0[1]); w.y = cvt_pk_bf16(v0[2], v0[3]); w.z = cvt_pk_bf16(v1[0], v1[1]); w.w = cvt_pk_bf16(v1[2], v1[3]);
                    *(u32x4*)(rowp + 32 * bj) = w; }
                }
            }
    }
};
__device__ __forceinline__ float hscale(float xmax) { return (1.25f * xmax + 1.0f) * (1.0f / 127.0f); }
struct EpiOut {
    static constexpr bool PERM = true, AFTER_DRAIN = false;
    const float* x; float* out; bf16_t* hb; const float* xm; unsigned char* hq; const float* ms; const float* cs;
    __device__ __forceinline__ void operator()(const f32x4 (&acc)[2][2][4][2], const Unit& u, int wr, int wc, int fr, int fq) const {
        const int row0 = u.pm * BM + wr * 64 + fr; const int col0 = u.pn * BM + wc * 32 + 8 * fq;
        typedef unsigned u32x2 __attribute__((ext_vector_type(2)));
        float xm8[8], ms8[8];
#pragma unroll
        for (int it = 0; it < 8; ++it) { xm8[it] = xm[row0 + (it >> 2) * HALF + (it & 3) * 16]; ms8[it] = ms[row0 + (it >> 2) * HALF + (it & 3) * 16]; }
        f32x4 csv[2][2];
#pragma unroll
        for (int bj = 0; bj < 2; ++bj)
#pragma unroll
            for (int n = 0; n < 2; ++n) csv[bj][n] = *(const f32x4*)(cs + col0 + bj * HALF + 4 * n);
        f32x4 xc[2][2], xn[2][2];
#pragma unroll
        for (int bj = 0; bj < 2; ++bj) { xc[bj][0] = *(const f32x4*)(x + (size_t)row0 * 1024 + col0 + bj * HALF); xc[bj][1] = *(const f32x4*)(x + (size_t)row0 * 1024 + col0 + bj * HALF + 4); }
#pragma unroll
        for (int it = 0; it < 8; ++it) { const int ai = it >> 2, m = it & 3; const int row = row0 + ai * HALF + m * 16; const size_t off = (size_t)row * 1024 + col0;
            if (it < 7) { const size_t offn = (size_t)(row0 + ((it + 1) >> 2) * HALF + ((it + 1) & 3) * 16) * 1024 + col0;
#pragma unroll
                for (int bj = 0; bj < 2; ++bj) { xn[bj][0] = *(const f32x4*)(x + offn + bj * HALF); xn[bj][1] = *(const f32x4*)(x + offn + bj * HALF + 4); } }
            const float inv = 1.0f / hscale(xm8[it]);
#pragma unroll
            for (int bj = 0; bj < 2; ++bj) {
                const i32x4 i0 = __builtin_bit_cast(i32x4, acc[ai][bj][m][0]), i1 = __builtin_bit_cast(i32x4, acc[ai][bj][m][1]);
                const f32x4 v0 = (f32x4){(float)i0[0], (float)i0[1], (float)i0[2], (float)i0[3]} * (csv[bj][0] * ms8[it]) + xc[bj][0], v1 = (f32x4){(float)i1[0], (float)i1[1], (float)i1[2], (float)i1[3]} * (csv[bj][1] * ms8[it]) + xc[bj][1];
                u32x4 w; w.x = cvt_pk_bf16(v0[0], v0[1]); w.y = cvt_pk_bf16(v0[2], v0[3]); w.z = cvt_pk_bf16(v1[0], v1[1]); w.w = cvt_pk_bf16(v1[2], v1[3]);
                *(u32x4*)(hb + off + bj * HALF) = w;
                unsigned q0 = 0u, q1 = 0u;
#pragma unroll
                for (int e = 0; e < 4; ++e) { q0 = __builtin_amdgcn_cvt_pk_u8_f32(__builtin_amdgcn_fmed3f(__builtin_rintf(fmaf(v0[e], inv, 128.0f)), 1.0f, 255.0f), e, q0);
                                              q1 = __builtin_amdgcn_cvt_pk_u8_f32(__builtin_amdgcn_fmed3f(__builtin_rintf(fmaf(v1[e], inv, 128.0f)), 1.0f, 255.0f), e, q1); }
                *(u32x2*)(hq + off + bj * HALF) = (u32x2){q0 ^ 0x80808080u, q1 ^ 0x80808080u}; }
#pragma unroll
            for (int bj = 0; bj < 2; ++bj) { xc[bj][0] = xn[bj][0]; xc[bj][1] = xn[bj][1]; } }
    }
};
__device__ __forceinline__ void EpiPlainI8::operator()(const f32x4 (&acc)[2][2][4][2], const Unit& u, int wr, int wc, int fr, int fq) const {
    const int row0 = u.pm * BM + wr * 64 + fr; const int col0 = u.pn * BM + wc * 32 + 8 * fq;
    f32x4 csv[2][2];
#pragma unroll
    for (int bj = 0; bj < 2; ++bj)
#pragma unroll
        for (int n = 0; n < 2; ++n) csv[bj][n] = *(const f32x4*)(cs + col0 + bj * HALF + 4 * n);
    float xm8[2][4];
#pragma unroll
    for (int ai = 0; ai < 2; ++ai)
#pragma unroll
        for (int m = 0; m < 4; ++m) xm8[ai][m] = xm[row0 + ai * HALF + m * 16];
#pragma unroll
    for (int ai = 0; ai < 2; ++ai)
#pragma unroll
        for (int m = 0; m < 4; ++m) { const int row = row0 + ai * HALF + m * 16; bf16_t* rowp = O + (size_t)row * ldc + col0; const float rsv = hscale(xm8[ai][m]);
#pragma unroll
            for (int bj = 0; bj < 2; ++bj) { const i32x4 i0 = __builtin_bit_cast(i32x4, acc[ai][bj][m][0]), i1 = __builtin_bit_cast(i32x4, acc[ai][bj][m][1]);
                const f32x4 v0 = (f32x4){(float)i0[0], (float)i0[1], (float)i0[2], (float)i0[3]} * csv[bj][0] * rsv, v1 = (f32x4){(float)i1[0], (float)i1[1], (float)i1[2], (float)i1[3]} * csv[bj][1] * rsv;
                u32x4 w; w.x = cvt_pk_bf16(v0[0], v0[1]); w.y = cvt_pk_bf16(v0[2], v0[3]); w.z = cvt_pk_bf16(v1[0], v1[1]); w.w = cvt_pk_bf16(v1[2], v1[3]);
                *(u32x4*)(rowp + bj * HALF) = w; } }
}
template <class Epi, class Sched, bool ALIGN_EPI = false, bool SP2 = false, bool I8 = false>
__device__ __forceinline__ void gemm_phase(PG8_LAS unsigned char* lds, const Gemm g, const Sched& S, const Epi& E) {
    const int tid = threadIdx.x, wid = __builtin_amdgcn_readfirstlane(tid >> 6), lane = tid & 63, wr = wid >> 2, wc = wid & 3, fr = lane & 15, fq = lane >> 4;
    const int K = g.K, nt = K / BK;
    unsigned voffA[2], voffB[2];
#pragma unroll
    for (int i = 0; i < 2; ++i) { int R, C; stage_rc(tid * 16 + i * 8192, R, C); const int Rb = Epi::PERM ? ((R & ~31) + perm32(R & 31)) : R;
        voffA[i] = (unsigned)(R * K + C) * 2u; voffB[i] = (unsigned)(Rb * K + C) * 2u; }
    const size_t kstep = (size_t)(BK * 2);
    const size_t hstep = (size_t)HALF * K * 2;
    const size_t tstep = 2 * hstep;
    const unsigned ldsw = (unsigned)wid * 1024u;
    const int aoff = lds_byte(wr * 64 + fr, fq * 8), boff = lds_byte(wc * 32 + fr, fq * 8);
#define PG8_SA(b, h) (((b) * 2 + (h)) * HTB)
#define PG8_SB(b, h) ((4 + (b) * 2 + (h)) * HTB)
#define PG8_STAGE(bufoff, gbase, voff) do { _Pragma("unroll") for (int _i = 0; _i < 2; ++_i) \
        __builtin_amdgcn_global_load_lds((const unsigned*)((const char*)(gbase) + (voff)[_i]), (PG8_LAS unsigned*)(lds + (bufoff) + ldsw + _i * 8192), 16, 0, 0); } while (0)
#define PG8_LDA(dst, b, h) do { _Pragma("unroll") for (int m = 0; m < 4; ++m) _Pragma("unroll") for (int k = 0; k < 2; ++k) dst[m][k] = *(const PG8_LAS bf16x8*)(lds + PG8_SA(b, h) + aoff + m * 2048 + k * 1024); } while (0)
#define PG8_LDB(dst, b, h) do { _Pragma("unroll") for (int n = 0; n < 2; ++n) _Pragma("unroll") for (int k = 0; k < 2; ++k) dst[n][k] = *(const PG8_LAS bf16x8*)(lds + PG8_SB(b, h) + boff + n * 2048 + k * 1024); } while (0)
#define PG8_MMA(ai, bj, At, Bt) do { __builtin_amdgcn_s_setprio(1); _Pragma("unroll") for (int m = 0; m < 4; ++m) _Pragma("unroll") for (int n = 0; n < 2; ++n) _Pragma("unroll") for (int k = 0; k < 2; ++k) \
        { if constexpr (I8) acc[ai][bj][m][n] = __builtin_bit_cast(f32x4, __builtin_amdgcn_mfma_i32_16x16x64_i8(__builtin_bit_cast(i32x4, Bt[n][k]), __builtin_bit_cast(i32x4, At[m][k]), __builtin_bit_cast(i32x4, acc[ai][bj][m][n]), 0, 0, 0)); \
          else acc[ai][bj][m][n] = __builtin_amdgcn_mfma_f32_16x16x32_bf16(Bt[n][k], At[m][k], acc[ai][bj][m][n], 0, 0, 0); } __builtin_amdgcn_s_setprio(0); } while (0)
#define PG8_WAIT_V(n) asm volatile("s_waitcnt vmcnt(" #n ")" ::: "memory")
#define PG8_WAIT_L(n) asm volatile("s_waitcnt lgkmcnt(" #n ")" ::: "memory")
#define PG8_BAR __builtin_amdgcn_s_barrier()
#define PG8_SCHED __builtin_amdgcn_sched_barrier(0)
    Unit cur, nxt; int ui = 0;
    if (!S.next(0, cur)) return;
    f32x4 acc[2][2][4][2];
#pragma unroll
    for (int a = 0; a < 2; ++a)
#pragma unroll
        for (int b = 0; b < 2; ++b)
#pragma unroll
            for (int m = 0; m < 4; ++m)
#pragma unroll
                for (int n = 0; n < 2; ++n) acc[a][b][m][n] = (f32x4){0.f, 0.f, 0.f, 0.f};
    bf16x8 At[4][2], B0[2][2], B1[2][2];
    const char* cA = (const char*)g.A + (size_t)cur.pm * tstep; const char* cB = (const char*)g.Bt + (size_t)cur.pn * tstep;
    S.a_ready(cur);
    if constexpr (SP2) {
        PG8_STAGE(PG8_SB(0, 0), cB, voffB); PG8_STAGE(PG8_SB(0, 1), cB + hstep, voffB); PG8_STAGE(PG8_SA(0, 0), cA, voffA); PG8_STAGE(PG8_SA(0, 1), cA + hstep, voffA);
        if (wr == 1) PG8_BAR;
        PG8_WAIT_V(2); PG8_BAR;
        PG8_STAGE(PG8_SB(1, 0), cB + kstep, voffB); PG8_STAGE(PG8_SA(1, 0), cA + kstep, voffA); PG8_STAGE(PG8_SB(1, 1), cB + hstep + kstep, voffB);
        PG8_WAIT_V(6); PG8_BAR;
    } else {
        PG8_STAGE(PG8_SB(0, 0), cB, voffB); PG8_STAGE(PG8_SA(0, 0), cA, voffA); PG8_STAGE(PG8_SB(0, 1), cB + hstep, voffB); PG8_STAGE(PG8_SA(0, 1), cA + hstep, voffA);
        if (wr == 1) PG8_BAR;
        PG8_WAIT_V(4); PG8_BAR;
        PG8_STAGE(PG8_SB(1, 0), cB + kstep, voffB); PG8_STAGE(PG8_SA(1, 0), cA + kstep, voffA); PG8_STAGE(PG8_SB(1, 1), cB + hstep + kstep, voffB);
        PG8_WAIT_V(6); PG8_BAR;
    }
    for (;;) {
        const bool has_next = S.next(ui + 1, nxt);
        const char* nA = has_next ? (const char*)g.A + (size_t)nxt.pm * tstep : cA; const char* nB = has_next ? (const char*)g.Bt + (size_t)nxt.pn * tstep : cB;
        for (int t = 0; t < nt; t += 2) {
            const bool last = (t == nt - 2);
            const char* a1 = cA + (size_t)(t + 1) * kstep;
            const char* a2 = last ? nA : cA + (size_t)(t + 2) * kstep; const char* b2 = last ? nB : cB + (size_t)(t + 2) * kstep;
            const char* a3 = a2 + kstep; const char* b3 = b2 + kstep;
            if (last && has_next) S.a_ready(nxt);
            if constexpr (SP2) {
            PG8_LDB(B0, 0, 0); PG8_LDB(B1, 0, 1); PG8_SCHED; PG8_LDA(At, 0, 0); PG8_STAGE(PG8_SA(1, 1), a1 + hstep, voffA);
            PG8_WAIT_V(8); PG8_WAIT_L(0); PG8_BAR; PG8_MMA(0, 0, At, B0); PG8_MMA(0, 1, At, B1); PG8_BAR; PG8_SCHED;
            PG8_LDA(At, 0, 1); PG8_STAGE(PG8_SB(0, 0), b2, voffB); PG8_STAGE(PG8_SB(0, 1), b2 + hstep, voffB); PG8_STAGE(PG8_SA(0, 0), a2, voffA);
            PG8_WAIT_V(8); PG8_WAIT_L(0); PG8_BAR; PG8_MMA(1, 0, At, B0); PG8_MMA(1, 1, At, B1); PG8_BAR; PG8_SCHED;
            PG8_LDB(B0, 1, 0); PG8_LDB(B1, 1, 1); PG8_SCHED; PG8_LDA(At, 1, 0); PG8_STAGE(PG8_SA(0, 1), a2 + hstep, voffA);
            PG8_WAIT_V(8); PG8_WAIT_L(0); PG8_BAR; PG8_MMA(0, 0, At, B0); PG8_MMA(0, 1, At, B1); PG8_BAR; PG8_SCHED;
            PG8_LDA(At, 1, 1); PG8_STAGE(PG8_SB(1, 0), b3, voffB); PG8_STAGE(PG8_SB(1, 1), b3 + hstep, voffB); PG8_STAGE(PG8_SA(1, 0), a3, voffA);
            PG8_WAIT_V(8); PG8_WAIT_L(0); PG8_BAR; PG8_MMA(1, 0, At, B0); PG8_MMA(1, 1, At, B1); PG8_BAR; PG8_SCHED;
            } else {
            PG8_LDB(B0, 0, 0); PG8_SCHED; PG8_LDA(At, 0, 0); PG8_STAGE(PG8_SA(1, 1), a1 + hstep, voffA);
            PG8_WAIT_L(8); PG8_BAR; PG8_WAIT_L(0); PG8_MMA(0, 0, At, B0); PG8_BAR; PG8_SCHED;
            PG8_LDB(B1, 0, 1); PG8_STAGE(PG8_SB(0, 0), b2, voffB);
            PG8_BAR; PG8_WAIT_L(0); PG8_MMA(0, 1, At, B1); PG8_BAR;
            PG8_LDA(At, 0, 1); PG8_STAGE(PG8_SA(0, 0), a2, voffA);
            PG8_BAR; PG8_WAIT_L(0); PG8_MMA(1, 0, At, B0); PG8_BAR; PG8_SCHED;
            PG8_STAGE(PG8_SB(0, 1), b2 + hstep, voffB);
            PG8_WAIT_V(6); PG8_BAR; PG8_MMA(1, 1, At, B1); PG8_BAR;
            PG8_LDB(B0, 1, 0); PG8_SCHED; PG8_LDA(At, 1, 0); PG8_STAGE(PG8_SA(0, 1), a2 + hstep, voffA);
            PG8_WAIT_L(8); PG8_BAR; PG8_WAIT_L(0); PG8_MMA(0, 0, At, B0); PG8_BAR; PG8_SCHED;
            PG8_LDB(B1, 1, 1); PG8_STAGE(PG8_SB(1, 0), b3, voffB);
            PG8_BAR; PG8_WAIT_L(0); PG8_MMA(0, 1, At, B1); PG8_BAR;
            PG8_LDA(At, 1, 1); PG8_STAGE(PG8_SA(1, 0), a3, voffA);
            PG8_BAR; PG8_WAIT_L(0); PG8_MMA(1, 0, At, B0); PG8_BAR; PG8_SCHED;
            PG8_STAGE(PG8_SB(1, 1), b3 + hstep, voffB);
            PG8_WAIT_V(6); PG8_BAR; PG8_MMA(1, 1, At, B1); PG8_BAR;
            }
        }
        if constexpr (ALIGN_EPI) { if (wr == 0) PG8_BAR; }
        if constexpr (!Epi::AFTER_DRAIN) { E(acc, cur, wr, wc, fr, fq); S.done(cur); }
        if (!has_next) break;
#pragma unroll
        for (int a = 0; a < 2; ++a)
#pragma unroll
            for (int b = 0; b < 2; ++b)
#pragma unroll
                for (int m = 0; m < 4; ++m)
#pragma unroll
                    for (int n = 0; n < 2; ++n) acc[a][b][m][n] = (f32x4){0.f, 0.f, 0.f, 0.f};
        cur = nxt; cA = nA; cB = nB; ++ui;
        if constexpr (ALIGN_EPI) { if (wr == 1) PG8_BAR; }
    }
    PG8_WAIT_V(0);
    if constexpr (!ALIGN_EPI) { if (wr == 0) PG8_BAR; }
    PG8_BAR;
    if constexpr (Epi::AFTER_DRAIN) { E.fused(acc, cur, wr, wc, fr, fq, lds, wid, lane); S.done(cur); }
#undef PG8_SA
#undef PG8_SB
#undef PG8_STAGE
#undef PG8_LDA
#undef PG8_LDB
#undef PG8_MMA
#undef PG8_WAIT_V
#undef PG8_WAIT_L
#undef PG8_BAR
#undef PG8_SCHED
}
}

constexpr int NWAVES = 8;
constexpr int BATCH = 8, SEQ = 8192, DM = 1024, T = BATCH * SEQ;
constexpr int INW = 7680, QW = 3072, GATEW = 2048, POOLW = 512;
constexpr int NEXP = 16384;
constexpr float EPS = 1e-6f;
constexpr float LOG2E = 1.4426950408889634f;

constexpr size_t MiB = 1u << 20;
constexpr size_t WS_CTL = 0, CTL_ZERO_BYTES = 1 * MiB;
constexpr size_t WS_W1T = 2 * MiB;
constexpr size_t WS_WOT = 17 * MiB;
constexpr size_t WS_WQT = 19 * MiB;
constexpr size_t WS_WPT = 23 * MiB;
constexpr size_t WS_SKB = 23 * MiB + 512 * 1024;
constexpr size_t WS_S1 = 24 * MiB;
constexpr size_t WS_SU = 24 * MiB + 256 * 1024, WS_SV = 24 * MiB + 512 * 1024;
constexpr size_t WS_UB = 25 * MiB;
constexpr size_t WS_VB = 57 * MiB;
constexpr size_t WS_MD = 89 * MiB;
constexpr size_t WS_XB = 113 * MiB;
constexpr size_t WS_AIN = 241 * MiB;
constexpr size_t WS_Q = 305 * MiB;
constexpr size_t WS_G = 689 * MiB;
constexpr size_t WS_END = 945 * MiB;
constexpr size_t WS_HB = WS_AIN;
constexpr size_t WS_CMAX = 64 * 1024;
constexpr size_t WS_CS = 128 * 1024;
constexpr size_t WS_CMAX2 = 96 * 1024;
constexpr size_t WS_CS2 = 192 * 1024;
constexpr size_t WS_CMAX3 = 104 * 1024;
constexpr size_t WS_CS3 = 200 * 1024;
constexpr size_t WS_MS = 512 * 1024;
constexpr size_t WS_XM = 256 * 1024;

constexpr int CW_BAR = 4096;
constexpr int RING_OFF = 0, RING_BYTES = 131072;
constexpr int LDSCTL_OFF = 162816, MISC_OFF = LDSCTL_OFF + 320;
constexpr int LDS_BYTES = 163840;

#define GAS __attribute__((address_space(1)))
#define LAS __attribute__((address_space(3)))
typedef unsigned short bf16;
typedef unsigned v4u __attribute__((ext_vector_type(4)));
typedef unsigned v2u __attribute__((ext_vector_type(2)));
typedef float f32x4 __attribute__((ext_vector_type(4)));
typedef float f32x16 __attribute__((ext_vector_type(16)));
typedef short bf16x8 __attribute__((ext_vector_type(8)));
typedef short s16x4 __attribute__((ext_vector_type(4)));
typedef __bf16 bf16x2_t __attribute__((ext_vector_type(2)));
typedef GAS unsigned gu32;
#define RLX_AGENT __ATOMIC_RELAXED, __HIP_MEMORY_SCOPE_AGENT
#define LDS_WAIT() asm volatile("s_waitcnt lgkmcnt(0)" ::: "memory")
#define VM_WAIT() asm volatile("s_waitcnt vmcnt(0)" ::: "memory")
__device__ __forceinline__ unsigned f2bf(float f) { unsigned u = __builtin_bit_cast(unsigned, f); return (u + 0x7fffu + ((u >> 16) & 1u)) >> 16; }
__device__ __forceinline__ unsigned pk2(float lo, float hi) { return f2bf(lo) | (f2bf(hi) << 16); }
__device__ __forceinline__ float bflo(unsigned w) { return __uint_as_float(w << 16); }
__device__ __forceinline__ float bfhi(unsigned w) { return __uint_as_float(w & 0xffff0000u); }
__device__ __forceinline__ int crow(int r, int hi) { return (r & 3) + 8 * (r >> 2) + 4 * hi; }
__device__ __forceinline__ float xhalf_max(float x) { auto t = __builtin_amdgcn_permlane32_swap(__float_as_uint(x), __float_as_uint(x), false, false); return fmaxf(__uint_as_float(t[0]), __uint_as_float(t[1])); }
__device__ __forceinline__ float xhalf_sum(float x) { auto t = __builtin_amdgcn_permlane32_swap(__float_as_uint(x), __float_as_uint(x), false, false); return __uint_as_float(t[0]) + __uint_as_float(t[1]); }
__device__ __forceinline__ float wave_sum(float v) {
#pragma unroll
    for (int o = 1; o < 64; o <<= 1) v += __shfl_xor(v, o);
    return v;
}
__device__ __forceinline__ float dot2bf(unsigned a, unsigned b, float acc) { return __builtin_amdgcn_fdot2_f32_bf16(__builtin_bit_cast(bf16x2_t, a), __builtin_bit_cast(bf16x2_t, b), acc, false); }

#define XB_TMO      128
#define XB_XCNT(j)  (256  + 64 * (j))
#define XB_XSUB(j)  (1280 + 64 * (j))
#define XB_XGEN(j)  (2304 + 64 * (j))
#define XB_TOP      3328
#define XB_TOPGEN   3392
#define XCD_BAR_WORDS 3456
#define XB_SPIN_CAP (1u << 18)

__device__ __forceinline__ unsigned xb_ld(unsigned* p)              { return __hip_atomic_load(p, __ATOMIC_RELAXED, __HIP_MEMORY_SCOPE_AGENT); }
__device__ __forceinline__ unsigned xb_add(unsigned* p, unsigned v) { return __hip_atomic_fetch_add(p, v, __ATOMIC_RELAXED, __HIP_MEMORY_SCOPE_AGENT); }
__device__ __forceinline__ unsigned xb_xcc_id() { return (unsigned)__builtin_amdgcn_s_getreg((3 << 11) | 20) & 0xFu; }
#define XB_SPIN(cond, bar) do { unsigned _sp = 0; while (cond) { __builtin_amdgcn_s_sleep(1); \
    if ((++_sp & 255u) == 0u) { if (xb_ld(&(bar)[XB_TMO])) break; if (_sp > XB_SPIN_CAP) { atomicAdd(&(bar)[XB_TMO], 1u); break; } } } } while (0)

struct XcdBarrier {
    unsigned* bar; unsigned x;
    volatile LAS unsigned* st;
};

__device__ __forceinline__ XcdBarrier xcd_barrier_post(unsigned* bar, volatile LAS unsigned* st) {
    XcdBarrier b; b.bar = bar; b.x = xb_xcc_id(); b.st = st;
    if (threadIdx.x == 0) (void)xb_add(&bar[XB_XCNT(b.x)], 1u);
    return b;
}
__device__ __forceinline__ void xcd_barrier_complete(unsigned* bar, unsigned x, unsigned& nloc, unsigned& nx) {
    const unsigned G = gridDim.x * gridDim.y * gridDim.z;
    unsigned sum, cnt, mine, sp = 0u;
    for (;;) {
        sum = 0u; cnt = 0u; mine = 0u;
#pragma unroll
        for (unsigned j = 0; j < 16; ++j) { const unsigned c = xb_ld(&bar[XB_XCNT(j)]); sum += c; cnt += (c > 0u) ? 1u : 0u; mine = (j == x) ? c : mine; }
        if (sum == G) break;
        __builtin_amdgcn_s_sleep(1);
        if ((++sp & 255u) == 0u) { if (xb_ld(&bar[XB_TMO])) break; if (sp > XB_SPIN_CAP) { atomicAdd(&bar[XB_TMO], 1u); break; } }
    }
    nloc = mine > 0u ? mine : 1u; nx = cnt > 0u ? cnt : 1u;
}

__device__ __forceinline__ void xcd_barrier(const XcdBarrier& b) {
    asm volatile("s_waitcnt vmcnt(0)" ::: "memory");
    __syncthreads();
    if (threadIdx.x == 0) {
        unsigned* bar = b.bar;
        __builtin_amdgcn_s_waitcnt(0);
        unsigned nloc = b.st[0], nx = b.st[1];
        if (nloc == 0u) { xcd_barrier_complete(bar, b.x, nloc, nx); b.st[0] = nloc; b.st[1] = nx; }
        const unsigned old = xb_add(&bar[XB_XSUB(b.x)], 1u);
        const unsigned gen = old / nloc;
        if (old + 1u == (gen + 1u) * nloc) {
            __builtin_amdgcn_fence(__ATOMIC_RELEASE, "agent");
            asm volatile("s_waitcnt vmcnt(0)" ::: "memory");
            const unsigned og = xb_add(&bar[XB_TOP], 1u);
            const unsigned tg = og / nx;
            if (og + 1u == (tg + 1u) * nx) xb_add(&bar[XB_TOPGEN], 1u);
            else XB_SPIN(xb_ld(&bar[XB_TOPGEN]) == tg, bar);
            __builtin_amdgcn_fence(__ATOMIC_ACQUIRE, "agent");
            xb_add(&bar[XB_XGEN(b.x)], 1u);
            asm volatile("s_waitcnt vmcnt(0)" ::: "memory");
        } else {
            XB_SPIN(xb_ld(&bar[XB_XGEN(b.x)]) == gen, bar);
            __builtin_amdgcn_fence(__ATOMIC_ACQUIRE, "agent");
            asm volatile("s_waitcnt vmcnt(0)" ::: "memory");
        }
    }
    __syncthreads();
}

struct Frame {
    LAS unsigned char* lds;
    volatile LAS unsigned* MISC;
    gu32* ctl;
    int tid, lane, wave, G;
    const float *x, *norm1_g, *w_in, *q_norm_g, *k_norm_g, *w_pool, *pool_scale, *w_out, *norm2_g, *w_query, *sub_keys, *expert_u, *expert_v;
    float* out; unsigned char* ws;
};
template <int CTRL> __device__ __forceinline__ float dppf(float x) { return __builtin_bit_cast(float, __builtin_amdgcn_mov_dpp(__builtin_bit_cast(int, x), CTRL, 0xf, 0xf, true)); }
__device__ __forceinline__ float wave_sum_dpp(float x) {
    x += dppf<0xB1>(x);
    x += dppf<0x4E>(x);
    x += dppf<0x141>(x);
    x += dppf<0x128>(x);
    return pg8::xrow16_sum(x);
}

__device__ __forceinline__ float wave_max_dpp(float x) {
    x = fmaxf(x, dppf<0xB1>(x)); x = fmaxf(x, dppf<0x4E>(x)); x = fmaxf(x, dppf<0x141>(x)); x = fmaxf(x, dppf<0x128>(x));
    auto s = __builtin_amdgcn_permlane16_swap(__float_as_uint(x), __float_as_uint(x), false, false);
    x = fmaxf(__uint_as_float(s[0]), __uint_as_float(s[1]));
    auto t = __builtin_amdgcn_permlane32_swap(__float_as_uint(x), __float_as_uint(x), false, false);
    return fmaxf(__uint_as_float(t[0]), __uint_as_float(t[1]));
}
template <int CTRL> __device__ __forceinline__ int dppi(int x) { return __builtin_amdgcn_mov_dpp(x, CTRL, 0xf, 0xf, true); }
__device__ __forceinline__ int wave_sum_dpp_i(int x) {
    x += dppi<0xB1>(x); x += dppi<0x4E>(x); x += dppi<0x141>(x); x += dppi<0x128>(x);
    auto s = __builtin_amdgcn_permlane16_swap((unsigned)x, (unsigned)x, false, false); x = (int)(s[0] + s[1]);
    auto t = __builtin_amdgcn_permlane32_swap((unsigned)x, (unsigned)x, false, false); return (int)(t[0] + t[1]);
}
__device__ __forceinline__ v4u quant16(const f32x4 (&v)[4], float inv, int off) {
    v4u o;
#pragma unroll
    for (int j = 0; j < 4; ++j) {
        const int a = (int)__builtin_rintf(v[j].x * inv) + off, b = (int)__builtin_rintf(v[j].y * inv) + off, c = (int)__builtin_rintf(v[j].z * inv) + off, d = (int)__builtin_rintf(v[j].w * inv) + off;
        o[j] = (unsigned)(a & 255) | ((unsigned)(b & 255) << 8) | ((unsigned)(c & 255) << 16) | ((unsigned)(d & 255) << 24);
    }
    return o;
}
__device__ __forceinline__ void p0_quant_row(const float* xrow, const float* gain, unsigned char* orow, float* scale_out, int off, int lane) {
    const GAS f32x4* xr = (const GAS f32x4*)xrow + lane;
    f32x4 v[4]; float mx = 0.f;
#pragma unroll
    for (int j = 0; j < 4; ++j) { v[j] = xr[64 * j]; if (gain) v[j] = v[j] * ((const f32x4*)gain)[64 * j + lane];
        mx = fmaxf(mx, fmaxf(fmaxf(fabsf(v[j].x), fabsf(v[j].y)), fmaxf(fabsf(v[j].z), fabsf(v[j].w)))); }
    mx = wave_max_dpp(mx);
    const float sc = mx > 0.f ? mx * (1.0f / 127.0f) : 1.0f, inv = 1.0f / sc;
    *(GAS v4u*)(orow + 16 * lane) = quant16(v, inv, off);
    if (lane == 0) __hip_atomic_store(scale_out, sc, __ATOMIC_RELAXED, __HIP_MEMORY_SCOPE_AGENT);
}
__device__ __forceinline__ void p0_fp8_row(const float* xrow, unsigned char* orow, float* scale_out, int lane) {
    const GAS f32x4* xr = (const GAS f32x4*)xrow + lane;
    f32x4 v[4]; float mx = 0.f;
#pragma unroll
    for (int j = 0; j < 4; ++j) { v[j] = xr[64 * j]; mx = fmaxf(mx, fmaxf(fmaxf(fabsf(v[j].x), fabsf(v[j].y)), fmaxf(fabsf(v[j].z), fabsf(v[j].w)))); }
    mx = wave_max_dpp(mx);
    const float sc = mx > 0.f ? mx * (1.0f / 400.0f) : 1.0f, inv = 1.0f / sc;
    v4u o;
#pragma unroll
    for (int j = 0; j < 4; ++j) { int pk = __builtin_amdgcn_cvt_pk_fp8_f32(v[j].x * inv, v[j].y * inv, 0, false); pk = __builtin_amdgcn_cvt_pk_fp8_f32(v[j].z * inv, v[j].w * inv, pk, true); o[j] = (unsigned)pk; }
    *(GAS v4u*)(orow + 16 * lane) = o;
    if (lane == 0) __hip_atomic_store(scale_out, sc, __ATOMIC_RELAXED, __HIP_MEMORY_SCOPE_AGENT);
}
__device__ __forceinline__ void p0_transpose_item(const float* W, int K, int N, const float* rs, const float* cs, bf16* WT, int permute, LAS float* scr, int item, int lane) {
    const int nblk = N / 32, kb = item / nblk, nb = item % nblk, k0 = 64 * kb, n0 = 32 * nb;
    const float csv = cs ? cs[n0 + (lane & 31)] : 1.f;
#pragma unroll 8
    for (int i = 0; i < 32; ++i) { const int kk = 2 * i + (lane >> 5); const float r = rs ? rs[k0 + kk] : 1.f; scr[kk * 33 + (lane & 31)] = W[(size_t)(k0 + kk) * N + n0 + (lane & 31)] * r * csv; }
    LDS_WAIT(); asm volatile("" ::: "memory");
    int nout0 = n0;
    if (permute) { const int gl = (n0 & 255) >> 5; const int gp = 4 * (gl & 1) + (gl >> 1); nout0 = (n0 & ~255) + 32 * gp; }
    const int c = lane & 7;
#pragma unroll
    for (int j = 0; j < 4; ++j) { const int n = (lane >> 3) + 8 * j; const LAS float* s = scr + (8 * c) * 33 + n;
        v4u o; o.x = pk2(s[0 * 33], s[1 * 33]); o.y = pk2(s[2 * 33], s[3 * 33]); o.z = pk2(s[4 * 33], s[5 * 33]); o.w = pk2(s[6 * 33], s[7 * 33]);
        *(GAS v4u*)(WT + (size_t)(nout0 + n) * K + k0 + 8 * c) = o; }
    LDS_WAIT(); asm volatile("" ::: "memory");
}
__device__ __forceinline__ void p0_row(const float* xrow, const float* gain, bf16* orow, bool rms, int lane) {
    const GAS f32x4* xr = (const GAS f32x4*)xrow + lane;
    f32x4 v[4]; float s = 0.f;
#pragma unroll
    for (int j = 0; j < 4; ++j) { v[j] = xr[64 * j]; s += (v[j].x * v[j].x + v[j].y * v[j].y) + (v[j].z * v[j].z + v[j].w * v[j].w); }
    if (rms) { s = wave_sum(s); const float r = 1.0f / sqrtf(s * (1.0f / 1024.0f) + EPS);
#pragma unroll
        for (int j = 0; j < 4; ++j) v[j] = v[j] * r; }
    if (gain) {
#pragma unroll
        for (int j = 0; j < 4; ++j) v[j] = v[j] * ((const f32x4*)gain)[64 * j + lane];
    }
    GAS unsigned long long* o8 = (GAS unsigned long long*)orow + lane;
#pragma unroll
    for (int j = 0; j < 4; ++j) o8[64 * j] = (unsigned long long)pk2(v[j].x, v[j].y) | ((unsigned long long)pk2(v[j].z, v[j].w) << 32);
}
__device__ __forceinline__ void p0_colmax_item(const float* W, int N, const float* rs, unsigned* cmax, int item, int lane) {
    const int nblk = N / 32, kb = item / nblk, nb = item % nblk, k0 = 64 * kb, n0 = 32 * nb;
    float mx = 0.f;
    const int half = lane >> 5, col = lane & 31;
    const int rsreg = rs ? __float_as_int(rs[k0 + lane]) : __float_as_int(1.f);
#pragma unroll
    for (int c = 0; c < 2; ++c) { float wv[16];
#pragma unroll
        for (int j = 0; j < 16; ++j) wv[j] = W[(size_t)(k0 + 2 * (16 * c + j) + half) * N + n0 + col];
        __builtin_amdgcn_sched_barrier(0);
#pragma unroll
        for (int j = 0; j < 16; ++j) { const int i = 16 * c + j; const float r0 = __int_as_float(__builtin_amdgcn_readlane(rsreg, 2 * i)), r1 = __int_as_float(__builtin_amdgcn_readlane(rsreg, 2 * i + 1));
            mx = fmaxf(mx, fabsf(wv[j] * (half ? r1 : r0))); }
        __builtin_amdgcn_sched_barrier(0); }
    mx = xhalf_max(mx);
    if (lane < 32) (void)__hip_atomic_fetch_max(cmax + n0 + lane, __float_as_uint(mx), __ATOMIC_RELAXED, __HIP_MEMORY_SCOPE_AGENT);
}
__device__ __forceinline__ void p0_transpose_q8_item(const float* W, int N, const float* rs, unsigned* cmax, float* cscale, unsigned char* WT, int permute, LAS float* scr, int item, int lane) {
    constexpr int K = 1024;
    const int nblk = N / 32, kb = item / nblk, nb = item % nblk, k0 = 128 * kb, n0 = 32 * nb;
    const float cm = __uint_as_float(__hip_atomic_load(cmax + n0 + (lane & 31), __ATOMIC_RELAXED, __HIP_MEMORY_SCOPE_AGENT));
    const float inv = cm > 0.f ? 127.0f / cm : 0.f;
    if (kb == 0 && lane < 32) cscale[n0 + lane] = cm * (1.0f / 127.0f);
    const int half = lane >> 5, col = lane & 31;
    const int rs0 = rs ? __float_as_int(rs[k0 + lane]) : __float_as_int(1.f), rs1 = rs ? __float_as_int(rs[k0 + 64 + lane]) : __float_as_int(1.f);
#pragma unroll
    for (int c = 0; c < 4; ++c) { float wv[16];
#pragma unroll
        for (int j = 0; j < 16; ++j) wv[j] = W[(size_t)(k0 + 2 * (16 * c + j) + half) * N + n0 + col];
        __builtin_amdgcn_sched_barrier(0);
#pragma unroll
        for (int j = 0; j < 16; ++j) { const int i = 16 * c + j; const int rr = (i < 32) ? rs0 : rs1; const float r0 = __int_as_float(__builtin_amdgcn_readlane(rr, (2 * i) & 63)), r1 = __int_as_float(__builtin_amdgcn_readlane(rr, (2 * i + 1) & 63));
            scr[(2 * i + half) * 33 + col] = __builtin_rintf(wv[j] * (half ? r1 : r0) * inv); }
        __builtin_amdgcn_sched_barrier(0); }
    LDS_WAIT(); asm volatile("" ::: "memory");
    int nout0 = n0;
    if (permute) { const int gl = (n0 & 255) >> 5; const int gp = 4 * (gl & 1) + (gl >> 1); nout0 = (n0 & ~255) + 32 * gp; }
    const int c = lane & 7;
#pragma unroll
    for (int j = 0; j < 4; ++j) { const int n = (lane >> 3) + 8 * j; const LAS float* sp = scr + (16 * c) * 33 + n;
        v4u o;
#pragma unroll
        for (int d = 0; d < 4; ++d) o[d] = ((unsigned)(int)sp[(4 * d) * 33] & 255u) | (((unsigned)(int)sp[(4 * d + 1) * 33] & 255u) << 8) | (((unsigned)(int)sp[(4 * d + 2) * 33] & 255u) << 16) | ((unsigned)(int)sp[(4 * d + 3) * 33] << 24);
        *(GAS v4u*)(WT + (size_t)(nout0 + n) * K + k0 + 16 * c) = o; }
    LDS_WAIT(); asm volatile("" ::: "memory");
}
__device__ __forceinline__ void p0_xrow_q8(const float* xrow, unsigned char* orow, float* rs_out, float* xm_out, int lane) {
    const GAS f32x4* xr = (const GAS f32x4*)xrow + lane;
    f32x4 v[4]; float s = 0.f, mx = 0.f;
#pragma unroll
    for (int j = 0; j < 4; ++j) { v[j] = xr[64 * j]; s += (v[j].x * v[j].x + v[j].y * v[j].y) + (v[j].z * v[j].z + v[j].w * v[j].w);
        mx = fmaxf(mx, fmaxf(fmaxf(fabsf(v[j].x), fabsf(v[j].y)), fmaxf(fabsf(v[j].z), fabsf(v[j].w)))); }
    s = wave_sum_dpp(s); mx = wave_max_dpp(mx);
    const float r = 1.0f / sqrtf(s * (1.0f / 1024.0f) + EPS);
    const float q = mx > 0.f ? mx * (1.0f / 127.0f) : 1.0f, inv = 1.0f / q;
    const v4u o = quant16(v, inv, 0);
#pragma unroll
    for (int j = 0; j < 4; ++j) ((GAS unsigned*)orow)[64 * j + lane] = o[j];
    if (lane == 0) { *xm_out = mx; *rs_out = r * q; }
}
__device__ __forceinline__ void p0_part_a(Frame& F) {
    const int gw = blockIdx.x * NWAVES + F.wave, NGW = F.G * NWAVES;
    unsigned char* ws = F.ws;
    constexpr int I_IN = (DM / 64) * (INW / 32);
    constexpr int I_Q = (DM / 64) * (2048 / 32);
    for (int it = gw; it < I_IN + I_Q; it += NGW) {
        if (it < I_IN) p0_colmax_item(F.w_in, INW, F.norm1_g, (unsigned*)(ws + WS_CMAX), it, F.lane);
        else p0_colmax_item(F.w_query, 2048, F.norm2_g, (unsigned*)(ws + WS_CMAX2), it - I_IN, F.lane);
    }
    constexpr int I_O = (DM / 64) * (DM / 32);
    for (int it = gw; it < I_O; it += NGW) p0_colmax_item(F.w_out, DM, nullptr, (unsigned*)(ws + WS_CMAX3), it, F.lane);
    for (int q = blockIdx.x; q < T / 32; q += F.G)
        for (int i = F.wave; i < 32; i += NWAVES) { const int m = 32 * q + i; p0_xrow_q8(F.x + (size_t)m * DM, ws + WS_XB + (size_t)m * DM, (float*)(ws + WS_S1) + m, (float*)(ws + WS_XM) + m, F.lane); }
    constexpr int NROWS = 2 * NEXP + 512;
    for (int m = gw; m < NROWS; m += NGW) {
        int r = m;
        if (r < NEXP) { p0_quant_row(F.expert_u + (size_t)r * DM, F.norm2_g, ws + WS_UB + (size_t)r * 2048, (float*)(ws + WS_SU) + r, 0, F.lane); continue; } r -= NEXP;
        if (r < NEXP) { p0_fp8_row(F.expert_v + (size_t)r * DM, ws + WS_UB + (size_t)r * 2048 + 1024, (float*)(ws + WS_SV) + r, F.lane); continue; } r -= NEXP;
        {
            const int hp = r >> 5, ks = (r >> 2) & 7, mt = r & 3, key = 32 * mt + (F.lane & 31), d0 = 16 * ks + 8 * (F.lane >> 5);
            const GAS f32x4* sp = (const GAS f32x4*)(F.sub_keys + ((size_t)(hp * 128 + key) * 128 + d0)); const f32x4 a = sp[0], b = sp[1];
            v4u o; o.x = pk2(a.x, a.y); o.y = pk2(a.z, a.w); o.z = pk2(b.x, b.y); o.w = pk2(b.z, b.w);
            *(GAS v4u*)((bf16*)(ws + WS_SKB) + ((size_t)r * 64 + F.lane) * 8) = o; }
    }
}
__device__ __forceinline__ void p0_part_b(Frame& F) {
    LAS float* scr = (LAS float*)(F.lds + RING_OFF + F.wave * 16896);
    const int gw = blockIdx.x * NWAVES + F.wave, NGW = F.G * NWAVES;
    unsigned char* ws = F.ws;
    constexpr int I_IN = (DM / 128) * (INW / 32), I_O = (DM / 128) * (DM / 32), I_Q = (DM / 128) * (2048 / 32), I_P = 4 * (128 / 64) * (256 / 32);
    constexpr int NITEMS = I_IN + I_O + I_Q + I_P;
    for (int it = gw; it < NITEMS; it += NGW) {
        int r = it;
        if (r < I_IN) { p0_transpose_q8_item(F.w_in, INW, F.norm1_g, (unsigned*)(ws + WS_CMAX), (float*)(ws + WS_CS), ws + WS_W1T, 1, scr, r, F.lane); continue; } r -= I_IN;
        if (r < I_O) { p0_transpose_q8_item(F.w_out, DM, nullptr, (unsigned*)(ws + WS_CMAX3), (float*)(ws + WS_CS3), ws + WS_WOT, 0, scr, r, F.lane); continue; } r -= I_O;
        if (r < I_Q) { p0_transpose_q8_item(F.w_query, 2048, F.norm2_g, (unsigned*)(ws + WS_CMAX2), (float*)(ws + WS_CS2), ws + WS_WQT, 0, scr, r, F.lane); continue; } r -= I_Q;
        { const int g = r / 16, ri = r % 16;
          p0_transpose_item(F.w_pool + (size_t)g * 128 * 256, 128, 256, nullptr, F.pool_scale + g * 256, (bf16*)(ws + WS_WPT) + (size_t)g * 256 * 128, 0, scr, ri, F.lane); }
    }
}

constexpr int ATT_NK = 384, ATT_K_OFF = 0, ATT_V_OFF = ATT_NK * 128;
typedef short v4i16_t __attribute__((ext_vector_type(4)));
__device__ __forceinline__ s16x4 vtr(unsigned ldsaddr) { return __builtin_bit_cast(s16x4, __builtin_amdgcn_ds_read_tr16_b64_v4i16((LAS v4i16_t*)(uintptr_t)ldsaddr)); }
struct AttnU { int p, b, h, dil, r, bp; };
__device__ __forceinline__ AttnU attn_decode(int unit) {
    AttnU u; const int idx = unit & 31; int t1 = unit >> 5; u.h = t1 & 15; t1 >>= 4; u.b = t1 & 7; u.p = t1 >> 3;
    const int dl = (u.p == 0) ? 0 : (u.p == 1 ? 2 : 4); u.dil = 1 << dl; const int nbp = 32 >> dl; u.r = idx >> (5 - dl); u.bp = idx & (nbp - 1); return u;
}
__device__ __forceinline__ void attn_load_kv(const AttnU& u, int tid, const unsigned char* __restrict__ K8, const unsigned char* __restrict__ V8, v2u (&kr)[6], v2u (&vr)[6]) {
    const int rsub = tid >> 3, ch = tid & 7;
#pragma unroll
    for (int i = 0; i < 6; ++i) { const int ki = i * 64 + rsub; const int sidx = u.bp * 256 - 128 + ki; const bool ok = sidx >= 0;
        const long pos = ok ? ((long)sidx * u.dil + u.r) : 0; const size_t off = ((size_t)(u.b * 16 + u.h) * 8192 + pos) * 64 + ch * 8;
        kr[i] = *(const GAS v2u*)(K8 + off); vr[i] = *(const GAS v2u*)(V8 + off);
        if (!ok) { kr[i] = (v2u){0u, 0u}; vr[i] = (v2u){0u, 0u}; } }
}
__device__ __forceinline__ void attn_load_q(const AttnU& u, int w, int c32, int hi, const bf16* Qg, bf16x8 (&qf)[4]) {
    const long qt = (long)(u.bp * 256 + 32 * w + c32) * u.dil + u.r;
    const bf16* qp = Qg + ((size_t)((u.p * 8 + u.b) * 16 + u.h) * 8192 + qt) * 64;
#pragma unroll
    for (int d0 = 0; d0 < 4; ++d0) qf[d0] = *(const GAS bf16x8*)(qp + d0 * 16 + hi * 8);
}
__device__ __forceinline__ v4u fp8x8_to_bf16(v2u x) {
    const auto f0 = __builtin_amdgcn_cvt_pk_f32_fp8((int)x.x, false), f1 = __builtin_amdgcn_cvt_pk_f32_fp8((int)x.x, true), f2 = __builtin_amdgcn_cvt_pk_f32_fp8((int)x.y, false), f3 = __builtin_amdgcn_cvt_pk_f32_fp8((int)x.y, true);
    v4u r; r.x = pg8::cvt_pk_bf16(f0[0], f0[1]); r.y = pg8::cvt_pk_bf16(f1[0], f1[1]); r.z = pg8::cvt_pk_bf16(f2[0], f2[1]); r.w = pg8::cvt_pk_bf16(f3[0], f3[1]); return r;
}
__device__ __forceinline__ void attn_body(Frame& F, const AttnU& u, bool has_nn, const AttnU& nn, bool has_nq, const AttnU& nq, v2u (&kr)[6], v2u (&vr)[6], bf16x8 (&qf)[4],
                                          const unsigned char* __restrict__ K8, const unsigned char* __restrict__ V8, bf16* Qg, float* MDd) {
    const int tid = F.tid, lane = F.lane, w = F.wave, c32 = lane & 31, hi = lane >> 5;
    LAS unsigned char* lds = F.lds;
    const int rsub = tid >> 3, ch = tid & 7;
    const int lam = lane & 15;
    const unsigned vbase = (unsigned)(uintptr_t)(lds + ATT_V_OFF) + (unsigned)((4 * hi + (lam >> 2)) * 64 + (16 * ((lane >> 4) & 1) + 4 * (lam & 3)) * 2);
    const int cz = c32 - 4 * hi;
#pragma unroll
    for (int i = 0; i < 6; ++i) { const int ki = i * 64 + rsub;
        *(LAS v4u*)(lds + ATT_K_OFF + ki * 128 + ((ch ^ ((ki >> 1) & 7)) * 16)) = fp8x8_to_bf16(kr[i]);
        *(LAS v4u*)(lds + ATT_V_OFF + (ch >> 2) * (ATT_NK * 64) + ki * 64 + (ch & 3) * 16) = fp8x8_to_bf16(vr[i]); }
    __syncthreads();
    if (has_nn) attn_load_kv(nn, tid, K8, V8, kr, vr);
    const int sidx = u.p * 16 + u.h; const float sexp = sidx < 32 ? 0.125f * (float)(sidx + 1) : 4.0f + 0.25f * (float)(sidx - 31);
    const float slope2 = exp2f(-sexp) * LOG2E * (float)u.dil;
    const float a0 = -slope2 * (float)(128 + cz) - 16.0f;
    f32x16 st[5]; f32x16 a0v;
#pragma unroll
    for (int rr = 0; rr < 16; ++rr) a0v[rr] = a0;
#pragma unroll
    for (int kt = 0; kt < 5; ++kt) {
        const int key = 32 * (w + kt) + c32; const LAS unsigned char* kb = lds + ATT_K_OFF + key * 128; const int sw = (key >> 1) & 7;
        f32x16 a;
#pragma unroll
        for (int d0 = 0; d0 < 4; ++d0) { const bf16x8 kf = *(const LAS bf16x8*)(kb + (((2 * d0 + hi) ^ sw) * 16)); a = __builtin_amdgcn_mfma_f32_32x32x16_bf16(kf, qf[d0], d0 == 0 ? a0v : a, 0, 0, 0); }
        st[kt] = a;
    }
    if (has_nq) attn_load_q(nq, w, c32, hi, Qg, qf);
    float l = 0.f;
#pragma unroll
    for (int kt = 0; kt < 5; ++kt) {
        float lt = 0.f;
#pragma unroll
        for (int rr = 0; rr < 16; ++rr) { const int rc = (rr & 3) + 8 * (rr >> 2);
            float e = __builtin_amdgcn_exp2f(fmaf(slope2, (float)(32 * kt + rc), st[kt][rr]));
            if (kt == 0) e = (rc >= cz) ? e : 0.f;
            if (kt == 4) e = (rc <= cz) ? e : 0.f;
            st[kt][rr] = e; lt += e; }
        l += ((u.bp == 0) && (w + kt < 4)) ? 0.f : lt;
    }
    l = xhalf_sum(l);
    f32x16 o[2]; o[0] = f32x16{}; o[1] = f32x16{};
#pragma unroll
    for (int kt = 0; kt < 5; ++kt)
#pragma unroll
        for (int s2 = 0; s2 < 2; ++s2) {
            v4u pw; pw.x = pg8::cvt_pk_bf16(st[kt][8 * s2 + 0], st[kt][8 * s2 + 1]); pw.y = pg8::cvt_pk_bf16(st[kt][8 * s2 + 2], st[kt][8 * s2 + 3]);
            pw.z = pg8::cvt_pk_bf16(st[kt][8 * s2 + 4], st[kt][8 * s2 + 5]); pw.w = pg8::cvt_pk_bf16(st[kt][8 * s2 + 6], st[kt][8 * s2 + 7]);
            const bf16x8 pf = __builtin_bit_cast(bf16x8, pw);
#pragma unroll
            for (int dt = 0; dt < 2; ++dt) {
                const unsigned a = vbase + (unsigned)(dt * (ATT_NK * 64) + (32 * (w + kt) + 16 * s2) * 64);
                const s16x4 lo = vtr(a), hi4 = vtr(a + 8 * 64);
                const bf16x8 vf = (bf16x8){lo[0], lo[1], lo[2], lo[3], hi4[0], hi4[1], hi4[2], hi4[3]};
                o[dt] = __builtin_amdgcn_mfma_f32_32x32x16_bf16(vf, pf, o[dt], 0, 0, 0);
            }
        }
    const float inv = 1.0f / l;
    const long qt = (long)(u.bp * 256 + 32 * w + c32) * u.dil + u.r; const long qrow = (long)u.b * SEQ + qt;
    bf16* qp = Qg + ((size_t)((u.p * 8 + u.b) * 16 + u.h) * 8192 + qt) * 64;
#pragma unroll
    for (int dt = 0; dt < 2; ++dt)
#pragma unroll
        for (int g = 0; g < 4; ++g) { v2u ow; ow.x = pg8::cvt_pk_bf16(o[dt][4 * g] * inv, o[dt][4 * g + 1] * inv); ow.y = pg8::cvt_pk_bf16(o[dt][4 * g + 2] * inv, o[dt][4 * g + 3] * inv);
            *(GAS v2u*)(qp + 32 * dt + 8 * g + 4 * hi) = ow; }
    if (hi == 0) { const size_t mi = ((size_t)u.p * T + (size_t)qrow) * 16 + u.h; __hip_atomic_store(MDd + mi, l, __ATOMIC_RELAXED, __HIP_MEMORY_SCOPE_AGENT); }
    __syncthreads();
}
__device__ __forceinline__ void attn_phase(Frame& F, int u0, int u1, bool xl, const bf16* Kg, const bf16* Vg, bf16* Qg, float* MDm, float* MDd) {
    if (u0 >= u1) return;
    const int xrank = (int)blockIdx.x >> 3, xbh0 = ((int)blockIdx.x & 7) * 16;
#define ATT_UMAP(i_) (xl ? ((((i_) % 3) * 128 + xbh0 + (i_) / 3) * 32 + xrank) : (i_))
    const int tid = F.tid, lane = F.lane, w = F.wave, c32 = lane & 31, hi = lane >> 5;
    const unsigned char* K8 = (const unsigned char*)Kg; const unsigned char* V8 = (const unsigned char*)Vg;
    v2u krA[6], vrA[6], krB[6], vrB[6]; bf16x8 qf[4];
    AttnU uA = attn_decode(ATT_UMAP(u0)), uB = uA;
    attn_load_kv(uA, tid, K8, V8, krA, vrA); attn_load_q(uA, w, c32, hi, Qg, qf);
    if (u0 + 1 < u1) { uB = attn_decode(ATT_UMAP(u0 + 1)); attn_load_kv(uB, tid, K8, V8, krB, vrB); }
#pragma unroll 1
    for (int uu = u0; uu < u1; uu += 2) {
        { const AttnU cur = uA; const bool nx = uu + 2 < u1; if (nx) uA = attn_decode(ATT_UMAP(uu + 2));
          attn_body(F, cur, nx, uA, uu + 1 < u1, uB, krA, vrA, qf, K8, V8, Qg, MDd); }
        if (uu + 1 < u1) { const AttnU cur = uB; const bool nx = uu + 3 < u1; if (nx) uB = attn_decode(ATT_UMAP(uu + 3));
          attn_body(F, cur, nx, uB, uu + 2 < u1, uA, krB, vrB, qf, K8, V8, Qg, MDd); }
    }
#undef ATT_UMAP
}

constexpr int PB_AIN_PITCH = 272, PB_POOL_OFF = 40960, PB_POOL_PITCH = 528;
__device__ __forceinline__ void pool_merge_unit(Frame& F, int unit, const bf16* AIN, const bf16* Wpt, const bf16* OP, const bf16* Gt, const float* MDm, const float* MDd, bf16* MERGED) {
    const int tid = F.tid, lane = F.lane, w = F.wave, c32 = lane & 31, hi = lane >> 5;
    const int g = unit & 3, tile = unit >> 2, t0 = tile * 128, tin = t0 & (SEQ - 1), win = 2 << g;
    LAS unsigned char* lds = F.lds;
    for (int id = tid; id < 143 * 16; id += NWAVES * 64) { const int rr = id >> 4, ch = id & 15; v4u v = (v4u){0u, 0u, 0u, 0u};
        if (tin - 15 + rr >= 0) v = *(const GAS v4u*)(AIN + (size_t)(t0 - 15 + rr) * POOLW + g * 128 + ch * 8);
        *(LAS v4u*)(lds + rr * PB_AIN_PITCH + ch * 16) = v; }
    __syncthreads();
    {
        const int tq = w & 3, oh = w >> 2, tokl = 32 * tq + c32;
        const int cnt = (tin + tokl + 1) < win ? (tin + tokl + 1) : win; const float rc = 1.0f / (float)cnt;
        f32x16 acc[4]; acc[0] = f32x16{}; acc[1] = f32x16{}; acc[2] = f32x16{}; acc[3] = f32x16{};
        const bf16* wp = Wpt + (size_t)(g * 256 + oh * 128 + c32) * 128 + 8 * hi;
#pragma unroll 1
        for (int ks = 0; ks < 8; ++ks) {
            const LAS unsigned char* ap = lds + (15 + tokl) * PB_AIN_PITCH + (16 * ks + 8 * hi) * 2;
            const v4u own = *(const LAS v4u*)ap;
            float s[8] = {0.f, 0.f, 0.f, 0.f, 0.f, 0.f, 0.f, 0.f};
            for (int i = 0; i < win; ++i) { const v4u a = *(const LAS v4u*)(ap - i * PB_AIN_PITCH);
                s[0] += bflo(a.x); s[1] += bfhi(a.x); s[2] += bflo(a.y); s[3] += bfhi(a.y); s[4] += bflo(a.z); s[5] += bfhi(a.z); s[6] += bflo(a.w); s[7] += bfhi(a.w); }
            v4u dw; dw.x = pg8::cvt_pk_bf16(s[0] * rc - bflo(own.x), s[1] * rc - bfhi(own.x)); dw.y = pg8::cvt_pk_bf16(s[2] * rc - bflo(own.y), s[3] * rc - bfhi(own.y));
            dw.z = pg8::cvt_pk_bf16(s[4] * rc - bflo(own.z), s[5] * rc - bfhi(own.z)); dw.w = pg8::cvt_pk_bf16(s[6] * rc - bflo(own.w), s[7] * rc - bfhi(own.w));
            const bf16x8 df = __builtin_bit_cast(bf16x8, dw);
#pragma unroll
            for (int mt = 0; mt < 4; ++mt) { const bf16x8 wf = *(const GAS bf16x8*)(wp + (size_t)(32 * mt) * 128 + 16 * ks); acc[mt] = __builtin_amdgcn_mfma_f32_32x32x16_bf16(wf, df, acc[mt], 0, 0, 0); }
        }
#pragma unroll
        for (int mt = 0; mt < 4; ++mt)
#pragma unroll
            for (int gq = 0; gq < 4; ++gq) { v2u ow; ow.x = pg8::cvt_pk_bf16(acc[mt][4 * gq], acc[mt][4 * gq + 1]); ow.y = pg8::cvt_pk_bf16(acc[mt][4 * gq + 2], acc[mt][4 * gq + 3]);
                *(LAS v2u*)(lds + PB_POOL_OFF + tokl * PB_POOL_PITCH + (oh * 128 + 32 * mt + 8 * gq + 4 * hi) * 2) = ow; }
    }
    __syncthreads();
#pragma unroll 1
    for (int pass = 0; pass < 8; ++pass) {
        const int id = pass * 512 + tid, tok = id >> 5, cc = id & 31, col = g * 256 + 8 * cc, head = col >> 6; const size_t row = (size_t)t0 + tok;
        float wgt[3]; float ws_ = 0.f;
#pragma unroll
        for (int p = 0; p < 3; ++p) { wgt[p] = __hip_atomic_load(MDd + ((size_t)p * T + row) * 16 + head, __ATOMIC_RELAXED, __HIP_MEMORY_SCOPE_AGENT); ws_ += wgt[p]; }
        const float iw = 1.0f / ws_;
        const size_t ob = ((size_t)((row >> 13) * 16 + head) * 8192 + (row & 8191)) * 64 + (col & 63); constexpr size_t PST = (size_t)8 * 16 * 8192 * 64;
        const v4u o0 = *(const GAS v4u*)(OP + ob), o1 = *(const GAS v4u*)(OP + PST + ob), o2 = *(const GAS v4u*)(OP + 2 * PST + ob);
        const v2u g0 = *(const GAS v2u*)((const unsigned char*)Gt + row * GATEW + col), g1 = *(const GAS v2u*)((const unsigned char*)Gt + row * GATEW + 1024 + col);
        const v4u pl = *(const LAS v4u*)(lds + PB_POOL_OFF + tok * PB_POOL_PITCH + cc * 16);
        const float w0 = wgt[0] * iw, w1 = wgt[1] * iw, w2 = wgt[2] * iw;
        v4u res;
#define SIG(x_) __builtin_amdgcn_rcpf(1.0f + __builtin_amdgcn_exp2f(-LOG2E * (x_)))
#define MRG(f, gw, HI) { const float alo = w0 * bflo(o0.f) + w1 * bflo(o1.f) + w2 * bflo(o2.f), ahi = w0 * bfhi(o0.f) + w1 * bfhi(o1.f) + w2 * bfhi(o2.f); \
                 const auto ga = __builtin_amdgcn_cvt_pk_f32_fp8((int)g0.gw, HI), gb = __builtin_amdgcn_cvt_pk_f32_fp8((int)g1.gw, HI); \
                 res.f = pg8::cvt_pk_bf16(SIG(ga[0]) * bflo(pl.f) + SIG(gb[0]) * alo, SIG(ga[1]) * bfhi(pl.f) + SIG(gb[1]) * ahi); }
        MRG(x, x, false) MRG(y, x, true) MRG(z, y, false) MRG(w, y, true)
#undef MRG
#undef SIG
        *(GAS v4u*)(MERGED + row * DM + col) = res;
    }
    __syncthreads();
}


constexpr int PC_AIN_PITCH = 1040, PC_POOL_OFF = 49152, PC_POOL_PITCH = 2064, PC_RMAX_OFF = PC_POOL_OFF + 32 * PC_POOL_PITCH, PC_D_OFF = 117760, PC_D_PITCH = 1040;
__device__ __forceinline__ void pool_merge_unit32(Frame& F, int unit, const bf16* AIN, const bf16* Wpt, const bf16* OP, const bf16* Gt, const float* MDd, unsigned char* M8, float* MS) {
    const int tid = F.tid, lane = F.lane, w = F.wave, c32 = lane & 31, hi = lane >> 5;
    const int t0 = unit * 32, tin = t0 & (SEQ - 1);
    LAS unsigned char* lds = F.lds;
    LAS unsigned* rmax = (LAS unsigned*)(lds + PC_RMAX_OFF);
    {
        v4u tv[6];
#pragma unroll
        for (int i = 0; i < 6; ++i) { const int id = tid + i * NWAVES * 64, rr = id >> 6, ch = id & 63; const int rs_ = (rr < 47) ? rr : 46; const int tr = t0 - 15 + rs_;
            tv[i] = *(const GAS v4u*)(AIN + (size_t)(tr >= 0 ? tr : 0) * POOLW + ch * 8); }
        __builtin_amdgcn_sched_barrier(0);
#pragma unroll
        for (int i = 0; i < 6; ++i) { const int id = tid + i * NWAVES * 64, rr = id >> 6, ch = id & 63;
            if (rr < 47) *(LAS v4u*)(lds + rr * PC_AIN_PITCH + ch * 16) = (tin - 15 + rr >= 0) ? tv[i] : (v4u){0u, 0u, 0u, 0u}; }
        __builtin_amdgcn_sched_barrier(0);
    }
    if (tid < 32) rmax[tid] = 0u;
    __syncthreads();
    {
        const int tokd = tid & 31, sub = tid >> 5;
#pragma unroll
        for (int g = 0; g < 4; ++g) { const int win = 2 << g; const int cnt = (tin + tokd + 1) < win ? (tin + tokd + 1) : win; const float rc = 1.0f / (float)cnt;
            const LAS unsigned char* ap = lds + (15 + tokd) * PC_AIN_PITCH + (16 * g + sub) * 16;
            const v4u own = *(const LAS v4u*)ap;
            float s[8] = {0.f, 0.f, 0.f, 0.f, 0.f, 0.f, 0.f, 0.f};
#pragma unroll
            for (int i = 0; i < win; ++i) { const v4u a = *(const LAS v4u*)(ap - i * PC_AIN_PITCH);
                s[0] += bflo(a.x); s[1] += bfhi(a.x); s[2] += bflo(a.y); s[3] += bfhi(a.y); s[4] += bflo(a.z); s[5] += bfhi(a.z); s[6] += bflo(a.w); s[7] += bfhi(a.w); }
            v4u dw; dw.x = pg8::cvt_pk_bf16(s[0] * rc - bflo(own.x), s[1] * rc - bfhi(own.x)); dw.y = pg8::cvt_pk_bf16(s[2] * rc - bflo(own.y), s[3] * rc - bfhi(own.y));
            dw.z = pg8::cvt_pk_bf16(s[4] * rc - bflo(own.z), s[5] * rc - bfhi(own.z)); dw.w = pg8::cvt_pk_bf16(s[6] * rc - bflo(own.w), s[7] * rc - bfhi(own.w));
            *(LAS v4u*)(lds + PC_D_OFF + tokd * PC_D_PITCH + (16 * g + sub) * 16) = dw; }
    }
    __syncthreads();
    {
        const int g = w >> 1, oh = w & 1, tokl = c32;
        f32x16 acc[4]; acc[0] = f32x16{}; acc[1] = f32x16{}; acc[2] = f32x16{}; acc[3] = f32x16{};
        const bf16* wp = Wpt + (size_t)(g * 256 + oh * 128 + c32) * 128 + 8 * hi;
#pragma unroll 1
        for (int kg = 0; kg < 2; ++kg) {
            bf16x8 wf[4][4];
#pragma unroll
            for (int k = 0; k < 4; ++k)
#pragma unroll
                for (int mt = 0; mt < 4; ++mt) wf[k][mt] = *(const GAS bf16x8*)(wp + (size_t)(32 * mt) * 128 + 16 * (4 * kg + k));
            __builtin_amdgcn_sched_barrier(0);
#pragma unroll
            for (int k = 0; k < 4; ++k) { const bf16x8 df = *(const LAS bf16x8*)(lds + PC_D_OFF + tokl * PC_D_PITCH + (g * 128 + 16 * (4 * kg + k) + 8 * hi) * 2);
#pragma unroll
                for (int mt = 0; mt < 4; ++mt) acc[mt] = __builtin_amdgcn_mfma_f32_32x32x16_bf16(wf[k][mt], df, acc[mt], 0, 0, 0); }
            __builtin_amdgcn_sched_barrier(0);
        }
#pragma unroll
        for (int mt = 0; mt < 4; ++mt)
#pragma unroll
            for (int gq = 0; gq < 4; ++gq) { v2u ow; ow.x = pg8::cvt_pk_bf16(acc[mt][4 * gq], acc[mt][4 * gq + 1]); ow.y = pg8::cvt_pk_bf16(acc[mt][4 * gq + 2], acc[mt][4 * gq + 3]);
                *(LAS v2u*)(lds + PC_POOL_OFF + tokl * PC_POOL_PITCH + (g * 256 + oh * 128 + 32 * mt + 8 * gq + 4 * hi) * 2) = ow; }
    }
    __syncthreads();
    v4u res[8];
#define SIG(x_) __builtin_amdgcn_rcpf(1.0f + __builtin_amdgcn_exp2f(-LOG2E * (x_)))
#define MRG(f, gw, HI) { const float alo = w0 * bflo(L.o0.f) + w1 * bflo(L.o1.f) + w2 * bflo(L.o2.f), ahi = w0 * bfhi(L.o0.f) + w1 * bfhi(L.o1.f) + w2 * bfhi(L.o2.f); \
                 const auto ga = __builtin_amdgcn_cvt_pk_f32_fp8((int)L.g0.gw, HI), gb = __builtin_amdgcn_cvt_pk_f32_fp8((int)L.g1.gw, HI); \
                 r.f = pg8::cvt_pk_bf16(SIG(ga[0]) * bflo(pl.f) + SIG(gb[0]) * alo, SIG(ga[1]) * bfhi(pl.f) + SIG(gb[1]) * ahi); \
                 mx = fmaxf(mx, fmaxf(fabsf(bflo(r.f)), fabsf(bfhi(r.f)))); }
    struct PcIn { float wg[3]; v4u o0, o1, o2; v2u g0, g1; };
#pragma unroll
    for (int pg = 0; pg < 2; ++pg) {
        PcIn Ls[4];
#pragma unroll
        for (int q = 0; q < 4; ++q) { const int pass = 4 * pg + q; PcIn& L = Ls[q];
            const int tok = pass * 4 + (tid >> 7), cc = tid & 127, col = 8 * cc, head = col >> 6; const size_t row = (size_t)t0 + tok;
#pragma unroll
            for (int p = 0; p < 3; ++p) L.wg[p] = __hip_atomic_load(MDd + ((size_t)p * T + row) * 16 + head, __ATOMIC_RELAXED, __HIP_MEMORY_SCOPE_AGENT);
            const size_t ob = ((size_t)((row >> 13) * 16 + head) * 8192 + (row & 8191)) * 64 + (col & 63); constexpr size_t PST = (size_t)8 * 16 * 8192 * 64;
            L.o0 = *(const GAS v4u*)(OP + ob); L.o1 = *(const GAS v4u*)(OP + PST + ob); L.o2 = *(const GAS v4u*)(OP + 2 * PST + ob);
            L.g0 = *(const GAS v2u*)((const unsigned char*)Gt + row * GATEW + col); L.g1 = *(const GAS v2u*)((const unsigned char*)Gt + row * GATEW + 1024 + col); }
        __builtin_amdgcn_sched_barrier(0);
#pragma unroll
        for (int q = 0; q < 4; ++q) { const int pass = 4 * pg + q; const PcIn& L = Ls[q];
            const int tok = pass * 4 + (tid >> 7), cc = tid & 127;
            const float iw = 1.0f / (L.wg[0] + L.wg[1] + L.wg[2]); const float w0 = L.wg[0] * iw, w1 = L.wg[1] * iw, w2 = L.wg[2] * iw;
            const v4u pl = *(const LAS v4u*)(lds + PC_POOL_OFF + tok * PC_POOL_PITCH + cc * 16);
            v4u r; float mx = 0.f;
            MRG(x, x, false) MRG(y, x, true) MRG(z, y, false) MRG(w, y, true)
            res[pass] = r;
            mx = wave_max_dpp(mx);
            if (lane == 0) (void)__hip_atomic_fetch_max(rmax + tok, __float_as_uint(mx), __ATOMIC_RELAXED, __HIP_MEMORY_SCOPE_WORKGROUP); }
        __builtin_amdgcn_sched_barrier(0);
    }
#undef MRG
#undef SIG
    __syncthreads();
#pragma unroll
    for (int pass = 0; pass < 8; ++pass) {
        const int tok = pass * 4 + (tid >> 7), cc = tid & 127; const size_t row = (size_t)t0 + tok;
        const float rm = __uint_as_float(rmax[tok]); const float inv = rm > 0.f ? 127.0f / rm : 0.f;
        const v4u r = res[pass];
        const int a0 = (int)__builtin_rintf(bflo(r.x) * inv), a1 = (int)__builtin_rintf(bfhi(r.x) * inv), a2 = (int)__builtin_rintf(bflo(r.y) * inv), a3 = (int)__builtin_rintf(bfhi(r.y) * inv);
        const int a4 = (int)__builtin_rintf(bflo(r.z) * inv), a5 = (int)__builtin_rintf(bfhi(r.z) * inv), a6 = (int)__builtin_rintf(bflo(r.w) * inv), a7 = (int)__builtin_rintf(bfhi(r.w) * inv);
        v2u q; q.x = ((unsigned)a0 & 255u) | (((unsigned)a1 & 255u) << 8) | (((unsigned)a2 & 255u) << 16) | ((unsigned)a3 << 24);
        q.y = ((unsigned)a4 & 255u) | (((unsigned)a5 & 255u) << 8) | (((unsigned)a6 & 255u) << 16) | ((unsigned)a7 << 24);
        *(GAS v2u*)(M8 + row * DM + 8 * cc) = q;
    }
    if (tid < 32) MS[t0 + tid] = __uint_as_float(rmax[tid]) * (1.0f / 127.0f);
    __syncthreads();
}

#ifndef P5_LOGNB
#define P5_LOGNB 4
#endif
#define P5_NBUCKET (1 << P5_LOGNB)
#ifndef P5_NSLOT_M
#define P5_NSLOT_M 5
#endif
#define P5_STR2(x) #x
#define P5_STR(x) P5_STR2(x)
#if P5_NSLOT_M == 3
#define P5_VM1 4
#define P5_VM2 2
#define P5_O1 24
#define P5_O2A 3
#define P5_O2B 4
#elif P5_NSLOT_M == 4
#define P5_VM1 6
#define P5_VM2 4
#define P5_O1 32
#define P5_O2A 4
#define P5_O2B 5
#elif P5_NSLOT_M == 5
#define P5_VM1 8
#define P5_VM2 6
#define P5_VM4 2
#define P5_O1 40
#define P5_O2A 5
#define P5_O2B 6
#define P5_O2C 7
#define P5_O2D 8
#endif
constexpr int P5_LIST_WAVE = 1032  , P5_LIST_OFF = 0, P5_RING_OFF = 66048, P5_RING_WAVE = 10240, P5_NSLOT = P5_NSLOT_M, P5_TL_OFF = 147968, P5_S2_OFF = 156160, P5_SH_OFF = 156416, P5_CNT_OFF = 147968  ;
constexpr int P5_DUMMY_OFF = 158720;
constexpr float P5_GSCALE = 256.0f;
__device__ __forceinline__ float gelu_tanh(float x) {
    const float z = 0.7978845608028654f * (x + 0.044715f * x * x * x);
    const float e = __builtin_amdgcn_exp2f(2.0f * LOG2E * z);
    const float th = 1.0f - 2.0f * __builtin_amdgcn_rcpf(1.0f + e);
    return 0.5f * x * (1.0f + th);
}
#define P5_CE(a, b) { const float hi__ = fmaxf(a, b), lo__ = fminf(a, b); a = hi__; b = lo__; }
__device__ __forceinline__ void sort16_desc(float (&v)[16]) {
#pragma unroll
    for (int k = 2; k <= 16; k <<= 1)
#pragma unroll
        for (int j = k >> 1; j > 0; j >>= 1)
#pragma unroll
            for (int i = 0; i < 16; ++i) { const int l = i ^ j; if (l > i) { if ((i & k) == 0) P5_CE(v[i], v[l]) else P5_CE(v[l], v[i]) } }
}
__device__ __forceinline__ void merge_top16(float (&a)[16], const float (&b)[16]) {
#pragma unroll
    for (int i = 0; i < 16; ++i) a[i] = fmaxf(a[i], b[15 - i]);
#pragma unroll
    for (int j = 8; j > 0; j >>= 1)
#pragma unroll
        for (int i = 0; i < 16; ++i) { const int l = i ^ j; if (l > i) P5_CE(a[i], a[l]) }
}
__device__ __forceinline__ void pair_merge_top16(float (&a)[16]) {
    float lo[16], hi[16];
#pragma unroll
    for (int i = 0; i < 16; ++i) { auto t = __builtin_amdgcn_permlane32_swap(__float_as_uint(a[i]), __float_as_uint(a[i]), false, false); lo[i] = __uint_as_float(t[0]); hi[i] = __uint_as_float(t[1]); }
    merge_top16(lo, hi);
#pragma unroll
    for (int i = 0; i < 16; ++i) a[i] = lo[i];
}
__device__ __forceinline__ void peer_stage_a(Frame& F, int t0, int hh, const bf16* QP, const bf16* SKB, const float* SU, const float* SV) {
    int lane = F.lane; asm volatile("" : "+v"(lane));
    const int w = F.wave, c32 = lane & 31, hi = lane >> 5;
    LAS unsigned char* lds = F.lds;
    const LAS float* s2l = (const LAS float*)(lds + P5_S2_OFF);
    float tops[2][16];
#pragma unroll
    for (int p = 0; p < 2; ++p) {
        f32x16 acc[4]; acc[0] = f32x16{}; acc[1] = f32x16{}; acc[2] = f32x16{}; acc[3] = f32x16{};
        const bf16* qrow = QP + (size_t)(t0 + 32 * hh + c32) * 2048 + (w * 2 + p) * 128 + 8 * hi;
        const bf16* skp = SKB + ((size_t)(w * 2 + p) * 32 * 64 + lane) * 8;
#pragma unroll 1
        for (int kg = 0; kg < 2; ++kg) {
            bf16x8 bq[4], af[4][4];
#pragma unroll
            for (int k = 0; k < 4; ++k) { bq[k] = *(const GAS bf16x8*)(qrow + 16 * (4 * kg + k));
#pragma unroll
                for (int mt = 0; mt < 4; ++mt) af[k][mt] = *(const GAS bf16x8*)(skp + (size_t)((4 * kg + k) * 4 + mt) * 512); }
            __builtin_amdgcn_sched_barrier(0);
#pragma unroll
            for (int k = 0; k < 4; ++k)
#pragma unroll
                for (int mt = 0; mt < 4; ++mt) acc[mt] = __builtin_amdgcn_mfma_f32_32x32x16_bf16(af[k][mt], bq[k], acc[mt], 0, 0, 0);
            __builtin_amdgcn_sched_barrier(0);
        }
#pragma unroll
        for (int mt = 0; mt < 4; ++mt)
#pragma unroll
            for (int rr = 0; rr < 16; ++rr) acc[mt][rr] = __uint_as_float((__float_as_uint(acc[mt][rr]) & ~127u) | (unsigned)(32 * mt + crow(rr, hi)));
        {   float g0[16], g1[16], g2[16], g3[16];
#pragma unroll
            for (int rr = 0; rr < 16; ++rr) { g0[rr] = acc[0][rr]; g1[rr] = acc[1][rr]; g2[rr] = acc[2][rr]; g3[rr] = acc[3][rr]; }
            sort16_desc(g0); sort16_desc(g1); sort16_desc(g2); sort16_desc(g3);
            merge_top16(g0, g1); merge_top16(g2, g3); merge_top16(g0, g2);
            pair_merge_top16(g0);
#pragma unroll
            for (int k = 0; k < 16; ++k) tops[p][k] = g0[k];
        }
    }
    {
        v4u tb; unsigned b_[16];
#pragma unroll
        for (int k = 0; k < 16; ++k) b_[k] = __float_as_uint(hi ? tops[1][k] : tops[0][k]) & 127u;
        tb.x = b_[0] | (b_[1] << 8) | (b_[2] << 16) | (b_[3] << 24); tb.y = b_[4] | (b_[5] << 8) | (b_[6] << 16) | (b_[7] << 24);
        tb.z = b_[8] | (b_[9] << 8) | (b_[10] << 16) | (b_[11] << 24); tb.w = b_[12] | (b_[13] << 8) | (b_[14] << 16) | (b_[15] << 24);
        *(LAS v4u*)(lds + P5_TL_OFF + ((c32 * 8 + w) * 2 + hi) * 16) = tb;
    }
    float best[16];
    {   float ca[16], cb[16];
#pragma unroll
        for (int i = 0; i < 16; ++i) { ca[i] = -3.0e38f; cb[i] = -3.0e38f; }
        int c = 0;
#pragma unroll
        for (int i = 0; i < 16; ++i)
#pragma unroll
            for (int j = 0; j < 16; ++j)
                if ((i + 1) * (j + 1) <= 16) {
                    const float val = tops[0][i] + tops[1][j];
                    const float pk = __uint_as_float((__float_as_uint(val) & ~255u) | (unsigned)(i * 16 + j));
                    const int sl = c >> 1;
                    if (sl < 16) { if ((c & 1) == 0) ca[sl] = pk; else ca[sl] = hi ? pk : ca[sl]; }
                    else         { if ((c & 1) == 0) cb[sl - 16] = pk; else cb[sl - 16] = hi ? pk : cb[sl - 16]; }
                    ++c;
                }
        sort16_desc(ca); sort16_desc(cb); merge_top16(ca, cb); pair_merge_top16(ca);
#pragma unroll
        for (int k = 0; k < 16; ++k) best[k] = ca[k];
    }
    const int tokc = 32 * hh + c32;
    const float s2v = s2l[tokc] * LOG2E;
    float ge[16]; float gs = 0.f;
#pragma unroll
    for (int k = 0; k < 16; ++k) { ge[k] = __builtin_amdgcn_exp2f((best[k] - best[0]) * s2v); gs += ge[k]; }
    const float gi = 1.0f / gs;
    asm volatile("s_waitcnt lgkmcnt(0)" ::: "memory");
    const LAS unsigned char* tl0 = lds + P5_TL_OFF + ((c32 * 8 + w) * 2) * 16;
    LAS v2u* lst = (LAS v2u*)(lds + P5_LIST_OFF) + (tokc >> 3) * P5_LIST_WAVE + (tokc & 7) * 128 + w * 16 + 8 * hi;
    unsigned ex[8]; float svx[8], sux[8];
#pragma unroll
    for (int k = 0; k < 8; ++k) { const float bsel = hi ? best[k + 8] : best[k]; const unsigned code = __float_as_uint(bsel) & 255u; ex[k] = (unsigned)tl0[code >> 4] * 128u + (unsigned)tl0[16 + (code & 15u)]; }
    __builtin_amdgcn_sched_barrier(0);
#pragma unroll
    for (int k = 0; k < 8; ++k) { svx[k] = SV[ex[k]]; sux[k] = SU[ex[k]]; }
    __builtin_amdgcn_sched_barrier(0);
#pragma unroll
    for (int k = 0; k < 8; ++k) {
        const float gsel = (hi ? ge[k + 8] : ge[k]) * gi;
        const unsigned g16 = (unsigned)__builtin_bit_cast(unsigned short, (_Float16)(gsel * svx[k] * P5_GSCALE)) & 0x7fffu;
        v2u ent; ent.x = (ex[k] << 18) | ((unsigned)(tokc & 7) << 15) | g16; ent.y = __float_as_uint(sux[k]);
        lst[k] = ent;
    }
}
#define P5_BODY(S) { int d_ = 0; \
        d_ = __builtin_amdgcn_sdot4((int)uq.x, (int)hq[S].x, d_, false); d_ = __builtin_amdgcn_sdot4((int)uq.y, (int)hq[S].y, d_, false); \
        d_ = __builtin_amdgcn_sdot4((int)uq.z, (int)hq[S].z, d_, false); d_ = __builtin_amdgcn_sdot4((int)uq.w, (int)hq[S].w, d_, false); \
        d_ += dppi<0xB1>(d_); d_ += dppi<0x4E>(d_); d_ += dppi<0x141>(d_); d_ += dppi<0x140>(d_);              \
        d_ += __builtin_amdgcn_update_dpp(0, d_, 0x142, 0xA, 0xF, false); d_ += __builtin_amdgcn_update_dpp(0, d_, 0x143, 0xC, 0xF, false);     \
        const float x_ = (float)__builtin_amdgcn_readlane(d_, 63) * (su * kx[S]); \
        const float t_ = x_ * fmaf(x_ * x_, -0.10294324f, -2.30220819f);                                        \
        const float cf = gate * x_ * __builtin_amdgcn_rcpf(1.0f + __builtin_amdgcn_exp2f(t_)); \
        const _Float16 ch_ = (_Float16)cf; const h2v cp_ = (h2v){ch_, ch_}; \
        _Pragma("unroll") for (int j_ = 0; j_ < 4; ++j_) { \
        acc[S][2 * j_ + 0] = __builtin_elementwise_fma(cp_, f8h<false>(vq[j_]), acc[S][2 * j_ + 0]); \
        acc[S][2 * j_ + 1] = __builtin_elementwise_fma(cp_, f8h<true>(vq[j_]), acc[S][2 * j_ + 1]); } }
typedef _Float16 h2v __attribute__((ext_vector_type(2)));
template <bool HI> __device__ __forceinline__ h2v f8h(unsigned w) { return __builtin_bit_cast(h2v, __builtin_amdgcn_cvt_scalef32_pk_f16_fp8((int)w, 1.0f, HI)); }
typedef float f32x2v __attribute__((ext_vector_type(2)));
__device__ __forceinline__ void peer_unit(Frame& F, int unit, const bf16* QP, const bf16* SKB, const unsigned char* UQ, const unsigned char* VQ, const float* SU, const float* SV, const bf16* HB, float* out) {
    int lane = F.lane; asm volatile("" : "+v"(lane));
    const int w = F.wave;
    const int t0 = unit * 64;
    LAS unsigned char* lds = F.lds;
    LAS float* s2l = (LAS float*)(lds + P5_S2_OFF);
    LAS unsigned char* ringw = lds + P5_RING_OFF + w * P5_RING_WAVE; LAS float* kxl = (LAS float*)(lds + P5_SH_OFF);
#pragma unroll
    for (int hf = 0; hf < 2; ++hf) {
        f32x4 v[4][4];
#pragma unroll
        for (int q = 0; q < 4; ++q) { const GAS v2u* xr = (const GAS v2u*)(HB + (size_t)(t0 + 8 * w + 4 * hf + q) * DM) + lane;
#pragma unroll
            for (int j = 0; j < 4; ++j) { const v2u hw = xr[64 * j]; v[q][j] = (f32x4){bflo(hw.x), bfhi(hw.x), bflo(hw.y), bfhi(hw.y)}; } }
#pragma unroll
        for (int q = 0; q < 4; ++q) { float s = 0.f, mx = 0.f;
#pragma unroll
            for (int j = 0; j < 4; ++j) { const f32x4 x = v[q][j]; s += (x.x * x.x + x.y * x.y) + (x.z * x.z + x.w * x.w); mx = fmaxf(mx, fmaxf(fmaxf(fabsf(x.x), fabsf(x.y)), fmaxf(fabsf(x.z), fabsf(x.w)))); }
            s = wave_sum_dpp(s); mx = wave_max_dpp(mx);
            const float s2 = 1.0f / sqrtf(s * (1.0f / 1024.0f) + EPS), sh = mx > 0.f ? mx * (1.0f / 127.0f) : 1.0f;
            *(LAS v4u*)(ringw + (4 * hf + q) * 1024 + 16 * lane) = quant16(v[q], 1.0f / sh, 0);
            if (lane == 0) { s2l[8 * w + 4 * hf + q] = s2; kxl[8 * w + 4 * hf + q] = sh * s2; } }
    }
    __syncthreads();
#pragma unroll 1
    for (int hh = 0; hh < 2; ++hh) { peer_stage_a(F, t0, hh, QP, SKB, SU, SV); __syncthreads(); }
    lane = F.lane; asm volatile("" : "+v"(lane));
    LAS v2u* lw = (LAS v2u*)(lds + P5_LIST_OFF) + w * P5_LIST_WAVE;
    constexpr int NBK = P5_NBUCKET, WPL = NBK / 16;
    LAS unsigned* cnt = (LAS unsigned*)(lds + P5_CNT_OFF) + w * (NBK * 4);
#define P5_BIN(x) ((((x) >> (32 - P5_LOGNB)) << 3) | (((x) >> 15) & 7u))
    {
        v2u e16[16];
#pragma unroll
        for (int i = 0; i < 16; ++i) e16[i] = lw[64 * i + lane];
#pragma unroll
        for (int k = 0; k < WPL; ++k) cnt[WPL * lane + k] = 0u;
        asm volatile("s_waitcnt lgkmcnt(0)" ::: "memory");
        unsigned rk[16];
#pragma unroll
        for (int i = 0; i < 16; ++i) { const unsigned bin = P5_BIN(e16[i].x); const unsigned sh = (bin & 1u) * 16u;
            const unsigned old = __hip_atomic_fetch_add(cnt + (bin >> 1), 1u << sh, __ATOMIC_RELAXED, __HIP_MEMORY_SCOPE_WORKGROUP); rk[i] = (old >> sh) & 0xffffu; }
        asm volatile("s_waitcnt lgkmcnt(0)" ::: "memory");
        unsigned cb[2 * WPL]; unsigned tot = 0;
#pragma unroll
        for (int k = 0; k < WPL; ++k) { const unsigned cwd = cnt[WPL * lane + k]; cb[2 * k] = cwd & 0xffffu; cb[2 * k + 1] = cwd >> 16; tot += cb[2 * k] + cb[2 * k + 1]; }
        unsigned incl = tot;
#pragma unroll
        for (int o = 1; o < 64; o <<= 1) { const unsigned t = (unsigned)__shfl_up((int)incl, o); if (lane >= o) incl += t; }
        unsigned run = incl - tot; unsigned stt[2 * WPL];
#pragma unroll
        for (int k = 0; k < 2 * WPL; ++k) { stt[k] = run; run += cb[k]; }
        asm volatile("s_waitcnt lgkmcnt(0)" ::: "memory");
#pragma unroll
        for (int k = 0; k < WPL; ++k) cnt[WPL * lane + k] = stt[2 * k] | (stt[2 * k + 1] << 16);
        asm volatile("s_waitcnt lgkmcnt(0)" ::: "memory");
#pragma unroll
        for (int i = 0; i < 16; ++i) { const unsigned bin = P5_BIN(e16[i].x);
            const unsigned base = (cnt[bin >> 1] >> ((bin & 1u) * 16u)) & 0xffffu; lw[base + rk[i]] = e16[i]; }
        asm volatile("s_waitcnt lgkmcnt(0)" ::: "memory");
        if (lane < 8) lw[1024 + lane] = lw[lane];
        asm volatile("s_waitcnt lgkmcnt(0)" ::: "memory");
    }
#undef P5_BIN
    lane = F.lane; asm volatile("" : "+v"(lane));
    v4u hq[8]; float kx[8];
#pragma unroll
    for (int s = 0; s < 8; ++s) { hq[s] = *(const LAS v4u*)(lds + P5_RING_OFF + w * P5_RING_WAVE + s * 1024 + 16 * lane); kx[s] = ((const LAS float*)(lds + P5_SH_OFF))[8 * w + s]; }
    asm volatile("s_waitcnt lgkmcnt(0)" : "+v"(hq[0]), "+v"(hq[1]), "+v"(hq[2]), "+v"(hq[3]), "+v"(hq[4]), "+v"(hq[5]), "+v"(hq[6]), "+v"(hq[7]) :: "memory");
    h2v acc[8][8];
#pragma unroll
    for (int s = 0; s < 8; ++s)
#pragma unroll
        for (int j = 0; j < 8; ++j) acc[s][j] = (h2v){(_Float16)0.f, (_Float16)0.f};
    asm volatile("s_waitcnt vmcnt(0)" ::: "memory");
    LAS unsigned char* ring = lds + P5_RING_OFF + w * P5_RING_WAVE;
    const unsigned char* uvgl = UQ + 16 * lane;
#define P5_ISSUE(idx, slot_) { const v2u en_ = lw[(idx) & 1023]; const unsigned e_ = (unsigned)__builtin_amdgcn_readfirstlane((int)en_.x) >> 18; \
        const unsigned* gp_ = (const unsigned*)(uvgl + (size_t)e_ * 2048); \
        __builtin_amdgcn_global_load_lds(gp_, (LAS unsigned*)(ring + (slot_) * 2048), 16, 0, 0); \
        __builtin_amdgcn_global_load_lds(gp_, (LAS unsigned*)(ring + (slot_) * 2048), 16, 1024, 0); }
#pragma unroll
    for (int i = 0; i < P5_NSLOT; ++i) P5_ISSUE(i, i)
    int slot = 0, i = 0;
    const unsigned xw = (unsigned)(((blockIdx.x >> 3) & 31) * 8 + w);
    const bool hih = lane >= 32; const unsigned lane16 = 16u * (unsigned)lane; const unsigned ringa = (unsigned)(uintptr_t)ring;
    const unsigned lwa = (unsigned)(uintptr_t)lw;
    const unsigned lwah = lwa + (hih ? 8u : 0u);
    const unsigned lwaq = lwa + 8u * ((unsigned)lane >> 4);
#define P5_DMA(e_, slot_) { const unsigned char* rb_ = UQ + (size_t)(e_) * 2048; const unsigned la_ = ringa + (unsigned)(slot_) * 2048u; unsigned keep_; \
        asm volatile("s_mov_b32 %0, m0\n\ts_mov_b32 m0, %3\n\ts_nop 0\n\tglobal_load_lds_dwordx4 %1, %2\n\tglobal_load_lds_dwordx4 %1, %2 offset:1024\n\ts_mov_b32 m0, %0" \
                     : "=&s"(keep_) : "v"(lane16), "s"(rb_), "s"(la_) : "memory"); }
#define P5_PAIR(S) { v2u ent; unsigned nx_;     \
        asm volatile("ds_read_b64 %0, %2\n\tds_read_b32 %1, %2 offset:" P5_STR(P5_O1) : "=&v"(ent), "=&v"(nx_) : "v"(lwa + 8u * (unsigned)i) : "memory"); \
        asm volatile("s_waitcnt vmcnt(" P5_STR(P5_VM1) ")" ::: "memory"); \
        const v4u uq = *(const LAS v4u*)(ring + slot * 2048 + 16 * lane), vq = *(const LAS v4u*)(ring + slot * 2048 + 1024 + 16 * lane); \
        asm volatile("s_waitcnt lgkmcnt(0)" : "+v"(ent), "+v"(nx_) :: "memory");         \
        const unsigned key = (unsigned)__builtin_amdgcn_readfirstlane((int)ent.x); const float su = __uint_as_float((unsigned)__builtin_amdgcn_readfirstlane((int)ent.y)); \
        P5_DMA((unsigned)__builtin_amdgcn_readfirstlane((int)nx_) >> 18, slot) \
        slot = (slot == P5_NSLOT - 1) ? 0 : slot + 1; \
        const float gate = (float)__builtin_bit_cast(_Float16, (unsigned short)(key & 0x7fffu)); \
        P5_BODY(S) }
#define P5_PAIR2(S) { v2u entl_; v4u nab_;                  \
        asm volatile("ds_read_b64 %0, %2\n\tds_read2_b64 %1, %3 offset0:" P5_STR(P5_O2A) " offset1:" P5_STR(P5_O2B) : "=&v"(entl_), "=&v"(nab_) : "v"(lwah + 8u * (unsigned)i), "v"(lwa + 8u * (unsigned)i) : "memory"); \
        asm volatile("s_waitcnt vmcnt(" P5_STR(P5_VM2) ")" ::: "memory"); \
        const int slotB = (slot == P5_NSLOT - 1) ? 0 : slot + 1; \
        const v4u uqA = *(const LAS v4u*)(ring + slot * 2048 + 16 * lane), vqA = *(const LAS v4u*)(ring + slot * 2048 + 1024 + 16 * lane); \
        const v4u uqB = *(const LAS v4u*)(ring + slotB * 2048 + 16 * lane), vqB = *(const LAS v4u*)(ring + slotB * 2048 + 1024 + 16 * lane); \
        asm volatile("s_waitcnt lgkmcnt(0)" : "+v"(entl_), "+v"(nab_) :: "memory"); \
        P5_DMA((unsigned)__builtin_amdgcn_readfirstlane((int)nab_.x) >> 18, slot) P5_DMA((unsigned)__builtin_amdgcn_readfirstlane((int)nab_.z) >> 18, slotB) \
        slot = (slotB == P5_NSLOT - 1) ? 0 : slotB + 1; \
        int dA_ = 0, dB_ = 0; \
        dA_ = __builtin_amdgcn_sdot4((int)uqA.x, (int)hq[S].x, dA_, false); dB_ = __builtin_amdgcn_sdot4((int)uqB.x, (int)hq[S].x, dB_, false); \
        dA_ = __builtin_amdgcn_sdot4((int)uqA.y, (int)hq[S].y, dA_, false); dB_ = __builtin_amdgcn_sdot4((int)uqB.y, (int)hq[S].y, dB_, false); \
        dA_ = __builtin_amdgcn_sdot4((int)uqA.z, (int)hq[S].z, dA_, false); dB_ = __builtin_amdgcn_sdot4((int)uqB.z, (int)hq[S].z, dB_, false); \
        dA_ = __builtin_amdgcn_sdot4((int)uqA.w, (int)hq[S].w, dA_, false); dB_ = __builtin_amdgcn_sdot4((int)uqB.w, (int)hq[S].w, dB_, false); \
        auto sw_ = __builtin_amdgcn_permlane32_swap((unsigned)dA_, (unsigned)dB_, false, false); int e_ = (int)(sw_[0] + sw_[1]);        \
        e_ += dppi<0xB1>(e_); e_ += dppi<0x4E>(e_); e_ += dppi<0x141>(e_); e_ += dppi<0x140>(e_); \
        e_ += __builtin_amdgcn_update_dpp(0, e_, 0x142, 0xA, 0xF, false);                   \
        const float x_ = (float)e_ * (__uint_as_float(entl_.y) * kx[S]); \
        const float t_ = x_ * fmaf(x_ * x_, -0.10294324f, -2.30220819f); \
        const float cfv_ = (float)__builtin_bit_cast(_Float16, (unsigned short)(entl_.x & 0x7fffu)) * x_ * __builtin_amdgcn_rcpf(1.0f + __builtin_amdgcn_exp2f(t_)); \
        const _Float16 ch_ = (_Float16)cfv_; const unsigned cpk_ = __builtin_bit_cast(unsigned, (h2v){ch_, ch_}); \
        const h2v cpA = __builtin_bit_cast(h2v, (unsigned)__builtin_amdgcn_readlane((int)cpk_, 31)), cpB = __builtin_bit_cast(h2v, (unsigned)__builtin_amdgcn_readlane((int)cpk_, 63)); \
        _Pragma("unroll") for (int j_ = 0; j_ < 4; ++j_) { \
        acc[S][2 * j_ + 0] = __builtin_elementwise_fma(cpB, f8h<false>(vqB[j_]), __builtin_elementwise_fma(cpA, f8h<false>(vqA[j_]), acc[S][2 * j_ + 0])); \
        acc[S][2 * j_ + 1] = __builtin_elementwise_fma(cpB, f8h<true>(vqB[j_]), __builtin_elementwise_fma(cpA, f8h<true>(vqA[j_]), acc[S][2 * j_ + 1])); } }
#define P5_QUAD(S) { v2u entl_; v4u n01_, n23_; \
        asm volatile("ds_read_b64 %0, %3\n\tds_read2_b64 %1, %4 offset0:" P5_STR(P5_O2A) " offset1:" P5_STR(P5_O2B) "\n\tds_read2_b64 %2, %4 offset0:" P5_STR(P5_O2C) " offset1:" P5_STR(P5_O2D) \
                     : "=&v"(entl_), "=&v"(n01_), "=&v"(n23_) : "v"(lwaq + 8u * (unsigned)i), "v"(lwa + 8u * (unsigned)i) : "memory"); \
        asm volatile("s_waitcnt vmcnt(" P5_STR(P5_VM4) ")" ::: "memory"); \
        const int s1_ = (slot == P5_NSLOT - 1) ? 0 : slot + 1, s2_ = (s1_ == P5_NSLOT - 1) ? 0 : s1_ + 1, s3_ = (s2_ == P5_NSLOT - 1) ? 0 : s2_ + 1; \
        const v4u uqA = *(const LAS v4u*)(ring + slot * 2048 + 16 * lane), vqA = *(const LAS v4u*)(ring + slot * 2048 + 1024 + 16 * lane); \
        const v4u uqB = *(const LAS v4u*)(ring + s1_ * 2048 + 16 * lane), vqB = *(const LAS v4u*)(ring + s1_ * 2048 + 1024 + 16 * lane); \
        const v4u uqC = *(const LAS v4u*)(ring + s2_ * 2048 + 16 * lane), vqC = *(const LAS v4u*)(ring + s2_ * 2048 + 1024 + 16 * lane); \
        const v4u uqD = *(const LAS v4u*)(ring + s3_ * 2048 + 16 * lane), vqD = *(const LAS v4u*)(ring + s3_ * 2048 + 1024 + 16 * lane); \
        asm volatile("s_waitcnt lgkmcnt(0)" : "+v"(entl_), "+v"(n01_), "+v"(n23_) :: "memory"); \
        P5_DMA((unsigned)__builtin_amdgcn_readfirstlane((int)n01_.x) >> 18, slot) P5_DMA((unsigned)__builtin_amdgcn_readfirstlane((int)n01_.z) >> 18, s1_) \
        P5_DMA((unsigned)__builtin_amdgcn_readfirstlane((int)n23_.x) >> 18, s2_) P5_DMA((unsigned)__builtin_amdgcn_readfirstlane((int)n23_.z) >> 18, s3_) \
        slot = (s3_ == P5_NSLOT - 1) ? 0 : s3_ + 1; \
        int dA_ = 0, dB_ = 0, dC_ = 0, dD_ = 0; \
        dA_ = __builtin_amdgcn_sdot4((int)uqA.x, (int)hq[S].x, dA_, false); dB_ = __builtin_amdgcn_sdot4((int)uqB.x, (int)hq[S].x, dB_, false); dC_ = __builtin_amdgcn_sdot4((int)uqC.x, (int)hq[S].x, dC_, false); dD_ = __builtin_amdgcn_sdot4((int)uqD.x, (int)hq[S].x, dD_, false); \
        dA_ = __builtin_amdgcn_sdot4((int)uqA.y, (int)hq[S].y, dA_, false); dB_ = __builtin_amdgcn_sdot4((int)uqB.y, (int)hq[S].y, dB_, false); dC_ = __builtin_amdgcn_sdot4((int)uqC.y, (int)hq[S].y, dC_, false); dD_ = __builtin_amdgcn_sdot4((int)uqD.y, (int)hq[S].y, dD_, false); \
        dA_ = __builtin_amdgcn_sdot4((int)uqA.z, (int)hq[S].z, dA_, false); dB_ = __builtin_amdgcn_sdot4((int)uqB.z, (int)hq[S].z, dB_, false); dC_ = __builtin_amdgcn_sdot4((int)uqC.z, (int)hq[S].z, dC_, false); dD_ = __builtin_amdgcn_sdot4((int)uqD.z, (int)hq[S].z, dD_, false); \
        dA_ = __builtin_amdgcn_sdot4((int)uqA.w, (int)hq[S].w, dA_, false); dB_ = __builtin_amdgcn_sdot4((int)uqB.w, (int)hq[S].w, dB_, false); dC_ = __builtin_amdgcn_sdot4((int)uqC.w, (int)hq[S].w, dC_, false); dD_ = __builtin_amdgcn_sdot4((int)uqD.w, (int)hq[S].w, dD_, false); \
        auto w1_ = __builtin_amdgcn_permlane32_swap((unsigned)dA_, (unsigned)dC_, false, false); const unsigned e1_ = w1_[0] + w1_[1];          \
        auto w2_ = __builtin_amdgcn_permlane32_swap((unsigned)dB_, (unsigned)dD_, false, false); const unsigned e2_ = w2_[0] + w2_[1];          \
        auto w3_ = __builtin_amdgcn_permlane16_swap(e1_, e2_, false, false); int e_ = (int)(w3_[0] + w3_[1]);                                    \
        e_ += dppi<0xB1>(e_); e_ += dppi<0x4E>(e_); e_ += dppi<0x141>(e_); e_ += dppi<0x140>(e_); \
        const float x_ = (float)e_ * (__uint_as_float(entl_.y) * kx[S]); \
        const float t_ = x_ * fmaf(x_ * x_, -0.10294324f, -2.30220819f); \
        const float cfv_ = (float)__builtin_bit_cast(_Float16, (unsigned short)(entl_.x & 0x7fffu)) * x_ * __builtin_amdgcn_rcpf(1.0f + __builtin_amdgcn_exp2f(t_)); \
        const _Float16 ch_ = (_Float16)cfv_; const unsigned cpk_ = __builtin_bit_cast(unsigned, (h2v){ch_, ch_}); \
        const h2v cpA = __builtin_bit_cast(h2v, (unsigned)__builtin_amdgcn_readlane((int)cpk_, 0)), cpB = __builtin_bit_cast(h2v, (unsigned)__builtin_amdgcn_readlane((int)cpk_, 16)); \
        const h2v cpC = __builtin_bit_cast(h2v, (unsigned)__builtin_amdgcn_readlane((int)cpk_, 32)), cpD = __builtin_bit_cast(h2v, (unsigned)__builtin_amdgcn_readlane((int)cpk_, 48)); \
        _Pragma("unroll") for (int j_ = 0; j_ < 4; ++j_) { \
        acc[S][2 * j_ + 0] = __builtin_elementwise_fma(cpD, f8h<false>(vqD[j_]), __builtin_elementwise_fma(cpC, f8h<false>(vqC[j_]), __builtin_elementwise_fma(cpB, f8h<false>(vqB[j_]), __builtin_elementwise_fma(cpA, f8h<false>(vqA[j_]), acc[S][2 * j_ + 0])))); \
        acc[S][2 * j_ + 1] = __builtin_elementwise_fma(cpD, f8h<true>(vqD[j_]), __builtin_elementwise_fma(cpC, f8h<true>(vqC[j_]), __builtin_elementwise_fma(cpB, f8h<true>(vqB[j_]), __builtin_elementwise_fma(cpA, f8h<true>(vqA[j_]), acc[S][2 * j_ + 1])))); } }
#define P5_RUN(S, END) { _Pragma("unroll 1") for (; i + 3 < (END); i += 4) P5_QUAD(S) if (i + 1 < (END)) { P5_PAIR2(S) i += 2; } if (i < (END)) { P5_PAIR(S) ++i; } }
#pragma unroll 1
    for (int b = 0; b < NBK; ++b) {
        {
            constexpr int RPB = NEXP / NBK;
#pragma unroll
            for (int k = 0; k < (RPB + 255) / 256; ++k) { const unsigned pe = (unsigned)(((b + 2) & (NBK - 1)) * RPB) + ((xw + 256u * k) & (unsigned)(RPB - 1));
                const unsigned* gp = (const unsigned*)(uvgl + (size_t)pe * 2048);
                __builtin_amdgcn_global_load_lds(gp, (LAS unsigned*)(lds + P5_DUMMY_OFF), 16, 0, 0);
                __builtin_amdgcn_global_load_lds(gp, (LAS unsigned*)(lds + P5_DUMMY_OFF), 16, 1024, 0); } }
        const v4u sw = *(const LAS v4u*)(cnt + 4 * b);
        const unsigned w0 = (unsigned)__builtin_amdgcn_readfirstlane((int)sw.x), w1 = (unsigned)__builtin_amdgcn_readfirstlane((int)sw.y), w2 = (unsigned)__builtin_amdgcn_readfirstlane((int)sw.z), w3 = (unsigned)__builtin_amdgcn_readfirstlane((int)sw.w);
        const unsigned nb = (b == NBK - 1) ? 1024u : ((unsigned)__builtin_amdgcn_readfirstlane((int)cnt[4 * b + 4]) & 0xffffu);
        const int e0 = (int)(w0 >> 16), e1 = (int)(w1 & 0xffffu), e2 = (int)(w1 >> 16), e3 = (int)(w2 & 0xffffu), e4 = (int)(w2 >> 16), e5 = (int)(w3 & 0xffffu), e6 = (int)(w3 >> 16), e7 = (int)nb;
        P5_RUN(0, e0) P5_RUN(1, e1) P5_RUN(2, e2) P5_RUN(3, e3) P5_RUN(4, e4) P5_RUN(5, e5) P5_RUN(6, e6) P5_RUN(7, e7)
    }
#undef P5_RUN
#undef P5_QUAD
#undef P5_PAIR2
#undef P5_PAIR
#undef P5_DMA
    asm volatile("s_waitcnt vmcnt(0)" ::: "memory");
    lane = F.lane; asm volatile("" : "+v"(lane));
    v2u hw[8][4];
#pragma unroll
    for (int s = 0; s < 8; ++s) { const GAS v2u* hrow = (const GAS v2u*)(HB + (size_t)(t0 + 8 * w + s) * DM) + lane;
#pragma unroll
        for (int j = 0; j < 4; ++j) hw[s][j] = hrow[64 * j]; }
#pragma unroll
    for (int s = 0; s < 8; ++s) { GAS f32x4* orow = (GAS f32x4*)(out + (size_t)(t0 + 8 * w + s) * DM) + lane;
#pragma unroll
        for (int j = 0; j < 4; ++j) { f32x4 a = (f32x4){bflo(hw[s][j].x), bfhi(hw[s][j].x), bflo(hw[s][j].y), bfhi(hw[s][j].y)}; const float c = 1.0f / P5_GSCALE;
            a.x += (float)acc[s][2 * j][0] * c; a.y += (float)acc[s][2 * j][1] * c; a.z += (float)acc[s][2 * j + 1][0] * c; a.w += (float)acc[s][2 * j + 1][1] * c; orow[64 * j] = a; } }
    __syncthreads();
}
#undef P5_ISSUE
#undef P5_BODY

#ifndef GEMM_WGM1
#define GEMM_WGM1 2
#endif
#ifndef GEMM_WGM3
#define GEMM_WGM3 2
#endif
#ifndef GEMM_WGM4
#define GEMM_WGM4 2
#endif
#ifndef MK_N_LAUNCHES
#define MK_N_LAUNCHES 1
#endif
constexpr int N_LAUNCHES = MK_N_LAUNCHES;
constexpr int PER_PHASE = 7;
struct Args { const float* in[13]; float* out; unsigned char* ws; int ph_lo, ph_hi; };
__global__ void __launch_bounds__(NWAVES * 64, 2) fwd_megakernel(Args args) {
    extern __shared__ __attribute__((aligned(16))) unsigned char lds[];
    Frame F;
    F.lds = (LAS unsigned char*)lds;
    F.MISC = (volatile LAS unsigned*)(F.lds + MISC_OFF);
    F.tid = threadIdx.x; F.lane = F.tid & 63; F.wave = __builtin_amdgcn_readfirstlane(F.tid >> 6);
    F.G = gridDim.x;
    unsigned char* ws = args.ws; F.ws = ws;
    F.ctl = (gu32*)(ws + WS_CTL);
    F.x = args.in[0]; F.norm1_g = args.in[1]; F.w_in = args.in[2]; F.q_norm_g = args.in[3]; F.k_norm_g = args.in[4]; F.w_pool = args.in[5]; F.pool_scale = args.in[6];
    F.w_out = args.in[7]; F.norm2_g = args.in[8]; F.w_query = args.in[9]; F.sub_keys = args.in[10]; F.expert_u = args.in[11]; F.expert_v = args.in[12]; F.out = args.out;
    for (int u = F.tid; u < (LDS_BYTES - LDSCTL_OFF) / 4; u += NWAVES * 64) ((LAS unsigned*)(F.lds + LDSCTL_OFF))[u] = 0u;
    __syncthreads();
    XcdBarrier bar; bar.bar = (unsigned*)(F.ctl + CW_BAR); bar.x = 0; bar.st = nullptr;
    if (N_LAUNCHES == 1) bar = xcd_barrier_post((unsigned*)(F.ctl + CW_BAR), F.MISC + 8);
#define GRID_BAR() do { if (N_LAUNCHES == 1) xcd_barrier(bar); } while (0)
    const int lo = args.ph_lo, hi = args.ph_hi;
#define IN(k) (lo <= (k) && (k) < hi)
    bf16* const XB = (bf16*)(ws + WS_XB); bf16* const W1T = (bf16*)(ws + WS_W1T); bf16* const WOT = (bf16*)(ws + WS_WOT); bf16* const WQT = (bf16*)(ws + WS_WQT);
    bf16* const AIN = (bf16*)(ws + WS_AIN); bf16* const Qb = (bf16*)(ws + WS_Q); bf16* const Gb = (bf16*)(ws + WS_G);
    bf16* const Kb = (bf16*)args.out; bf16* const Vb = (bf16*)args.out + (size_t)T * DM;
    float* const MDm = (float*)(ws + WS_MD); float* const MDd = MDm + (size_t)3 * T * 16;
    bf16* const MERGED = XB; bf16* const HB = (bf16*)(ws + WS_HB); bf16* const QP = Gb;

    if (IN(0)) { p0_part_a(F); GRID_BAR(); p0_part_b(F); GRID_BAR(); }
    if (IN(1)) {
        pg8::Gemm g{XB, W1T, T, INW, DM / 2}; pg8::StaticOrder S; S.init(T, INW, F.G, (int)blockIdx.x, GEMM_WGM1);
        pg8::EpiProj E{AIN, Qb, Kb, Vb, Gb, F.q_norm_g, F.k_norm_g, (const float*)(ws + WS_S1), (const float*)(ws + WS_CS)};
        pg8::gemm_phase<pg8::EpiProj, pg8::StaticOrder, true, true, true>(F.lds + RING_OFF, g, S, E);
        GRID_BAR();
    }
    if (IN(2)) {
        constexpr int NU = 3 * BATCH * 16 * 32; const int per = (NU + F.G - 1) / F.G; const int u0 = blockIdx.x * per, u1 = (u0 + per) < NU ? (u0 + per) : NU;
        const bool xl = (F.G == 256);
        attn_phase(F, xl ? 0 : u0, xl ? 48 : u1, xl, Kb, Vb, Qb, MDm, MDd);
        GRID_BAR();
    }
    if (IN(3)) {
        constexpr int NU = T / 32; const int per = (NU + F.G - 1) / F.G; const int u0 = blockIdx.x * per, u1 = (u0 + per) < NU ? (u0 + per) : NU;
        for (int u = u0; u < u1; ++u) pool_merge_unit32(F, u, AIN, (const bf16*)(ws + WS_WPT), Qb, Gb, MDd, (unsigned char*)MERGED, (float*)(ws + WS_MS));
        GRID_BAR();
    }
    if (IN(4)) {
        pg8::Gemm g{MERGED, WOT, T, DM, DM / 2}; pg8::StaticOrder S; S.init(T, DM, F.G, (int)blockIdx.x, GEMM_WGM3);
        pg8::EpiOut E{F.x, F.out, HB, (const float*)(ws + WS_XM), (unsigned char*)args.out, (const float*)(ws + WS_MS), (const float*)(ws + WS_CS3)};
        pg8::gemm_phase<pg8::EpiOut, pg8::StaticOrder, true, true, true>(F.lds + RING_OFF, g, S, E);
        GRID_BAR();
    }
    if (IN(5)) {
        pg8::Gemm g{(const bf16*)args.out, WQT, T, 2048, DM / 2}; pg8::StaticOrder S; S.init(T, 2048, F.G, (int)blockIdx.x, GEMM_WGM4);
        pg8::EpiPlainI8 E{QP, 2048, (const float*)(ws + WS_XM), (const float*)(ws + WS_CS2)};
        pg8::gemm_phase<pg8::EpiPlainI8, pg8::StaticOrder, true, true, true>(F.lds + RING_OFF, g, S, E);
        GRID_BAR();
    }
    if (IN(6)) {
        constexpr int NU = T / 64; const int per = (NU + F.G - 1) / F.G; const int u0 = blockIdx.x * per, u1 = (u0 + per) < NU ? (u0 + per) : NU;
        for (int u = u0; u < u1; ++u) peer_unit(F, u, QP, (const bf16*)(ws + WS_SKB), ws + WS_UB, ws + WS_VB, (const float*)(ws + WS_SU), (const float*)(ws + WS_SV), HB, F.out);
    }
#undef IN
#undef GRID_BAR
}

extern "C" void kernel_launch(void* const* d_in, const int* in_sizes, int n_in, void* d_out, int out_size, void* d_ws, size_t ws_size, hipStream_t stream) {
    static int grid = 0;
    if (grid == 0) {
        if (n_in != 13 || in_sizes[0] != T * DM || out_size != T * DM || ws_size < WS_END) {
            fprintf(stderr, "kernel_launch: unexpected shapes (n_in %d, in0 %d, out %d, ws %zu, need %zu); nothing launched\n", n_in, n_in > 0 ? in_sizes[0] : -1, out_size, ws_size, (size_t)WS_END); grid = -1; return; }
        int dev = 0, cus = 0, per_cu = 0;
        if (hipGetDevice(&dev) != hipSuccess || hipDeviceGetAttribute(&cus, hipDeviceAttributeMultiprocessorCount, dev) != hipSuccess) { grid = -1; return; }
        if (hipFuncSetAttribute((const void*)fwd_megakernel, hipFuncAttributeMaxDynamicSharedMemorySize, LDS_BYTES) != hipSuccess) { fprintf(stderr, "kernel_launch: hipFuncSetAttribute failed\n"); grid = -1; return; }
        if (hipOccupancyMaxActiveBlocksPerMultiprocessor(&per_cu, (const void*)fwd_megakernel, NWAVES * 64, LDS_BYTES) != hipSuccess || per_cu < 1) { fprintf(stderr, "kernel_launch: occupancy query reports %d workgroups per CU\n", per_cu); grid = -1; (void)hipGetLastError(); return; }
        (void)hipGetLastError();
        grid = cus;
    }
    if (grid < 0) return;
    if (hipMemsetAsync((char*)d_ws + WS_CTL, 0, CTL_ZERO_BYTES, stream) != hipSuccess) return;
    Args a{};
    for (int i = 0; i < 13; ++i) a.in[i] = (const float*)d_in[i];
    a.out = (float*)d_out; a.ws = (unsigned char*)d_ws;
    for (int li = 0; li < N_LAUNCHES; ++li) {
        a.ph_lo = (N_LAUNCHES == 1) ? 0 : li; a.ph_hi = (N_LAUNCHES == 1) ? PER_PHASE : li + 1;
        hipLaunchKernelGGL(fwd_megakernel, dim3(grid), dim3(NWAVES * 64), LDS_BYTES, stream, a);
    }
}
```

```cpp
#include <hip/hip_runtime.h>
#include <cstdio>
#include <cstdint>
namespace pg8 {
#define PG8_LAS __attribute__((address_space(3)))
typedef unsigned short bf16_t;
typedef short bf16x8 __attribute__((ext_vector_type(8)));
typedef float f32x4 __attribute__((ext_vector_type(4)));
typedef unsigned u32x4 __attribute__((ext_vector_type(4)));
typedef int i32x4 __attribute__((ext_vector_type(4)));
constexpr int BM = 256, BK = 64, HALF = 128, HTB = HALF * BK * 2  , STAGE_BYTES = 8 * HTB, NXCD = 8;

__host__ __device__ __forceinline__ int lds_byte(int r, int c) { const int st = (r >> 4) * 2 + (c >> 5), rr = r & 15, cc = c & 31, ob = rr * 64 + cc * 2; return st * 1024 + (ob ^ (((ob >> 9) & 1) << 5)); }
__host__ __device__ __forceinline__ void stage_rc(int b, int& R, int& C) { const int st = b / 1024, sb = b % 1024, swz = sb ^ (((sb >> 9) & 1) << 5); R = (st >> 1) * 16 + swz / 64; C = (st & 1) * 32 + (swz % 64) / 2; }
__host__ __device__ __forceinline__ int perm32(int rho) { const int n = rho >> 4, i = rho & 15; return 8 * (i >> 2) + 4 * n + (i & 3); }

struct Unit { int pm, pn; };
struct Gemm { const bf16_t* A; const bf16_t* Bt; int M, N, K; };

struct StaticOrder {
    int nM, nN, nwg, G, c, WGM;
    __host__ __device__ void init(int M, int N, int G_, int c_, int wgm_ = 8) { nM = M / BM; nN = N / BM; nwg = nM * nN; G = G_; c = c_; WGM = wgm_; }
    __host__ __device__ bool next(int i, Unit& u) const {
        const long L = (long)i * G + c; if (L >= nwg) return false;
        int wgid = (int)L; { const int q = nwg / NXCD, r = nwg % NXCD, xcd = wgid % NXCD, off = wgid / NXCD; wgid = (xcd < r ? xcd * (q + 1) : r * (q + 1) + (xcd - r) * q) + off; }
        const int nig = WGM * nN, gid = wgid / nig, fm = gid * WGM, gsz = (nM - fm) < WGM ? (nM - fm) : WGM;
        u.pm = fm + ((wgid % nig) % gsz); u.pn = (wgid % nig) / gsz; return true;
    }
    __device__ __forceinline__ void a_ready(const Unit&) const {}
    __device__ __forceinline__ void done(const Unit&) const {}
};
__device__ __forceinline__ unsigned cvt_pk_bf16(float lo, float hi) { unsigned r; asm volatile("v_cvt_pk_bf16_f32 %0, %1, %2" : "=v"(r) : "v"(lo), "v"(hi)); return r; }

typedef float f32x2 __attribute__((ext_vector_type(2)));
__device__ __forceinline__ float xrow16_sum(float x) {
    auto s = __builtin_amdgcn_permlane16_swap(__float_as_uint(x), __float_as_uint(x), false, false);
    x = __uint_as_float(s[0]) + __uint_as_float(s[1]);
    auto t = __builtin_amdgcn_permlane32_swap(__float_as_uint(x), __float_as_uint(x), false, false);
    return __uint_as_float(t[0]) + __uint_as_float(t[1]);
}
struct EpiPlain {
    static constexpr bool PERM = true, AFTER_DRAIN = false;
    bf16_t* O; int ldc;
    __device__ __forceinline__ void operator()(const f32x4 (&acc)[2][2][4][2], const Unit& u, int wr, int wc, int fr, int fq) const {
        const int row0 = u.pm * BM + wr * 64 + fr; const int col0 = u.pn * BM + wc * 32 + 8 * fq;
#pragma unroll
        for (int ai = 0; ai < 2; ++ai)
#pragma unroll
            for (int m = 0; m < 4; ++m) { bf16_t* rowp = O + (size_t)(row0 + ai * HALF + m * 16) * ldc + col0;
#pragma unroll
                for (int bj = 0; bj < 2; ++bj) { const f32x4 v0 = acc[ai][bj][m][0], v1 = acc[ai][bj][m][1];
                    u32x4 w; w.x = cvt_pk_bf16(v0[0], v0[1]); w.y = cvt_pk_bf16(v0[2], v0[3]); w.z = cvt_pk_bf16(v1[0], v1[1]); w.w = cvt_pk_bf16(v1[2], v1[3]);
                    *(u32x4*)(rowp + bj * HALF) = w; } }
    }
};
struct EpiPlainI8 {
    static constexpr bool PERM = true, AFTER_DRAIN = false;
    bf16_t* O; int ldc; const float* xm; const float* cs;
    __device__ __forceinline__ void operator()(const f32x4 (&acc)[2][2][4][2], const Unit& u, int wr, int wc, int fr, int fq) const;
};
struct EpiProj {
    static constexpr bool PERM = true, AFTER_DRAIN = false;
    bf16_t *AIN, *Q, *K, *V, *G; const float* qg; const float* kg; const float* rs; const float* cs;
    __device__ __forceinline__ void operator()(const f32x4 (&acc)[2][2][4][2], const Unit& u, int wr, int wc, int fr, int fq) const {
        const int pn = u.pn; int type, ldc, colt; bf16_t* base;
        if (pn < 2)       { type = 0; base = AIN; ldc = 512;  colt = pn * 256; }
        else if (pn < 14) { type = 1; base = Q;   ldc = 3072; colt = (pn - 2) * 256; }
        else if (pn < 18) { type = 2; base = K;   ldc = 1024; colt = (pn - 14) * 256; }
        else if (pn < 22) { type = 3; base = V;   ldc = 1024; colt = (pn - 18) * 256; }
        else              { type = 4; base = G;   ldc = 2048; colt = (pn - 22) * 256; }
        const int col0 = colt + 64 * wc + 8 * fq;
        const int row0 = u.pm * BM + wr * 64 + fr;
        f32x4 gn[2][2], csv[2][2];
        const float* csp = cs + pn * 256 + 64 * wc + 8 * fq;
#pragma unroll
        for (int bj = 0; bj < 2; ++bj)
#pragma unroll
            for (int n = 0; n < 2; ++n) csv[bj][n] = *(const f32x4*)(csp + 32 * bj + 4 * n);
        float rs8[2][4];
#pragma unroll
        for (int ai = 0; ai < 2; ++ai)
#pragma unroll
            for (int m = 0; m < 4; ++m) rs8[ai][m] = rs[row0 + ai * HALF + m * 16];
        const float* gp = (type == 2) ? kg : qg;
        const float gmul = (type == 1) ? 0.125f * 1.4426950408889634f : 1.0f;
#pragma unroll
        for (int bj = 0; bj < 2; ++bj)
#pragma unroll
            for (int n = 0; n < 2; ++n) gn[bj][n] = *(const f32x4*)(gp + 32 * bj + 8 * fq + 4 * n) * gmul;
#pragma unroll
        for (int ai = 0; ai < 2; ++ai)
#pragma unroll
            for (int m = 0; m < 4; ++m) {
                const int row = row0 + ai * HALF + m * 16;
                f32x4 v[2][2];
#pragma unroll
                for (int bj = 0; bj < 2; ++bj)
#pragma unroll
                    for (int n = 0; n < 2; ++n) { const i32x4 iv = __builtin_bit_cast(i32x4, acc[ai][bj][m][n]); v[bj][n] = (f32x4){(float)iv[0], (float)iv[1], (float)iv[2], (float)iv[3]} * csv[bj][n]; }
                const float rsv = rs8[ai][m];
                if (type == 1 || type == 2) {
                    float ss = 0.f;
#pragma unroll
                    for (int bj = 0; bj < 2; ++bj)
#pragma unroll
                        for (int n = 0; n < 2; ++n) { const f32x4 x = v[bj][n]; ss += (x[0] * x[0] + x[1] * x[1]) + (x[2] * x[2] + x[3] * x[3]); }
                    ss = xrow16_sum(ss);
                    const float rn = __builtin_amdgcn_rsqf(ss * (rsv * rsv * (1.0f / 64.0f)) + 1e-6f) * rsv;
#pragma unroll
                    for (int bj = 0; bj < 2; ++bj)
#pragma unroll
                        for (int n = 0; n < 2; ++n) v[bj][n] = v[bj][n] * rn * gn[bj][n];
                } else {
#pragma unroll
                    for (int bj = 0; bj < 2; ++bj)
#pragma unroll
                        for (int n = 0; n < 2; ++n) v[bj][n] = v[bj][n] * rsv;
                }
                bf16_t* rowp = base + (size_t)row * ldc + col0;
                if (type >= 1 && type <= 3) {
                    const int hh = (colt >> 6) + wc;
                    const int bb = row >> 13, tt = row & 8191;
                    const size_t slab = (type == 1) ? (size_t)((hh >> 4) * 8 + bb) * 16 + (hh & 15) : (size_t)bb * 16 + hh;
                    rowp = base + (slab * 8192 + tt) * 64 + 8 * fq; }
                if (type >= 2) {
                    unsigned char* gp8 = (type == 4) ? (unsigned char*)G + (size_t)row * 2048 + col0 : (unsigned char*)(type == 2 ? K : V) + (((size_t)(row >> 13) * 16 + ((colt >> 6) + wc)) * 8192 + (row & 8191)) * 64 + 8 * fq;
                    typedef unsigned u32x2 __attribute__((ext_vector_type(2)));
#pragma unroll
                    for (int bj = 0; bj < 2; ++bj) { const f32x4 v0 = v[bj][0], v1 = v[bj][1];
                        int p0 = __builtin_amdgcn_cvt_pk_fp8_f32(v0[0], v0[1], 0, false); p0 = __builtin_amdgcn_cvt_pk_fp8_f32(v0[2], v0[3], p0, true);
                        int p1 = __builtin_amdgcn_cvt_pk_fp8_f32(v1[0], v1[1], 0, false); p1 = __builtin_amdgcn_cvt_pk_fp8_f32(v1[2], v1[3], p1, true);
                        *(u32x2*)(gp8 + 32 * bj) = (u32x2){(unsigned)p0, (unsigned)p1}; }
                } else {
#pragma unroll
                for (int bj = 0; bj < 2; ++bj) { const f32x4 v0 = v[bj][0], v1 = v[bj][1];
                    u32x4 w; w.x = cvt_pk_bf16(v0[0], v0[1]); w.y = cvt_pk_bf16(v0[2], v0[3]); w.z = cvt_pk_bf16(v1[0], v1[1]); w.w = cvt_pk_bf16(v1[2], v1[3]);
                    *(u32x4*)(rowp + 32 * bj) = w; }
                }
            }
    }
};
__device__ __forceinline__ float hscale(float xmax) { return (1.25f * xmax + 1.0f) * (1.0f / 127.0f); }
struct EpiOut {
    static constexpr bool PERM = true, AFTER_DRAIN = false;
    const float* x; float* out; bf16_t* hb; const float* xm; unsigned char* hq; const float* ms; const float* cs;
    __device__ __forceinline__ void operator()(const f32x4 (&acc)[2][2][4][2], const Unit& u, int wr, int wc, int fr, int fq) const {
        const int row0 = u.pm * BM + wr * 64 + fr; const int col0 = u.pn * BM + wc * 32 + 8 * fq;
        typedef unsigned u32x2 __attribute__((ext_vector_type(2)));
        float xm8[8], ms8[8];
#pragma unroll
        for (int it = 0; it < 8; ++it) { xm8[it] = xm[row0 + (it >> 2) * HALF + (it & 3) * 16]; ms8[it] = ms[row0 + (it >> 2) * HALF + (it & 3) * 16]; }
        f32x4 csv[2][2];
#pragma unroll
        for (int bj = 0; bj < 2; ++bj)
#pragma unroll
            for (int n = 0; n < 2; ++n) csv[bj][n] = *(const f32x4*)(cs + col0 + bj * HALF + 4 * n);
        f32x4 xc[2][2], xn[2][2];
#pragma unroll
        for (int bj = 0; bj < 2; ++bj) { xc[bj][0] = *(const f32x4*)(x + (size_t)row0 * 1024 + col0 + bj * HALF); xc[bj][1] = *(const f32x4*)(x + (size_t)row0 * 1024 + col0 + bj * HALF + 4); }
#pragma unroll
        for (int it = 0; it < 8; ++it) { const int ai = it >> 2, m = it & 3; const int row = row0 + ai * HALF + m * 16; const size_t off = (size_t)row * 1024 + col0;
            if (it < 7) { const size_t offn = (size_t)(row0 + ((it + 1) >> 2) * HALF + ((it + 1) & 3) * 16) * 1024 + col0;
#pragma unroll
                for (int bj = 0; bj < 2; ++bj) { xn[bj][0] = *(const f32x4*)(x + offn + bj * HALF); xn[bj][1] = *(const f32x4*)(x + offn + bj * HALF + 4); } }
            const float inv = 1.0f / hscale(xm8[it]);
#pragma unroll
            for (int bj = 0; bj < 2; ++bj) {
                const i32x4 i0 = __builtin_bit_cast(i32x4, acc[ai][bj][m][0]), i1 = __builtin_bit_cast(i32x4, acc[ai][bj][m][1]);
                const f32x4 v0 = (f32x4){(float)i0[0], (float)i0[1], (float)i0[2], (float)i0[3]} * (csv[bj][0] * ms8[it]) + xc[bj][0], v1 = (f32x4){(float)i1[0], (float)i1[1], (float)i1[2], (float)i1[3]} * (csv[bj][1] * ms8[it]) + xc[bj][1];
                u32x4 w; w.x = cvt_pk_bf16(v0[0], v0[1]); w.y = cvt_pk_bf16(v0[2], v0[3]); w.z = cvt_pk_bf16(v1[0], v1[1]); w.w = cvt_pk_bf16(v1[2], v1[3]);
                *(u32x4*)(hb + off + bj * HALF) = w;
                unsigned q0 = 0u, q1 = 0u;
#pragma unroll
                for (int e = 0; e < 4; ++e) { q0 = __builtin_amdgcn_cvt_pk_u8_f32(__builtin_amdgcn_fmed3f(__builtin_rintf(fmaf(v0[e], inv, 128.0f)), 1.0f, 255.0f), e, q0);
                                              q1 = __builtin_amdgcn_cvt_pk_u8_f32(__builtin_amdgcn_fmed3f(__builtin_rintf(fmaf(v1[e], inv, 128.0f)), 1.0f, 255.0f), e, q1); }
                *(u32x2*)(hq + off + bj * HALF) = (u32x2){q0 ^ 0x80808080u, q1 ^ 0x80808080u}; }
#pragma unroll
            for (int bj = 0; bj < 2; ++bj) { xc[bj][0] = xn[bj][0]; xc[bj][1] = xn[bj][1]; } }
    }
};
__device__ __forceinline__ void EpiPlainI8::operator()(const f32x4 (&acc)[2][2][4][2], const Unit& u, int wr, int wc, int fr, int fq) const {
    const int row0 = u.pm * BM + wr * 64 + fr; const int col0 = u.pn * BM + wc * 32 + 8 * fq;
    f32x4 csv[2][2];
#pragma unroll
    for (int bj = 0; bj < 2; ++bj)
#pragma unroll
        for (int n = 0; n < 2; ++n) csv[bj][n] = *(const f32x4*)(cs + col0 + bj * HALF + 4 * n);
    float xm8[2][4];
#pragma unroll
    for (int ai = 0; ai < 2; ++ai)
#pragma unroll
        for (int m = 0; m < 4; ++m) xm8[ai][m] = xm[row0 + ai * HALF + m * 16];
#pragma unroll
    for (int ai = 0; ai < 2; ++ai)
#pragma unroll
        for (int m = 0; m < 4; ++m) { const int row = row0 + ai * HALF + m * 16; bf16_t* rowp = O + (size_t)row * ldc + col0; const float rsv = hscale(xm8[ai][m]);
#pragma unroll
            for (int bj = 0; bj < 2; ++bj) { const i32x4 i0 = __builtin_bit_cast(i32x4, acc[ai][bj][m][0]), i1 = __builtin_bit_cast(i32x4, acc[ai][bj][m][1]);
                const f32x4 v0 = (f32x4){(float)i0[0], (float)i0[1], (float)i0[2], (float)i0[3]} * csv[bj][0] * rsv, v1 = (f32x4){(float)i1[0], (float)i1[1], (float)i1[2], (float)i1[3]} * csv[bj][1] * rsv;
                u32x4 w; w.x = cvt_pk_bf16(v0[0], v0[1]); w.y = cvt_pk_bf16(v0[2], v0[3]); w.z = cvt_pk_bf16(v1[0], v1[1]); w.w = cvt_pk_bf16(v1[2], v1[3]);
                *(u32x4*)(rowp + bj * HALF) = w; } }
}
template <class Epi, class Sched, bool ALIGN_EPI = false, bool SP2 = false, bool I8 = false>
__device__ __forceinline__ void gemm_phase(PG8_LAS unsigned char* lds, const Gemm g, const Sched& S, const Epi& E) {
    const int tid = threadIdx.x, wid = __builtin_amdgcn_readfirstlane(tid >> 6), lane = tid & 63, wr = wid >> 2, wc = wid & 3, fr = lane & 15, fq = lane >> 4;
    const int K = g.K, nt = K / BK;
    unsigned voffA[2], voffB[2];
#pragma unroll
    for (int i = 0; i < 2; ++i) { int R, C; stage_rc(tid * 16 + i * 8192, R, C); const int Rb = Epi::PERM ? ((R & ~31) + perm32(R & 31)) : R;
        voffA[i] = (unsigned)(R * K + C) * 2u; voffB[i] = (unsigned)(Rb * K + C) * 2u; }
    const size_t kstep = (size_t)(BK * 2);
    const size_t hstep = (size_t)HALF * K * 2;
    const size_t tstep = 2 * hstep;
    const unsigned ldsw = (unsigned)wid * 1024u;
    const int aoff = lds_byte(wr * 64 + fr, fq * 8), boff = lds_byte(wc * 32 + fr, fq * 8);
#define PG8_SA(b, h) (((b) * 2 + (h)) * HTB)
#define PG8_SB(b, h) ((4 + (b) * 2 + (h)) * HTB)
#define PG8_STAGE(bufoff, gbase, voff) do { _Pragma("unroll") for (int _i = 0; _i < 2; ++_i) \
        __builtin_amdgcn_global_load_lds((const unsigned*)((const char*)(gbase) + (voff)[_i]), (PG8_LAS unsigned*)(lds + (bufoff) + ldsw + _i * 8192), 16, 0, 0); } while (0)
#define PG8_LDA(dst, b, h) do { _Pragma("unroll") for (int m = 0; m < 4; ++m) _Pragma("unroll") for (int k = 0; k < 2; ++k) dst[m][k] = *(const PG8_LAS bf16x8*)(lds + PG8_SA(b, h) + aoff + m * 2048 + k * 1024); } while (0)
#define PG8_LDB(dst, b, h) do { _Pragma("unroll") for (int n = 0; n < 2; ++n) _Pragma("unroll") for (int k = 0; k < 2; ++k) dst[n][k] = *(const PG8_LAS bf16x8*)(lds + PG8_SB(b, h) + boff + n * 2048 + k * 1024); } while (0)
#define PG8_MMA(ai, bj, At, Bt) do { __builtin_amdgcn_s_setprio(1); _Pragma("unroll") for (int m = 0; m < 4; ++m) _Pragma("unroll") for (int n = 0; n < 2; ++n) _Pragma("unroll") for (int k = 0; k < 2; ++k) \
        { if constexpr (I8) acc[ai][bj][m][n] = __builtin_bit_cast(f32x4, __builtin_amdgcn_mfma_i32_16x16x64_i8(__builtin_bit_cast(i32x4, Bt[n][k]), __builtin_bit_cast(i32x4, At[m][k]), __builtin_bit_cast(i32x4, acc[ai][bj][m][n]), 0, 0, 0)); \
          else acc[ai][bj][m][n] = __builtin_amdgcn_mfma_f32_16x16x32_bf16(Bt[n][k], At[m][k], acc[ai][bj][m][n], 0, 0, 0); } __builtin_amdgcn_s_setprio(0); } while (0)
#define PG8_WAIT_V(n) asm volatile("s_waitcnt vmcnt(" #n ")" ::: "memory")
#define PG8_WAIT_L(n) asm volatile("s_waitcnt lgkmcnt(" #n ")" ::: "memory")
#define PG8_BAR __builtin_amdgcn_s_barrier()
#define PG8_SCHED __builtin_amdgcn_sched_barrier(0)
    Unit cur, nxt; int ui = 0;
    if (!S.next(0, cur)) return;
    f32x4 acc[2][2][4][2];
#pragma unroll
    for (int a = 0; a < 2; ++a)
#pragma unroll
        for (int b = 0; b < 2; ++b)
#pragma unroll
            for (int m = 0; m < 4; ++m)
#pragma unroll
                for (int n = 0; n < 2; ++n) acc[a][b][m][n] = (f32x4){0.f, 0.f, 0.f, 0.f};
    bf16x8 At[4][2], B0[2][2], B1[2][2];
    const char* cA = (const char*)g.A + (size_t)cur.pm * tstep; const char* cB = (const char*)g.Bt + (size_t)cur.pn * tstep;
    S.a_ready(cur);
    if constexpr (SP2) {
        PG8_STAGE(PG8_SB(0, 0), cB, voffB); PG8_STAGE(PG8_SB(0, 1), cB + hstep, voffB); PG8_STAGE(PG8_SA(0, 0), cA, voffA); PG8_STAGE(PG8_SA(0, 1), cA + hstep, voffA);
        if (wr == 1) PG8_BAR;
        PG8_WAIT_V(2); PG8_BAR;
        PG8_STAGE(PG8_SB(1, 0), cB + kstep, voffB); PG8_STAGE(PG8_SA(1, 0), cA + kstep, voffA); PG8_STAGE(PG8_SB(1, 1), cB + hstep + kstep, voffB);
        PG8_WAIT_V(6); PG8_BAR;
    } else {
        PG8_STAGE(PG8_SB(0, 0), cB, voffB); PG8_STAGE(PG8_SA(0, 0), cA, voffA); PG8_STAGE(PG8_SB(0, 1), cB + hstep, voffB); PG8_STAGE(PG8_SA(0, 1), cA + hstep, voffA);
        if (wr == 1) PG8_BAR;
        PG8_WAIT_V(4); PG8_BAR;
        PG8_STAGE(PG8_SB(1, 0), cB + kstep, voffB); PG8_STAGE(PG8_SA(1, 0), cA + kstep, voffA); PG8_STAGE(PG8_SB(1, 1), cB + hstep + kstep, voffB);
        PG8_WAIT_V(6); PG8_BAR;
    }
    for (;;) {
        const bool has_next = S.next(ui + 1, nxt);
        const char* nA = has_next ? (const char*)g.A + (size_t)nxt.pm * tstep : cA; const char* nB = has_next ? (const char*)g.Bt + (size_t)nxt.pn * tstep : cB;
        for (int t = 0; t < nt; t += 2) {
            const bool last = (t == nt - 2);
            const char* a1 = cA + (size_t)(t + 1) * kstep;
            const char* a2 = last ? nA : cA + (size_t)(t + 2) * kstep; const char* b2 = last ? nB : cB + (size_t)(t + 2) * kstep;
            const char* a3 = a2 + kstep; const char* b3 = b2 + kstep;
            if (last && has_next) S.a_ready(nxt);
            if constexpr (SP2) {
            PG8_LDB(B0, 0, 0); PG8_LDB(B1, 0, 1); PG8_SCHED; PG8_LDA(At, 0, 0); PG8_STAGE(PG8_SA(1, 1), a1 + hstep, voffA);
            PG8_WAIT_V(8); PG8_WAIT_L(0); PG8_BAR; PG8_MMA(0, 0, At, B0); PG8_MMA(0, 1, At, B1); PG8_BAR; PG8_SCHED;
            PG8_LDA(At, 0, 1); PG8_STAGE(PG8_SB(0, 0), b2, voffB); PG8_STAGE(PG8_SB(0, 1), b2 + hstep, voffB); PG8_STAGE(PG8_SA(0, 0), a2, voffA);
            PG8_WAIT_V(8); PG8_WAIT_L(0); PG8_BAR; PG8_MMA(1, 0, At, B0); PG8_MMA(1, 1, At, B1); PG8_BAR; PG8_SCHED;
            PG8_LDB(B0, 1, 0); PG8_LDB(B1, 1, 1); PG8_SCHED; PG8_LDA(At, 1, 0); PG8_STAGE(PG8_SA(0, 1), a2 + hstep, voffA);
            PG8_WAIT_V(8); PG8_WAIT_L(0); PG8_BAR; PG8_MMA(0, 0, At, B0); PG8_MMA(0, 1, At, B1); PG8_BAR; PG8_SCHED;
            PG8_LDA(At, 1, 1); PG8_STAGE(PG8_SB(1, 0), b3, voffB); PG8_STAGE(PG8_SB(1, 1), b3 + hstep, voffB); PG8_STAGE(PG8_SA(1, 0), a3, voffA);
            PG8_WAIT_V(8); PG8_WAIT_L(0); PG8_BAR; PG8_MMA(1, 0, At, B0); PG8_MMA(1, 1, At, B1); PG8_BAR; PG8_SCHED;
            } else {
            PG8_LDB(B0, 0, 0); PG8_SCHED; PG8_LDA(At, 0, 0); PG8_STAGE(PG8_SA(1, 1), a1 + hstep, voffA);
            PG8_WAIT_L(8); PG8_BAR; PG8_WAIT_L(0); PG8_MMA(0, 0, At, B0); PG8_BAR; PG8_SCHED;
            PG8_LDB(B1, 0, 1); PG8_STAGE(PG8_SB(0, 0), b2, voffB);
            PG8_BAR; PG8_WAIT_L(0); PG8_MMA(0, 1, At, B1); PG8_BAR;
            PG8_LDA(At, 0, 1); PG8_STAGE(PG8_SA(0, 0), a2, voffA);
            PG8_BAR; PG8_WAIT_L(0); PG8_MMA(1, 0, At, B0); PG8_BAR; PG8_SCHED;
            PG8_STAGE(PG8_SB(0, 1), b2 + hstep, voffB);
            PG8_WAIT_V(6); PG8_BAR; PG8_MMA(1, 1, At, B1); PG8_BAR;
            PG8_LDB(B0, 1, 0); PG8_SCHED; PG8_LDA(At, 1, 0); PG8_STAGE(PG8_SA(0, 1), a2 + hstep, voffA);
            PG8_WAIT_L(8); PG8_BAR; PG8_WAIT_L(0); PG8_MMA(0, 0, At, B0); PG8_BAR; PG8_SCHED;
            PG8_LDB(B1, 1, 1); PG8_STAGE(PG8_SB(1, 0), b3, voffB);
            PG8_BAR; PG8_WAIT_L(0); PG8_MMA(0, 1, At, B1); PG8_BAR;
            PG8_LDA(At, 1, 1); PG8_STAGE(PG8_SA(1, 0), a3, voffA);
            PG8_BAR; PG8_WAIT_L(0); PG8_MMA(1, 0, At, B0); PG8_BAR; PG8_SCHED;
            PG8_STAGE(PG8_SB(1, 1), b3 + hstep, voffB);
            PG8_WAIT_V(6); PG8_BAR; PG8_MMA(1, 1, At, B1); PG8_BAR;
            }
        }
        if constexpr (ALIGN_EPI) { if (wr == 0) PG8_BAR; }
        if constexpr (!Epi::AFTER_DRAIN) { E(acc, cur, wr, wc, fr, fq); S.done(cur); }
        if (!has_next) break;
#pragma unroll
        for (int a = 0; a < 2; ++a)
#pragma unroll
            for (int b = 0; b < 2; ++b)
#pragma unroll
                for (int m = 0; m < 4; ++m)
#pragma unroll
                    for (int n = 0; n < 2; ++n) acc[a][b][m][n] = (f32x4){0.f, 0.f, 0.f, 0.f};
        cur = nxt; cA = nA; cB = nB; ++ui;
        if constexpr (ALIGN_EPI) { if (wr == 1) PG8_BAR; }
    }
    PG8_WAIT_V(0);
    if constexpr (!ALIGN_EPI) { if (wr == 0) PG8_BAR; }
    PG8_BAR;
    if constexpr (Epi::AFTER_DRAIN) { E.fused(acc, cur, wr, wc, fr, fq, lds, wid, lane); S.done(cur); }
#undef PG8_SA
#undef PG8_SB
#undef PG8_STAGE
#undef PG8_LDA
#undef PG8_LDB
#undef PG8_MMA
#undef PG8_WAIT_V
#undef PG8_WAIT_L
#undef PG8_BAR
#undef PG8_SCHED
}
}

constexpr int NWAVES = 8;
constexpr int BATCH = 8, SEQ = 8192, DM = 1024, T = BATCH * SEQ;
constexpr int INW = 7680, QW = 3072, GATEW = 2048, POOLW = 512;
constexpr int NEXP = 16384;
constexpr float EPS = 1e-6f;
constexpr float LOG2E = 1.4426950408889634f;

constexpr size_t MiB = 1u << 20;
constexpr size_t WS_CTL = 0, CTL_ZERO_BYTES = 1 * MiB;
constexpr size_t WS_W1T = 2 * MiB;
constexpr size_t WS_WOT = 17 * MiB;
constexpr size_t WS_WQT = 19 * MiB;
constexpr size_t WS_WPT = 23 * MiB;
constexpr size_t WS_SKB = 23 * MiB + 512 * 1024;
constexpr size_t WS_S1 = 24 * MiB;
constexpr size_t WS_SU = 24 * MiB + 256 * 1024, WS_SV = 24 * MiB + 512 * 1024;
constexpr size_t WS_UB = 25 * MiB;
constexpr size_t WS_VB = 57 * MiB;
constexpr size_t WS_MD = 89 * MiB;
constexpr size_t WS_XB = 113 * MiB;
constexpr size_t WS_AIN = 241 * MiB;
constexpr size_t WS_Q = 305 * MiB;
constexpr size_t WS_G = 689 * MiB;
constexpr size_t WS_END = 945 * MiB;
constexpr size_t WS_HB = WS_AIN;
constexpr size_t WS_CMAX = 64 * 1024;
constexpr size_t WS_CS = 128 * 1024;
constexpr size_t WS_CMAX2 = 96 * 1024;
constexpr size_t WS_CS2 = 192 * 1024;
constexpr size_t WS_CMAX3 = 104 * 1024;
constexpr size_t WS_CS3 = 200 * 1024;
constexpr size_t WS_MS = 512 * 1024;
constexpr size_t WS_XM = 256 * 1024;

constexpr int CW_BAR = 4096;
constexpr int RING_OFF = 0, RING_BYTES = 131072;
constexpr int LDSCTL_OFF = 162816, MISC_OFF = LDSCTL_OFF + 320;
constexpr int LDS_BYTES = 163840;

#define GAS __attribute__((address_space(1)))
#define LAS __attribute__((address_space(3)))
typedef unsigned short bf16;
typedef unsigned v4u __attribute__((ext_vector_type(4)));
typedef unsigned v2u __attribute__((ext_vector_type(2)));
typedef float f32x4 __attribute__((ext_vector_type(4)));
typedef float f32x16 __attribute__((ext_vector_type(16)));
typedef short bf16x8 __attribute__((ext_vector_type(8)));
typedef short s16x4 __attribute__((ext_vector_type(4)));
typedef __bf16 bf16x2_t __attribute__((ext_vector_type(2)));
typedef GAS unsigned gu32;
#define RLX_AGENT __ATOMIC_RELAXED, __HIP_MEMORY_SCOPE_AGENT
#define LDS_WAIT() asm volatile("s_waitcnt lgkmcnt(0)" ::: "memory")
#define VM_WAIT() asm volatile("s_waitcnt vmcnt(0)" ::: "memory")
__device__ __forceinline__ unsigned f2bf(float f) { unsigned u = __builtin_bit_cast(unsigned, f); return (u + 0x7fffu + ((u >> 16) & 1u)) >> 16; }
__device__ __forceinline__ unsigned pk2(float lo, float hi) { return f2bf(lo) | (f2bf(hi) << 16); }
__device__ __forceinline__ float bflo(unsigned w) { return __uint_as_float(w << 16); }
__device__ __forceinline__ float bfhi(unsigned w) { return __uint_as_float(w & 0xffff0000u); }
__device__ __forceinline__ int crow(int r, int hi) { return (r & 3) + 8 * (r >> 2) + 4 * hi; }
__device__ __forceinline__ float xhalf_max(float x) { auto t = __builtin_amdgcn_permlane32_swap(__float_as_uint(x), __float_as_uint(x), false, false); return fmaxf(__uint_as_float(t[0]), __uint_as_float(t[1])); }
__device__ __forceinline__ float xhalf_sum(float x) { auto t = __builtin_amdgcn_permlane32_swap(__float_as_uint(x), __float_as_uint(x), false, false); return __uint_as_float(t[0]) + __uint_as_float(t[1]); }
__device__ __forceinline__ float wave_sum(float v) {
#pragma unroll
    for (int o = 1; o < 64; o <<= 1) v += __shfl_xor(v, o);
    return v;
}
__device__ __forceinline__ float dot2bf(unsigned a, unsigned b, float acc) { return __builtin_amdgcn_fdot2_f32_bf16(__builtin_bit_cast(bf16x2_t, a), __builtin_bit_cast(bf16x2_t, b), acc, false); }

#define XB_TMO      128
#define XB_XCNT(j)  (256  + 64 * (j))
#define XB_XSUB(j)  (1280 + 64 * (j))
#define XB_XGEN(j)  (2304 + 64 * (j))
#define XB_TOP      3328
#define XB_TOPGEN   3392
#define XCD_BAR_WORDS 3456
#define XB_SPIN_CAP (1u << 18)

__device__ __forceinline__ unsigned xb_ld(unsigned* p)              { return __hip_atomic_load(p, __ATOMIC_RELAXED, __HIP_MEMORY_SCOPE_AGENT); }
__device__ __forceinline__ unsigned xb_add(unsigned* p, unsigned v) { return __hip_atomic_fetch_add(p, v, __ATOMIC_RELAXED, __HIP_MEMORY_SCOPE_AGENT); }
__device__ __forceinline__ unsigned xb_xcc_id() { return (unsigned)__builtin_amdgcn_s_getreg((3 << 11) | 20) & 0xFu; }
#define XB_SPIN(cond, bar) do { unsigned _sp = 0; while (cond) { __builtin_amdgcn_s_sleep(1); \
    if ((++_sp & 255u) == 0u) { if (xb_ld(&(bar)[XB_TMO])) break; if (_sp > XB_SPIN_CAP) { atomicAdd(&(bar)[XB_TMO], 1u); break; } } } } while (0)

struct XcdBarrier {
    unsigned* bar; unsigned x;
    volatile LAS unsigned* st;
};

__device__ __forceinline__ XcdBarrier xcd_barrier_post(unsigned* bar, volatile LAS unsigned* st) {
    XcdBarrier b; b.bar = bar; b.x = xb_xcc_id(); b.st = st;
    if (threadIdx.x == 0) (void)xb_add(&bar[XB_XCNT(b.x)], 1u);
    return b;
}
__device__ __forceinline__ void xcd_barrier_complete(unsigned* bar, unsigned x, unsigned& nloc, unsigned& nx) {
    const unsigned G = gridDim.x * gridDim.y * gridDim.z;
    unsigned sum, cnt, mine, sp = 0u;
    for (;;) {
        sum = 0u; cnt = 0u; mine = 0u;
#pragma unroll
        for (unsigned j = 0; j < 16; ++j) { const unsigned c = xb_ld(&bar[XB_XCNT(j)]); sum += c; cnt += (c > 0u) ? 1u : 0u; mine = (j == x) ? c : mine; }
        if (sum == G) break;
        __builtin_amdgcn_s_sleep(1);
        if ((++sp & 255u) == 0u) { if (xb_ld(&bar[XB_TMO])) break; if (sp > XB_SPIN_CAP) { atomicAdd(&bar[XB_TMO], 1u); break; } }
    }
    nloc = mine > 0u ? mine : 1u; nx = cnt > 0u ? cnt : 1u;
}

__device__ __forceinline__ void xcd_barrier(const XcdBarrier& b) {
    asm volatile("s_waitcnt vmcnt(0)" ::: "memory");
    __syncthreads();
    if (threadIdx.x == 0) {
        unsigned* bar = b.bar;
        __builtin_amdgcn_s_waitcnt(0);
        unsigned nloc = b.st[0], nx = b.st[1];
        if (nloc == 0u) { xcd_barrier_complete(bar, b.x, nloc, nx); b.st[0] = nloc; b.st[1] = nx; }
        const unsigned old = xb_add(&bar[XB_XSUB(b.x)], 1u);
        const unsigned gen = old / nloc;
        if (old + 1u == (gen + 1u) * nloc) {
            __builtin_amdgcn_fence(__ATOMIC_RELEASE, "agent");
            asm volatile("s_waitcnt vmcnt(0)" ::: "memory");
            const unsigned og = xb_add(&bar[XB_TOP], 1u);
            const unsigned tg = og / nx;
            if (og + 1u == (tg + 1u) * nx) xb_add(&bar[XB_TOPGEN], 1u);
            else XB_SPIN(xb_ld(&bar[XB_TOPGEN]) == tg, bar);
            __builtin_amdgcn_fence(__ATOMIC_ACQUIRE, "agent");
            xb_add(&bar[XB_XGEN(b.x)], 1u);
            asm volatile("s_waitcnt vmcnt(0)" ::: "memory");
        } else {
            XB_SPIN(xb_ld(&bar[XB_XGEN(b.x)]) == gen, bar);
            __builtin_amdgcn_fence(__ATOMIC_ACQUIRE, "agent");
            asm volatile("s_waitcnt vmcnt(0)" ::: "memory");
        }
    }
    __syncthreads();
}

struct Frame {
    LAS unsigned char* lds;
    volatile LAS unsigned* MISC;
    gu32* ctl;
    int tid, lane, wave, G;
    const float *x, *norm1_g, *w_in, *q_norm_g, *k_norm_g, *w_pool, *pool_scale, *w_out, *norm2_g, *w_query, *sub_keys, *expert_u, *expert_v;
    float* out; unsigned char* ws;
};
template <int CTRL> __device__ __forceinline__ float dppf(float x) { return __builtin_bit_cast(float, __builtin_amdgcn_mov_dpp(__builtin_bit_cast(int, x), CTRL, 0xf, 0xf, true)); }
__device__ __forceinline__ float wave_sum_dpp(float x) {
    x += dppf<0xB1>(x);
    x += dppf<0x4E>(x);
    x += dppf<0x141>(x);
    x += dppf<0x128>(x);
    return pg8::xrow16_sum(x);
}

__device__ __forceinline__ float wave_max_dpp(float x) {
    x = fmaxf(x, dppf<0xB1>(x)); x = fmaxf(x, dppf<0x4E>(x)); x = fmaxf(x, dppf<0x141>(x)); x = fmaxf(x, dppf<0x128>(x));
    auto s = __builtin_amdgcn_permlane16_swap(__float_as_uint(x), __float_as_uint(x), false, false);
    x = fmaxf(__uint_as_float(s[0]), __uint_as_float(s[1]));
    auto t = __builtin_amdgcn_permlane32_swap(__float_as_uint(x), __float_as_uint(x), false, false);
    return fmaxf(__uint_as_float(t[0]), __uint_as_float(t[1]));
}
template <int CTRL> __device__ __forceinline__ int dppi(int x) { return __builtin_amdgcn_mov_dpp(x, CTRL, 0xf, 0xf, true); }
__device__ __forceinline__ int wave_sum_dpp_i(int x) {
    x += dppi<0xB1>(x); x += dppi<0x4E>(x); x += dppi<0x141>(x); x += dppi<0x128>(x);
    auto s = __builtin_amdgcn_permlane16_swap((unsigned)x, (unsigned)x, false, false); x = (int)(s[0] + s[1]);
    auto t = __builtin_amdgcn_permlane32_swap((unsigned)x, (unsigned)x, false, false); return (int)(t[0] + t[1]);
}
__device__ __forceinline__ v4u quant16(const f32x4 (&v)[4], float inv, int off) {
    v4u o;
#pragma unroll
    for (int j = 0; j < 4; ++j) {
        const int a = (int)__builtin_rintf(v[j].x * inv) + off, b = (int)__builtin_rintf(v[j].y * inv) + off, c = (int)__builtin_rintf(v[j].z * inv) + off, d = (int)__builtin_rintf(v[j].w * inv) + off;
        o[j] = (unsigned)(a & 255) | ((unsigned)(b & 255) << 8) | ((unsigned)(c & 255) << 16) | ((unsigned)(d & 255) << 24);
    }
    return o;
}
__device__ __forceinline__ void p0_quant_row(const float* xrow, const float* gain, unsigned char* orow, float* scale_out, int off, int lane) {
    const GAS f32x4* xr = (const GAS f32x4*)xrow + lane;
    f32x4 v[4]; float mx = 0.f;
#pragma unroll
    for (int j = 0; j < 4; ++j) { v[j] = xr[64 * j]; if (gain) v[j] = v[j] * ((const f32x4*)gain)[64 * j + lane];
        mx = fmaxf(mx, fmaxf(fmaxf(fabsf(v[j].x), fabsf(v[j].y)), fmaxf(fabsf(v[j].z), fabsf(v[j].w)))); }
    mx = wave_max_dpp(mx);
    const float sc = mx > 0.f ? mx * (1.0f / 127.0f) : 1.0f, inv = 1.0f / sc;
    *(GAS v4u*)(orow + 16 * lane) = quant16(v, inv, off);
    if (lane == 0) __hip_atomic_store(scale_out, sc, __ATOMIC_RELAXED, __HIP_MEMORY_SCOPE_AGENT);
}
__device__ __forceinline__ void p0_fp8_row(const float* xrow, unsigned char* orow, float* scale_out, int lane) {
    const GAS f32x4* xr = (const GAS f32x4*)xrow + lane;
    f32x4 v[4]; float mx = 0.f;
#pragma unroll
    for (int j = 0; j < 4; ++j) { v[j] = xr[64 * j]; mx = fmaxf(mx, fmaxf(fmaxf(fabsf(v[j].x), fabsf(v[j].y)), fmaxf(fabsf(v[j].z), fabsf(v[j].w)))); }
    mx = wave_max_dpp(mx);
    const float sc = mx > 0.f ? mx * (1.0f / 400.0f) : 1.0f, inv = 1.0f / sc;
    v4u o;
#pragma unroll
    for (int j = 0; j < 4; ++j) { int pk = __builtin_amdgcn_cvt_pk_fp8_f32(v[j].x * inv, v[j].y * inv, 0, false); pk = __builtin_amdgcn_cvt_pk_fp8_f32(v[j].z * inv, v[j].w * inv, pk, true); o[j] = (unsigned)pk; }
    *(GAS v4u*)(orow + 16 * lane) = o;
    if (lane == 0) __hip_atomic_store(scale_out, sc, __ATOMIC_RELAXED, __HIP_MEMORY_SCOPE_AGENT);
}
__device__ __forceinline__ void p0_transpose_item(const float* W, int K, int N, const float* rs, const float* cs, bf16* WT, int permute, LAS float* scr, int item, int lane) {
    const int nblk = N / 32, kb = item / nblk, nb = item % nblk, k0 = 64 * kb, n0 = 32 * nb;
    const float csv = cs ? cs[n0 + (lane & 31)] : 1.f;
#pragma unroll 8
    for (int i = 0; i < 32; ++i) { const int kk = 2 * i + (lane >> 5); const float r = rs ? rs[k0 + kk] : 1.f; scr[kk * 33 + (lane & 31)] = W[(size_t)(k0 + kk) * N + n0 + (lane & 31)] * r * csv; }
    LDS_WAIT(); asm volatile("" ::: "memory");
    int nout0 = n0;
    if (permute) { const int gl = (n0 & 255) >> 5; const int gp = 4 * (gl & 1) + (gl >> 1); nout0 = (n0 & ~255) + 32 * gp; }
    const int c = lane & 7;
#pragma unroll
    for (int j = 0; j < 4; ++j) { const int n = (lane >> 3) + 8 * j; const LAS float* s = scr + (8 * c) * 33 + n;
        v4u o; o.x = pk2(s[0 * 33], s[1 * 33]); o.y = pk2(s[2 * 33], s[3 * 33]); o.z = pk2(s[4 * 33], s[5 * 33]); o.w = pk2(s[6 * 33], s[7 * 33]);
        *(GAS v4u*)(WT + (size_t)(nout0 + n) * K + k0 + 8 * c) = o; }
    LDS_WAIT(); asm volatile("" ::: "memory");
}
__device__ __forceinline__ void p0_row(const float* xrow, const float* gain, bf16* orow, bool rms, int lane) {
    const GAS f32x4* xr = (const GAS f32x4*)xrow + lane;
    f32x4 v[4]; float s = 0.f;
#pragma unroll
    for (int j = 0; j < 4; ++j) { v[j] = xr[64 * j]; s += (v[j].x * v[j].x + v[j].y * v[j].y) + (v[j].z * v[j].z + v[j].w * v[j].w); }
    if (rms) { s = wave_sum(s); const float r = 1.0f / sqrtf(s * (1.0f / 1024.0f) + EPS);
#pragma unroll
        for (int j = 0; j < 4; ++j) v[j] = v[j] * r; }
    if (gain) {
#pragma unroll
        for (int j = 0; j < 4; ++j) v[j] = v[j] * ((const f32x4*)gain)[64 * j + lane];
    }
    GAS unsigned long long* o8 = (GAS unsigned long long*)orow + lane;
#pragma unroll
    for (int j = 0; j < 4; ++j) o8[64 * j] = (unsigned long long)pk2(v[j].x, v[j].y) | ((unsigned long long)pk2(v[j].z, v[j].w) << 32);
}
__device__ __forceinline__ void p0_colmax_item(const float* W, int N, const float* rs, unsigned* cmax, int item, int lane) {
    const int nblk = N / 32, kb = item / nblk, nb = item % nblk, k0 = 64 * kb, n0 = 32 * nb;
    float mx = 0.f;
    const int half = lane >> 5, col = lane & 31;
    const int rsreg = rs ? __float_as_int(rs[k0 + lane]) : __float_as_int(1.f);
#pragma unroll
    for (int c = 0; c < 2; ++c) { float wv[16];
#pragma unroll
        for (int j = 0; j < 16; ++j) wv[j] = W[(size_t)(k0 + 2 * (16 * c + j) + half) * N + n0 + col];
        __builtin_amdgcn_sched_barrier(0);
#pragma unroll
        for (int j = 0; j < 16; ++j) { const int i = 16 * c + j; const float r0 = __int_as_float(__builtin_amdgcn_readlane(rsreg, 2 * i)), r1 = __int_as_float(__builtin_amdgcn_readlane(rsreg, 2 * i + 1));
            mx = fmaxf(mx, fabsf(wv[j] * (half ? r1 : r0))); }
        __builtin_amdgcn_sched_barrier(0); }
    mx = xhalf_max(mx);
    if (lane < 32) (void)__hip_atomic_fetch_max(cmax + n0 + lane, __float_as_uint(mx), __ATOMIC_RELAXED, __HIP_MEMORY_SCOPE_AGENT);
}
__device__ __forceinline__ void p0_transpose_q8_item(const float* W, int N, const float* rs, unsigned* cmax, float* cscale, unsigned char* WT, int permute, LAS float* scr, int item, int lane) {
    constexpr int K = 1024;
    const int nblk = N / 32, kb = item / nblk, nb = item % nblk, k0 = 128 * kb, n0 = 32 * nb;
    const float cm = __uint_as_float(__hip_atomic_load(cmax + n0 + (lane & 31), __ATOMIC_RELAXED, __HIP_MEMORY_SCOPE_AGENT));
    const float inv = cm > 0.f ? 127.0f / cm : 0.f;
    if (kb == 0 && lane < 32) cscale[n0 + lane] = cm * (1.0f / 127.0f);
    const int half = lane >> 5, col = lane & 31;
    const int rs0 = rs ? __float_as_int(rs[k0 + lane]) : __float_as_int(1.f), rs1 = rs ? __float_as_int(rs[k0 + 64 + lane]) : __float_as_int(1.f);
#pragma unroll
    for (int c = 0; c < 4; ++c) { float wv[16];
#pragma unroll
        for (int j = 0; j < 16; ++j) wv[j] = W[(size_t)(k0 + 2 * (16 * c + j) + half) * N + n0 + col];
        __builtin_amdgcn_sched_barrier(0);
#pragma unroll
        for (int j = 0; j < 16; ++j) { const int i = 16 * c + j; const int rr = (i < 32) ? rs0 : rs1; const float r0 = __int_as_float(__builtin_amdgcn_readlane(rr, (2 * i) & 63)), r1 = __int_as_float(__builtin_amdgcn_readlane(rr, (2 * i + 1) & 63));
            scr[(2 * i + half) * 33 + col] = __builtin_rintf(wv[j] * (half ? r1 : r0) * inv); }
        __builtin_amdgcn_sched_barrier(0); }
    LDS_WAIT(); asm volatile("" ::: "memory");
    int nout0 = n0;
    if (permute) { const int gl = (n0 & 255) >> 5; const int gp = 4 * (gl & 1) + (gl >> 1); nout0 = (n0 & ~255) + 32 * gp; }
    const int c = lane & 7;
#pragma unroll
    for (int j = 0; j < 4; ++j) { const int n = (lane >> 3) + 8 * j; const LAS float* sp = scr + (16 * c) * 33 + n;
        v4u o;
#pragma unroll
        for (int d = 0; d < 4; ++d) o[d] = ((unsigned)(int)sp[(4 * d) * 33] & 255u) | (((unsigned)(int)sp[(4 * d + 1) * 33] & 255u) << 8) | (((unsigned)(int)sp[(4 * d + 2) * 33] & 255u) << 16) | ((unsigned)(int)sp[(4 * d + 3) * 33] << 24);
        *(GAS v4u*)(WT + (size_t)(nout0 + n) * K + k0 + 16 * c) = o; }
    LDS_WAIT(); asm volatile("" ::: "memory");
}
__device__ __forceinline__ void p0_xrow_q8(const float* xrow, unsigned char* orow, float* rs_out, float* xm_out, int lane) {
    const GAS f32x4* xr = (const GAS f32x4*)xrow + lane;
    f32x4 v[4]; float s = 0.f, mx = 0.f;
#pragma unroll
    for (int j = 0; j < 4; ++j) { v[j] = xr[64 * j]; s += (v[j].x * v[j].x + v[j].y * v[j].y) + (v[j].z * v[j].z + v[j].w * v[j].w);
        mx = fmaxf(mx, fmaxf(fmaxf(fabsf(v[j].x), fabsf(v[j].y)), fmaxf(fabsf(v[j].z), fabsf(v[j].w)))); }
    s = wave_sum_dpp(s); mx = wave_max_dpp(mx);
    const float r = 1.0f / sqrtf(s * (1.0f / 1024.0f) + EPS);
    const float q = mx > 0.f ? mx * (1.0f / 127.0f) : 1.0f, inv = 1.0f / q;
    const v4u o = quant16(v, inv, 0);
#pragma unroll
    for (int j = 0; j < 4; ++j) ((GAS unsigned*)orow)[64 * j + lane] = o[j];
    if (lane == 0) { *xm_out = mx; *rs_out = r * q; }
}
__device__ __forceinline__ void p0_part_a(Frame& F) {
    const int gw = blockIdx.x * NWAVES + F.wave, NGW = F.G * NWAVES;
    unsigned char* ws = F.ws;
    constexpr int I_IN = (DM / 64) * (INW / 32);
    constexpr int I_Q = (DM / 64) * (2048 / 32);
    for (int it = gw; it < I_IN + I_Q; it += NGW) {
        if (it < I_IN) p0_colmax_item(F.w_in, INW, F.norm1_g, (unsigned*)(ws + WS_CMAX), it, F.lane);
        else p0_colmax_item(F.w_query, 2048, F.norm2_g, (unsigned*)(ws + WS_CMAX2), it - I_IN, F.lane);
    }
    constexpr int I_O = (DM / 64) * (DM / 32);
    for (int it = gw; it < I_O; it += NGW) p0_colmax_item(F.w_out, DM, nullptr, (unsigned*)(ws + WS_CMAX3), it, F.lane);
    for (int q = blockIdx.x; q < T / 32; q += F.G)
        for (int i = F.wave; i < 32; i += NWAVES) { const int m = 32 * q + i; p0_xrow_q8(F.x + (size_t)m * DM, ws + WS_XB + (size_t)m * DM, (float*)(ws + WS_S1) + m, (float*)(ws + WS_XM) + m, F.lane); }
    constexpr int NROWS = 2 * NEXP + 512;
    for (int m = gw; m < NROWS; m += NGW) {
        int r = m;
        if (r < NEXP) { p0_quant_row(F.expert_u + (size_t)r * DM, F.norm2_g, ws + WS_UB + (size_t)r * 2048, (float*)(ws + WS_SU) + r, 0, F.lane); continue; } r -= NEXP;
        if (r < NEXP) { p0_fp8_row(F.expert_v + (size_t)r * DM, ws + WS_UB + (size_t)r * 2048 + 1024, (float*)(ws + WS_SV) + r, F.lane); continue; } r -= NEXP;
        {
            const int hp = r >> 5, ks = (r >> 2) & 7, mt = r & 3, key = 32 * mt + (F.lane & 31), d0 = 16 * ks + 8 * (F.lane >> 5);
            const GAS f32x4* sp = (const GAS f32x4*)(F.sub_keys + ((size_t)(hp * 128 + key) * 128 + d0)); const f32x4 a = sp[0], b = sp[1];
            v4u o; o.x = pk2(a.x, a.y); o.y = pk2(a.z, a.w); o.z = pk2(b.x, b.y); o.w = pk2(b.z, b.w);
            *(GAS v4u*)((bf16*)(ws + WS_SKB) + ((size_t)r * 64 + F.lane) * 8) = o; }
    }
}
__device__ __forceinline__ void p0_part_b(Frame& F) {
    LAS float* scr = (LAS float*)(F.lds + RING_OFF + F.wave * 16896);
    const int gw = blockIdx.x * NWAVES + F.wave, NGW = F.G * NWAVES;
    unsigned char* ws = F.ws;
    constexpr int I_IN = (DM / 128) * (INW / 32), I_O = (DM / 128) * (DM / 32), I_Q = (DM / 128) * (2048 / 32), I_P = 4 * (128 / 64) * (256 / 32);
    constexpr int NITEMS = I_IN + I_O + I_Q + I_P;
    for (int it = gw; it < NITEMS; it += NGW) {
        int r = it;
        if (r < I_IN) { p0_transpose_q8_item(F.w_in, INW, F.norm1_g, (unsigned*)(ws + WS_CMAX), (float*)(ws + WS_CS), ws + WS_W1T, 1, scr, r, F.lane); continue; } r -= I_IN;
        if (r < I_O) { p0_transpose_q8_item(F.w_out, DM, nullptr, (unsigned*)(ws + WS_CMAX3), (float*)(ws + WS_CS3), ws + WS_WOT, 0, scr, r, F.lane); continue; } r -= I_O;
        if (r < I_Q) { p0_transpose_q8_item(F.w_query, 2048, F.norm2_g, (unsigned*)(ws + WS_CMAX2), (float*)(ws + WS_CS2), ws + WS_WQT, 0, scr, r, F.lane); continue; } r -= I_Q;
        { const int g = r / 16, ri = r % 16;
          p0_transpose_item(F.w_pool + (size_t)g * 128 * 256, 128, 256, nullptr, F.pool_scale + g * 256, (bf16*)(ws + WS_WPT) + (size_t)g * 256 * 128, 0, scr, ri, F.lane); }
    }
}

constexpr int ATT_NK = 384, ATT_K_OFF = 0, ATT_V_OFF = ATT_NK * 128;
typedef short v4i16_t __attribute__((ext_vector_type(4)));
__device__ __forceinline__ s16x4 vtr(unsigned ldsaddr) { return __builtin_bit_cast(s16x4, __builtin_amdgcn_ds_read_tr16_b64_v4i16((LAS v4i16_t*)(uintptr_t)ldsaddr)); }
struct AttnU { int p, b, h, dil, r, bp; };
__device__ __forceinline__ AttnU attn_decode(int unit) {
    AttnU u; const int idx = unit & 31; int t1 = unit >> 5; u.h = t1 & 15; t1 >>= 4; u.b = t1 & 7; u.p = t1 >> 3;
    const int dl = (u.p == 0) ? 0 : (u.p == 1 ? 2 : 4); u.dil = 1 << dl; const int nbp = 32 >> dl; u.r = idx >> (5 - dl); u.bp = idx & (nbp - 1); return u;
}
__device__ __forceinline__ void attn_load_kv(const AttnU& u, int tid, const unsigned char* __restrict__ K8, const unsigned char* __restrict__ V8, v2u (&kr)[6], v2u (&vr)[6]) {
    const int rsub = tid >> 3, ch = tid & 7;
#pragma unroll
    for (int i = 0; i < 6; ++i) { const int ki = i * 64 + rsub; const int sidx = u.bp * 256 - 128 + ki; const bool ok = sidx >= 0;
        const long pos = ok ? ((long)sidx * u.dil + u.r) : 0; const size_t off = ((size_t)(u.b * 16 + u.h) * 8192 + pos) * 64 + ch * 8;
        kr[i] = *(const GAS v2u*)(K8 + off); vr[i] = *(const GAS v2u*)(V8 + off);
        if (!ok) { kr[i] = (v2u){0u, 0u}; vr[i] = (v2u){0u, 0u}; } }
}
__device__ __forceinline__ void attn_load_q(const AttnU& u, int w, int c32, int hi, const bf16* Qg, bf16x8 (&qf)[4]) {
    const long qt = (long)(u.bp * 256 + 32 * w + c32) * u.dil + u.r;
    const bf16* qp = Qg + ((size_t)((u.p * 8 + u.b) * 16 + u.h) * 8192 + qt) * 64;
#pragma unroll
    for (int d0 = 0; d0 < 4; ++d0) qf[d0] = *(const GAS bf16x8*)(qp + d0 * 16 + hi * 8);
}
__device__ __forceinline__ v4u fp8x8_to_bf16(v2u x) {
    const auto f0 = __builtin_amdgcn_cvt_pk_f32_fp8((int)x.x, false), f1 = __builtin_amdgcn_cvt_pk_f32_fp8((int)x.x, true), f2 = __builtin_amdgcn_cvt_pk_f32_fp8((int)x.y, false), f3 = __builtin_amdgcn_cvt_pk_f32_fp8((int)x.y, true);
    v4u r; r.x = pg8::cvt_pk_bf16(f0[0], f0[1]); r.y = pg8::cvt_pk_bf16(f1[0], f1[1]); r.z = pg8::cvt_pk_bf16(f2[0], f2[1]); r.w = pg8::cvt_pk_bf16(f3[0], f3[1]); return r;
}
__device__ __forceinline__ void attn_body(Frame& F, const AttnU& u, bool has_nn, const AttnU& nn, bool has_nq, const AttnU& nq, v2u (&kr)[6], v2u (&vr)[6], bf16x8 (&qf)[4],
                                          const unsigned char* __restrict__ K8, const unsigned char* __restrict__ V8, bf16* Qg, float* MDd) {
    const int tid = F.tid, lane = F.lane, w = F.wave, c32 = lane & 31, hi = lane >> 5;
    LAS unsigned char* lds = F.lds;
    const int rsub = tid >> 3, ch = tid & 7;
    const int lam = lane & 15;
    const unsigned vbase = (unsigned)(uintptr_t)(lds + ATT_V_OFF) + (unsigned)((4 * hi + (lam >> 2)) * 64 + (16 * ((lane >> 4) & 1) + 4 * (lam & 3)) * 2);
    const int cz = c32 - 4 * hi;
#pragma unroll
    for (int i = 0; i < 6; ++i) { const int ki = i * 64 + rsub;
        *(LAS v4u*)(lds + ATT_K_OFF + ki * 128 + ((ch ^ ((ki >> 1) & 7)) * 16)) = fp8x8_to_bf16(kr[i]);
        *(LAS v4u*)(lds + ATT_V_OFF + (ch >> 2) * (ATT_NK * 64) + ki * 64 + (ch & 3) * 16) = fp8x8_to_bf16(vr[i]); }
    __syncthreads();
    if (has_nn) attn_load_kv(nn, tid, K8, V8, kr, vr);
    const int sidx = u.p * 16 + u.h; const float sexp = sidx < 32 ? 0.125f * (float)(sidx + 1) : 4.0f + 0.25f * (float)(sidx - 31);
    const float slope2 = exp2f(-sexp) * LOG2E * (float)u.dil;
    const float a0 = -slope2 * (float)(128 + cz) - 16.0f;
    f32x16 st[5]; f32x16 a0v;
#pragma unroll
    for (int rr = 0; rr < 16; ++rr) a0v[rr] = a0;
#pragma unroll
    for (int kt = 0; kt < 5; ++kt) {
        const int key = 32 * (w + kt) + c32; const LAS unsigned char* kb = lds + ATT_K_OFF + key * 128; const int sw = (key >> 1) & 7;
        f32x16 a;
#pragma unroll
        for (int d0 = 0; d0 < 4; ++d0) { const bf16x8 kf = *(const LAS bf16x8*)(kb + (((2 * d0 + hi) ^ sw) * 16)); a = __builtin_amdgcn_mfma_f32_32x32x16_bf16(kf, qf[d0], d0 == 0 ? a0v : a, 0, 0, 0); }
        st[kt] = a;
    }
    if (has_nq) attn_load_q(nq, w, c32, hi, Qg, qf);
    float l = 0.f;
#pragma unroll
    for (int kt = 0; kt < 5; ++kt) {
        float lt = 0.f;
#pragma unroll
        for (int rr = 0; rr < 16; ++rr) { const int rc = (rr & 3) + 8 * (rr >> 2);
            float e = __builtin_amdgcn_exp2f(fmaf(slope2, (float)(32 * kt + rc), st[kt][rr]));
            if (kt == 0) e = (rc >= cz) ? e : 0.f;
            if (kt == 4) e = (rc <= cz) ? e : 0.f;
            st[kt][rr] = e; lt += e; }
        l += ((u.bp == 0) && (w + kt < 4)) ? 0.f : lt;
    }
    l = xhalf_sum(l);
    f32x16 o[2]; o[0] = f32x16{}; o[1] = f32x16{};
#pragma unroll
    for (int kt = 0; kt < 5; ++kt)
#pragma unroll
        for (int s2 = 0; s2 < 2; ++s2) {
            v4u pw; pw.x = pg8::cvt_pk_bf16(st[kt][8 * s2 + 0], st[kt][8 * s2 + 1]); pw.y = pg8::cvt_pk_bf16(st[kt][8 * s2 + 2], st[kt][8 * s2 + 3]);
            pw.z = pg8::cvt_pk_bf16(st[kt][8 * s2 + 4], st[kt][8 * s2 + 5]); pw.w = pg8::cvt_pk_bf16(st[kt][8 * s2 + 6], st[kt][8 * s2 + 7]);
            const bf16x8 pf = __builtin_bit_cast(bf16x8, pw);
#pragma unroll
            for (int dt = 0; dt < 2; ++dt) {
                const unsigned a = vbase + (unsigned)(dt * (ATT_NK * 64) + (32 * (w + kt) + 16 * s2) * 64);
                const s16x4 lo = vtr(a), hi4 = vtr(a + 8 * 64);
                const bf16x8 vf = (bf16x8){lo[0], lo[1], lo[2], lo[3], hi4[0], hi4[1], hi4[2], hi4[3]};
                o[dt] = __builtin_amdgcn_mfma_f32_32x32x16_bf16(vf, pf, o[dt], 0, 0, 0);
            }
        }
    const float inv = 1.0f / l;
    const long qt = (long)(u.bp * 256 + 32 * w + c32) * u.dil + u.r; const long qrow = (long)u.b * SEQ + qt;
    bf16* qp = Qg + ((size_t)((u.p * 8 + u.b) * 16 + u.h) * 8192 + qt) * 64;
#pragma unroll
    for (int dt = 0; dt < 2; ++dt)
#pragma unroll
        for (int g = 0; g < 4; ++g) { v2u ow; ow.x = pg8::cvt_pk_bf16(o[dt][4 * g] * inv, o[dt][4 * g + 1] * inv); ow.y = pg8::cvt_pk_bf16(o[dt][4 * g + 2] * inv, o[dt][4 * g + 3] * inv);
            *(GAS v2u*)(qp + 32 * dt + 8 * g + 4 * hi) = ow; }
    if (hi == 0) { const size_t mi = ((size_t)u.p * T + (size_t)qrow) * 16 + u.h; __hip_atomic_store(MDd + mi, l, __ATOMIC_RELAXED, __HIP_MEMORY_SCOPE_AGENT); }
    __syncthreads();
}
__device__ __forceinline__ void attn_phase(Frame& F, int u0, int u1, bool xl, const bf16* Kg, const bf16* Vg, bf16* Qg, float* MDm, float* MDd) {
    if (u0 >= u1) return;
    const int xrank = (int)blockIdx.x >> 3, xbh0 = ((int)blockIdx.x & 7) * 16;
#define ATT_UMAP(i_) (xl ? ((((i_) % 3) * 128 + xbh0 + (i_) / 3) * 32 + xrank) : (i_))
    const int tid = F.tid, lane = F.lane, w = F.wave, c32 = lane & 31, hi = lane >> 5;
    const unsigned char* K8 = (const unsigned char*)Kg; const unsigned char* V8 = (const unsigned char*)Vg;
    v2u krA[6], vrA[6], krB[6], vrB[6]; bf16x8 qf[4];
    AttnU uA = attn_decode(ATT_UMAP(u0)), uB = uA;
    attn_load_kv(uA, tid, K8, V8, krA, vrA); attn_load_q(uA, w, c32, hi, Qg, qf);
    if (u0 + 1 < u1) { uB = attn_decode(ATT_UMAP(u0 + 1)); attn_load_kv(uB, tid, K8, V8, krB, vrB); }
#pragma unroll 1
    for (int uu = u0; uu < u1; uu += 2) {
        { const AttnU cur = uA; const bool nx = uu + 2 < u1; if (nx) uA = attn_decode(ATT_UMAP(uu + 2));
          attn_body(F, cur, nx, uA, uu + 1 < u1, uB, krA, vrA, qf, K8, V8, Qg, MDd); }
        if (uu + 1 < u1) { const AttnU cur = uB; const bool nx = uu + 3 < u1; if (nx) uB = attn_decode(ATT_UMAP(uu + 3));
          attn_body(F, cur, nx, uB, uu + 2 < u1, uA, krB, vrB, qf, K8, V8, Qg, MDd); }
    }
#undef ATT_UMAP
}

constexpr int PB_AIN_PITCH = 272, PB_POOL_OFF = 40960, PB_POOL_PITCH = 528;
__device__ __forceinline__ void pool_merge_unit(Frame& F, int unit, const bf16* AIN, const bf16* Wpt, const bf16* OP, const bf16* Gt, const float* MDm, const float* MDd, bf16* MERGED) {
    const int tid = F.tid, lane = F.lane, w = F.wave, c32 = lane & 31, hi = lane >> 5;
    const int g = unit & 3, tile = unit >> 2, t0 = tile * 128, tin = t0 & (SEQ - 1), win = 2 << g;
    LAS unsigned char* lds = F.lds;
    for (int id = tid; id < 143 * 16; id += NWAVES * 64) { const int rr = id >> 4, ch = id & 15; v4u v = (v4u){0u, 0u, 0u, 0u};
        if (tin - 15 + rr >= 0) v = *(const GAS v4u*)(AIN + (size_t)(t0 - 15 + rr) * POOLW + g * 128 + ch * 8);
        *(LAS v4u*)(lds + rr * PB_AIN_PITCH + ch * 16) = v; }
    __syncthreads();
    {
        const int tq = w & 3, oh = w >> 2, tokl = 32 * tq + c32;
        const int cnt = (tin + tokl + 1) < win ? (tin + tokl + 1) : win; const float rc = 1.0f / (float)cnt;
        f32x16 acc[4]; acc[0] = f32x16{}; acc[1] = f32x16{}; acc[2] = f32x16{}; acc[3] = f32x16{};
        const bf16* wp = Wpt + (size_t)(g * 256 + oh * 128 + c32) * 128 + 8 * hi;
#pragma unroll 1
        for (int ks = 0; ks < 8; ++ks) {
            const LAS unsigned char* ap = lds + (15 + tokl) * PB_AIN_PITCH + (16 * ks + 8 * hi) * 2;
            const v4u own = *(const LAS v4u*)ap;
            float s[8] = {0.f, 0.f, 0.f, 0.f, 0.f, 0.f, 0.f, 0.f};
            for (int i = 0; i < win; ++i) { const v4u a = *(const LAS v4u*)(ap - i * PB_AIN_PITCH);
                s[0] += bflo(a.x); s[1] += bfhi(a.x); s[2] += bflo(a.y); s[3] += bfhi(a.y); s[4] += bflo(a.z); s[5] += bfhi(a.z); s[6] += bflo(a.w); s[7] += bfhi(a.w); }
            v4u dw; dw.x = pg8::cvt_pk_bf16(s[0] * rc - bflo(own.x), s[1] * rc - bfhi(own.x)); dw.y = pg8::cvt_pk_bf16(s[2] * rc - bflo(own.y), s[3] * rc - bfhi(own.y));
            dw.z = pg8::cvt_pk_bf16(s[4] * rc - bflo(own.z), s[5] * rc - bfhi(own.z)); dw.w = pg8::cvt_pk_bf16(s[6] * rc - bflo(own.w), s[7] * rc - bfhi(own.w));
            const bf16x8 df = __builtin_bit_cast(bf16x8, dw);
#pragma unroll
            for (int mt = 0; mt < 4; ++mt) { const bf16x8 wf = *(const GAS bf16x8*)(wp + (size_t)(32 * mt) * 128 + 16 * ks); acc[mt] = __builtin_amdgcn_mfma_f32_32x32x16_bf16(wf, df, acc[mt], 0, 0, 0); }
        }
#pragma unroll
        for (int mt = 0; mt < 4; ++mt)
#pragma unroll
            for (int gq = 0; gq < 4; ++gq) { v2u ow; ow.x = pg8::cvt_pk_bf16(acc[mt][4 * gq], acc[mt][4 * gq + 1]); ow.y = pg8::cvt_pk_bf16(acc[mt][4 * gq + 2], acc[mt][4 * gq + 3]);
                *(LAS v2u*)(lds + PB_POOL_OFF + tokl * PB_POOL_PITCH + (oh * 128 + 32 * mt + 8 * gq + 4 * hi) * 2) = ow; }
    }
    __syncthreads();
#pragma unroll 1
    for (int pass = 0; pass < 8; ++pass) {
        const int id = pass * 512 + tid, tok = id >> 5, cc = id & 31, col = g * 256 + 8 * cc, head = col >> 6; const size_t row = (size_t)t0 + tok;
        float wgt[3]; float ws_ = 0.f;
#pragma unroll
        for (int p = 0; p < 3; ++p) { wgt[p] = __hip_atomic_load(MDd + ((size_t)p * T + row) * 16 + head, __ATOMIC_RELAXED, __HIP_MEMORY_SCOPE_AGENT); ws_ += wgt[p]; }
        const float iw = 1.0f / ws_;
        const size_t ob = ((size_t)((row >> 13) * 16 + head) * 8192 + (row & 8191)) * 64 + (col & 63); constexpr size_t PST = (size_t)8 * 16 * 8192 * 64;
        const v4u o0 = *(const GAS v4u*)(OP + ob), o1 = *(const GAS v4u*)(OP + PST + ob), o2 = *(const GAS v4u*)(OP + 2 * PST + ob);
        const v2u g0 = *(const GAS v2u*)((const unsigned char*)Gt + row * GATEW + col), g1 = *(const GAS v2u*)((const unsigned char*)Gt + row * GATEW + 1024 + col);
        const v4u pl = *(const LAS v4u*)(lds + PB_POOL_OFF + tok * PB_POOL_PITCH + cc * 16);
        const float w0 = wgt[0] * iw, w1 = wgt[1] * iw, w2 = wgt[2] * iw;
        v4u res;
#define SIG(x_) __builtin_amdgcn_rcpf(1.0f + __builtin_amdgcn_exp2f(-LOG2E * (x_)))
#define MRG(f, gw, HI) { const float alo = w0 * bflo(o0.f) + w1 * bflo(o1.f) + w2 * bflo(o2.f), ahi = w0 * bfhi(o0.f) + w1 * bfhi(o1.f) + w2 * bfhi(o2.f); \
                 const auto ga = __builtin_amdgcn_cvt_pk_f32_fp8((int)g0.gw, HI), gb = __builtin_amdgcn_cvt_pk_f32_fp8((int)g1.gw, HI); \
                 res.f = pg8::cvt_pk_bf16(SIG(ga[0]) * bflo(pl.f) + SIG(gb[0]) * alo, SIG(ga[1]) * bfhi(pl.f) + SIG(gb[1]) * ahi); }
        MRG(x, x, false) MRG(y, x, true) MRG(z, y, false) MRG(w, y, true)
#undef MRG
#undef SIG
        *(GAS v4u*)(MERGED + row * DM + col) = res;
    }
    __syncthreads();
}


constexpr int PC_AIN_PITCH = 1040, PC_POOL_OFF = 49152, PC_POOL_PITCH = 2064, PC_RMAX_OFF = PC_POOL_OFF + 32 * PC_POOL_PITCH, PC_D_OFF = 117760, PC_D_PITCH = 1040;
__device__ __forceinline__ void pool_merge_unit32(Frame& F, int unit, const bf16* AIN, const bf16* Wpt, const bf16* OP, const bf16* Gt, const float* MDd, unsigned char* M8, float* MS) {
    const int tid = F.tid, lane = F.lane, w = F.wave, c32 = lane & 31, hi = lane >> 5;
    const int t0 = unit * 32, tin = t0 & (SEQ - 1);
    LAS unsigned char* lds = F.lds;
    LAS unsigned* rmax = (LAS unsigned*)(lds + PC_RMAX_OFF);
    {
        v4u tv[6];
#pragma unroll
        for (int i = 0; i < 6; ++i) { const int id = tid + i * NWAVES * 64, rr = id >> 6, ch = id & 63; const int rs_ = (rr < 47) ? rr : 46; const int tr = t0 - 15 + rs_;
            tv[i] = *(const GAS v4u*)(AIN + (size_t)(tr >= 0 ? tr : 0) * POOLW + ch * 8); }
        __builtin_amdgcn_sched_barrier(0);
#pragma unroll
        for (int i = 0; i < 6; ++i) { const int id = tid + i * NWAVES * 64, rr = id >> 6, ch = id & 63;
            if (rr < 47) *(LAS v4u*)(lds + rr * PC_AIN_PITCH + ch * 16) = (tin - 15 + rr >= 0) ? tv[i] : (v4u){0u, 0u, 0u, 0u}; }
        __builtin_amdgcn_sched_barrier(0);
    }
    if (tid < 32) rmax[tid] = 0u;
    __syncthreads();
    {
        const int tokd = tid & 31, sub = tid >> 5;
#pragma unroll
        for (int g = 0; g < 4; ++g) { const int win = 2 << g; const int cnt = (tin + tokd + 1) < win ? (tin + tokd + 1) : win; const float rc = 1.0f / (float)cnt;
            const LAS unsigned char* ap = lds + (15 + tokd) * PC_AIN_PITCH + (16 * g + sub) * 16;
            const v4u own = *(const LAS v4u*)ap;
            float s[8] = {0.f, 0.f, 0.f, 0.f, 0.f, 0.f, 0.f, 0.f};
#pragma unroll
            for (int i = 0; i < win; ++i) { const v4u a = *(const LAS v4u*)(ap - i * PC_AIN_PITCH);
                s[0] += bflo(a.x); s[1] += bfhi(a.x); s[2] += bflo(a.y); s[3] += bfhi(a.y); s[4] += bflo(a.z); s[5] += bfhi(a.z); s[6] += bflo(a.w); s[7] += bfhi(a.w); }
            v4u dw; dw.x = pg8::cvt_pk_bf16(s[0] * rc - bflo(own.x), s[1] * rc - bfhi(own.x)); dw.y = pg8::cvt_pk_bf16(s[2] * rc - bflo(own.y), s[3] * rc - bfhi(own.y));
            dw.z = pg8::cvt_pk_bf16(s[4] * rc - bflo(own.z), s[5] * rc - bfhi(own.z)); dw.w = pg8::cvt_pk_bf16(s[6] * rc - bflo(own.w), s[7] * rc - bfhi(own.w));
            *(LAS v4u*)(lds + PC_D_OFF + tokd * PC_D_PITCH + (16 * g + sub) * 16) = dw; }
    }
    __syncthreads();
    {
        const int g = w >> 1, oh = w & 1, tokl = c32;
        f32x16 acc[4]; acc[0] = f32x16{}; acc[1] = f32x16{}; acc[2] = f32x16{}; acc[3] = f32x16{};
        const bf16* wp = Wpt + (size_t)(g * 256 + oh * 128 + c32) * 128 + 8 * hi;
#pragma unroll 1
        for (int kg = 0; kg < 2; ++kg) {
            bf16x8 wf[4][4];
#pragma unroll
            for (int k = 0; k < 4; ++k)
#pragma unroll
                for (int mt = 0; mt < 4; ++mt) wf[k][mt] = *(const GAS bf16x8*)(wp + (size_t)(32 * mt) * 128 + 16 * (4 * kg + k));
            __builtin_amdgcn_sched_barrier(0);
#pragma unroll
            for (int k = 0; k < 4; ++k) { const bf16x8 df = *(const LAS bf16x8*)(lds + PC_D_OFF + tokl * PC_D_PITCH + (g * 128 + 16 * (4 * kg + k) + 8 * hi) * 2);
#pragma unroll
                for (int mt = 0; mt < 4; ++mt) acc[mt] = __builtin_amdgcn_mfma_f32_32x32x16_bf16(wf[k][mt], df, acc[mt], 0, 0, 0); }
            __builtin_amdgcn_sched_barrier(0);
        }
#pragma unroll
        for (int mt = 0; mt < 4; ++mt)
#pragma unroll
            for (int gq = 0; gq < 4; ++gq) { v2u ow; ow.x = pg8::cvt_pk_bf16(acc[mt][4 * gq], acc[mt][4 * gq + 1]); ow.y = pg8::cvt_pk_bf16(acc[mt][4 * gq + 2], acc[mt][4 * gq + 3]);
                *(LAS v2u*)(lds + PC_POOL_OFF + tokl * PC_POOL_PITCH + (g * 256 + oh * 128 + 32 * mt + 8 * gq + 4 * hi) * 2) = ow; }
    }
    __syncthreads();
    v4u res[8];
#define SIG(x_) __builtin_amdgcn_rcpf(1.0f + __builtin_amdgcn_exp2f(-LOG2E * (x_)))
#define MRG(f, gw, HI) { const float alo = w0 * bflo(L.o0.f) + w1 * bflo(L.o1.f) + w2 * bflo(L.o2.f), ahi = w0 * bfhi(L.o0.f) + w1 * bfhi(L.o1.f) + w2 * bfhi(L.o2.f); \
                 const auto ga = __builtin_amdgcn_cvt_pk_f32_fp8((int)L.g0.gw, HI), gb = __builtin_amdgcn_cvt_pk_f32_fp8((int)L.g1.gw, HI); \
                 r.f = pg8::cvt_pk_bf16(SIG(ga[0]) * bflo(pl.f) + SIG(gb[0]) * alo, SIG(ga[1]) * bfhi(pl.f) + SIG(gb[1]) * ahi); \
                 mx = fmaxf(mx, fmaxf(fabsf(bflo(r.f)), fabsf(bfhi(r.f)))); }
    struct PcIn { float wg[3]; v4u o0, o1, o2; v2u g0, g1; };
#pragma unroll
    for (int pg = 0; pg < 2; ++pg) {
        PcIn Ls[4];
#pragma unroll
        for (int q = 0; q < 4; ++q) { const int pass = 4 * pg + q; PcIn& L = Ls[q];
            const int tok = pass * 4 + (tid >> 7), cc = tid & 127, col = 8 * cc, head = col >> 6; const size_t row = (size_t)t0 + tok;
#pragma unroll
            for (int p = 0; p < 3; ++p) L.wg[p] = __hip_atomic_load(MDd + ((size_t)p * T + row) * 16 + head, __ATOMIC_RELAXED, __HIP_MEMORY_SCOPE_AGENT);
            const size_t ob = ((size_t)((row >> 13) * 16 + head) * 8192 + (row & 8191)) * 64 + (col & 63); constexpr size_t PST = (size_t)8 * 16 * 8192 * 64;
            L.o0 = *(const GAS v4u*)(OP + ob); L.o1 = *(const GAS v4u*)(OP + PST + ob); L.o2 = *(const GAS v4u*)(OP + 2 * PST + ob);
            L.g0 = *(const GAS v2u*)((const unsigned char*)Gt + row * GATEW + col); L.g1 = *(const GAS v2u*)((const unsigned char*)Gt + row * GATEW + 1024 + col); }
        __builtin_amdgcn_sched_barrier(0);
#pragma unroll
        for (int q = 0; q < 4; ++q) { const int pass = 4 * pg + q; const PcIn& L = Ls[q];
            const int tok = pass * 4 + (tid >> 7), cc = tid & 127;
            const float iw = 1.0f / (L.wg[0] + L.wg[1] + L.wg[2]); const float w0 = L.wg[0] * iw, w1 = L.wg[1] * iw, w2 = L.wg[2] * iw;
            const v4u pl = *(const LAS v4u*)(lds + PC_POOL_OFF + tok * PC_POOL_PITCH + cc * 16);
            v4u r; float mx = 0.f;
            MRG(x, x, false) MRG(y, x, true) MRG(z, y, false) MRG(w, y, true)
            res[pass] = r;
            mx = wave_max_dpp(mx);
            if (lane == 0) (void)__hip_atomic_fetch_max(rmax + tok, __float_as_uint(mx), __ATOMIC_RELAXED, __HIP_MEMORY_SCOPE_WORKGROUP); }
        __builtin_amdgcn_sched_barrier(0);
    }
#undef MRG
#undef SIG
    __syncthreads();
#pragma unroll
    for (int pass = 0; pass < 8; ++pass) {
        const int tok = pass * 4 + (tid >> 7), cc = tid & 127; const size_t row = (size_t)t0 + tok;
        const float rm = __uint_as_float(rmax[tok]); const float inv = rm > 0.f ? 127.0f / rm : 0.f;
        const v4u r = res[pass];
        const int a0 = (int)__builtin_rintf(bflo(r.x) * inv), a1 = (int)__builtin_rintf(bfhi(r.x) * inv), a2 = (int)__builtin_rintf(bflo(r.y) * inv), a3 = (int)__builtin_rintf(bfhi(r.y) * inv);
        const int a4 = (int)__builtin_rintf(bflo(r.z) * inv), a5 = (int)__builtin_rintf(bfhi(r.z) * inv), a6 = (int)__builtin_rintf(bflo(r.w) * inv), a7 = (int)__builtin_rintf(bfhi(r.w) * inv);
        v2u q; q.x = ((unsigned)a0 & 255u) | (((unsigned)a1 & 255u) << 8) | (((unsigned)a2 & 255u) << 16) | ((unsigned)a3 << 24);
        q.y = ((unsigned)a4 & 255u) | (((unsigned)a5 & 255u) << 8) | (((unsigned)a6 & 255u) << 16) | ((unsigned)a7 << 24);
        *(GAS v2u*)(M8 + row * DM + 8 * cc) = q;
    }
    if (tid < 32) MS[t0 + tid] = __uint_as_float(rmax[tid]) * (1.0f / 127.0f);
    __syncthreads();
}

#ifndef P5_LOGNB
#define P5_LOGNB 4
#endif
#define P5_NBUCKET (1 << P5_LOGNB)
#ifndef P5_NSLOT_M
#define P5_NSLOT_M 5
#endif
#define P5_STR2(x) #x
#define P5_STR(x) P5_STR2(x)
#if P5_NSLOT_M == 3
#define P5_VM1 4
#define P5_VM2 2
#define P5_O1 24
#define P5_O2A 3
#define P5_O2B 4
#elif P5_NSLOT_M == 4
#define P5_VM1 6
#define P5_VM2 4
#define P5_O1 32
#define P5_O2A 4
#define P5_O2B 5
#elif P5_NSLOT_M == 5
#define P5_VM1 8
#define P5_VM2 6
#define P5_VM4 2
#define P5_O1 40
#define P5_O2A 5
#define P5_O2B 6
#define P5_O2C 7
#define P5_O2D 8
#endif
constexpr int P5_LIST_WAVE = 1032  , P5_LIST_OFF = 0, P5_RING_OFF = 66048, P5_RING_WAVE = 10240, P5_NSLOT = P5_NSLOT_M, P5_TL_OFF = 147968, P5_S2_OFF = 156160, P5_SH_OFF = 156416, P5_CNT_OFF = 147968  ;
constexpr int P5_DUMMY_OFF = 158720;
constexpr float P5_GSCALE = 256.0f;
__device__ __forceinline__ float gelu_tanh(float x) {
    const float z = 0.7978845608028654f * (x + 0.044715f * x * x * x);
    const float e = __builtin_amdgcn_exp2f(2.0f * LOG2E * z);
    const float th = 1.0f - 2.0f * __builtin_amdgcn_rcpf(1.0f + e);
    return 0.5f * x * (1.0f + th);
}
#define P5_CE(a, b) { const float hi__ = fmaxf(a, b), lo__ = fminf(a, b); a = hi__; b = lo__; }
__device__ __forceinline__ void sort16_desc(float (&v)[16]) {
#pragma unroll
    for (int k = 2; k <= 16; k <<= 1)
#pragma unroll
        for (int j = k >> 1; j > 0; j >>= 1)
#pragma unroll
            for (int i = 0; i < 16; ++i) { const int l = i ^ j; if (l > i) { if ((i & k) == 0) P5_CE(v[i], v[l]) else P5_CE(v[l], v[i]) } }
}
__device__ __forceinline__ void merge_top16(float (&a)[16], const float (&b)[16]) {
#pragma unroll
    for (int i = 0; i < 16; ++i) a[i] = fmaxf(a[i], b[15 - i]);
#pragma unroll
    for (int j = 8; j > 0; j >>= 1)
#pragma unroll
        for (int i = 0; i < 16; ++i) { const int l = i ^ j; if (l > i) P5_CE(a[i], a[l]) }
}
__device__ __forceinline__ void pair_merge_top16(float (&a)[16]) {
    float lo[16], hi[16];
#pragma unroll
    for (int i = 0; i < 16; ++i) { auto t = __builtin_amdgcn_permlane32_swap(__float_as_uint(a[i]), __float_as_uint(a[i]), false, false); lo[i] = __uint_as_float(t[0]); hi[i] = __uint_as_float(t[1]); }
    merge_top16(lo, hi);
#pragma unroll
    for (int i = 0; i < 16; ++i) a[i] = lo[i];
}
__device__ __forceinline__ void peer_stage_a(Frame& F, int t0, int hh, const bf16* QP, const bf16* SKB, const float* SU, const float* SV) {
    int lane = F.lane; asm volatile("" : "+v"(lane));
    const int w = F.wave, c32 = lane & 31, hi = lane >> 5;
    LAS unsigned char* lds = F.lds;
    const LAS float* s2l = (const LAS float*)(lds + P5_S2_OFF);
    float tops[2][16];
#pragma unroll
    for (int p = 0; p < 2; ++p) {
        f32x16 acc[4]; acc[0] = f32x16{}; acc[1] = f32x16{}; acc[2] = f32x16{}; acc[3] = f32x16{};
        const bf16* qrow = QP + (size_t)(t0 + 32 * hh + c32) * 2048 + (w * 2 + p) * 128 + 8 * hi;
        const bf16* skp = SKB + ((size_t)(w * 2 + p) * 32 * 64 + lane) * 8;
#pragma unroll 1
        for (int kg = 0; kg < 2; ++kg) {
            bf16x8 bq[4], af[4][4];
#pragma unroll
            for (int k = 0; k < 4; ++k) { bq[k] = *(const GAS bf16x8*)(qrow + 16 * (4 * kg + k));
#pragma unroll
                for (int mt = 0; mt < 4; ++mt) af[k][mt] = *(const GAS bf16x8*)(skp + (size_t)((4 * kg + k) * 4 + mt) * 512); }
            __builtin_amdgcn_sched_barrier(0);
#pragma unroll
            for (int k = 0; k < 4; ++k)
#pragma unroll
                for (int mt = 0; mt < 4; ++mt) acc[mt] = __builtin_amdgcn_mfma_f32_32x32x16_bf16(af[k][mt], bq[k], acc[mt], 0, 0, 0);
            __builtin_amdgcn_sched_barrier(0);
        }
#pragma unroll
        for (int mt = 0; mt < 4; ++mt)
#pragma unroll
            for (int rr = 0; rr < 16; ++rr) acc[mt][rr] = __uint_as_float((__float_as_uint(acc[mt][rr]) & ~127u) | (unsigned)(32 * mt + crow(rr, hi)));
        {   float g0[16], g1[16], g2[16], g3[16];
#pragma unroll
            for (int rr = 0; rr < 16; ++rr) { g0[rr] = acc[0][rr]; g1[rr] = acc[1][rr]; g2[rr] = acc[2][rr]; g3[rr] = acc[3][rr]; }
            sort16_desc(g0); sort16_desc(g1); sort16_desc(g2); sort16_desc(g3);
            merge_top16(g0, g1); merge_top16(g2, g3); merge_top16(g0, g2);
            pair_merge_top16(g0);
#pragma unroll
            for (int k = 0; k < 16; ++k) tops[p][k] = g0[k];
        }
    }
    {
        v4u tb; unsigned b_[16];
#pragma unroll
        for (int k = 0; k < 16; ++k) b_[k] = __float_as_uint(hi ? tops[1][k] : tops[0][k]) & 127u;
        tb.x = b_[0] | (b_[1] << 8) | (b_[2] << 16) | (b_[3] << 24); tb.y = b_[4] | (b_[5] << 8) | (b_[6] << 16) | (b_[7] << 24);
        tb.z = b_[8] | (b_[9] << 8) | (b_[10] << 16) | (b_[11] << 24); tb.w = b_[12] | (b_[13] << 8) | (b_[14] << 16) | (b_[15] << 24);
        *(LAS v4u*)(lds + P5_TL_OFF + ((c32 * 8 + w) * 2 + hi) * 16) = tb;
    }
    float best[16];
    {   float ca[16], cb[16];
#pragma unroll
        for (int i = 0; i < 16; ++i) { ca[i] = -3.0e38f; cb[i] = -3.0e38f; }
        int c = 0;
#pragma unroll
        for (int i = 0; i < 16; ++i)
#pragma unroll
            for (int j = 0; j < 16; ++j)
                if ((i + 1) * (j + 1) <= 16) {
                    const float val = tops[0][i] + tops[1][j];
                    const float pk = __uint_as_float((__float_as_uint(val) & ~255u) | (unsigned)(i * 16 + j));
                    const int sl = c >> 1;
                    if (sl < 16) { if ((c & 1) == 0) ca[sl] = pk; else ca[sl] = hi ? pk : ca[sl]; }
                    else         { if ((c & 1) == 0) cb[sl - 16] = pk; else cb[sl - 16] = hi ? pk : cb[sl - 16]; }
                    ++c;
                }
        sort16_desc(ca); sort16_desc(cb); merge_top16(ca, cb); pair_merge_top16(ca);
#pragma unroll
        for (int k = 0; k < 16; ++k) best[k] = ca[k];
    }
    const int tokc = 32 * hh + c32;
    const float s2v = s2l[tokc] * LOG2E;
    float ge[16]; float gs = 0.f;
#pragma unroll
    for (int k = 0; k < 16; ++k) { ge[k] = __builtin_amdgcn_exp2f((best[k] - best[0]) * s2v); gs += ge[k]; }
    const float gi = 1.0f / gs;
    asm volatile("s_waitcnt lgkmcnt(0)" ::: "memory");
    const LAS unsigned char* tl0 = lds + P5_TL_OFF + ((c32 * 8 + w) * 2) * 16;
    LAS v2u* lst = (LAS v2u*)(lds + P5_LIST_OFF) + (tokc >> 3) * P5_LIST_WAVE + (tokc & 7) * 128 + w * 16 + 8 * hi;
    unsigned ex[8]; float svx[8], sux[8];
#pragma unroll
    for (int k = 0; k < 8; ++k) { const float bsel = hi ? best[k + 8] : best[k]; const unsigned code = __float_as_uint(bsel) & 255u; ex[k] = (unsigned)tl0[code >> 4] * 128u + (unsigned)tl0[16 + (code & 15u)]; }
    __builtin_amdgcn_sched_barrier(0);
#pragma unroll
    for (int k = 0; k < 8; ++k) { svx[k] = SV[ex[k]]; sux[k] = SU[ex[k]]; }
    __builtin_amdgcn_sched_barrier(0);
#pragma unroll
    for (int k = 0; k < 8; ++k) {
        const float gsel = (hi ? ge[k + 8] : ge[k]) * gi;
        const unsigned g16 = (unsigned)__builtin_bit_cast(unsigned short, (_Float16)(gsel * svx[k] * P5_GSCALE)) & 0x7fffu;
        v2u ent; ent.x = (ex[k] << 18) | ((unsigned)(tokc & 7) << 15) | g16; ent.y = __float_as_uint(sux[k]);
        lst[k] = ent;
    }
}
#define P5_BODY(S) { int d_ = 0; \
        d_ = __builtin_amdgcn_sdot4((int)uq.x, (int)hq[S].x, d_, false); d_ = __builtin_amdgcn_sdot4((int)uq.y, (int)hq[S].y, d_, false); \
        d_ = __builtin_amdgcn_sdot4((int)uq.z, (int)hq[S].z, d_, false); d_ = __builtin_amdgcn_sdot4((int)uq.w, (int)hq[S].w, d_, false); \
        d_ += dppi<0xB1>(d_); d_ += dppi<0x4E>(d_); d_ += dppi<0x141>(d_); d_ += dppi<0x140>(d_);              \
        d_ += __builtin_amdgcn_update_dpp(0, d_, 0x142, 0xA, 0xF, false); d_ += __builtin_amdgcn_update_dpp(0, d_, 0x143, 0xC, 0xF, false);     \
        const float x_ = (float)__builtin_amdgcn_readlane(d_, 63) * (su * kx[S]); \
        const float t_ = x_ * fmaf(x_ * x_, -0.10294324f, -2.30220819f);                                        \
        const float cf = gate * x_ * __builtin_amdgcn_rcpf(1.0f + __builtin_amdgcn_exp2f(t_)); \
        const _Float16 ch_ = (_Float16)cf; const h2v cp_ = (h2v){ch_, ch_}; \
        _Pragma("unroll") for (int j_ = 0; j_ < 4; ++j_) { \
        acc[S][2 * j_ + 0] = __builtin_elementwise_fma(cp_, f8h<false>(vq[j_]), acc[S][2 * j_ + 0]); \
        acc[S][2 * j_ + 1] = __builtin_elementwise_fma(cp_, f8h<true>(vq[j_]), acc[S][2 * j_ + 1]); } }
typedef _Float16 h2v __attribute__((ext_vector_type(2)));
template <bool HI> __device__ __forceinline__ h2v f8h(unsigned w) { return __builtin_bit_cast(h2v, __builtin_amdgcn_cvt_scalef32_pk_f16_fp8((int)w, 1.0f, HI)); }
typedef float f32x2v __attribute__((ext_vector_type(2)));
__device__ __forceinline__ void peer_unit(Frame& F, int unit, const bf16* QP, const bf16* SKB, const unsigned char* UQ, const unsigned char* VQ, const float* SU, const float* SV, const bf16* HB, const unsigned char* HQ, const float* XM, float* out) {
    int lane = F.lane; asm volatile("" : "+v"(lane));
    const int w = F.wave;
    const int t0 = unit * 64;
    LAS unsigned char* lds = F.lds;
    LAS float* s2l = (LAS float*)(lds + P5_S2_OFF);
    LAS unsigned char* ringw = lds + P5_RING_OFF + w * P5_RING_WAVE; LAS float* kxl = (LAS float*)(lds + P5_SH_OFF);
#pragma unroll
    for (int hf = 0; hf < 2; ++hf) {
        unsigned qd[4][4]; float xmv[4];
#pragma unroll
        for (int q = 0; q < 4; ++q) { const int row = t0 + 8 * w + 4 * hf + q; const GAS unsigned* hr = (const GAS unsigned*)(HQ + (size_t)row * DM) + lane; xmv[q] = XM[row];
#pragma unroll
            for (int j = 0; j < 4; ++j) qd[q][j] = hr[64 * j]; }
#pragma unroll
        for (int q = 0; q < 4; ++q) { int ss = 0;
#pragma unroll
            for (int j = 0; j < 4; ++j) ss = __builtin_amdgcn_sdot4((int)qd[q][j], (int)qd[q][j], ss, false);
            ss = wave_sum_dpp_i(ss);
            const float sh = pg8::hscale(xmv[q]); const float s2 = 1.0f / sqrtf((float)ss * (sh * sh * (1.0f / 1024.0f)) + EPS);
            *(LAS v4u*)(ringw + (4 * hf + q) * 1024 + 16 * lane) = (v4u){qd[q][0], qd[q][1], qd[q][2], qd[q][3]};
            if (lane == 0) { s2l[8 * w + 4 * hf + q] = s2; kxl[8 * w + 4 * hf + q] = sh * s2; } }
    }
    __syncthreads();
#pragma unroll 1
    for (int hh = 0; hh < 2; ++hh) { peer_stage_a(F, t0, hh, QP, SKB, SU, SV); __syncthreads(); }
    lane = F.lane; asm volatile("" : "+v"(lane));
    LAS v2u* lw = (LAS v2u*)(lds + P5_LIST_OFF) + w * P5_LIST_WAVE;
    constexpr int NBK = P5_NBUCKET, WPL = NBK / 16;
    LAS unsigned* cnt = (LAS unsigned*)(lds + P5_CNT_OFF) + w * (NBK * 4);
#define P5_BIN(x) ((((x) >> (32 - P5_LOGNB)) << 3) | (((x) >> 15) & 7u))
    {
        v2u e16[16];
#pragma unroll
        for (int i = 0; i < 16; ++i) e16[i] = lw[64 * i + lane];
#pragma unroll
        for (int k = 0; k < WPL; ++k) cnt[WPL * lane + k] = 0u;
        asm volatile("s_waitcnt lgkmcnt(0)" ::: "memory");
        unsigned rk[16];
#pragma unroll
        for (int i = 0; i < 16; ++i) { const unsigned bin = P5_BIN(e16[i].x); const unsigned sh = (bin & 1u) * 16u;
            const unsigned old = __hip_atomic_fetch_add(cnt + (bin >> 1), 1u << sh, __ATOMIC_RELAXED, __HIP_MEMORY_SCOPE_WORKGROUP); rk[i] = (old >> sh) & 0xffffu; }
        asm volatile("s_waitcnt lgkmcnt(0)" ::: "memory");
        unsigned cb[2 * WPL]; unsigned tot = 0;
#pragma unroll
        for (int k = 0; k < WPL; ++k) { const unsigned cwd = cnt[WPL * lane + k]; cb[2 * k] = cwd & 0xffffu; cb[2 * k + 1] = cwd >> 16; tot += cb[2 * k] + cb[2 * k + 1]; }
        unsigned incl = tot;
#pragma unroll
        for (int o = 1; o < 64; o <<= 1) { const unsigned t = (unsigned)__shfl_up((int)incl, o); if (lane >= o) incl += t; }
        unsigned run = incl - tot; unsigned stt[2 * WPL];
#pragma unroll
        for (int k = 0; k < 2 * WPL; ++k) { stt[k] = run; run += cb[k]; }
        asm volatile("s_waitcnt lgkmcnt(0)" ::: "memory");
#pragma unroll
        for (int k = 0; k < WPL; ++k) cnt[WPL * lane + k] = stt[2 * k] | (stt[2 * k + 1] << 16);
        asm volatile("s_waitcnt lgkmcnt(0)" ::: "memory");
#pragma unroll
        for (int i = 0; i < 16; ++i) { const unsigned bin = P5_BIN(e16[i].x);
            const unsigned base = (cnt[bin >> 1] >> ((bin & 1u) * 16u)) & 0xffffu; lw[base + rk[i]] = e16[i]; }
        asm volatile("s_waitcnt lgkmcnt(0)" ::: "memory");
        if (lane < 8) lw[1024 + lane] = lw[lane];
        asm volatile("s_waitcnt lgkmcnt(0)" ::: "memory");
    }
#undef P5_BIN
    lane = F.lane; asm volatile("" : "+v"(lane));
    v4u hq[8]; float kx[8];
#pragma unroll
    for (int s = 0; s < 8; ++s) { hq[s] = *(const LAS v4u*)(lds + P5_RING_OFF + w * P5_RING_WAVE + s * 1024 + 16 * lane); kx[s] = ((const LAS float*)(lds + P5_SH_OFF))[8 * w + s]; }
    asm volatile("s_waitcnt lgkmcnt(0)" : "+v"(hq[0]), "+v"(hq[1]), "+v"(hq[2]), "+v"(hq[3]), "+v"(hq[4]), "+v"(hq[5]), "+v"(hq[6]), "+v"(hq[7]) :: "memory");
    h2v acc[8][8];
#pragma unroll
    for (int s = 0; s < 8; ++s)
#pragma unroll
        for (int j = 0; j < 8; ++j) acc[s][j] = (h2v){(_Float16)0.f, (_Float16)0.f};
    asm volatile("s_waitcnt vmcnt(0)" ::: "memory");
    LAS unsigned char* ring = lds + P5_RING_OFF + w * P5_RING_WAVE;
    const unsigned char* uvgl = UQ + 16 * lane;
#define P5_ISSUE(idx, slot_) { const v2u en_ = lw[(idx) & 1023]; const unsigned e_ = (unsigned)__builtin_amdgcn_readfirstlane((int)en_.x) >> 18; \
        const unsigned* gp_ = (const unsigned*)(uvgl + (size_t)e_ * 2048); \
        __builtin_amdgcn_global_load_lds(gp_, (LAS unsigned*)(ring + (slot_) * 2048), 16, 0, 0); \
        __builtin_amdgcn_global_load_lds(gp_, (LAS unsigned*)(ring + (slot_) * 2048), 16, 1024, 0); }
#pragma unroll
    for (int i = 0; i < P5_NSLOT; ++i) P5_ISSUE(i, i)
    int slot = 0, i = 0;
    const unsigned xw = (unsigned)(((blockIdx.x >> 3) & 31) * 8 + w);
    const bool hih = lane >= 32; const unsigned lane16 = 16u * (unsigned)lane; const unsigned ringa = (unsigned)(uintptr_t)ring;
    const unsigned lwa = (unsigned)(uintptr_t)lw;
    const unsigned lwah = lwa + (hih ? 8u : 0u);
    const unsigned lwaq = lwa + 8u * ((unsigned)lane >> 4);
#define P5_DMA(e_, slot_) { const unsigned char* rb_ = UQ + (size_t)(e_) * 2048; const unsigned la_ = ringa + (unsigned)(slot_) * 2048u; unsigned keep_; \
        asm volatile("s_mov_b32 %0, m0\n\ts_mov_b32 m0, %3\n\ts_nop 0\n\tglobal_load_lds_dwordx4 %1, %2\n\tglobal_load_lds_dwordx4 %1, %2 offset:1024\n\ts_mov_b32 m0, %0" \
                     : "=&s"(keep_) : "v"(lane16), "s"(rb_), "s"(la_) : "memory"); }
#define P5_PAIR(S) { v2u ent; unsigned nx_;     \
        asm volatile("ds_read_b64 %0, %2\n\tds_read_b32 %1, %2 offset:" P5_STR(P5_O1) : "=&v"(ent), "=&v"(nx_) : "v"(lwa + 8u * (unsigned)i) : "memory"); \
        asm volatile("s_waitcnt vmcnt(" P5_STR(P5_VM1) ")" ::: "memory"); \
        const v4u uq = *(const LAS v4u*)(ring + slot * 2048 + 16 * lane), vq = *(const LAS v4u*)(ring + slot * 2048 + 1024 + 16 * lane); \
        asm volatile("s_waitcnt lgkmcnt(0)" : "+v"(ent), "+v"(nx_) :: "memory");         \
        const unsigned key = (unsigned)__builtin_amdgcn_readfirstlane((int)ent.x); const float su = __uint_as_float((unsigned)__builtin_amdgcn_readfirstlane((int)ent.y)); \
        P5_DMA((unsigned)__builtin_amdgcn_readfirstlane((int)nx_) >> 18, slot) \
        slot = (slot == P5_NSLOT - 1) ? 0 : slot + 1; \
        const float gate = (float)__builtin_bit_cast(_Float16, (unsigned short)(key & 0x7fffu)); \
        P5_BODY(S) }
#define P5_PAIR2(S) { v2u entl_; v4u nab_;                  \
        asm volatile("ds_read_b64 %0, %2\n\tds_read2_b64 %1, %3 offset0:" P5_STR(P5_O2A) " offset1:" P5_STR(P5_O2B) : "=&v"(entl_), "=&v"(nab_) : "v"(lwah + 8u * (unsigned)i), "v"(lwa + 8u * (unsigned)i) : "memory"); \
        asm volatile("s_waitcnt vmcnt(" P5_STR(P5_VM2) ")" ::: "memory"); \
        const int slotB = (slot == P5_NSLOT - 1) ? 0 : slot + 1; \
        const v4u uqA = *(const LAS v4u*)(ring + slot * 2048 + 16 * lane), vqA = *(const LAS v4u*)(ring + slot * 2048 + 1024 + 16 * lane); \
        const v4u uqB = *(const LAS v4u*)(ring + slotB * 2048 + 16 * lane), vqB = *(const LAS v4u*)(ring + slotB * 2048 + 1024 + 16 * lane); \
        asm volatile("s_waitcnt lgkmcnt(0)" : "+v"(entl_), "+v"(nab_) :: "memory"); \
        P5_DMA((unsigned)__builtin_amdgcn_readfirstlane((int)nab_.x) >> 18, slot) P5_DMA((unsigned)__builtin_amdgcn_readfirstlane((int)nab_.z) >> 18, slotB) \
        slot = (slotB == P5_NSLOT - 1) ? 0 : slotB + 1; \
        int dA_ = 0, dB_ = 0; \
        dA_ = __builtin_amdgcn_sdot4((int)uqA.x, (int)hq[S].x, dA_, false); dB_ = __builtin_amdgcn_sdot4((int)uqB.x, (int)hq[S].x, dB_, false); \
        dA_ = __builtin_amdgcn_sdot4((int)uqA.y, (int)hq[S].y, dA_, false); dB_ = __builtin_amdgcn_sdot4((int)uqB.y, (int)hq[S].y, dB_, false); \
        dA_ = __builtin_amdgcn_sdot4((int)uqA.z, (int)hq[S].z, dA_, false); dB_ = __builtin_amdgcn_sdot4((int)uqB.z, (int)hq[S].z, dB_, false); \
        dA_ = __builtin_amdgcn_sdot4((int)uqA.w, (int)hq[S].w, dA_, false); dB_ = __builtin_amdgcn_sdot4((int)uqB.w, (int)hq[S].w, dB_, false); \
        auto sw_ = __builtin_amdgcn_permlane32_swap((unsigned)dA_, (unsigned)dB_, false, false); int e_ = (int)(sw_[0] + sw_[1]);        \
        e_ += dppi<0xB1>(e_); e_ += dppi<0x4E>(e_); e_ += dppi<0x141>(e_); e_ += dppi<0x140>(e_); \
        e_ += __builtin_amdgcn_update_dpp(0, e_, 0x142, 0xA, 0xF, false);                   \
        const float x_ = (float)e_ * (__uint_as_float(entl_.y) * kx[S]); \
        const float t_ = x_ * fmaf(x_ * x_, -0.10294324f, -2.30220819f); \
        const float cfv_ = (float)__builtin_bit_cast(_Float16, (unsigned short)(entl_.x & 0x7fffu)) * x_ * __builtin_amdgcn_rcpf(1.0f + __builtin_amdgcn_exp2f(t_)); \
        const _Float16 ch_ = (_Float16)cfv_; const unsigned cpk_ = __builtin_bit_cast(unsigned, (h2v){ch_, ch_}); \
        const h2v cpA = __builtin_bit_cast(h2v, (unsigned)__builtin_amdgcn_readlane((int)cpk_, 31)), cpB = __builtin_bit_cast(h2v, (unsigned)__builtin_amdgcn_readlane((int)cpk_, 63)); \
        _Pragma("unroll") for (int j_ = 0; j_ < 4; ++j_) { \
        acc[S][2 * j_ + 0] = __builtin_elementwise_fma(cpB, f8h<false>(vqB[j_]), __builtin_elementwise_fma(cpA, f8h<false>(vqA[j_]), acc[S][2 * j_ + 0])); \
        acc[S][2 * j_ + 1] = __builtin_elementwise_fma(cpB, f8h<true>(vqB[j_]), __builtin_elementwise_fma(cpA, f8h<true>(vqA[j_]), acc[S][2 * j_ + 1])); } }
#define P5_QUAD(S) { v2u entl_; v4u n01_, n23_; \
        asm volatile("ds_read_b64 %0, %3\n\tds_read2_b64 %1, %4 offset0:" P5_STR(P5_O2A) " offset1:" P5_STR(P5_O2B) "\n\tds_read2_b64 %2, %4 offset0:" P5_STR(P5_O2C) " offset1:" P5_STR(P5_O2D) \
                     : "=&v"(entl_), "=&v"(n01_), "=&v"(n23_) : "v"(lwaq + 8u * (unsigned)i), "v"(lwa + 8u * (unsigned)i) : "memory"); \
        asm volatile("s_waitcnt vmcnt(" P5_STR(P5_VM4) ")" ::: "memory"); \
        const int s1_ = (slot == P5_NSLOT - 1) ? 0 : slot + 1, s2_ = (s1_ == P5_NSLOT - 1) ? 0 : s1_ + 1, s3_ = (s2_ == P5_NSLOT - 1) ? 0 : s2_ + 1; \
        const v4u uqA = *(const LAS v4u*)(ring + slot * 2048 + 16 * lane), vqA = *(const LAS v4u*)(ring + slot * 2048 + 1024 + 16 * lane); \
        const v4u uqB = *(const LAS v4u*)(ring + s1_ * 2048 + 16 * lane), vqB = *(const LAS v4u*)(ring + s1_ * 2048 + 1024 + 16 * lane); \
        const v4u uqC = *(const LAS v4u*)(ring + s2_ * 2048 + 16 * lane), vqC = *(const LAS v4u*)(ring + s2_ * 2048 + 1024 + 16 * lane); \
        const v4u uqD = *(const LAS v4u*)(ring + s3_ * 2048 + 16 * lane), vqD = *(const LAS v4u*)(ring + s3_ * 2048 + 1024 + 16 * lane); \
        asm volatile("s_waitcnt lgkmcnt(0)" : "+v"(entl_), "+v"(n01_), "+v"(n23_) :: "memory"); \
        P5_DMA((unsigned)__builtin_amdgcn_readfirstlane((int)n01_.x) >> 18, slot) P5_DMA((unsigned)__builtin_amdgcn_readfirstlane((int)n01_.z) >> 18, s1_) \
        P5_DMA((unsigned)__builtin_amdgcn_readfirstlane((int)n23_.x) >> 18, s2_) P5_DMA((unsigned)__builtin_amdgcn_readfirstlane((int)n23_.z) >> 18, s3_) \
        slot = (s3_ == P5_NSLOT - 1) ? 0 : s3_ + 1; \
        int dA_ = 0, dB_ = 0, dC_ = 0, dD_ = 0; \
        dA_ = __builtin_amdgcn_sdot4((int)uqA.x, (int)hq[S].x, dA_, false); dB_ = __builtin_amdgcn_sdot4((int)uqB.x, (int)hq[S].x, dB_, false); dC_ = __builtin_amdgcn_sdot4((int)uqC.x, (int)hq[S].x, dC_, false); dD_ = __builtin_amdgcn_sdot4((int)uqD.x, (int)hq[S].x, dD_, false); \
        dA_ = __builtin_amdgcn_sdot4((int)uqA.y, (int)hq[S].y, dA_, false); dB_ = __builtin_amdgcn_sdot4((int)uqB.y, (int)hq[S].y, dB_, false); dC_ = __builtin_amdgcn_sdot4((int)uqC.y, (int)hq[S].y, dC_, false); dD_ = __builtin_amdgcn_sdot4((int)uqD.y, (int)hq[S].y, dD_, false); \
        dA_ = __builtin_amdgcn_sdot4((int)uqA.z, (int)hq[S].z, dA_, false); dB_ = __builtin_amdgcn_sdot4((int)uqB.z, (int)hq[S].z, dB_, false); dC_ = __builtin_amdgcn_sdot4((int)uqC.z, (int)hq[S].z, dC_, false); dD_ = __builtin_amdgcn_sdot4((int)uqD.z, (int)hq[S].z, dD_, false); \
        dA_ = __builtin_amdgcn_sdot4((int)uqA.w, (int)hq[S].w, dA_, false); dB_ = __builtin_amdgcn_sdot4((int)uqB.w, (int)hq[S].w, dB_, false); dC_ = __builtin_amdgcn_sdot4((int)uqC.w, (int)hq[S].w, dC_, false); dD_ = __builtin_amdgcn_sdot4((int)uqD.w, (int)hq[S].w, dD_, false); \
        auto w1_ = __builtin_amdgcn_permlane32_swap((unsigned)dA_, (unsigned)dC_, false, false); const unsigned e1_ = w1_[0] + w1_[1];          \
        auto w2_ = __builtin_amdgcn_permlane32_swap((unsigned)dB_, (unsigned)dD_, false, false); const unsigned e2_ = w2_[0] + w2_[1];          \
        auto w3_ = __builtin_amdgcn_permlane16_swap(e1_, e2_, false, false); int e_ = (int)(w3_[0] + w3_[1]);                                    \
        e_ += dppi<0xB1>(e_); e_ += dppi<0x4E>(e_); e_ += dppi<0x141>(e_); e_ += dppi<0x140>(e_); \
        const float x_ = (float)e_ * (__uint_as_float(entl_.y) * kx[S]); \
        const float t_ = x_ * fmaf(x_ * x_, -0.10294324f, -2.30220819f); \
        const float cfv_ = (float)__builtin_bit_cast(_Float16, (unsigned short)(entl_.x & 0x7fffu)) * x_ * __builtin_amdgcn_rcpf(1.0f + __builtin_amdgcn_exp2f(t_)); \
        const _Float16 ch_ = (_Float16)cfv_; const unsigned cpk_ = __builtin_bit_cast(unsigned, (h2v){ch_, ch_}); \
        const h2v cpA = __builtin_bit_cast(h2v, (unsigned)__builtin_amdgcn_readlane((int)cpk_, 0)), cpB = __builtin_bit_cast(h2v, (unsigned)__builtin_amdgcn_readlane((int)cpk_, 16)); \
        const h2v cpC = __builtin_bit_cast(h2v, (unsigned)__builtin_amdgcn_readlane((int)cpk_, 32)), cpD = __builtin_bit_cast(h2v, (unsigned)__builtin_amdgcn_readlane((int)cpk_, 48)); \
        _Pragma("unroll") for (int j_ = 0; j_ < 4; ++j_) { \
        acc[S][2 * j_ + 0] = __builtin_elementwise_fma(cpD, f8h<false>(vqD[j_]), __builtin_elementwise_fma(cpC, f8h<false>(vqC[j_]), __builtin_elementwise_fma(cpB, f8h<false>(vqB[j_]), __builtin_elementwise_fma(cpA, f8h<false>(vqA[j_]), acc[S][2 * j_ + 0])))); \
        acc[S][2 * j_ + 1] = __builtin_elementwise_fma(cpD, f8h<true>(vqD[j_]), __builtin_elementwise_fma(cpC, f8h<true>(vqC[j_]), __builtin_elementwise_fma(cpB, f8h<true>(vqB[j_]), __builtin_elementwise_fma(cpA, f8h<true>(vqA[j_]), acc[S][2 * j_ + 1])))); } }
#define P5_RUN(S, END) { _Pragma("unroll 1") for (; i + 3 < (END); i += 4) P5_QUAD(S) if (i + 1 < (END)) { P5_PAIR2(S) i += 2; } if (i < (END)) { P5_PAIR(S) ++i; } }
#pragma unroll 1
    for (int b = 0; b < NBK; ++b) {
        {
            constexpr int RPB = NEXP / NBK;
#pragma unroll
            for (int k = 0; k < (RPB + 255) / 256; ++k) { const unsigned pe = (unsigned)(((b + 2) & (NBK - 1)) * RPB) + ((xw + 256u * k) & (unsigned)(RPB - 1));
                const unsigned* gp = (const unsigned*)(uvgl + (size_t)pe * 2048);
                __builtin_amdgcn_global_load_lds(gp, (LAS unsigned*)(lds + P5_DUMMY_OFF), 16, 0, 0);
                __builtin_amdgcn_global_load_lds(gp, (LAS unsigned*)(lds + P5_DUMMY_OFF), 16, 1024, 0); } }
        const v4u sw = *(const LAS v4u*)(cnt + 4 * b);
        const unsigned w0 = (unsigned)__builtin_amdgcn_readfirstlane((int)sw.x), w1 = (unsigned)__builtin_amdgcn_readfirstlane((int)sw.y), w2 = (unsigned)__builtin_amdgcn_readfirstlane((int)sw.z), w3 = (unsigned)__builtin_amdgcn_readfirstlane((int)sw.w);
        const unsigned nb = (b == NBK - 1) ? 1024u : ((unsigned)__builtin_amdgcn_readfirstlane((int)cnt[4 * b + 4]) & 0xffffu);
        const int e0 = (int)(w0 >> 16), e1 = (int)(w1 & 0xffffu), e2 = (int)(w1 >> 16), e3 = (int)(w2 & 0xffffu), e4 = (int)(w2 >> 16), e5 = (int)(w3 & 0xffffu), e6 = (int)(w3 >> 16), e7 = (int)nb;
        P5_RUN(0, e0) P5_RUN(1, e1) P5_RUN(2, e2) P5_RUN(3, e3) P5_RUN(4, e4) P5_RUN(5, e5) P5_RUN(6, e6) P5_RUN(7, e7)
    }
#undef P5_RUN
#undef P5_QUAD
#undef P5_PAIR2
#undef P5_PAIR
#undef P5_DMA
    asm volatile("s_waitcnt vmcnt(0)" ::: "memory");
    lane = F.lane; asm volatile("" : "+v"(lane));
    v2u hw[8][4];
#pragma unroll
    for (int s = 0; s < 8; ++s) { const GAS v2u* hrow = (const GAS v2u*)(HB + (size_t)(t0 + 8 * w + s) * DM) + lane;
#pragma unroll
        for (int j = 0; j < 4; ++j) hw[s][j] = hrow[64 * j]; }
#pragma unroll
    for (int s = 0; s < 8; ++s) { GAS f32x4* orow = (GAS f32x4*)(out + (size_t)(t0 + 8 * w + s) * DM) + lane;
#pragma unroll
        for (int j = 0; j < 4; ++j) { f32x4 a = (f32x4){bflo(hw[s][j].x), bfhi(hw[s][j].x), bflo(hw[s][j].y), bfhi(hw[s][j].y)}; const float c = 1.0f / P5_GSCALE;
            a.x += (float)acc[s][2 * j][0] * c; a.y += (float)acc[s][2 * j][1] * c; a.z += (float)acc[s][2 * j + 1][0] * c; a.w += (float)acc[s][2 * j + 1][1] * c; orow[64 * j] = a; } }
    __syncthreads();
}
#undef P5_ISSUE
#undef P5_BODY

#ifndef GEMM_WGM1
#define GEMM_WGM1 2
#endif
#ifndef GEMM_WGM3
#define GEMM_WGM3 2
#endif
#ifndef GEMM_WGM4
#define GEMM_WGM4 2
#endif
#ifndef MK_N_LAUNCHES
#define MK_N_LAUNCHES 1
#endif
constexpr int N_LAUNCHES = MK_N_LAUNCHES;
constexpr int PER_PHASE = 7;
struct Args { const float* in[13]; float* out; unsigned char* ws; int ph_lo, ph_hi; };
__global__ void __launch_bounds__(NWAVES * 64, 2) fwd_megakernel(Args args) {
    extern __shared__ __attribute__((aligned(16))) unsigned char lds[];
    Frame F;
    F.lds = (LAS unsigned char*)lds;
    F.MISC = (volatile LAS unsigned*)(F.lds + MISC_OFF);
    F.tid = threadIdx.x; F.lane = F.tid & 63; F.wave = __builtin_amdgcn_readfirstlane(F.tid >> 6);
    F.G = gridDim.x;
    unsigned char* ws = args.ws; F.ws = ws;
    F.ctl = (gu32*)(ws + WS_CTL);
    F.x = args.in[0]; F.norm1_g = args.in[1]; F.w_in = args.in[2]; F.q_norm_g = args.in[3]; F.k_norm_g = args.in[4]; F.w_pool = args.in[5]; F.pool_scale = args.in[6];
    F.w_out = args.in[7]; F.norm2_g = args.in[8]; F.w_query = args.in[9]; F.sub_keys = args.in[10]; F.expert_u = args.in[11]; F.expert_v = args.in[12]; F.out = args.out;
    for (int u = F.tid; u < (LDS_BYTES - LDSCTL_OFF) / 4; u += NWAVES * 64) ((LAS unsigned*)(F.lds + LDSCTL_OFF))[u] = 0u;
    __syncthreads();
    XcdBarrier bar; bar.bar = (unsigned*)(F.ctl + CW_BAR); bar.x = 0; bar.st = nullptr;
    if (N_LAUNCHES == 1) bar = xcd_barrier_post((unsigned*)(F.ctl + CW_BAR), F.MISC + 8);
#define GRID_BAR() do { if (N_LAUNCHES == 1) xcd_barrier(bar); } while (0)
    const int lo = args.ph_lo, hi = args.ph_hi;
#define IN(k) (lo <= (k) && (k) < hi)
    bf16* const XB = (bf16*)(ws + WS_XB); bf16* const W1T = (bf16*)(ws + WS_W1T); bf16* const WOT = (bf16*)(ws + WS_WOT); bf16* const WQT = (bf16*)(ws + WS_WQT);
    bf16* const AIN = (bf16*)(ws + WS_AIN); bf16* const Qb = (bf16*)(ws + WS_Q); bf16* const Gb = (bf16*)(ws + WS_G);
    bf16* const Kb = (bf16*)args.out; bf16* const Vb = (bf16*)args.out + (size_t)T * DM;
    float* const MDm = (float*)(ws + WS_MD); float* const MDd = MDm + (size_t)3 * T * 16;
    bf16* const MERGED = XB; bf16* const HB = (bf16*)(ws + WS_HB); bf16* const QP = Gb;

    if (IN(0)) { p0_part_a(F); GRID_BAR(); p0_part_b(F); GRID_BAR(); }
    if (IN(1)) {
        pg8::Gemm g{XB, W1T, T, INW, DM / 2}; pg8::StaticOrder S; S.init(T, INW, F.G, (int)blockIdx.x, GEMM_WGM1);
        pg8::EpiProj E{AIN, Qb, Kb, Vb, Gb, F.q_norm_g, F.k_norm_g, (const float*)(ws + WS_S1), (const float*)(ws + WS_CS)};
        pg8::gemm_phase<pg8::EpiProj, pg8::StaticOrder, true, true, true>(F.lds + RING_OFF, g, S, E);
        GRID_BAR();
    }
    if (IN(2)) {
        constexpr int NU = 3 * BATCH * 16 * 32; const int per = (NU + F.G - 1) / F.G; const int u0 = blockIdx.x * per, u1 = (u0 + per) < NU ? (u0 + per) : NU;
        const bool xl = (F.G == 256);
        attn_phase(F, xl ? 0 : u0, xl ? 48 : u1, xl, Kb, Vb, Qb, MDm, MDd);
        GRID_BAR();
    }
    if (IN(3)) {
        constexpr int NU = T / 32; const int per = (NU + F.G - 1) / F.G; const int u0 = blockIdx.x * per, u1 = (u0 + per) < NU ? (u0 + per) : NU;
        for (int u = u0; u < u1; ++u) pool_merge_unit32(F, u, AIN, (const bf16*)(ws + WS_WPT), Qb, Gb, MDd, (unsigned char*)MERGED, (float*)(ws + WS_MS));
        GRID_BAR();
    }
    if (IN(4)) {
        pg8::Gemm g{MERGED, WOT, T, DM, DM / 2}; pg8::StaticOrder S; S.init(T, DM, F.G, (int)blockIdx.x, GEMM_WGM3);
        pg8::EpiOut E{F.x, F.out, HB, (const float*)(ws + WS_XM), ws + WS_XB + 64 * MiB, (const float*)(ws + WS_MS), (const float*)(ws + WS_CS3)};
        pg8::gemm_phase<pg8::EpiOut, pg8::StaticOrder, true, true, true>(F.lds + RING_OFF, g, S, E);
        GRID_BAR();
    }
    if (IN(5)) {
        pg8::Gemm g{(const bf16*)(ws + WS_XB + 64 * MiB), WQT, T, 2048, DM / 2}; pg8::StaticOrder S; S.init(T, 2048, F.G, (int)blockIdx.x, GEMM_WGM4);
        pg8::EpiPlainI8 E{QP, 2048, (const float*)(ws + WS_XM), (const float*)(ws + WS_CS2)};
        pg8::gemm_phase<pg8::EpiPlainI8, pg8::StaticOrder, true, true, true>(F.lds + RING_OFF, g, S, E);
        GRID_BAR();
    }
    if (IN(6)) {
        constexpr int NU = T / 64; const int per = (NU + F.G - 1) / F.G; const int u0 = blockIdx.x * per, u1 = (u0 + per) < NU ? (u0 + per) : NU;
        for (int u = u0; u < u1; ++u) peer_unit(F, u, QP, (const bf16*)(ws + WS_SKB), ws + WS_UB, ws + WS_VB, (const float*)(ws + WS_SU), (const float*)(ws + WS_SV), HB, ws + WS_XB + 64 * MiB, (const float*)(ws + WS_XM), F.out);
    }
#undef IN
#undef GRID_BAR
}

extern "C" void kernel_launch(void* const* d_in, const int* in_sizes, int n_in, void* d_out, int out_size, void* d_ws, size_t ws_size, hipStream_t stream) {
    static int grid = 0;
    if (grid == 0) {
        if (n_in != 13 || in_sizes[0] != T * DM || out_size != T * DM || ws_size < WS_END) {
            fprintf(stderr, "kernel_launch: unexpected shapes (n_in %d, in0 %d, out %d, ws %zu, need %zu); nothing launched\n", n_in, n_in > 0 ? in_sizes[0] : -1, out_size, ws_size, (size_t)WS_END); grid = -1; return; }
        int dev = 0, cus = 0, per_cu = 0;
        if (hipGetDevice(&dev) != hipSuccess || hipDeviceGetAttribute(&cus, hipDeviceAttributeMultiprocessorCount, dev) != hipSuccess) { grid = -1; return; }
        if (hipFuncSetAttribute((const void*)fwd_megakernel, hipFuncAttributeMaxDynamicSharedMemorySize, LDS_BYTES) != hipSuccess) { fprintf(stderr, "kernel_launch: hipFuncSetAttribute failed\n"); grid = -1; return; }
        if (hipOccupancyMaxActiveBlocksPerMultiprocessor(&per_cu, (const void*)fwd_megakernel, NWAVES * 64, LDS_BYTES) != hipSuccess || per_cu < 1) { fprintf(stderr, "kernel_launch: occupancy query reports %d workgroups per CU\n", per_cu); grid = -1; (void)hipGetLastError(); return; }
        (void)hipGetLastError();
        grid = cus;
    }
    if (grid < 0) return;
    if (hipMemsetAsync((char*)d_ws + WS_CTL, 0, CTL_ZERO_BYTES, stream) != hipSuccess) return;
    Args a{};
    for (int i = 0; i < 13; ++i) a.in[i] = (const float*)d_in[i];
    a.out = (float*)d_out; a.ws = (unsigned char*)d_ws;
    for (int li = 0; li < N_LAUNCHES; ++li) {
        a.ph_lo = (N_LAUNCHES == 1) ? 0 : li; a.ph_hi = (N_LAUNCHES == 1) ? PER_PHASE : li + 1;
        hipLaunchKernelGGL(fwd_megakernel, dim3(grid), dim3(NWAVES * 64), LDS_BYTES, stream, a);
    }
}
```
